# Optimizing an MI355X kernel written in HIP

```python
import math
import jax, jax.numpy as jnp
from jax import lax
import numpy as np

D_MODEL = 1024
BATCH = 8
SEQ = 4096
DEPTH = 1

HEAD_DIM = 64
N_HEADS_A = 8
WIDTH_A = N_HEADS_A * HEAD_DIM
DILATED_PATTERNS = ((128, 1), (512, 4), (2048, 16))
N_HEADS_B = 4
DIFF_DIM = HEAD_DIM
DIFF_V_DIM = 2 * DIFF_DIM
WIDTH_B = N_HEADS_B * DIFF_V_DIM
MIX_WIDTH = WIDTH_A + WIDTH_B
IN_PROJ_COLS = 3 * WIDTH_A + 3 * WIDTH_B
ROPE_THETA = 500000.0
ROT_DIM = HEAD_DIM // 4
BLOCK = 128
NORM_EPS = 1e-6
ATTN_SCALE = 1.0 / math.sqrt(HEAD_DIM)

PEER_HEADS = 8
N_KEYS = 128
N_EXPERTS = N_KEYS * N_KEYS
KEY_DIM = 128
PEER_TOPK = 16
TOKEN_CHUNK = 128

kernel_name = "hybrid_dilated_diffattn_peer"


def rms_norm(x, g):
    x32 = x.astype(jnp.float32)
    y = x32 * lax.rsqrt(jnp.mean(x32 * x32, axis=-1, keepdims=True) + NORM_EPS)
    return (y * g.astype(jnp.float32)).astype(x.dtype)


def rope_tables(seq_len):
    pos = jnp.arange(seq_len, dtype=jnp.float32)
    inv_freq = ROPE_THETA ** (-jnp.arange(0, ROT_DIM, 2, dtype=jnp.float32) / ROT_DIM)
    ang = pos[:, None] * inv_freq[None, :]
    return jnp.cos(ang), jnp.sin(ang)


def apply_partial_rope(x, cos, sin):
    half = ROT_DIM // 2
    shape = (x.shape[1],) + (1,) * (x.ndim - 3) + (half,)
    c = cos.reshape(shape).astype(x.dtype)
    s = sin.reshape(shape).astype(x.dtype)
    x1 = x[..., :half]
    x2 = x[..., half:ROT_DIM]
    return jnp.concatenate([x1 * c - x2 * s, x2 * c + x1 * s, x[..., ROT_DIM:]], axis=-1)


def dilated_branch(q, k, v, window, dilation):
    B, H, S, Dh = q.shape
    w_s = window // dilation
    assert w_s <= BLOCK
    chunk = dilation * BLOCK
    L_pad = -(-S // chunk) * chunk
    pad = ((0, 0), (0, 0), (0, L_pad - S), (0, 0))
    Ls = L_pad // dilation
    nb = Ls // BLOCK

    def to_blocks(a):
        a = jnp.pad(a, pad).reshape(B, H, Ls, dilation, Dh).transpose(0, 1, 3, 2, 4)
        return a.reshape(B, H, dilation, nb, BLOCK, Dh)

    def band(a):
        prev = jnp.pad(a, ((0, 0), (0, 0), (0, 0), (1, 0), (0, 0), (0, 0)))[:, :, :, :-1]
        return jnp.concatenate([prev, a], axis=4)

    qb = to_blocks(q)
    kb = band(to_blocks(k))
    vb = band(to_blocks(v))
    s = jnp.einsum('bhrnqd,bhrnkd->bhrnqk', qb, kb,
                   preferred_element_type=jnp.float32) * ATTN_SCALE
    qi = jnp.arange(BLOCK)[:, None]
    kj = jnp.arange(2 * BLOCK)[None, :]
    dist = qi + BLOCK - kj
    blk = jnp.arange(nb)[:, None, None]
    valid = (dist >= 0) & (dist <= w_s) & (blk * BLOCK + kj - BLOCK >= 0)
    s = jnp.where(valid, s, -jnp.inf)
    m = jnp.max(s, axis=-1, keepdims=True)
    p = jnp.exp(s - m)
    denom = jnp.sum(p, axis=-1)
    o = jnp.einsum('bhrnqk,bhrnkd->bhrnqd', p, vb) / denom[..., None]
    lse = m[..., 0] + jnp.log(denom)
    o = o.reshape(B, H, dilation, Ls, Dh).transpose(0, 1, 3, 2, 4).reshape(B, H, L_pad, Dh)[:, :, :S]
    lse = lse.reshape(B, H, dilation, Ls).transpose(0, 1, 3, 2).reshape(B, H, L_pad)[:, :, :S]
    return o, lse


def dilated_mixture(q, k, v):
    outs, lses = [], []
    for window, dilation in DILATED_PATTERNS:
        o, lse = dilated_branch(q, k, v, window, dilation)
        outs.append(o)
        lses.append(lse)
    o = jnp.stack(outs)
    w = jax.nn.softmax(jnp.stack(lses), axis=0)
    return jnp.sum(w[..., None] * o, axis=0)


def diff_attention(q, k, v, lam):
    B, H, _, S, dd = q.shape
    Dv = v.shape[-1]
    nq = S // BLOCK
    qb = q.reshape(B, H, 2, nq, BLOCK, dd).transpose(3, 0, 1, 2, 4, 5)
    starts = jnp.arange(nq, dtype=jnp.int32) * BLOCK
    kpos = jnp.arange(S, dtype=jnp.int32)

    def attend(args):
        qblk, start = args
        s = jnp.einsum('bhcqd,bhckd->bhcqk', qblk, k,
                       preferred_element_type=jnp.float32) * ATTN_SCALE
        causal = (start + jnp.arange(BLOCK, dtype=jnp.int32))[:, None] >= kpos[None, :]
        p = jax.nn.softmax(jnp.where(causal, s, -jnp.inf), axis=-1)
        a = p[:, :, 0] - lam * p[:, :, 1]
        return jnp.einsum('bhqk,bhkd->bhqd', a, v)

    o = lax.map(attend, (qb, starts))
    return o.transpose(1, 0, 3, 2, 4).reshape(B, S, H, Dv)


def peer_layer(x, w_q, sub_keys, u_table, v_table):
    B, S, D = x.shape
    T = B * S
    tok = x.reshape(T, D)
    q = (tok @ w_q).reshape(T, PEER_HEADS, 2, KEY_DIM)
    s = jnp.einsum('thcd,hckd->thck', q, sub_keys, preferred_element_type=jnp.float32)
    s1, i1 = lax.top_k(s[:, :, 0], PEER_TOPK)
    s2, i2 = lax.top_k(s[:, :, 1], PEER_TOPK)
    cand = (s1[..., :, None] + s2[..., None, :]).reshape(T, PEER_HEADS, PEER_TOPK * PEER_TOPK)
    top, pos = lax.top_k(cand, PEER_TOPK)
    e1 = jnp.take_along_axis(i1, pos // PEER_TOPK, axis=-1)
    e2 = jnp.take_along_axis(i2, pos % PEER_TOPK, axis=-1)
    idx = e1 * N_KEYS + e2
    gates = jax.nn.softmax(top, axis=-1)

    n_chunks = T // TOKEN_CHUNK

    def expert_chunk(args):
        xc, ic, gc = args
        u = u_table[ic]
        act = jax.nn.gelu(jnp.einsum('cd,chkd->chk', xc, u), approximate=False) * gc.astype(xc.dtype)
        v = v_table[ic]
        return jnp.einsum('chk,chkd->cd', act, v)

    out = lax.map(expert_chunk, (tok.reshape(n_chunks, TOKEN_CHUNK, D),
                                 idx.reshape(n_chunks, TOKEN_CHUNK, PEER_HEADS, PEER_TOPK),
                                 gates.reshape(n_chunks, TOKEN_CHUNK, PEER_HEADS, PEER_TOPK)))
    return out.reshape(B, S, D)


def setup_inputs(seed: int = 0) -> dict:
    key = jax.random.key(seed)
    ks = jax.random.split(key, 19)
    f32 = jnp.float32
    L = DEPTH

    def nrm(k, shape, scale):
        return jax.random.normal(k, shape, f32) * scale

    def gain(k, shape):
        return 1.0 + 0.02 * jax.random.normal(k, shape, f32)

    return {
        "x": jax.random.normal(ks[0], (BATCH, SEQ, D_MODEL), f32),
        "attn_norm_g": gain(ks[1], (L, D_MODEL)),
        "w_in": nrm(ks[2], (L, D_MODEL, IN_PROJ_COLS), D_MODEL ** -0.5),
        "q_norm_a": gain(ks[3], (L, HEAD_DIM)),
        "k_norm_a": gain(ks[4], (L, HEAD_DIM)),
        "out_norm_a": gain(ks[5], (L, WIDTH_A)),
        "q_norm_b": gain(ks[6], (L, DIFF_DIM)),
        "k_norm_b": gain(ks[7], (L, DIFF_DIM)),
        "lambda_q1": nrm(ks[8], (L, DIFF_DIM), 0.1),
        "lambda_k1": nrm(ks[9], (L, DIFF_DIM), 0.1),
        "lambda_q2": nrm(ks[10], (L, DIFF_DIM), 0.1),
        "lambda_k2": nrm(ks[11], (L, DIFF_DIM), 0.1),
        "out_norm_b": gain(ks[12], (L, WIDTH_B)),
        "w_out": nrm(ks[13], (L, MIX_WIDTH, D_MODEL), MIX_WIDTH ** -0.5),
        "ffn_norm_g": gain(ks[14], (L, D_MODEL)),
        "w_peer_q": nrm(ks[15], (L, D_MODEL, PEER_HEADS * 2 * KEY_DIM), D_MODEL ** -0.5),
        "peer_sub_keys": nrm(ks[16], (L, PEER_HEADS, 2, N_KEYS, KEY_DIM), KEY_DIM ** -0.5),
        "peer_u": nrm(ks[17], (L, N_EXPERTS, D_MODEL), D_MODEL ** -0.5),
        "peer_v": nrm(ks[18], (L, N_EXPERTS, D_MODEL), (PEER_HEADS * PEER_TOPK) ** -0.5),
    }


def reference(x, attn_norm_g, w_in, q_norm_a, k_norm_a, out_norm_a, q_norm_b, k_norm_b,
              lambda_q1, lambda_k1, lambda_q2, lambda_k2, out_norm_b, w_out,
              ffn_norm_g, w_peer_q, peer_sub_keys, peer_u, peer_v):
    B, S, D = x.shape
    cos, sin = rope_tables(S)
    h = x
    for l in range(DEPTH):
        xn = rms_norm(h, attn_norm_g[l])
        proj = xn @ w_in[l]
        qa, ka, va, qb, kb, vb = jnp.split(
            proj, np.cumsum([WIDTH_A, WIDTH_A, WIDTH_A, WIDTH_B, WIDTH_B])[:].tolist(), axis=-1)

        qa = apply_partial_rope(rms_norm(qa.reshape(B, S, N_HEADS_A, HEAD_DIM), q_norm_a[l]), cos, sin)
        ka = apply_partial_rope(rms_norm(ka.reshape(B, S, N_HEADS_A, HEAD_DIM), k_norm_a[l]), cos, sin)
        va = va.reshape(B, S, N_HEADS_A, HEAD_DIM)
        oa = dilated_mixture(qa.transpose(0, 2, 1, 3), ka.transpose(0, 2, 1, 3), va.transpose(0, 2, 1, 3))
        oa = rms_norm(oa.transpose(0, 2, 1, 3), out_norm_a[l].reshape(N_HEADS_A, HEAD_DIM))
        oa = oa.reshape(B, S, WIDTH_A).astype(x.dtype)

        lam_init = 0.8 - 0.6 * math.exp(-0.3 * l)
        lam = (jnp.exp(jnp.sum(lambda_q1[l].astype(jnp.float32) * lambda_k1[l].astype(jnp.float32)))
               - jnp.exp(jnp.sum(lambda_q2[l].astype(jnp.float32) * lambda_k2[l].astype(jnp.float32)))
               + lam_init)
        qb = apply_partial_rope(rms_norm(qb.reshape(B, S, N_HEADS_B, 2, DIFF_DIM), q_norm_b[l]), cos, sin)
        kb = apply_partial_rope(rms_norm(kb.reshape(B, S, N_HEADS_B, 2, DIFF_DIM), k_norm_b[l]), cos, sin)
        vb = vb.reshape(B, S, N_HEADS_B, DIFF_V_DIM).transpose(0, 2, 1, 3)
        ob = diff_attention(qb.transpose(0, 2, 3, 1, 4), kb.transpose(0, 2, 3, 1, 4), vb, lam)
        ob = rms_norm(ob, out_norm_b[l].reshape(N_HEADS_B, DIFF_V_DIM)) * (1.0 - lam_init)
        ob = ob.reshape(B, S, WIDTH_B).astype(x.dtype)

        h = h + jnp.concatenate([oa, ob], axis=-1) @ w_out[l]

        hn = rms_norm(h, ffn_norm_g[l])
        h = h + peer_layer(hn, w_peer_q[l], peer_sub_keys[l], peer_u[l], peer_v[l]).astype(x.dtype)
    return h.astype(x.dtype)
```

```cpp
#include <hip/hip_runtime.h>
#include <hip/hip_cooperative_groups.h>
#include <cstdio>
#include <cstdint>
namespace cg = cooperative_groups;

#ifndef FUSED
#define FUSED 0
#endif

typedef unsigned short u16;
typedef unsigned char u8;
typedef __attribute__((ext_vector_type(8))) short bf16x8;
typedef __attribute__((ext_vector_type(4))) short s16x4;
typedef __attribute__((ext_vector_type(16))) float f32x16;
typedef __attribute__((ext_vector_type(2))) __bf16 bf2_t;
typedef __attribute__((ext_vector_type(4))) unsigned u32x4;
#define DI __device__ __forceinline__
#define MFMA(a, b, c) __builtin_amdgcn_mfma_f32_32x32x16_bf16((a), (b), (c), 0, 0, 0)

constexpr int T_TOK = 32768;
constexpr int SEQ = 4096;
constexpr size_t MB = 1u << 20;
constexpr size_t OFF_XNB = 0;
constexpr size_t OFF_QA = 64 * MB, OFF_KA = 96 * MB, OFF_VA = 128 * MB, OFF_QB = 160 * MB, OFF_KB = 192 * MB, OFF_VB = 224 * MB;
constexpr size_t OFF_TOPS = 64 * MB;
constexpr size_t OFF_TOPI = 96 * MB;
constexpr size_t OFF_OAP = 256 * MB;
constexpr size_t OFF_OBC = 352 * MB;
constexpr size_t OFF_PUB = 416 * MB, OFF_PVB = 448 * MB;
constexpr size_t OFF_WIN = 480 * MB, OFF_WOUT = 486 * MB, OFF_WPQ = 488 * MB, OFF_SUBK = 492 * MB;
constexpr size_t OFF_ROPEC = 493 * MB, OFF_ROPES = 493 * MB + 128 * 1024;
constexpr size_t OFF_LSE = 494 * MB;
constexpr size_t OFF_HSS = 497 * MB;
constexpr size_t OFF_MISC = 497 * MB + 128 * 1024;

constexpr int SMEM_BYTES = 73728;
constexpr float QSCALE = 0.125f * 1.4426950408889634f;
constexpr float NEG_INF = -__builtin_huge_valf();

struct Params {
  const float *x, *g_attn, *w_in, *qna, *kna, *ona, *qnb, *knb, *lq1, *lk1, *lq2, *lk2, *onb, *w_out, *g_ffn, *w_pq, *subk, *pu, *pv;
  float* out;
  char* ws;
};

DI u16 f2bf(float x) { unsigned u = __float_as_uint(x); u += 0x7fffu + ((u >> 16) & 1u); return (u16)(u >> 16); }
DI float bf2f(u16 b) { return __uint_as_float(((unsigned)b) << 16); }
DI unsigned pack2(float a, float b) { return (unsigned)f2bf(a) | ((unsigned)f2bf(b) << 16); }
DI float bflo(unsigned u) { return __uint_as_float(u << 16); }
DI float bfhi(unsigned u) { return __uint_as_float(u & 0xffff0000u); }
DI float wave_sum(float v) {
  v += __shfl_xor(v, 32); v += __shfl_xor(v, 16); v += __shfl_xor(v, 8); v += __shfl_xor(v, 4); v += __shfl_xor(v, 2); v += __shfl_xor(v, 1);
  return v;
}
DI int crow(int reg, int h) { return (reg & 3) + 8 * (reg >> 2) + 4 * h; }

__device__ void phase0(const Params& p, char* smem) {
  const int tid = threadIdx.x, lane = tid & 63, wid = tid >> 6;
  const int gw = blockIdx.x * 4 + wid, nw = gridDim.x * 4;
  const int gt = blockIdx.x * 256 + tid, nt = gridDim.x * 256;
  u16* xnb = (u16*)(p.ws + OFF_XNB);
  for (int row = gw; row < T_TOK; row += nw) {
    const float4* xr = (const float4*)(p.x + (size_t)row * 1024);
    float4 v[4]; float ss = 0.f;
#pragma unroll
    for (int i = 0; i < 4; ++i) { v[i] = xr[lane + 64 * i]; ss += v[i].x * v[i].x + v[i].y * v[i].y + v[i].z * v[i].z + v[i].w * v[i].w; }
    ss = wave_sum(ss);
    const float r = rsqrtf(ss * (1.f / 1024.f) + 1e-6f);
    uint2* dst = (uint2*)(xnb + (size_t)row * 1024);
#pragma unroll
    for (int i = 0; i < 4; ++i) dst[lane + 64 * i] = make_uint2(pack2(v[i].x * r, v[i].y * r), pack2(v[i].z * r, v[i].w * r));
  }
  float* tile = (float*)smem;
  for (int job = blockIdx.x; job < 1536; job += gridDim.x) {
    const float* W; const float* g; u16* outp; int N, j;
    if (job < 768) { W = p.w_in; g = p.g_attn; outp = (u16*)(p.ws + OFF_WIN); N = 3072; j = job; }
    else if (job < 1024) { W = p.w_out; g = nullptr; outp = (u16*)(p.ws + OFF_WOUT); N = 1024; j = job - 768; }
    else { W = p.w_pq; g = p.g_ffn; outp = (u16*)(p.ws + OFF_WPQ); N = 2048; j = job - 1024; }
    const int ntn = N >> 6, kt = j / ntn, ntile = j % ntn;
    const int tx = tid & 63, ty = tid >> 6;
#pragma unroll 4
    for (int r = 0; r < 16; ++r) {
      const int k = kt * 64 + ty + 4 * r;
      float v = W[(size_t)k * N + ntile * 64 + tx];
      if (g) v *= g[k];
      tile[(ty + 4 * r) * 65 + tx] = v;
    }
    __syncthreads();
#pragma unroll 4
    for (int r = 0; r < 16; ++r) {
      const int nl = ty + 4 * r;
      outp[(size_t)(ntile * 64 + nl) * 1024 + kt * 64 + tx] = f2bf(tile[tx * 65 + nl]);
    }
    __syncthreads();
  }
  {
    const float4* s = (const float4*)p.subk; uint2* d = (uint2*)(p.ws + OFF_SUBK);
    for (int i = gt; i < 262144 / 4; i += nt) { float4 v = s[i]; d[i] = make_uint2(pack2(v.x, v.y), pack2(v.z, v.w)); }
    const float4* su = (const float4*)p.pu; uint2* du = (uint2*)(p.ws + OFF_PUB);
    const float4* sv = (const float4*)p.pv; uint2* dv = (uint2*)(p.ws + OFF_PVB);
    for (int i = gt; i < 16384 * 1024 / 4; i += nt) {
      float4 a = su[i]; float4 b = sv[i];
      du[i] = make_uint2(pack2(a.x, a.y), pack2(a.z, a.w));
      dv[i] = make_uint2(pack2(b.x, b.y), pack2(b.z, b.w));
    }
  }
  {
    float* rc = (float*)(p.ws + OFF_ROPEC); float* rs = (float*)(p.ws + OFF_ROPES);
    for (int i = gt; i < SEQ * 8; i += nt) {
      const int pos = i >> 3, f = i & 7;
      const float invf = (float)pow(500000.0, -(double)f / 8.0);
      const float ang = (float)pos * invf;
      rc[i] = (float)cos((double)ang); rs[i] = (float)sin((double)ang);
    }
    float* hss = (float*)(p.ws + OFF_HSS);
    for (int i = gt; i < T_TOK; i += nt) hss[i] = 0.f;
    if (gt == 0) {
      float a = 0.f, b = 0.f;
      for (int i = 0; i < 64; ++i) { a += p.lq1[i] * p.lk1[i]; b += p.lq2[i] * p.lk2[i]; }
      float* misc = (float*)(p.ws + OFF_MISC);
      misc[0] = expf(a) - expf(b) + 0.2f;
      ((int*)misc)[1] = 0;
    }
  }
}

DI void gemm_mainloop(const u16* __restrict__ A, const u16* __restrict__ Bt, int m0, int n0, char* smem, f32x16 (&acc)[2][2]) {
  u16* As = (u16*)smem;
  u16* Bs = As + 2 * 128 * 72;
  const int tid = threadIdx.x, lane = tid & 63, w = tid >> 6, wm = w >> 1, wn = w & 1, lr = lane & 31, lh = lane >> 5;
#pragma unroll
  for (int a = 0; a < 2; ++a)
#pragma unroll
    for (int b = 0; b < 2; ++b)
#pragma unroll
      for (int r = 0; r < 16; ++r) acc[a][b][r] = 0.f;
  uint4 ra[4], rb[4];
  const int lrow = tid >> 3, lkc = tid & 7;
  const u16* Ag = A + (size_t)(m0 + lrow) * 1024 + lkc * 8;
  const u16* Bg = Bt + (size_t)(n0 + lrow) * 1024 + lkc * 8;
#define GLOAD(kt) { _Pragma("unroll") for (int i = 0; i < 4; ++i) { ra[i] = *(const uint4*)(Ag + (size_t)i * 32 * 1024 + (kt) * 64); rb[i] = *(const uint4*)(Bg + (size_t)i * 32 * 1024 + (kt) * 64); } }
#define SWRITE(buf) { _Pragma("unroll") for (int i = 0; i < 4; ++i) { *(uint4*)(As + ((buf) * 128 + lrow + 32 * i) * 72 + lkc * 8) = ra[i]; *(uint4*)(Bs + ((buf) * 128 + lrow + 32 * i) * 72 + lkc * 8) = rb[i]; } }
  GLOAD(0); SWRITE(0); __syncthreads();
  for (int kt = 0; kt < 16; ++kt) {
    if (kt < 15) GLOAD(kt + 1);
    const u16* ab = As + ((kt & 1) * 128 + wm * 64 + lr) * 72 + lh * 8;
    const u16* bb = Bs + ((kt & 1) * 128 + wn * 64 + lr) * 72 + lh * 8;
#pragma unroll
    for (int s = 0; s < 4; ++s) {
      const bf16x8 a0 = *(const bf16x8*)(ab + s * 16), a1 = *(const bf16x8*)(ab + 32 * 72 + s * 16);
      const bf16x8 b0 = *(const bf16x8*)(bb + s * 16), b1 = *(const bf16x8*)(bb + 32 * 72 + s * 16);
      acc[0][0] = MFMA(a0, b0, acc[0][0]); acc[0][1] = MFMA(a0, b1, acc[0][1]);
      acc[1][0] = MFMA(a1, b0, acc[1][0]); acc[1][1] = MFMA(a1, b1, acc[1][1]);
    }
    if (kt < 15) SWRITE((kt + 1) & 1);
    __syncthreads();
  }
#undef GLOAD
#undef SWRITE
}

DI void stage_acc(const f32x16 (&acc)[2][2], float* st) {
  const int tid = threadIdx.x, lane = tid & 63, w = tid >> 6, wm = w >> 1, wn = w & 1, lr = lane & 31, lh = lane >> 5;
#pragma unroll
  for (int mt = 0; mt < 2; ++mt)
#pragma unroll
    for (int nt = 0; nt < 2; ++nt)
#pragma unroll
      for (int r = 0; r < 16; ++r) st[(wm * 64 + mt * 32 + crow(r, lh)) * 132 + wn * 64 + nt * 32 + lr] = acc[mt][nt][r];
}

__device__ void phase1_tile(const Params& p, int mtile, int j, char* smem) {
  f32x16 acc[2][2];
  const int m0 = mtile * 128, n0 = j * 128;
  gemm_mainloop((const u16*)(p.ws + OFF_XNB), (const u16*)(p.ws + OFF_WIN), m0, n0, smem, acc);
  float* st = (float*)smem;
  stage_acc(acc, st);
  __syncthreads();
  const int tid = threadIdx.x, row = tid & 127, half = tid >> 7;
  const int sec = j >> 2;
  const int tok = m0 + row, b = tok >> 12, s = tok & 4095;
  float v[64];
#pragma unroll
  for (int c = 0; c < 16; ++c) { const float4 t4 = *(const float4*)(st + row * 132 + half * 64 + c * 4); v[4 * c] = t4.x; v[4 * c + 1] = t4.y; v[4 * c + 2] = t4.z; v[4 * c + 3] = t4.w; }
  if (sec != 2 && sec != 5) {
    const float* g = sec == 0 ? p.qna : sec == 1 ? p.kna : sec == 3 ? p.qnb : p.knb;
    float ss = 0.f;
#pragma unroll
    for (int i = 0; i < 64; ++i) ss += v[i] * v[i];
    float r = rsqrtf(ss * (1.f / 64.f) + 1e-6f);
    const float post = (sec == 0 || sec == 3) ? QSCALE : 1.f;
#pragma unroll
    for (int i = 0; i < 64; ++i) v[i] = v[i] * r * g[i];
    const float* rc = (const float*)(p.ws + OFF_ROPEC) + s * 8;
    const float* rs = (const float*)(p.ws + OFF_ROPES) + s * 8;
#pragma unroll
    for (int i = 0; i < 8; ++i) {
      const float c = rc[i], sn = rs[i], x1 = v[i], x2 = v[i + 8];
      v[i] = x1 * c - x2 * sn; v[i + 8] = x2 * c + x1 * sn;
    }
#pragma unroll
    for (int i = 0; i < 64; ++i) v[i] *= post;
  }
  u16* dst;
  if (sec == 5) {
    dst = (u16*)(p.ws + OFF_VB) + ((size_t)(b * 4 + (j & 3)) * 4096 + s) * 128 + half * 64;
  } else {
    const size_t off = sec == 0 ? OFF_QA : sec == 1 ? OFF_KA : sec == 2 ? OFF_VA : sec == 3 ? OFF_QB : OFF_KB;
    const int hc = (j & 3) * 2 + half;
    dst = (u16*)(p.ws + off) + ((size_t)(b * 8 + hc) * 4096 + s) * 64;
  }
#pragma unroll
  for (int c = 0; c < 8; ++c)
    ((uint4*)dst)[c] = make_uint4(pack2(v[8 * c], v[8 * c + 1]), pack2(v[8 * c + 2], v[8 * c + 3]), pack2(v[8 * c + 4], v[8 * c + 5]), pack2(v[8 * c + 6], v[8 * c + 7]));
  __syncthreads();
}

template <int OFF> DI s16x4 tr_read(unsigned addr) {
  s16x4 r; asm volatile("ds_read_b64_tr_b16 %0, %1 offset:%2" : "=v"(r) : "v"(addr), "n"(OFF) : "memory"); return r;
}
DI void wait_tr8(s16x4& a0, s16x4& a1, s16x4& a2, s16x4& a3, s16x4& a4, s16x4& a5, s16x4& a6, s16x4& a7) {
  asm volatile("s_waitcnt lgkmcnt(0)" : "+v"(a0), "+v"(a1), "+v"(a2), "+v"(a3), "+v"(a4), "+v"(a5), "+v"(a6), "+v"(a7) : : "memory");
}

template <int DV, bool CAUSAL>
__device__ void attn_unit(const u16* __restrict__ qbase, const u16* __restrict__ kbase, const u16* __restrict__ vbase, int n, int dil, int res,
                          u16* __restrict__ obase, int ostride, float* __restrict__ lsebase, char* smem) {
  constexpr int VST = DV + 8;
  constexpr int NMT = DV / 32;
  constexpr int WMAX = CAUSAL ? (1 << 30) : 128;
  u16* Ks = (u16*)smem;
  u16* Vs = Ks + 2 * 64 * 72;
  const int tid = threadIdx.x, lane = tid & 63, w = tid >> 6, lr = lane & 31, lh = lane >> 5;
  const int kb0 = CAUSAL ? 0 : 128 * (n - 1);
  const int kt_begin = CAUSAL ? 0 : (n == 0 ? 2 : 0);
  const int kt_end = CAUSAL ? (2 * n + 2) : 4;
  const int mq = 128 * n + 32 * w + lr;
  const size_t tq = (size_t)mq * dil + res;
  bf16x8 qf[4];
  {
    const u16* qp = qbase + tq * 64 + lh * 8;
#pragma unroll
    for (int s = 0; s < 4; ++s) qf[s] = *(const bf16x8*)(qp + s * 16);
  }
  f32x16 o[NMT];
#pragma unroll
  for (int mt = 0; mt < NMT; ++mt)
#pragma unroll
    for (int r = 0; r < 16; ++r) o[mt][r] = 0.f;
  float m_run = NEG_INF, l_run = 0.f;
  uint4 rk0, rk1, rv0, rv1, rv2, rv3;
  rv2 = rv3 = make_uint4(0, 0, 0, 0);
  const int krow_ = tid >> 3, kkc = tid & 7;
  constexpr int VCPR = DV / 8;
  const int vrow = tid / VCPR, vkc = tid % VCPR;
  constexpr int VRSTEP = 256 / VCPR;
  const u16* kgp = kbase + ((size_t)(kb0 + krow_) * dil + res) * 64 + kkc * 8;
  const u16* vgp = vbase + ((size_t)(kb0 + vrow) * dil + res) * DV + vkc * 8;
  const size_t kstep32 = (size_t)32 * dil * 64, kstep64 = (size_t)64 * dil * 64;
  const size_t vstepr = (size_t)VRSTEP * dil * DV, vstep64 = (size_t)64 * dil * DV;
  u16* ksw = Ks + krow_ * 72 + kkc * 8;
  u16* vsw = Vs + vrow * VST + vkc * 8;
#define AGLOAD(kt) { const u16* kp_ = kgp + (size_t)(kt) * kstep64; rk0 = *(const uint4*)kp_; rk1 = *(const uint4*)(kp_ + kstep32); \
    const u16* vp_ = vgp + (size_t)(kt) * vstep64; rv0 = *(const uint4*)vp_; rv1 = *(const uint4*)(vp_ + vstepr); \
    if (NMT == 4) { rv2 = *(const uint4*)(vp_ + 2 * vstepr); rv3 = *(const uint4*)(vp_ + 3 * vstepr); } }
#define ASWRITE(buf) { *(uint4*)(ksw + (buf) * 64 * 72) = rk0; *(uint4*)(ksw + (buf) * 64 * 72 + 32 * 72) = rk1; \
    *(uint4*)(vsw + (buf) * 64 * VST) = rv0; *(uint4*)(vsw + (buf) * 64 * VST + VRSTEP * VST) = rv1; \
    if (NMT == 4) { *(uint4*)(vsw + (buf) * 64 * VST + 2 * VRSTEP * VST) = rv2; *(uint4*)(vsw + (buf) * 64 * VST + 3 * VRSTEP * VST) = rv3; } }
  AGLOAD(kt_begin); ASWRITE(0); __syncthreads();
  const int li = lane & 31, blk = li >> 4, tq_ = (li >> 2) & 3, tp = li & 3;
  for (int kt = kt_begin; kt < kt_end; ++kt) {
    const int buf = (kt - kt_begin) & 1;
    if (kt + 1 < kt_end) AGLOAD(kt + 1);
    const int k_lo = kb0 + 64 * kt, q_lo = 128 * n + 32 * w;
    const int dmin = q_lo - (k_lo + 63), dmax = q_lo + 31 - k_lo;
    const bool skip = (dmax < 0) || (dmin > WMAX);
    if (!skip) {
      const bool need_mask = (dmin < 0) || (dmax > WMAX);
      const u16* kb = Ks + (buf * 64 + lr) * 72 + lh * 8;
      f32x16 st[2];
#pragma unroll
      for (int kk = 0; kk < 2; ++kk) {
#pragma unroll
        for (int r = 0; r < 16; ++r) st[kk][r] = 0.f;
#pragma unroll
        for (int s = 0; s < 4; ++s) { const bf16x8 a = *(const bf16x8*)(kb + kk * 32 * 72 + s * 16); st[kk] = MFMA(a, qf[s], st[kk]); }
      }
      if (need_mask) {
#pragma unroll
        for (int kk = 0; kk < 2; ++kk)
#pragma unroll
          for (int r = 0; r < 16; ++r) {
            const int d = mq - (k_lo + 32 * kk + crow(r, lh));
            if (d < 0 || d > WMAX) st[kk][r] = NEG_INF;
          }
      }
      float mx = NEG_INF;
#pragma unroll
      for (int kk = 0; kk < 2; ++kk)
#pragma unroll
        for (int r = 0; r < 16; ++r) mx = fmaxf(mx, st[kk][r]);
      mx = fmaxf(mx, __shfl_xor(mx, 32));
      const float m_new = fmaxf(m_run, mx);
      const float m_use = (m_new == NEG_INF) ? 0.f : m_new;
      const float alpha = exp2f(m_run - m_use);
      float ls = 0.f;
#pragma unroll
      for (int kk = 0; kk < 2; ++kk)
#pragma unroll
        for (int r = 0; r < 16; ++r) { const float e = exp2f(st[kk][r] - m_use); st[kk][r] = e; ls += e; }
      l_run = l_run * alpha + ls; m_run = m_new;
#pragma unroll
      for (int mt = 0; mt < NMT; ++mt)
#pragma unroll
        for (int r = 0; r < 16; ++r) o[mt][r] *= alpha;
      bf16x8 pf[4];
#pragma unroll
      for (int ks = 0; ks < 4; ++ks) {
        const int kk = ks >> 1, s2 = ks & 1;
        u32x4 cv;
        cv[0] = pack2(st[kk][8 * s2 + 0], st[kk][8 * s2 + 1]); cv[1] = pack2(st[kk][8 * s2 + 2], st[kk][8 * s2 + 3]);
        cv[2] = pack2(st[kk][8 * s2 + 4], st[kk][8 * s2 + 5]); cv[3] = pack2(st[kk][8 * s2 + 6], st[kk][8 * s2 + 7]);
        pf[ks] = __builtin_bit_cast(bf16x8, cv);
      }
      const unsigned vaddr = (unsigned)(size_t)(Vs + (buf * 64 + 4 * lh + tq_) * VST + 16 * blk + 4 * tp);
#pragma unroll
      for (int mt = 0; mt < NMT; ++mt) {
        const unsigned a0 = vaddr + mt * 64;
        s16x4 l0 = tr_read<0 * 16 * VST * 2>(a0), h0 = tr_read<(0 * 16 + 8) * VST * 2>(a0);
        s16x4 l1 = tr_read<1 * 16 * VST * 2>(a0), h1 = tr_read<(1 * 16 + 8) * VST * 2>(a0);
        s16x4 l2 = tr_read<2 * 16 * VST * 2>(a0), h2 = tr_read<(2 * 16 + 8) * VST * 2>(a0);
        s16x4 l3 = tr_read<3 * 16 * VST * 2>(a0), h3 = tr_read<(3 * 16 + 8) * VST * 2>(a0);
        wait_tr8(l0, h0, l1, h1, l2, h2, l3, h3);
        o[mt] = MFMA(__builtin_shufflevector(l0, h0, 0, 1, 2, 3, 4, 5, 6, 7), pf[0], o[mt]);
        o[mt] = MFMA(__builtin_shufflevector(l1, h1, 0, 1, 2, 3, 4, 5, 6, 7), pf[1], o[mt]);
        o[mt] = MFMA(__builtin_shufflevector(l2, h2, 0, 1, 2, 3, 4, 5, 6, 7), pf[2], o[mt]);
        o[mt] = MFMA(__builtin_shufflevector(l3, h3, 0, 1, 2, 3, 4, 5, 6, 7), pf[3], o[mt]);
      }
    }
    if (kt + 1 < kt_end) ASWRITE(buf ^ 1);
    __syncthreads();
  }
#undef AGLOAD
#undef ASWRITE
  const float l_tot = l_run + __shfl_xor(l_run, 32);
  const float inv = 1.f / l_tot;
  u16* op = obase + tq * ostride;
#pragma unroll
  for (int mt = 0; mt < NMT; ++mt)
#pragma unroll
    for (int g = 0; g < 4; ++g) {
      const int dv0 = 32 * mt + 8 * g + 4 * lh;
      *(uint2*)(op + dv0) = make_uint2(pack2(o[mt][4 * g] * inv, o[mt][4 * g + 1] * inv), pack2(o[mt][4 * g + 2] * inv, o[mt][4 * g + 3] * inv));
    }
  if (!CAUSAL && lh == 0) lsebase[tq * 8] = m_run + log2f(l_tot);
}

constexpr int N_DIFF_UNITS = 2048, N_DIL_UNITS = 6144;
__device__ void phase2_unit(const Params& p, int u, char* smem) {
  if (u < N_DIFF_UNITS) {
    const int n = 31 - (u >> 6), rem = u & 63, b = rem >> 3, hc = rem & 7, h4 = hc >> 1;
    const u16* qb = (const u16*)(p.ws + OFF_QB) + (size_t)(b * 8 + hc) * 4096 * 64;
    const u16* kb = (const u16*)(p.ws + OFF_KB) + (size_t)(b * 8 + hc) * 4096 * 64;
    const u16* vb = (const u16*)(p.ws + OFF_VB) + (size_t)(b * 4 + h4) * 4096 * 128;
    u16* ob = (u16*)(p.ws + OFF_OBC) + (size_t)b * 4096 * 1024 + hc * 128;
    attn_unit<128, true>(qb, kb, vb, n, 1, 0, ob, 1024, nullptr, smem);
  } else {
    const int u2 = u - N_DIFF_UNITS, pidx = u2 >> 11, rem = u2 & 2047, b = rem >> 8, h = (rem >> 5) & 7, rn = rem & 31;
    const int sh = 2 * pidx, dil = 1 << sh, nb = 32 >> sh, res = rn >> (5 - sh), n = rn & (nb - 1);
    const u16* qb = (const u16*)(p.ws + OFF_QA) + (size_t)(b * 8 + h) * 4096 * 64;
    const u16* kb = (const u16*)(p.ws + OFF_KA) + (size_t)(b * 8 + h) * 4096 * 64;
    const u16* vb = (const u16*)(p.ws + OFF_VA) + (size_t)(b * 8 + h) * 4096 * 64;
    u16* ob = (u16*)(p.ws + OFF_OAP) + ((size_t)pidx * T_TOK + (size_t)b * 4096) * 512 + h * 64;
    float* lse = (float*)(p.ws + OFF_LSE) + ((size_t)pidx * T_TOK + (size_t)b * 4096) * 8 + h;
    attn_unit<64, false>(qb, kb, vb, n, dil, res, ob, 512, lse, smem);
  }
}
__device__ void phase2(const Params& p, char* smem) {
  int* counter = (int*)(p.ws + OFF_MISC) + 1;
  int* s_unit = (int*)(smem + SMEM_BYTES - 16);
  while (true) {
    if (threadIdx.x == 0) *s_unit = atomicAdd(counter, 1);
    __syncthreads();
    const int u = *s_unit;
    __syncthreads();
    if (u >= N_DIFF_UNITS + N_DIL_UNITS) break;
    phase2_unit(p, u, smem);
  }
}

__device__ void phase3(const Params& p) {
  const int tid = threadIdx.x, lane = tid & 63, wid = tid >> 6;
  const int gw = blockIdx.x * 4 + wid, nw = gridDim.x * 4;
  const float lam = ((const float*)(p.ws + OFF_MISC))[0];
  const u16* oap = (const u16*)(p.ws + OFF_OAP);
  const u16* obc = (const u16*)(p.ws + OFF_OBC);
  const float* lse = (const float*)(p.ws + OFF_LSE);
  u16* mix = (u16*)(p.ws + OFF_XNB);
  for (int tok = gw; tok < T_TOK; tok += nw) {
    float o[16]; float ss = 0.f;
    if (lane < 32) {
      const int head = lane >> 2;
      float l0 = lse[(size_t)tok * 8 + head], l1 = lse[((size_t)T_TOK + tok) * 8 + head], l2 = lse[((size_t)2 * T_TOK + tok) * 8 + head];
      const float mx = fmaxf(l0, fmaxf(l1, l2));
      float w0 = exp2f(l0 - mx), w1 = exp2f(l1 - mx), w2 = exp2f(l2 - mx);
      const float inv = 1.f / (w0 + w1 + w2); w0 *= inv; w1 *= inv; w2 *= inv;
      const uint4* p0 = (const uint4*)(oap + (size_t)tok * 512 + lane * 16);
      const uint4* p1 = (const uint4*)(oap + ((size_t)T_TOK + tok) * 512 + lane * 16);
      const uint4* p2 = (const uint4*)(oap + ((size_t)2 * T_TOK + tok) * 512 + lane * 16);
#pragma unroll
      for (int c = 0; c < 2; ++c) {
        const uint4 a = p0[c], b = p1[c], d = p2[c];
        const unsigned au[4] = {a.x, a.y, a.z, a.w}, bu[4] = {b.x, b.y, b.z, b.w}, du[4] = {d.x, d.y, d.z, d.w};
#pragma unroll
        for (int k = 0; k < 4; ++k) {
          o[c * 8 + 2 * k] = w0 * bflo(au[k]) + w1 * bflo(bu[k]) + w2 * bflo(du[k]);
          o[c * 8 + 2 * k + 1] = w0 * bfhi(au[k]) + w1 * bfhi(bu[k]) + w2 * bfhi(du[k]);
        }
      }
    } else {
      const int l2 = lane - 32, head = l2 >> 3, cc = (l2 & 7) * 16;
      const uint4* p0 = (const uint4*)(obc + (size_t)tok * 1024 + (2 * head) * 128 + cc);
      const uint4* p1 = (const uint4*)(obc + (size_t)tok * 1024 + (2 * head + 1) * 128 + cc);
#pragma unroll
      for (int c = 0; c < 2; ++c) {
        const uint4 a = p0[c], b = p1[c];
        const unsigned au[4] = {a.x, a.y, a.z, a.w}, bu[4] = {b.x, b.y, b.z, b.w};
#pragma unroll
        for (int k = 0; k < 4; ++k) {
          o[c * 8 + 2 * k] = bflo(au[k]) - lam * bflo(bu[k]);
          o[c * 8 + 2 * k + 1] = bfhi(au[k]) - lam * bfhi(bu[k]);
        }
      }
    }
#pragma unroll
    for (int i = 0; i < 16; ++i) ss += o[i] * o[i];
    const float s1 = ss + __shfl_xor(ss, 1);
    const float s2 = s1 + __shfl_xor(s1, 2);
    const float s3 = s2 + __shfl_xor(s2, 4);
    float r; const float* g;
    if (lane < 32) { r = rsqrtf(s2 * (1.f / 64.f) + 1e-6f); g = p.ona + lane * 16; }
    else { r = rsqrtf(s3 * (1.f / 128.f) + 1e-6f) * 0.8f; g = p.onb + (lane - 32) * 16; }
    unsigned pk[8];
#pragma unroll
    for (int k = 0; k < 8; ++k) pk[k] = pack2(o[2 * k] * r * g[2 * k], o[2 * k + 1] * r * g[2 * k + 1]);
    uint4* dst = (uint4*)(mix + (size_t)tok * 1024 + lane * 16);
    dst[0] = make_uint4(pk[0], pk[1], pk[2], pk[3]); dst[1] = make_uint4(pk[4], pk[5], pk[6], pk[7]);
  }
}

__device__ void phase4_tile(const Params& p, int mtile, int j, char* smem) {
  f32x16 acc[2][2];
  const int m0 = mtile * 128, n0 = j * 128;
  gemm_mainloop((const u16*)(p.ws + OFF_XNB), (const u16*)(p.ws + OFF_WOUT), m0, n0, smem, acc);
  float* st = (float*)smem;
  stage_acc(acc, st);
  __syncthreads();
  const int tid = threadIdx.x, cgi = tid & 31, r0 = tid >> 5;
  float* hss = (float*)(p.ws + OFF_HSS);
  u16* hb = (u16*)(p.ws + OFF_OAP);
#pragma unroll 4
  for (int ps = 0; ps < 16; ++ps) {
    const int row = r0 + 8 * ps;
    const float4 a = *(const float4*)(st + row * 132 + cgi * 4);
    const size_t gi = (size_t)(m0 + row) * 1024 + n0 + cgi * 4;
    const float4 xv = *(const float4*)(p.x + gi);
    float4 hv; hv.x = xv.x + a.x; hv.y = xv.y + a.y; hv.z = xv.z + a.z; hv.w = xv.w + a.w;
    *(float4*)(p.out + gi) = hv;
    *(uint2*)(hb + gi) = make_uint2(pack2(hv.x, hv.y), pack2(hv.z, hv.w));
    float ss = hv.x * hv.x + hv.y * hv.y + hv.z * hv.z + hv.w * hv.w;
    ss += __shfl_xor(ss, 16); ss += __shfl_xor(ss, 8); ss += __shfl_xor(ss, 4); ss += __shfl_xor(ss, 2); ss += __shfl_xor(ss, 1);
    if (cgi == 0) atomicAdd(hss + m0 + row, ss);
  }
  __syncthreads();
}

#define TK_INSERT(xv, xi) { float x_ = (xv); int i_ = (xi); _Pragma("unroll") for (int q_ = 0; q_ < 16; ++q_) { const bool gt_ = x_ > tv[q_]; const float tvv = tv[q_]; const int tii = ti[q_]; tv[q_] = gt_ ? x_ : tvv; ti[q_] = gt_ ? i_ : tii; x_ = gt_ ? tvv : x_; i_ = gt_ ? tii : i_; } }
__device__ void phase5_tile(const Params& p, int mtile, int j, char* smem) {
  f32x16 acc[2][2];
  const int m0 = mtile * 128, n0 = j * 128;
  gemm_mainloop((const u16*)(p.ws + OFF_OAP), (const u16*)(p.ws + OFF_WPQ), m0, n0, smem, acc);
  const int tid = threadIdx.x, lane = tid & 63, w = tid >> 6, wm = w >> 1, wn = w & 1, lr = lane & 31, lh = lane >> 5;
  u16* Qs = (u16*)smem;
  u16* SKs = Qs + 128 * 136;
  float* rs = (float*)(smem + 2 * 128 * 136 * 2);
  const float* hss = (const float*)(p.ws + OFF_HSS);
  if (tid < 128) rs[tid] = rsqrtf(hss[m0 + tid] * (1.f / 1024.f) + 1e-6f);
  {
    const u16* sk = (const u16*)(p.ws + OFF_SUBK) + (size_t)j * 128 * 128;
#pragma unroll
    for (int i = 0; i < 8; ++i) { const int c = tid + 256 * i, row = c >> 4, kc = c & 15; *(uint4*)(SKs + row * 136 + kc * 8) = *(const uint4*)(sk + row * 128 + kc * 8); }
  }
  __syncthreads();
#pragma unroll
  for (int mt = 0; mt < 2; ++mt)
#pragma unroll
    for (int nt = 0; nt < 2; ++nt)
#pragma unroll
      for (int r = 0; r < 16; ++r) {
        const int row = wm * 64 + mt * 32 + crow(r, lh);
        Qs[row * 136 + wn * 64 + nt * 32 + lr] = f2bf(acc[mt][nt][r] * rs[row]);
      }
  __syncthreads();
#pragma unroll
  for (int a = 0; a < 2; ++a)
#pragma unroll
    for (int b = 0; b < 2; ++b)
#pragma unroll
      for (int r = 0; r < 16; ++r) acc[a][b][r] = 0.f;
  {
    const u16* ab = Qs + (wm * 64 + lr) * 136 + lh * 8;
    const u16* bb = SKs + (wn * 64 + lr) * 136 + lh * 8;
#pragma unroll
    for (int s = 0; s < 8; ++s) {
      const bf16x8 a0 = *(const bf16x8*)(ab + s * 16), a1 = *(const bf16x8*)(ab + 32 * 136 + s * 16);
      const bf16x8 b0 = *(const bf16x8*)(bb + s * 16), b1 = *(const bf16x8*)(bb + 32 * 136 + s * 16);
      acc[0][0] = MFMA(a0, b0, acc[0][0]); acc[0][1] = MFMA(a0, b1, acc[0][1]);
      acc[1][0] = MFMA(a1, b0, acc[1][0]); acc[1][1] = MFMA(a1, b1, acc[1][1]);
    }
  }
  __syncthreads();
  float* st = (float*)smem;
  stage_acc(acc, st);
  __syncthreads();
  const int row = tid & 127, half = tid >> 7;
  float tv[16]; int ti[16];
#pragma unroll
  for (int q = 0; q < 16; ++q) { tv[q] = NEG_INF; ti[q] = 0; }
#pragma unroll 2
  for (int c = 0; c < 16; ++c) {
    const float4 v4 = *(const float4*)(st + row * 132 + half * 64 + c * 4);
    const int bi = half * 64 + c * 4;
    TK_INSERT(v4.x, bi); TK_INSERT(v4.y, bi + 1); TK_INSERT(v4.z, bi + 2); TK_INSERT(v4.w, bi + 3);
  }
  __syncthreads();
  if (half == 1) {
#pragma unroll
    for (int q = 0; q < 16; ++q) { st[row * 132 + q] = tv[q]; st[row * 132 + 16 + q] = __int_as_float(ti[q]); }
  }
  __syncthreads();
  if (half == 0) {
#pragma unroll 2
    for (int q = 0; q < 16; ++q) { const float xv = st[row * 132 + q]; const int xi = __float_as_int(st[row * 132 + 16 + q]); TK_INSERT(xv, xi); }
    const size_t base = ((size_t)(m0 + row) * 16 + j) * 16;
    float* tops = (float*)(p.ws + OFF_TOPS) + base;
    u8* topi = (u8*)(p.ws + OFF_TOPI) + base;
#pragma unroll
    for (int c = 0; c < 4; ++c) ((float4*)tops)[c] = make_float4(tv[4 * c], tv[4 * c + 1], tv[4 * c + 2], tv[4 * c + 3]);
    unsigned pk[4];
#pragma unroll
    for (int c = 0; c < 4; ++c) pk[c] = (unsigned)ti[4 * c] | ((unsigned)ti[4 * c + 1] << 8) | ((unsigned)ti[4 * c + 2] << 16) | ((unsigned)ti[4 * c + 3] << 24);
    *(uint4*)topi = make_uint4(pk[0], pk[1], pk[2], pk[3]);
  }
  __syncthreads();
}

__device__ void phase6(const Params& p, char* smem) {
  const int tid = threadIdx.x, lane = tid & 63, wid = tid >> 6;
  const int gw = blockIdx.x * 4 + wid, nw = gridDim.x * 4;
  int* ids = (int*)(smem + wid * 1024);
  float* gts = (float*)(smem + wid * 1024 + 512);
  const float* hss = (const float*)(p.ws + OFF_HSS);
  const float* tops = (const float*)(p.ws + OFF_TOPS);
  const u8* topi = (const u8*)(p.ws + OFF_TOPI);
  const u16* ub = (const u16*)(p.ws + OFF_PUB);
  const u16* vb = (const u16*)(p.ws + OFF_PVB);
  int ci, cj;
  {
    const int L = lane;
    if (L < 16) { ci = 0; cj = L; } else if (L < 24) { ci = 1; cj = L - 16; } else if (L < 29) { ci = 2; cj = L - 24; }
    else if (L < 33) { ci = 3; cj = L - 29; } else if (L < 36) { ci = 4; cj = L - 33; } else if (L < 38) { ci = 5; cj = L - 36; }
    else if (L < 40) { ci = 6; cj = L - 38; } else if (L < 42) { ci = 7; cj = L - 40; } else if (L < 50) { ci = L - 34; cj = 0; }
    else { ci = 0; cj = 0; }
  }
  float gf[16];
  {
    const float4* gp = (const float4*)(p.g_ffn + lane * 16);
#pragma unroll
    for (int c = 0; c < 4; ++c) { const float4 t4 = gp[c]; gf[4 * c] = t4.x; gf[4 * c + 1] = t4.y; gf[4 * c + 2] = t4.z; gf[4 * c + 3] = t4.w; }
  }
  for (int tok = gw; tok < T_TOK; tok += nw) {
    const float rstd = rsqrtf(hss[tok] * (1.f / 1024.f) + 1e-6f);
    float hres[16]; unsigned hn[8];
    {
      const float4* hp = (const float4*)(p.out + (size_t)tok * 1024 + lane * 16);
#pragma unroll
      for (int c = 0; c < 4; ++c) { const float4 t4 = hp[c]; hres[4 * c] = t4.x; hres[4 * c + 1] = t4.y; hres[4 * c + 2] = t4.z; hres[4 * c + 3] = t4.w; }
#pragma unroll
      for (int k = 0; k < 8; ++k) hn[k] = pack2(hres[2 * k] * rstd * gf[2 * k], hres[2 * k + 1] * rstd * gf[2 * k + 1]);
    }
#pragma unroll 1
    for (int head = 0; head < 8; ++head) {
      const size_t b1 = ((size_t)tok * 16 + head * 2) * 16, b2 = b1 + 16;
      float sum = NEG_INF; int eid = 0;
      if (lane < 50) { sum = tops[b1 + ci] + tops[b2 + cj]; eid = (int)topi[b1 + ci] * 128 + (int)topi[b2 + cj]; }
      int rank = 0;
#pragma unroll
      for (int m = 0; m < 50; ++m) {
        const float v = __shfl(sum, m);
        rank += (v > sum || (v == sum && m < lane)) ? 1 : 0;
      }
      const float mxa = __shfl(sum, 0);
      const bool sel = (lane < 50) && (rank < 16);
      const float e = sel ? __expf(sum - mxa) : 0.f;
      const float den = wave_sum(e);
      if (sel) { ids[head * 16 + rank] = eid; gts[head * 16 + rank] = e / den; }
    }
    __builtin_amdgcn_wave_barrier();
    asm volatile("s_waitcnt lgkmcnt(0)" ::: "memory");
    float acc[16];
#pragma unroll
    for (int i = 0; i < 16; ++i) acc[i] = 0.f;
#pragma unroll 1
    for (int e0 = 0; e0 < 128; e0 += 4) {
      uint4 ur[4][2], vr[4][2]; float gate[4];
#pragma unroll
      for (int k = 0; k < 4; ++k) {
        const int id = __builtin_amdgcn_readfirstlane(ids[e0 + k]);
        gate[k] = gts[e0 + k];
        const uint4* up = (const uint4*)(ub + (size_t)id * 1024 + lane * 16);
        const uint4* vp = (const uint4*)(vb + (size_t)id * 1024 + lane * 16);
        ur[k][0] = up[0]; ur[k][1] = up[1]; vr[k][0] = vp[0]; vr[k][1] = vp[1];
      }
#pragma unroll
      for (int k = 0; k < 4; ++k) {
        const unsigned uu[8] = {ur[k][0].x, ur[k][0].y, ur[k][0].z, ur[k][0].w, ur[k][1].x, ur[k][1].y, ur[k][1].z, ur[k][1].w};
        float d = 0.f;
#pragma unroll
        for (int q = 0; q < 8; ++q) d = __builtin_amdgcn_fdot2_f32_bf16(__builtin_bit_cast(bf2_t, uu[q]), __builtin_bit_cast(bf2_t, hn[q]), d, false);
        d = wave_sum(d);
        const float a = 0.5f * d * (1.f + erff(d * 0.70710678118654752f)) * gate[k];
        const unsigned vv[8] = {vr[k][0].x, vr[k][0].y, vr[k][0].z, vr[k][0].w, vr[k][1].x, vr[k][1].y, vr[k][1].z, vr[k][1].w};
#pragma unroll
        for (int q = 0; q < 8; ++q) { acc[2 * q] += a * bflo(vv[q]); acc[2 * q + 1] += a * bfhi(vv[q]); }
      }
    }
    float4* op = (float4*)(p.out + (size_t)tok * 1024 + lane * 16);
#pragma unroll
    for (int c = 0; c < 4; ++c) op[c] = make_float4(hres[4 * c] + acc[4 * c], hres[4 * c + 1] + acc[4 * c + 1], hres[4 * c + 2] + acc[4 * c + 2], hres[4 * c + 3] + acc[4 * c + 3]);
    __builtin_amdgcn_wave_barrier();
  }
}

#if FUSED
__global__ void __launch_bounds__(256, 2) fwd_megakernel(Params p) {
  __shared__ __attribute__((aligned(16))) char smem[SMEM_BYTES];
  cg::grid_group grid = cg::this_grid();
  phase0(p, smem);
  grid.sync();
  for (int t = blockIdx.x; t < 256 * 24; t += gridDim.x) phase1_tile(p, t / 24, t % 24, smem);
  grid.sync();
  phase2(p, smem);
  grid.sync();
  phase3(p);
  grid.sync();
  for (int t = blockIdx.x; t < 256 * 8; t += gridDim.x) phase4_tile(p, t >> 3, t & 7, smem);
  grid.sync();
  for (int t = blockIdx.x; t < 256 * 16; t += gridDim.x) phase5_tile(p, t >> 4, t & 15, smem);
  grid.sync();
  phase6(p, smem);
}
#else
__global__ void __launch_bounds__(256, 2) k_p0(Params p) { __shared__ __attribute__((aligned(16))) char smem[SMEM_BYTES]; phase0(p, smem); }
__global__ void __launch_bounds__(256, 2) k_p1(Params p) { __shared__ __attribute__((aligned(16))) char smem[SMEM_BYTES]; for (int t = blockIdx.x; t < 256 * 24; t += gridDim.x) phase1_tile(p, t / 24, t % 24, smem); }
__global__ void __launch_bounds__(256, 2) k_p2(Params p) { __shared__ __attribute__((aligned(16))) char smem[SMEM_BYTES]; phase2(p, smem); }
__global__ void __launch_bounds__(256, 2) k_p3(Params p) { phase3(p); }
__global__ void __launch_bounds__(256, 2) k_p4(Params p) { __shared__ __attribute__((aligned(16))) char smem[SMEM_BYTES]; for (int t = blockIdx.x; t < 256 * 8; t += gridDim.x) phase4_tile(p, t >> 3, t & 7, smem); }
__global__ void __launch_bounds__(256, 2) k_p5(Params p) { __shared__ __attribute__((aligned(16))) char smem[SMEM_BYTES]; for (int t = blockIdx.x; t < 256 * 16; t += gridDim.x) phase5_tile(p, t >> 4, t & 15, smem); }
__global__ void __launch_bounds__(256, 2) k_p6(Params p) { __shared__ __attribute__((aligned(16))) char smem[SMEM_BYTES]; phase6(p, smem); }
#endif

extern "C" void kernel_launch(void* const* d_in, const int* in_sizes, int n_in, void* d_out, int out_size, void* d_ws, size_t ws_size,
                              hipStream_t stream) {
  Params p{};
  p.x = (const float*)d_in[0]; p.g_attn = (const float*)d_in[1]; p.w_in = (const float*)d_in[2]; p.qna = (const float*)d_in[3];
  p.kna = (const float*)d_in[4]; p.ona = (const float*)d_in[5]; p.qnb = (const float*)d_in[6]; p.knb = (const float*)d_in[7];
  p.lq1 = (const float*)d_in[8]; p.lk1 = (const float*)d_in[9]; p.lq2 = (const float*)d_in[10]; p.lk2 = (const float*)d_in[11];
  p.onb = (const float*)d_in[12]; p.w_out = (const float*)d_in[13]; p.g_ffn = (const float*)d_in[14]; p.w_pq = (const float*)d_in[15];
  p.subk = (const float*)d_in[16]; p.pu = (const float*)d_in[17]; p.pv = (const float*)d_in[18];
  p.out = (float*)d_out; p.ws = (char*)d_ws;
#if FUSED
  static int grid_blocks = 0;
  if (!grid_blocks) {
    int dev = 0, cus = 0, per_cu = 0;
    hipGetDevice(&dev);
    hipDeviceGetAttribute(&cus, hipDeviceAttributeMultiprocessorCount, dev);
    hipOccupancyMaxActiveBlocksPerMultiprocessor(&per_cu, fwd_megakernel, 256, 0);
    if (per_cu > 2) per_cu = 2;
    if (per_cu < 1) per_cu = 1;
    grid_blocks = cus * per_cu;
  }
  void* args[] = {&p};
  hipError_t e = hipLaunchCooperativeKernel((void*)fwd_megakernel, dim3(grid_blocks), dim3(256), args, 0, stream);
  if (e != hipSuccess) fprintf(stderr, "cooperative launch failed: %s (grid %d)\n", hipGetErrorString(e), grid_blocks);
#else
  const int G = 512;
  k_p0<<<G, 256, 0, stream>>>(p);
  k_p1<<<G, 256, 0, stream>>>(p);
  k_p2<<<G, 256, 0, stream>>>(p);
  k_p3<<<G, 256, 0, stream>>>(p);
  k_p4<<<G, 256, 0, stream>>>(p);
  k_p5<<<G, 256, 0, stream>>>(p);
  k_p6<<<G, 256, 0, stream>>>(p);
#endif
}
```

```cpp
#include <hip/hip_runtime.h>
#include <hip/hip_cooperative_groups.h>
#include <cstdio>
#include <cstdint>
namespace cg = cooperative_groups;

#ifndef FUSED
#define FUSED 1
#endif

typedef unsigned short u16;
typedef unsigned char u8;
typedef __attribute__((ext_vector_type(8))) short bf16x8;
typedef __attribute__((ext_vector_type(4))) short s16x4;
typedef __attribute__((ext_vector_type(16))) float f32x16;
typedef __attribute__((ext_vector_type(2))) __bf16 bf2_t;
typedef __attribute__((ext_vector_type(4))) unsigned u32x4;
#define DI __device__ __forceinline__
#define MFMA(a, b, c) __builtin_amdgcn_mfma_f32_32x32x16_bf16((a), (b), (c), 0, 0, 0)

constexpr int T_TOK = 32768;
constexpr int SEQ = 4096;
constexpr size_t MB = 1u << 20;
constexpr size_t OFF_XNB = 0;
constexpr size_t OFF_QA = 64 * MB, OFF_KA = 96 * MB, OFF_VA = 128 * MB, OFF_QB = 160 * MB, OFF_KB = 192 * MB, OFF_VB = 224 * MB;
constexpr size_t OFF_TOPS = 64 * MB;
constexpr size_t OFF_TOPI = 96 * MB;
constexpr size_t OFF_OAP = 256 * MB;
constexpr size_t OFF_OBC = 352 * MB;
constexpr size_t OFF_PUB = 416 * MB, OFF_PVB = 448 * MB;
constexpr size_t OFF_WIN = 480 * MB, OFF_WOUT = 486 * MB, OFF_WPQ = 488 * MB, OFF_SUBK = 492 * MB;
constexpr size_t OFF_ROPEC = 493 * MB, OFF_ROPES = 493 * MB + 128 * 1024;
constexpr size_t OFF_LSE = 494 * MB;
constexpr size_t OFF_HSS = 497 * MB;
constexpr size_t OFF_MISC = 497 * MB + 128 * 1024;

constexpr int SMEM_BYTES = 73728;
constexpr float QSCALE = 0.125f * 1.4426950408889634f;
constexpr float NEG_INF = -__builtin_huge_valf();

struct Params {
  const float *x, *g_attn, *w_in, *qna, *kna, *ona, *qnb, *knb, *lq1, *lk1, *lq2, *lk2, *onb, *w_out, *g_ffn, *w_pq, *subk, *pu, *pv;
  float* out;
  char* ws;
};

DI u16 f2bf(float x) { unsigned u = __float_as_uint(x); u += 0x7fffu + ((u >> 16) & 1u); return (u16)(u >> 16); }
DI float bf2f(u16 b) { return __uint_as_float(((unsigned)b) << 16); }
DI unsigned pack2(float a, float b) { return (unsigned)f2bf(a) | ((unsigned)f2bf(b) << 16); }
DI float bflo(unsigned u) { return __uint_as_float(u << 16); }
DI float bfhi(unsigned u) { return __uint_as_float(u & 0xffff0000u); }
DI float wave_sum(float v) {
  v += __shfl_xor(v, 32); v += __shfl_xor(v, 16); v += __shfl_xor(v, 8); v += __shfl_xor(v, 4); v += __shfl_xor(v, 2); v += __shfl_xor(v, 1);
  return v;
}
DI int crow(int reg, int h) { return (reg & 3) + 8 * (reg >> 2) + 4 * h; }

__device__ void phase0(const Params& p, char* smem) {
  const int tid = threadIdx.x, lane = tid & 63, wid = tid >> 6;
  const int gw = blockIdx.x * 4 + wid, nw = gridDim.x * 4;
  const int gt = blockIdx.x * 256 + tid, nt = gridDim.x * 256;
  u16* xnb = (u16*)(p.ws + OFF_XNB);
  for (int row = gw; row < T_TOK; row += nw) {
    const float4* xr = (const float4*)(p.x + (size_t)row * 1024);
    float4 v[4]; float ss = 0.f;
#pragma unroll
    for (int i = 0; i < 4; ++i) { v[i] = xr[lane + 64 * i]; ss += v[i].x * v[i].x + v[i].y * v[i].y + v[i].z * v[i].z + v[i].w * v[i].w; }
    ss = wave_sum(ss);
    const float r = rsqrtf(ss * (1.f / 1024.f) + 1e-6f);
    uint2* dst = (uint2*)(xnb + (size_t)row * 1024);
#pragma unroll
    for (int i = 0; i < 4; ++i) dst[lane + 64 * i] = make_uint2(pack2(v[i].x * r, v[i].y * r), pack2(v[i].z * r, v[i].w * r));
  }
  float* tile = (float*)smem;
  for (int job = blockIdx.x; job < 1536; job += gridDim.x) {
    const float* W; const float* g; u16* outp; int N, j;
    if (job < 768) { W = p.w_in; g = p.g_attn; outp = (u16*)(p.ws + OFF_WIN); N = 3072; j = job; }
    else if (job < 1024) { W = p.w_out; g = nullptr; outp = (u16*)(p.ws + OFF_WOUT); N = 1024; j = job - 768; }
    else { W = p.w_pq; g = p.g_ffn; outp = (u16*)(p.ws + OFF_WPQ); N = 2048; j = job - 1024; }
    const int ntn = N >> 6, kt = j / ntn, ntile = j % ntn;
    const int tx = tid & 63, ty = tid >> 6;
#pragma unroll 4
    for (int r = 0; r < 16; ++r) {
      const int k = kt * 64 + ty + 4 * r;
      float v = W[(size_t)k * N + ntile * 64 + tx];
      if (g) v *= g[k];
      tile[(ty + 4 * r) * 65 + tx] = v;
    }
    __syncthreads();
#pragma unroll 4
    for (int r = 0; r < 16; ++r) {
      const int nl = ty + 4 * r;
      outp[(size_t)(ntile * 64 + nl) * 1024 + kt * 64 + tx] = f2bf(tile[tx * 65 + nl]);
    }
    __syncthreads();
  }
  {
    const float4* s = (const float4*)p.subk; uint2* d = (uint2*)(p.ws + OFF_SUBK);
    for (int i = gt; i < 262144 / 4; i += nt) { float4 v = s[i]; d[i] = make_uint2(pack2(v.x, v.y), pack2(v.z, v.w)); }
    const float4* su = (const float4*)p.pu; uint2* du = (uint2*)(p.ws + OFF_PUB);
    const float4* sv = (const float4*)p.pv; uint2* dv = (uint2*)(p.ws + OFF_PVB);
    for (int i = gt; i < 16384 * 1024 / 4; i += nt) {
      float4 a = su[i]; float4 b = sv[i];
      du[i] = make_uint2(pack2(a.x, a.y), pack2(a.z, a.w));
      dv[i] = make_uint2(pack2(b.x, b.y), pack2(b.z, b.w));
    }
  }
  {
    float* rc = (float*)(p.ws + OFF_ROPEC); float* rs = (float*)(p.ws + OFF_ROPES);
    for (int i = gt; i < SEQ * 8; i += nt) {
      const int pos = i >> 3, f = i & 7;
      const float invf = (float)pow(500000.0, -(double)f / 8.0);
      const float ang = (float)pos * invf;
      rc[i] = (float)cos((double)ang); rs[i] = (float)sin((double)ang);
    }
    float* hss = (float*)(p.ws + OFF_HSS);
    for (int i = gt; i < T_TOK; i += nt) hss[i] = 0.f;
    if (gt == 0) {
      float a = 0.f, b = 0.f;
      for (int i = 0; i < 64; ++i) { a += p.lq1[i] * p.lk1[i]; b += p.lq2[i] * p.lk2[i]; }
      float* misc = (float*)(p.ws + OFF_MISC);
      misc[0] = expf(a) - expf(b) + 0.2f;
      ((int*)misc)[1] = 0;
    }
  }
}

DI void gemm_mainloop(const u16* __restrict__ A, const u16* __restrict__ Bt, int m0, int n0, char* smem, f32x16 (&acc)[2][2]) {
  u16* As = (u16*)smem;
  u16* Bs = As + 2 * 128 * 72;
  const int tid = threadIdx.x, lane = tid & 63, w = tid >> 6, wm = w >> 1, wn = w & 1, lr = lane & 31, lh = lane >> 5;
#pragma unroll
  for (int a = 0; a < 2; ++a)
#pragma unroll
    for (int b = 0; b < 2; ++b)
#pragma unroll
      for (int r = 0; r < 16; ++r) acc[a][b][r] = 0.f;
  uint4 ra[4], rb[4];
  const int lrow = tid >> 3, lkc = tid & 7;
  const u16* Ag = A + (size_t)(m0 + lrow) * 1024 + lkc * 8;
  const u16* Bg = Bt + (size_t)(n0 + lrow) * 1024 + lkc * 8;
#define GLOAD(kt) { _Pragma("unroll") for (int i = 0; i < 4; ++i) { ra[i] = *(const uint4*)(Ag + (size_t)i * 32 * 1024 + (kt) * 64); rb[i] = *(const uint4*)(Bg + (size_t)i * 32 * 1024 + (kt) * 64); } }
#define SWRITE(buf) { _Pragma("unroll") for (int i = 0; i < 4; ++i) { *(uint4*)(As + ((buf) * 128 + lrow + 32 * i) * 72 + lkc * 8) = ra[i]; *(uint4*)(Bs + ((buf) * 128 + lrow + 32 * i) * 72 + lkc * 8) = rb[i]; } }
  GLOAD(0); SWRITE(0); __syncthreads();
  for (int kt = 0; kt < 16; ++kt) {
    if (kt < 15) GLOAD(kt + 1);
    const u16* ab = As + ((kt & 1) * 128 + wm * 64 + lr) * 72 + lh * 8;
    const u16* bb = Bs + ((kt & 1) * 128 + wn * 64 + lr) * 72 + lh * 8;
#pragma unroll
    for (int s = 0; s < 4; ++s) {
      const bf16x8 a0 = *(const bf16x8*)(ab + s * 16), a1 = *(const bf16x8*)(ab + 32 * 72 + s * 16);
      const bf16x8 b0 = *(const bf16x8*)(bb + s * 16), b1 = *(const bf16x8*)(bb + 32 * 72 + s * 16);
      acc[0][0] = MFMA(a0, b0, acc[0][0]); acc[0][1] = MFMA(a0, b1, acc[0][1]);
      acc[1][0] = MFMA(a1, b0, acc[1][0]); acc[1][1] = MFMA(a1, b1, acc[1][1]);
    }
    if (kt < 15) SWRITE((kt + 1) & 1);
    __syncthreads();
  }
#undef GLOAD
#undef SWRITE
}

DI void stage_acc(const f32x16 (&acc)[2][2], float* st) {
  const int tid = threadIdx.x, lane = tid & 63, w = tid >> 6, wm = w >> 1, wn = w & 1, lr = lane & 31, lh = lane >> 5;
#pragma unroll
  for (int mt = 0; mt < 2; ++mt)
#pragma unroll
    for (int nt = 0; nt < 2; ++nt)
#pragma unroll
      for (int r = 0; r < 16; ++r) st[(wm * 64 + mt * 32 + crow(r, lh)) * 132 + wn * 64 + nt * 32 + lr] = acc[mt][nt][r];
}

__device__ void phase1_tile(const Params& p, int mtile, int j, char* smem) {
  f32x16 acc[2][2];
  const int m0 = mtile * 128, n0 = j * 128;
  gemm_mainloop((const u16*)(p.ws + OFF_XNB), (const u16*)(p.ws + OFF_WIN), m0, n0, smem, acc);
  float* st = (float*)smem;
  stage_acc(acc, st);
  __syncthreads();
  const int tid = threadIdx.x, row = tid & 127, half = tid >> 7;
  const int sec = j >> 2;
  const int tok = m0 + row, b = tok >> 12, s = tok & 4095;
  float v[64];
#pragma unroll
  for (int c = 0; c < 16; ++c) { const float4 t4 = *(const float4*)(st + row * 132 + half * 64 + c * 4); v[4 * c] = t4.x; v[4 * c + 1] = t4.y; v[4 * c + 2] = t4.z; v[4 * c + 3] = t4.w; }
  if (sec != 2 && sec != 5) {
    const float* g = sec == 0 ? p.qna : sec == 1 ? p.kna : sec == 3 ? p.qnb : p.knb;
    float ss = 0.f;
#pragma unroll
    for (int i = 0; i < 64; ++i) ss += v[i] * v[i];
    float r = rsqrtf(ss * (1.f / 64.f) + 1e-6f);
    const float post = (sec == 0 || sec == 3) ? QSCALE : 1.f;
#pragma unroll
    for (int i = 0; i < 64; ++i) v[i] = v[i] * r * g[i];
    const float* rc = (const float*)(p.ws + OFF_ROPEC) + s * 8;
    const float* rs = (const float*)(p.ws + OFF_ROPES) + s * 8;
#pragma unroll
    for (int i = 0; i < 8; ++i) {
      const float c = rc[i], sn = rs[i], x1 = v[i], x2 = v[i + 8];
      v[i] = x1 * c - x2 * sn; v[i + 8] = x2 * c + x1 * sn;
    }
#pragma unroll
    for (int i = 0; i < 64; ++i) v[i] *= post;
  }
  u16* dst;
  if (sec == 5) {
    dst = (u16*)(p.ws + OFF_VB) + ((size_t)(b * 4 + (j & 3)) * 4096 + s) * 128 + half * 64;
  } else {
    const size_t off = sec == 0 ? OFF_QA : sec == 1 ? OFF_KA : sec == 2 ? OFF_VA : sec == 3 ? OFF_QB : OFF_KB;
    const int hc = (j & 3) * 2 + half;
    dst = (u16*)(p.ws + off) + ((size_t)(b * 8 + hc) * 4096 + s) * 64;
  }
#pragma unroll
  for (int c = 0; c < 8; ++c)
    ((uint4*)dst)[c] = make_uint4(pack2(v[8 * c], v[8 * c + 1]), pack2(v[8 * c + 2], v[8 * c + 3]), pack2(v[8 * c + 4], v[8 * c + 5]), pack2(v[8 * c + 6], v[8 * c + 7]));
  __syncthreads();
}

template <int OFF> DI s16x4 tr_read(unsigned addr) {
  s16x4 r; asm volatile("ds_read_b64_tr_b16 %0, %1 offset:%2" : "=v"(r) : "v"(addr), "n"(OFF) : "memory"); return r;
}
DI void wait_tr8(s16x4& a0, s16x4& a1, s16x4& a2, s16x4& a3, s16x4& a4, s16x4& a5, s16x4& a6, s16x4& a7) {
  asm volatile("s_waitcnt lgkmcnt(0)" : "+v"(a0), "+v"(a1), "+v"(a2), "+v"(a3), "+v"(a4), "+v"(a5), "+v"(a6), "+v"(a7) : : "memory");
}

template <int DV, bool CAUSAL>
__device__ void attn_unit(const u16* __restrict__ qbase, const u16* __restrict__ kbase, const u16* __restrict__ vbase, int n, int dil, int res,
                          u16* __restrict__ obase, int ostride, float* __restrict__ lsebase, char* smem) {
  constexpr int VST = DV + 8;
  constexpr int NMT = DV / 32;
  constexpr int WMAX = CAUSAL ? (1 << 30) : 128;
  u16* Ks = (u16*)smem;
  u16* Vs = Ks + 2 * 64 * 72;
  const int tid = threadIdx.x, lane = tid & 63, w = tid >> 6, lr = lane & 31, lh = lane >> 5;
  const int kb0 = CAUSAL ? 0 : 128 * (n - 1);
  const int kt_begin = CAUSAL ? 0 : (n == 0 ? 2 : 0);
  const int kt_end = CAUSAL ? (2 * n + 2) : 4;
  const int mq = 128 * n + 32 * w + lr;
  const size_t tq = (size_t)mq * dil + res;
  bf16x8 qf[4];
  {
    const u16* qp = qbase + tq * 64 + lh * 8;
#pragma unroll
    for (int s = 0; s < 4; ++s) qf[s] = *(const bf16x8*)(qp + s * 16);
  }
  f32x16 o[NMT];
#pragma unroll
  for (int mt = 0; mt < NMT; ++mt)
#pragma unroll
    for (int r = 0; r < 16; ++r) o[mt][r] = 0.f;
  float m_run = NEG_INF, l_run = 0.f;
  uint4 rk0, rk1, rv0, rv1, rv2, rv3;
  rv2 = rv3 = make_uint4(0, 0, 0, 0);
  const int krow_ = tid >> 3, kkc = tid & 7;
  constexpr int VCPR = DV / 8;
  const int vrow = tid / VCPR, vkc = tid % VCPR;
  constexpr int VRSTEP = 256 / VCPR;
  const u16* kgp = kbase + ((size_t)(kb0 + krow_) * dil + res) * 64 + kkc * 8;
  const u16* vgp = vbase + ((size_t)(kb0 + vrow) * dil + res) * DV + vkc * 8;
  const size_t kstep32 = (size_t)32 * dil * 64, kstep64 = (size_t)64 * dil * 64;
  const size_t vstepr = (size_t)VRSTEP * dil * DV, vstep64 = (size_t)64 * dil * DV;
  u16* ksw = Ks + krow_ * 72 + kkc * 8;
  u16* vsw = Vs + vrow * VST + vkc * 8;
#define AGLOAD(kt) { const u16* kp_ = kgp + (size_t)(kt) * kstep64; rk0 = *(const uint4*)kp_; rk1 = *(const uint4*)(kp_ + kstep32); \
    const u16* vp_ = vgp + (size_t)(kt) * vstep64; rv0 = *(const uint4*)vp_; rv1 = *(const uint4*)(vp_ + vstepr); \
    if (NMT == 4) { rv2 = *(const uint4*)(vp_ + 2 * vstepr); rv3 = *(const uint4*)(vp_ + 3 * vstepr); } }
#define ASWRITE(buf) { *(uint4*)(ksw + (buf) * 64 * 72) = rk0; *(uint4*)(ksw + (buf) * 64 * 72 + 32 * 72) = rk1; \
    *(uint4*)(vsw + (buf) * 64 * VST) = rv0; *(uint4*)(vsw + (buf) * 64 * VST + VRSTEP * VST) = rv1; \
    if (NMT == 4) { *(uint4*)(vsw + (buf) * 64 * VST + 2 * VRSTEP * VST) = rv2; *(uint4*)(vsw + (buf) * 64 * VST + 3 * VRSTEP * VST) = rv3; } }
  AGLOAD(kt_begin); ASWRITE(0); __syncthreads();
  const int li = lane & 31, blk = li >> 4, tq_ = (li >> 2) & 3, tp = li & 3;
  for (int kt = kt_begin; kt < kt_end; ++kt) {
    const int buf = (kt - kt_begin) & 1;
    if (kt + 1 < kt_end) AGLOAD(kt + 1);
    const int k_lo = kb0 + 64 * kt, q_lo = 128 * n + 32 * w;
    const int dmin = q_lo - (k_lo + 63), dmax = q_lo + 31 - k_lo;
    const bool skip = (dmax < 0) || (dmin > WMAX);
    if (!skip) {
      const bool need_mask = (dmin < 0) || (dmax > WMAX);
      const u16* kb = Ks + (buf * 64 + lr) * 72 + lh * 8;
      f32x16 st[2];
#pragma unroll
      for (int kk = 0; kk < 2; ++kk) {
#pragma unroll
        for (int r = 0; r < 16; ++r) st[kk][r] = 0.f;
#pragma unroll
        for (int s = 0; s < 4; ++s) { const bf16x8 a = *(const bf16x8*)(kb + kk * 32 * 72 + s * 16); st[kk] = MFMA(a, qf[s], st[kk]); }
      }
      if (need_mask) {
#pragma unroll
        for (int kk = 0; kk < 2; ++kk)
#pragma unroll
          for (int r = 0; r < 16; ++r) {
            const int d = mq - (k_lo + 32 * kk + crow(r, lh));
            if (d < 0 || d > WMAX) st[kk][r] = NEG_INF;
          }
      }
      float mx = NEG_INF;
#pragma unroll
      for (int kk = 0; kk < 2; ++kk)
#pragma unroll
        for (int r = 0; r < 16; ++r) mx = fmaxf(mx, st[kk][r]);
      mx = fmaxf(mx, __shfl_xor(mx, 32));
      const float m_new = fmaxf(m_run, mx);
      const float m_use = (m_new == NEG_INF) ? 0.f : m_new;
      const float alpha = exp2f(m_run - m_use);
      float ls = 0.f;
#pragma unroll
      for (int kk = 0; kk < 2; ++kk)
#pragma unroll
        for (int r = 0; r < 16; ++r) { const float e = exp2f(st[kk][r] - m_use); st[kk][r] = e; ls += e; }
      l_run = l_run * alpha + ls; m_run = m_new;
#pragma unroll
      for (int mt = 0; mt < NMT; ++mt)
#pragma unroll
        for (int r = 0; r < 16; ++r) o[mt][r] *= alpha;
      bf16x8 pf[4];
#pragma unroll
      for (int ks = 0; ks < 4; ++ks) {
        const int kk = ks >> 1, s2 = ks & 1;
        u32x4 cv;
        cv[0] = pack2(st[kk][8 * s2 + 0], st[kk][8 * s2 + 1]); cv[1] = pack2(st[kk][8 * s2 + 2], st[kk][8 * s2 + 3]);
        cv[2] = pack2(st[kk][8 * s2 + 4], st[kk][8 * s2 + 5]); cv[3] = pack2(st[kk][8 * s2 + 6], st[kk][8 * s2 + 7]);
        pf[ks] = __builtin_bit_cast(bf16x8, cv);
      }
      const unsigned vaddr = (unsigned)(size_t)(Vs + (buf * 64 + 4 * lh + tq_) * VST + 16 * blk + 4 * tp);
#pragma unroll
      for (int mt = 0; mt < NMT; ++mt) {
        const unsigned a0 = vaddr + mt * 64;
        s16x4 l0 = tr_read<0 * 16 * VST * 2>(a0), h0 = tr_read<(0 * 16 + 8) * VST * 2>(a0);
        s16x4 l1 = tr_read<1 * 16 * VST * 2>(a0), h1 = tr_read<(1 * 16 + 8) * VST * 2>(a0);
        s16x4 l2 = tr_read<2 * 16 * VST * 2>(a0), h2 = tr_read<(2 * 16 + 8) * VST * 2>(a0);
        s16x4 l3 = tr_read<3 * 16 * VST * 2>(a0), h3 = tr_read<(3 * 16 + 8) * VST * 2>(a0);
        wait_tr8(l0, h0, l1, h1, l2, h2, l3, h3);
        o[mt] = MFMA(__builtin_shufflevector(l0, h0, 0, 1, 2, 3, 4, 5, 6, 7), pf[0], o[mt]);
        o[mt] = MFMA(__builtin_shufflevector(l1, h1, 0, 1, 2, 3, 4, 5, 6, 7), pf[1], o[mt]);
        o[mt] = MFMA(__builtin_shufflevector(l2, h2, 0, 1, 2, 3, 4, 5, 6, 7), pf[2], o[mt]);
        o[mt] = MFMA(__builtin_shufflevector(l3, h3, 0, 1, 2, 3, 4, 5, 6, 7), pf[3], o[mt]);
      }
    }
    if (kt + 1 < kt_end) ASWRITE(buf ^ 1);
    __syncthreads();
  }
#undef AGLOAD
#undef ASWRITE
  const float l_tot = l_run + __shfl_xor(l_run, 32);
  const float inv = 1.f / l_tot;
  u16* op = obase + tq * ostride;
#pragma unroll
  for (int mt = 0; mt < NMT; ++mt)
#pragma unroll
    for (int g = 0; g < 4; ++g) {
      const int dv0 = 32 * mt + 8 * g + 4 * lh;
      *(uint2*)(op + dv0) = make_uint2(pack2(o[mt][4 * g] * inv, o[mt][4 * g + 1] * inv), pack2(o[mt][4 * g + 2] * inv, o[mt][4 * g + 3] * inv));
    }
  if (!CAUSAL && lh == 0) lsebase[tq * 8] = m_run + log2f(l_tot);
}

constexpr int N_DIFF_UNITS = 2048, N_DIL_UNITS = 6144;
__device__ void phase2_unit(const Params& p, int u, char* smem) {
  if (u < N_DIFF_UNITS) {
    const int n = 31 - (u >> 6), rem = u & 63, b = rem >> 3, hc = rem & 7, h4 = hc >> 1;
    const u16* qb = (const u16*)(p.ws + OFF_QB) + (size_t)(b * 8 + hc) * 4096 * 64;
    const u16* kb = (const u16*)(p.ws + OFF_KB) + (size_t)(b * 8 + hc) * 4096 * 64;
    const u16* vb = (const u16*)(p.ws + OFF_VB) + (size_t)(b * 4 + h4) * 4096 * 128;
    u16* ob = (u16*)(p.ws + OFF_OBC) + (size_t)b * 4096 * 1024 + hc * 128;
    attn_unit<128, true>(qb, kb, vb, n, 1, 0, ob, 1024, nullptr, smem);
  } else {
    const int u2 = u - N_DIFF_UNITS, pidx = u2 >> 11, rem = u2 & 2047, b = rem >> 8, h = (rem >> 5) & 7, rn = rem & 31;
    const int sh = 2 * pidx, dil = 1 << sh, nb = 32 >> sh, res = rn >> (5 - sh), n = rn & (nb - 1);
    const u16* qb = (const u16*)(p.ws + OFF_QA) + (size_t)(b * 8 + h) * 4096 * 64;
    const u16* kb = (const u16*)(p.ws + OFF_KA) + (size_t)(b * 8 + h) * 4096 * 64;
    const u16* vb = (const u16*)(p.ws + OFF_VA) + (size_t)(b * 8 + h) * 4096 * 64;
    u16* ob = (u16*)(p.ws + OFF_OAP) + ((size_t)pidx * T_TOK + (size_t)b * 4096) * 512 + h * 64;
    float* lse = (float*)(p.ws + OFF_LSE) + ((size_t)pidx * T_TOK + (size_t)b * 4096) * 8 + h;
    attn_unit<64, false>(qb, kb, vb, n, dil, res, ob, 512, lse, smem);
  }
}
__device__ void phase2(const Params& p, char* smem) {
  int* counter = (int*)(p.ws + OFF_MISC) + 1;
  int* s_unit = (int*)(smem + SMEM_BYTES - 16);
  while (true) {
    if (threadIdx.x == 0) *s_unit = atomicAdd(counter, 1);
    __syncthreads();
    const int u = *s_unit;
    __syncthreads();
    if (u >= N_DIFF_UNITS + N_DIL_UNITS) break;
    phase2_unit(p, u, smem);
  }
}

__device__ void phase3(const Params& p) {
  const int tid = threadIdx.x, lane = tid & 63, wid = tid >> 6;
  const int gw = blockIdx.x * 4 + wid, nw = gridDim.x * 4;
  const float lam = ((const float*)(p.ws + OFF_MISC))[0];
  const u16* oap = (const u16*)(p.ws + OFF_OAP);
  const u16* obc = (const u16*)(p.ws + OFF_OBC);
  const float* lse = (const float*)(p.ws + OFF_LSE);
  u16* mix = (u16*)(p.ws + OFF_XNB);
  for (int tok = gw; tok < T_TOK; tok += nw) {
    float o[16]; float ss = 0.f;
    if (lane < 32) {
      const int head = lane >> 2;
      float l0 = lse[(size_t)tok * 8 + head], l1 = lse[((size_t)T_TOK + tok) * 8 + head], l2 = lse[((size_t)2 * T_TOK + tok) * 8 + head];
      const float mx = fmaxf(l0, fmaxf(l1, l2));
      float w0 = exp2f(l0 - mx), w1 = exp2f(l1 - mx), w2 = exp2f(l2 - mx);
      const float inv = 1.f / (w0 + w1 + w2); w0 *= inv; w1 *= inv; w2 *= inv;
      const uint4* p0 = (const uint4*)(oap + (size_t)tok * 512 + lane * 16);
      const uint4* p1 = (const uint4*)(oap + ((size_t)T_TOK + tok) * 512 + lane * 16);
      const uint4* p2 = (const uint4*)(oap + ((size_t)2 * T_TOK + tok) * 512 + lane * 16);
#pragma unroll
      for (int c = 0; c < 2; ++c) {
        const uint4 a = p0[c], b = p1[c], d = p2[c];
        const unsigned au[4] = {a.x, a.y, a.z, a.w}, bu[4] = {b.x, b.y, b.z, b.w}, du[4] = {d.x, d.y, d.z, d.w};
#pragma unroll
        for (int k = 0; k < 4; ++k) {
          o[c * 8 + 2 * k] = w0 * bflo(au[k]) + w1 * bflo(bu[k]) + w2 * bflo(du[k]);
          o[c * 8 + 2 * k + 1] = w0 * bfhi(au[k]) + w1 * bfhi(bu[k]) + w2 * bfhi(du[k]);
        }
      }
    } else {
      const int l2 = lane - 32, head = l2 >> 3, cc = (l2 & 7) * 16;
      const uint4* p0 = (const uint4*)(obc + (size_t)tok * 1024 + (2 * head) * 128 + cc);
      const uint4* p1 = (const uint4*)(obc + (size_t)tok * 1024 + (2 * head + 1) * 128 + cc);
#pragma unroll
      for (int c = 0; c < 2; ++c) {
        const uint4 a = p0[c], b = p1[c];
        const unsigned au[4] = {a.x, a.y, a.z, a.w}, bu[4] = {b.x, b.y, b.z, b.w};
#pragma unroll
        for (int k = 0; k < 4; ++k) {
          o[c * 8 + 2 * k] = bflo(au[k]) - lam * bflo(bu[k]);
          o[c * 8 + 2 * k + 1] = bfhi(au[k]) - lam * bfhi(bu[k]);
        }
      }
    }
#pragma unroll
    for (int i = 0; i < 16; ++i) ss += o[i] * o[i];
    const float s1 = ss + __shfl_xor(ss, 1);
    const float s2 = s1 + __shfl_xor(s1, 2);
    const float s3 = s2 + __shfl_xor(s2, 4);
    float r; const float* g;
    if (lane < 32) { r = rsqrtf(s2 * (1.f / 64.f) + 1e-6f); g = p.ona + lane * 16; }
    else { r = rsqrtf(s3 * (1.f / 128.f) + 1e-6f) * 0.8f; g = p.onb + (lane - 32) * 16; }
    unsigned pk[8];
#pragma unroll
    for (int k = 0; k < 8; ++k) pk[k] = pack2(o[2 * k] * r * g[2 * k], o[2 * k + 1] * r * g[2 * k + 1]);
    uint4* dst = (uint4*)(mix + (size_t)tok * 1024 + lane * 16);
    dst[0] = make_uint4(pk[0], pk[1], pk[2], pk[3]); dst[1] = make_uint4(pk[4], pk[5], pk[6], pk[7]);
  }
}

__device__ void phase4_tile(const Params& p, int mtile, int j, char* smem) {
  f32x16 acc[2][2];
  const int m0 = mtile * 128, n0 = j * 128;
  gemm_mainloop((const u16*)(p.ws + OFF_XNB), (const u16*)(p.ws + OFF_WOUT), m0, n0, smem, acc);
  float* st = (float*)smem;
  stage_acc(acc, st);
  __syncthreads();
  const int tid = threadIdx.x, cgi = tid & 31, r0 = tid >> 5;
  float* hss = (float*)(p.ws + OFF_HSS);
  u16* hb = (u16*)(p.ws + OFF_OAP);
#pragma unroll 4
  for (int ps = 0; ps < 16; ++ps) {
    const int row = r0 + 8 * ps;
    const float4 a = *(const float4*)(st + row * 132 + cgi * 4);
    const size_t gi = (size_t)(m0 + row) * 1024 + n0 + cgi * 4;
    const float4 xv = *(const float4*)(p.x + gi);
    float4 hv; hv.x = xv.x + a.x; hv.y = xv.y + a.y; hv.z = xv.z + a.z; hv.w = xv.w + a.w;
    *(float4*)(p.out + gi) = hv;
    *(uint2*)(hb + gi) = make_uint2(pack2(hv.x, hv.y), pack2(hv.z, hv.w));
    float ss = hv.x * hv.x + hv.y * hv.y + hv.z * hv.z + hv.w * hv.w;
    ss += __shfl_xor(ss, 16); ss += __shfl_xor(ss, 8); ss += __shfl_xor(ss, 4); ss += __shfl_xor(ss, 2); ss += __shfl_xor(ss, 1);
    if (cgi == 0) atomicAdd(hss + m0 + row, ss);
  }
  __syncthreads();
}

#define TK_INSERT(xv, xi) { float x_ = (xv); int i_ = (xi); _Pragma("unroll") for (int q_ = 0; q_ < 16; ++q_) { const bool gt_ = x_ > tv[q_]; const float tvv = tv[q_]; const int tii = ti[q_]; tv[q_] = gt_ ? x_ : tvv; ti[q_] = gt_ ? i_ : tii; x_ = gt_ ? tvv : x_; i_ = gt_ ? tii : i_; } }
__device__ void phase5_tile(const Params& p, int mtile, int j, char* smem) {
  f32x16 acc[2][2];
  const int m0 = mtile * 128, n0 = j * 128;
  gemm_mainloop((const u16*)(p.ws + OFF_OAP), (const u16*)(p.ws + OFF_WPQ), m0, n0, smem, acc);
  const int tid = threadIdx.x, lane = tid & 63, w = tid >> 6, wm = w >> 1, wn = w & 1, lr = lane & 31, lh = lane >> 5;
  u16* Qs = (u16*)smem;
  u16* SKs = Qs + 128 * 136;
  float* rs = (float*)(smem + 2 * 128 * 136 * 2);
  const float* hss = (const float*)(p.ws + OFF_HSS);
  if (tid < 128) rs[tid] = rsqrtf(hss[m0 + tid] * (1.f / 1024.f) + 1e-6f);
  {
    const u16* sk = (const u16*)(p.ws + OFF_SUBK) + (size_t)j * 128 * 128;
#pragma unroll
    for (int i = 0; i < 8; ++i) { const int c = tid + 256 * i, row = c >> 4, kc = c & 15; *(uint4*)(SKs + row * 136 + kc * 8) = *(const uint4*)(sk + row * 128 + kc * 8); }
  }
  __syncthreads();
#pragma unroll
  for (int mt = 0; mt < 2; ++mt)
#pragma unroll
    for (int nt = 0; nt < 2; ++nt)
#pragma unroll
      for (int r = 0; r < 16; ++r) {
        const int row = wm * 64 + mt * 32 + crow(r, lh);
        Qs[row * 136 + wn * 64 + nt * 32 + lr] = f2bf(acc[mt][nt][r] * rs[row]);
      }
  __syncthreads();
#pragma unroll
  for (int a = 0; a < 2; ++a)
#pragma unroll
    for (int b = 0; b < 2; ++b)
#pragma unroll
      for (int r = 0; r < 16; ++r) acc[a][b][r] = 0.f;
  {
    const u16* ab = Qs + (wm * 64 + lr) * 136 + lh * 8;
    const u16* bb = SKs + (wn * 64 + lr) * 136 + lh * 8;
#pragma unroll
    for (int s = 0; s < 8; ++s) {
      const bf16x8 a0 = *(const bf16x8*)(ab + s * 16), a1 = *(const bf16x8*)(ab + 32 * 136 + s * 16);
      const bf16x8 b0 = *(const bf16x8*)(bb + s * 16), b1 = *(const bf16x8*)(bb + 32 * 136 + s * 16);
      acc[0][0] = MFMA(a0, b0, acc[0][0]); acc[0][1] = MFMA(a0, b1, acc[0][1]);
      acc[1][0] = MFMA(a1, b0, acc[1][0]); acc[1][1] = MFMA(a1, b1, acc[1][1]);
    }
  }
  __syncthreads();
  float* st = (float*)smem;
  stage_acc(acc, st);
  __syncthreads();
  const int row = tid & 127, half = tid >> 7;
  float tv[16]; int ti[16];
#pragma unroll
  for (int q = 0; q < 16; ++q) { tv[q] = NEG_INF; ti[q] = 0; }
#pragma unroll 2
  for (int c = 0; c < 16; ++c) {
    const float4 v4 = *(const float4*)(st + row * 132 + half * 64 + c * 4);
    const int bi = half * 64 + c * 4;
    TK_INSERT(v4.x, bi); TK_INSERT(v4.y, bi + 1); TK_INSERT(v4.z, bi + 2); TK_INSERT(v4.w, bi + 3);
  }
  __syncthreads();
  if (half == 1) {
#pragma unroll
    for (int q = 0; q < 16; ++q) { st[row * 132 + q] = tv[q]; st[row * 132 + 16 + q] = __int_as_float(ti[q]); }
  }
  __syncthreads();
  if (half == 0) {
#pragma unroll 2
    for (int q = 0; q < 16; ++q) { const float xv = st[row * 132 + q]; const int xi = __float_as_int(st[row * 132 + 16 + q]); TK_INSERT(xv, xi); }
    const size_t base = ((size_t)(m0 + row) * 16 + j) * 16;
    float* tops = (float*)(p.ws + OFF_TOPS) + base;
    u8* topi = (u8*)(p.ws + OFF_TOPI) + base;
#pragma unroll
    for (int c = 0; c < 4; ++c) ((float4*)tops)[c] = make_float4(tv[4 * c], tv[4 * c + 1], tv[4 * c + 2], tv[4 * c + 3]);
    unsigned pk[4];
#pragma unroll
    for (int c = 0; c < 4; ++c) pk[c] = (unsigned)ti[4 * c] | ((unsigned)ti[4 * c + 1] << 8) | ((unsigned)ti[4 * c + 2] << 16) | ((unsigned)ti[4 * c + 3] << 24);
    *(uint4*)topi = make_uint4(pk[0], pk[1], pk[2], pk[3]);
  }
  __syncthreads();
}

__device__ void phase6(const Params& p, char* smem) {
  const int tid = threadIdx.x, lane = tid & 63, wid = tid >> 6;
  const int gw = blockIdx.x * 4 + wid, nw = gridDim.x * 4;
  int* ids = (int*)(smem + wid * 1024);
  float* gts = (float*)(smem + wid * 1024 + 512);
  const float* hss = (const float*)(p.ws + OFF_HSS);
  const float* tops = (const float*)(p.ws + OFF_TOPS);
  const u8* topi = (const u8*)(p.ws + OFF_TOPI);
  const u16* ub = (const u16*)(p.ws + OFF_PUB);
  const u16* vb = (const u16*)(p.ws + OFF_PVB);
  int ci, cj;
  {
    const int L = lane;
    if (L < 16) { ci = 0; cj = L; } else if (L < 24) { ci = 1; cj = L - 16; } else if (L < 29) { ci = 2; cj = L - 24; }
    else if (L < 33) { ci = 3; cj = L - 29; } else if (L < 36) { ci = 4; cj = L - 33; } else if (L < 38) { ci = 5; cj = L - 36; }
    else if (L < 40) { ci = 6; cj = L - 38; } else if (L < 42) { ci = 7; cj = L - 40; } else if (L < 50) { ci = L - 34; cj = 0; }
    else { ci = 0; cj = 0; }
  }
  float gf[16];
  {
    const float4* gp = (const float4*)(p.g_ffn + lane * 16);
#pragma unroll
    for (int c = 0; c < 4; ++c) { const float4 t4 = gp[c]; gf[4 * c] = t4.x; gf[4 * c + 1] = t4.y; gf[4 * c + 2] = t4.z; gf[4 * c + 3] = t4.w; }
  }
  for (int tok = gw; tok < T_TOK; tok += nw) {
    const float rstd = rsqrtf(hss[tok] * (1.f / 1024.f) + 1e-6f);
    float hres[16]; unsigned hn[8];
    {
      const float4* hp = (const float4*)(p.out + (size_t)tok * 1024 + lane * 16);
#pragma unroll
      for (int c = 0; c < 4; ++c) { const float4 t4 = hp[c]; hres[4 * c] = t4.x; hres[4 * c + 1] = t4.y; hres[4 * c + 2] = t4.z; hres[4 * c + 3] = t4.w; }
#pragma unroll
      for (int k = 0; k < 8; ++k) hn[k] = pack2(hres[2 * k] * rstd * gf[2 * k], hres[2 * k + 1] * rstd * gf[2 * k + 1]);
    }
#pragma unroll 1
    for (int head = 0; head < 8; ++head) {
      const size_t b1 = ((size_t)tok * 16 + head * 2) * 16, b2 = b1 + 16;
      float sum = NEG_INF; int eid = 0;
      if (lane < 50) { sum = tops[b1 + ci] + tops[b2 + cj]; eid = (int)topi[b1 + ci] * 128 + (int)topi[b2 + cj]; }
      int rank = 0;
#pragma unroll
      for (int m = 0; m < 50; ++m) {
        const float v = __shfl(sum, m);
        rank += (v > sum || (v == sum && m < lane)) ? 1 : 0;
      }
      const float mxa = __shfl(sum, 0);
      const bool sel = (lane < 50) && (rank < 16);
      const float e = sel ? __expf(sum - mxa) : 0.f;
      const float den = wave_sum(e);
      if (sel) { ids[head * 16 + rank] = eid; gts[head * 16 + rank] = e / den; }
    }
    __builtin_amdgcn_wave_barrier();
    asm volatile("s_waitcnt lgkmcnt(0)" ::: "memory");
    float acc[16];
#pragma unroll
    for (int i = 0; i < 16; ++i) acc[i] = 0.f;
#pragma unroll 1
    for (int e0 = 0; e0 < 128; e0 += 4) {
      uint4 ur[4][2], vr[4][2]; float gate[4];
#pragma unroll
      for (int k = 0; k < 4; ++k) {
        const int id = __builtin_amdgcn_readfirstlane(ids[e0 + k]);
        gate[k] = gts[e0 + k];
        const uint4* up = (const uint4*)(ub + (size_t)id * 1024 + lane * 16);
        const uint4* vp = (const uint4*)(vb + (size_t)id * 1024 + lane * 16);
        ur[k][0] = up[0]; ur[k][1] = up[1]; vr[k][0] = vp[0]; vr[k][1] = vp[1];
      }
#pragma unroll
      for (int k = 0; k < 4; ++k) {
        const unsigned uu[8] = {ur[k][0].x, ur[k][0].y, ur[k][0].z, ur[k][0].w, ur[k][1].x, ur[k][1].y, ur[k][1].z, ur[k][1].w};
        float d = 0.f;
#pragma unroll
        for (int q = 0; q < 8; ++q) d = __builtin_amdgcn_fdot2_f32_bf16(__builtin_bit_cast(bf2_t, uu[q]), __builtin_bit_cast(bf2_t, hn[q]), d, false);
        d = wave_sum(d);
        const float a = 0.5f * d * (1.f + erff(d * 0.70710678118654752f)) * gate[k];
        const unsigned vv[8] = {vr[k][0].x, vr[k][0].y, vr[k][0].z, vr[k][0].w, vr[k][1].x, vr[k][1].y, vr[k][1].z, vr[k][1].w};
#pragma unroll
        for (int q = 0; q < 8; ++q) { acc[2 * q] += a * bflo(vv[q]); acc[2 * q + 1] += a * bfhi(vv[q]); }
      }
    }
    float4* op = (float4*)(p.out + (size_t)tok * 1024 + lane * 16);
#pragma unroll
    for (int c = 0; c < 4; ++c) op[c] = make_float4(hres[4 * c] + acc[4 * c], hres[4 * c + 1] + acc[4 * c + 1], hres[4 * c + 2] + acc[4 * c + 2], hres[4 * c + 3] + acc[4 * c + 3]);
    __builtin_amdgcn_wave_barrier();
  }
}

#if FUSED
__global__ void __launch_bounds__(256, 2) fwd_megakernel(Params p) {
  __shared__ __attribute__((aligned(16))) char smem[SMEM_BYTES];
  cg::grid_group grid = cg::this_grid();
  phase0(p, smem);
  grid.sync();
  for (int t = blockIdx.x; t < 256 * 24; t += gridDim.x) phase1_tile(p, t / 24, t % 24, smem);
  grid.sync();
  phase2(p, smem);
  grid.sync();
  phase3(p);
  grid.sync();
  for (int t = blockIdx.x; t < 256 * 8; t += gridDim.x) phase4_tile(p, t >> 3, t & 7, smem);
  grid.sync();
  for (int t = blockIdx.x; t < 256 * 16; t += gridDim.x) phase5_tile(p, t >> 4, t & 15, smem);
  grid.sync();
  phase6(p, smem);
}
#else
__global__ void __launch_bounds__(256, 2) k_p0(Params p) { __shared__ __attribute__((aligned(16))) char smem[SMEM_BYTES]; phase0(p, smem); }
__global__ void __launch_bounds__(256, 2) k_p1(Params p) { __shared__ __attribute__((aligned(16))) char smem[SMEM_BYTES]; for (int t = blockIdx.x; t < 256 * 24; t += gridDim.x) phase1_tile(p, t / 24, t % 24, smem); }
__global__ void __launch_bounds__(256, 2) k_p2(Params p) { __shared__ __attribute__((aligned(16))) char smem[SMEM_BYTES]; phase2(p, smem); }
__global__ void __launch_bounds__(256, 2) k_p3(Params p) { phase3(p); }
__global__ void __launch_bounds__(256, 2) k_p4(Params p) { __shared__ __attribute__((aligned(16))) char smem[SMEM_BYTES]; for (int t = blockIdx.x; t < 256 * 8; t += gridDim.x) phase4_tile(p, t >> 3, t & 7, smem); }
__global__ void __launch_bounds__(256, 2) k_p5(Params p) { __shared__ __attribute__((aligned(16))) char smem[SMEM_BYTES]; for (int t = blockIdx.x; t < 256 * 16; t += gridDim.x) phase5_tile(p, t >> 4, t & 15, smem); }
__global__ void __launch_bounds__(256, 2) k_p6(Params p) { __shared__ __attribute__((aligned(16))) char smem[SMEM_BYTES]; phase6(p, smem); }
#endif

extern "C" void kernel_launch(void* const* d_in, const int* in_sizes, int n_in, void* d_out, int out_size, void* d_ws, size_t ws_size,
                              hipStream_t stream) {
  Params p{};
  p.x = (const float*)d_in[0]; p.g_attn = (const float*)d_in[1]; p.w_in = (const float*)d_in[2]; p.qna = (const float*)d_in[3];
  p.kna = (const float*)d_in[4]; p.ona = (const float*)d_in[5]; p.qnb = (const float*)d_in[6]; p.knb = (const float*)d_in[7];
  p.lq1 = (const float*)d_in[8]; p.lk1 = (const float*)d_in[9]; p.lq2 = (const float*)d_in[10]; p.lk2 = (const float*)d_in[11];
  p.onb = (const float*)d_in[12]; p.w_out = (const float*)d_in[13]; p.g_ffn = (const float*)d_in[14]; p.w_pq = (const float*)d_in[15];
  p.subk = (const float*)d_in[16]; p.pu = (const float*)d_in[17]; p.pv = (const float*)d_in[18];
  p.out = (float*)d_out; p.ws = (char*)d_ws;
#if FUSED
  static int grid_blocks = 0;
  if (!grid_blocks) {
    int dev = 0, cus = 0, per_cu = 0;
    hipGetDevice(&dev);
    hipDeviceGetAttribute(&cus, hipDeviceAttributeMultiprocessorCount, dev);
    hipOccupancyMaxActiveBlocksPerMultiprocessor(&per_cu, fwd_megakernel, 256, 0);
    if (per_cu > 2) per_cu = 2;
    if (per_cu < 1) per_cu = 1;
    grid_blocks = cus * per_cu;
  }
  void* args[] = {&p};
  hipError_t e = hipLaunchCooperativeKernel((void*)fwd_megakernel, dim3(grid_blocks), dim3(256), args, 0, stream);
  if (e != hipSuccess) fprintf(stderr, "cooperative launch failed: %s (grid %d)\n", hipGetErrorString(e), grid_blocks);
#else
  const int G = 512;
  k_p0<<<G, 256, 0, stream>>>(p);
  k_p1<<<G, 256, 0, stream>>>(p);
  k_p2<<<G, 256, 0, stream>>>(p);
  k_p3<<<G, 256, 0, stream>>>(p);
  k_p4<<<G, 256, 0, stream>>>(p);
  k_p5<<<G, 256, 0, stream>>>(p);
  k_p6<<<G, 256, 0, stream>>>(p);
#endif
}
```

```cpp
#include <hip/hip_runtime.h>
#include <hip/hip_cooperative_groups.h>
#include <cstdio>
#include <cstdint>
namespace cg = cooperative_groups;

#ifndef FUSED
#define FUSED 1
#endif
#ifndef PROBE_DUP
#define PROBE_DUP 0
#endif

typedef unsigned short u16;
typedef unsigned char u8;
typedef __attribute__((ext_vector_type(8))) short bf16x8;
typedef __attribute__((ext_vector_type(4))) short s16x4;
typedef __attribute__((ext_vector_type(16))) float f32x16;
typedef __attribute__((ext_vector_type(2))) __bf16 bf2_t;
typedef __attribute__((ext_vector_type(4))) unsigned u32x4;
#define DI __device__ __forceinline__
#define MFMA(a, b, c) __builtin_amdgcn_mfma_f32_32x32x16_bf16((a), (b), (c), 0, 0, 0)

constexpr int T_TOK = 32768;
constexpr int SEQ = 4096;
constexpr size_t MB = 1u << 20;
constexpr size_t OFF_XNB = 0;
constexpr size_t OFF_QA = 64 * MB, OFF_KA = 96 * MB, OFF_VA = 128 * MB, OFF_QB = 160 * MB, OFF_KB = 192 * MB, OFF_VB = 224 * MB;
constexpr size_t OFF_TOPS = 64 * MB;
constexpr size_t OFF_TOPI = 96 * MB;
constexpr size_t OFF_OAP = 256 * MB;
constexpr size_t OFF_OBC = 352 * MB;
constexpr size_t OFF_PUB = 416 * MB, OFF_PVB = 448 * MB;
constexpr size_t OFF_WIN = 480 * MB, OFF_WOUT = 486 * MB, OFF_WPQ = 488 * MB, OFF_SUBK = 492 * MB;
constexpr size_t OFF_ROPEC = 493 * MB, OFF_ROPES = 493 * MB + 128 * 1024;
constexpr size_t OFF_LSE = 494 * MB;
constexpr size_t OFF_HSS = 497 * MB;
constexpr size_t OFF_MISC = 497 * MB + 128 * 1024;

constexpr int SMEM_BYTES = 73728;
constexpr float QSCALE = 0.125f * 1.4426950408889634f;
constexpr float NEG_INF = -__builtin_huge_valf();
constexpr float USCALE = 64.f, VSCALE = 16.f;
typedef float f32x2 __attribute__((ext_vector_type(2)));

struct Params {
  const float *x, *g_attn, *w_in, *qna, *kna, *ona, *qnb, *knb, *lq1, *lk1, *lq2, *lk2, *onb, *w_out, *g_ffn, *w_pq, *subk, *pu, *pv;
  float* out;
  char* ws;
};

DI u16 f2bf(float x) { unsigned u = __float_as_uint(x); u += 0x7fffu + ((u >> 16) & 1u); return (u16)(u >> 16); }
DI float bf2f(u16 b) { return __uint_as_float(((unsigned)b) << 16); }
DI unsigned pack2(float a, float b) { return (unsigned)f2bf(a) | ((unsigned)f2bf(b) << 16); }
DI float bflo(unsigned u) { return __uint_as_float(u << 16); }
DI float bfhi(unsigned u) { return __uint_as_float(u & 0xffff0000u); }
DI float wave_sum(float v) {
  v += __shfl_xor(v, 32); v += __shfl_xor(v, 16); v += __shfl_xor(v, 8); v += __shfl_xor(v, 4); v += __shfl_xor(v, 2); v += __shfl_xor(v, 1);
  return v;
}
DI int crow(int reg, int h) { return (reg & 3) + 8 * (reg >> 2) + 4 * h; }

__device__ void phase0(const Params& p, char* smem) {
  const int tid = threadIdx.x, lane = tid & 63, wid = tid >> 6;
  const int gw = blockIdx.x * 4 + wid, nw = gridDim.x * 4;
  const int gt = blockIdx.x * 256 + tid, nt = gridDim.x * 256;
  u16* xnb = (u16*)(p.ws + OFF_XNB);
  for (int row = gw; row < T_TOK; row += nw) {
    const float4* xr = (const float4*)(p.x + (size_t)row * 1024);
    float4 v[4]; float ss = 0.f;
#pragma unroll
    for (int i = 0; i < 4; ++i) { v[i] = xr[lane + 64 * i]; ss += v[i].x * v[i].x + v[i].y * v[i].y + v[i].z * v[i].z + v[i].w * v[i].w; }
    ss = wave_sum(ss);
    const float r = rsqrtf(ss * (1.f / 1024.f) + 1e-6f);
    uint2* dst = (uint2*)(xnb + (size_t)row * 1024);
#pragma unroll
    for (int i = 0; i < 4; ++i) dst[lane + 64 * i] = make_uint2(pack2(v[i].x * r, v[i].y * r), pack2(v[i].z * r, v[i].w * r));
  }
  float* tile = (float*)smem;
  for (int job = blockIdx.x; job < 1536; job += gridDim.x) {
    const float* W; const float* g; u16* outp; int N, j;
    if (job < 768) { W = p.w_in; g = p.g_attn; outp = (u16*)(p.ws + OFF_WIN); N = 3072; j = job; }
    else if (job < 1024) { W = p.w_out; g = nullptr; outp = (u16*)(p.ws + OFF_WOUT); N = 1024; j = job - 768; }
    else { W = p.w_pq; g = p.g_ffn; outp = (u16*)(p.ws + OFF_WPQ); N = 2048; j = job - 1024; }
    const int ntn = N >> 6, kt = j / ntn, ntile = j % ntn;
    const int tx = tid & 63, ty = tid >> 6;
#pragma unroll 4
    for (int r = 0; r < 16; ++r) {
      const int k = kt * 64 + ty + 4 * r;
      float v = W[(size_t)k * N + ntile * 64 + tx];
      if (g) v *= g[k];
      tile[(ty + 4 * r) * 65 + tx] = v;
    }
    __syncthreads();
#pragma unroll 4
    for (int r = 0; r < 16; ++r) {
      const int nl = ty + 4 * r;
      outp[(size_t)(ntile * 64 + nl) * 1024 + kt * 64 + tx] = f2bf(tile[tx * 65 + nl]);
    }
    __syncthreads();
  }
  {
    const float4* s = (const float4*)p.subk; uint2* d = (uint2*)(p.ws + OFF_SUBK);
    for (int i = gt; i < 262144 / 4; i += nt) { float4 v = s[i]; d[i] = make_uint2(pack2(v.x, v.y), pack2(v.z, v.w)); }
    const float4* su = (const float4*)p.pu; int* du = (int*)(p.ws + OFF_PUB);
    const float4* sv = (const float4*)p.pv; int* dv = (int*)(p.ws + OFF_PVB);
    for (int i = gt; i < 16384 * 1024 / 4; i += nt) {
      float4 a = su[i]; float4 b = sv[i];
      int ra = __builtin_amdgcn_cvt_pk_fp8_f32(a.x * USCALE, a.y * USCALE, 0, false);
      ra = __builtin_amdgcn_cvt_pk_fp8_f32(a.z * USCALE, a.w * USCALE, ra, true);
      int rb = __builtin_amdgcn_cvt_pk_fp8_f32(b.x * VSCALE, b.y * VSCALE, 0, false);
      rb = __builtin_amdgcn_cvt_pk_fp8_f32(b.z * VSCALE, b.w * VSCALE, rb, true);
      du[i] = ra; dv[i] = rb;
    }
  }
  {
    float* rc = (float*)(p.ws + OFF_ROPEC); float* rs = (float*)(p.ws + OFF_ROPES);
    for (int i = gt; i < SEQ * 8; i += nt) {
      const int pos = i >> 3, f = i & 7;
      const float invf = (float)pow(500000.0, -(double)f / 8.0);
      const float ang = (float)pos * invf;
      rc[i] = (float)cos((double)ang); rs[i] = (float)sin((double)ang);
    }
    float* hss = (float*)(p.ws + OFF_HSS);
    for (int i = gt; i < T_TOK; i += nt) hss[i] = 0.f;
    if (gt == 0) {
      float a = 0.f, b = 0.f;
      for (int i = 0; i < 64; ++i) { a += p.lq1[i] * p.lk1[i]; b += p.lq2[i] * p.lk2[i]; }
      float* misc = (float*)(p.ws + OFF_MISC);
      misc[0] = expf(a) - expf(b) + 0.2f;
      ((int*)misc)[1] = 0; ((int*)misc)[2] = 0;
    }
  }
}

DI void gemm_mainloop(const u16* __restrict__ A, const u16* __restrict__ Bt, int m0, int n0, char* smem, f32x16 (&acc)[2][2]) {
  u16* As = (u16*)smem;
  u16* Bs = As + 2 * 128 * 72;
  const int tid = threadIdx.x, lane = tid & 63, w = tid >> 6, wm = w >> 1, wn = w & 1, lr = lane & 31, lh = lane >> 5;
#pragma unroll
  for (int a = 0; a < 2; ++a)
#pragma unroll
    for (int b = 0; b < 2; ++b)
#pragma unroll
      for (int r = 0; r < 16; ++r) acc[a][b][r] = 0.f;
  uint4 ra[4], rb[4];
  const int lrow = tid >> 3, lkc = tid & 7;
  const u16* Ag = A + (size_t)(m0 + lrow) * 1024 + lkc * 8;
  const u16* Bg = Bt + (size_t)(n0 + lrow) * 1024 + lkc * 8;
#define GLOAD(kt) { _Pragma("unroll") for (int i = 0; i < 4; ++i) { ra[i] = *(const uint4*)(Ag + (size_t)i * 32 * 1024 + (kt) * 64); rb[i] = *(const uint4*)(Bg + (size_t)i * 32 * 1024 + (kt) * 64); } }
#define SWRITE(buf) { _Pragma("unroll") for (int i = 0; i < 4; ++i) { *(uint4*)(As + ((buf) * 128 + lrow + 32 * i) * 72 + lkc * 8) = ra[i]; *(uint4*)(Bs + ((buf) * 128 + lrow + 32 * i) * 72 + lkc * 8) = rb[i]; } }
  GLOAD(0); SWRITE(0); __syncthreads();
  for (int kt = 0; kt < 16; ++kt) {
    if (kt < 15) GLOAD(kt + 1);
    const u16* ab = As + ((kt & 1) * 128 + wm * 64 + lr) * 72 + lh * 8;
    const u16* bb = Bs + ((kt & 1) * 128 + wn * 64 + lr) * 72 + lh * 8;
#pragma unroll
    for (int s = 0; s < 4; ++s) {
      const bf16x8 a0 = *(const bf16x8*)(ab + s * 16), a1 = *(const bf16x8*)(ab + 32 * 72 + s * 16);
      const bf16x8 b0 = *(const bf16x8*)(bb + s * 16), b1 = *(const bf16x8*)(bb + 32 * 72 + s * 16);
      acc[0][0] = MFMA(a0, b0, acc[0][0]); acc[0][1] = MFMA(a0, b1, acc[0][1]);
      acc[1][0] = MFMA(a1, b0, acc[1][0]); acc[1][1] = MFMA(a1, b1, acc[1][1]);
    }
    if (kt < 15) SWRITE((kt + 1) & 1);
    __syncthreads();
  }
#undef GLOAD
#undef SWRITE
}

DI void stage_acc(const f32x16 (&acc)[2][2], float* st) {
  const int tid = threadIdx.x, lane = tid & 63, w = tid >> 6, wm = w >> 1, wn = w & 1, lr = lane & 31, lh = lane >> 5;
#pragma unroll
  for (int mt = 0; mt < 2; ++mt)
#pragma unroll
    for (int nt = 0; nt < 2; ++nt)
#pragma unroll
      for (int r = 0; r < 16; ++r) st[(wm * 64 + mt * 32 + crow(r, lh)) * 132 + wn * 64 + nt * 32 + lr] = acc[mt][nt][r];
}

__device__ void phase1_tile(const Params& p, int mtile, int j, char* smem) {
  f32x16 acc[2][2];
  const int m0 = mtile * 128, n0 = j * 128;
  gemm_mainloop((const u16*)(p.ws + OFF_XNB), (const u16*)(p.ws + OFF_WIN), m0, n0, smem, acc);
  float* st = (float*)smem;
  stage_acc(acc, st);
  __syncthreads();
  const int tid = threadIdx.x, row = tid & 127, half = tid >> 7;
  const int sec = j >> 2;
  const int tok = m0 + row, b = tok >> 12, s = tok & 4095;
  float v[64];
#pragma unroll
  for (int c = 0; c < 16; ++c) { const float4 t4 = *(const float4*)(st + row * 132 + half * 64 + c * 4); v[4 * c] = t4.x; v[4 * c + 1] = t4.y; v[4 * c + 2] = t4.z; v[4 * c + 3] = t4.w; }
  if (sec != 2 && sec != 5) {
    const float* g = sec == 0 ? p.qna : sec == 1 ? p.kna : sec == 3 ? p.qnb : p.knb;
    float ss = 0.f;
#pragma unroll
    for (int i = 0; i < 64; ++i) ss += v[i] * v[i];
    float r = rsqrtf(ss * (1.f / 64.f) + 1e-6f);
    const float post = (sec == 0 || sec == 3) ? QSCALE : 1.f;
#pragma unroll
    for (int i = 0; i < 64; ++i) v[i] = v[i] * r * g[i];
    const float* rc = (const float*)(p.ws + OFF_ROPEC) + s * 8;
    const float* rs = (const float*)(p.ws + OFF_ROPES) + s * 8;
#pragma unroll
    for (int i = 0; i < 8; ++i) {
      const float c = rc[i], sn = rs[i], x1 = v[i], x2 = v[i + 8];
      v[i] = x1 * c - x2 * sn; v[i + 8] = x2 * c + x1 * sn;
    }
#pragma unroll
    for (int i = 0; i < 64; ++i) v[i] *= post;
  }
  u16* dst;
  if (sec == 5) {
    dst = (u16*)(p.ws + OFF_VB) + ((size_t)(b * 4 + (j & 3)) * 4096 + s) * 128 + half * 64;
  } else {
    const size_t off = sec == 0 ? OFF_QA : sec == 1 ? OFF_KA : sec == 2 ? OFF_VA : sec == 3 ? OFF_QB : OFF_KB;
    const int hc = (j & 3) * 2 + half;
    dst = (u16*)(p.ws + off) + ((size_t)(b * 8 + hc) * 4096 + s) * 64;
  }
#pragma unroll
  for (int c = 0; c < 8; ++c)
    ((uint4*)dst)[c] = make_uint4(pack2(v[8 * c], v[8 * c + 1]), pack2(v[8 * c + 2], v[8 * c + 3]), pack2(v[8 * c + 4], v[8 * c + 5]), pack2(v[8 * c + 6], v[8 * c + 7]));
  __syncthreads();
}

template <int OFF> DI s16x4 tr_read(unsigned addr) {
  s16x4 r; asm volatile("ds_read_b64_tr_b16 %0, %1 offset:%2" : "=v"(r) : "v"(addr), "n"(OFF) : "memory"); return r;
}
DI void wait_tr8(s16x4& a0, s16x4& a1, s16x4& a2, s16x4& a3, s16x4& a4, s16x4& a5, s16x4& a6, s16x4& a7) {
  asm volatile("s_waitcnt lgkmcnt(0)" : "+v"(a0), "+v"(a1), "+v"(a2), "+v"(a3), "+v"(a4), "+v"(a5), "+v"(a6), "+v"(a7) : : "memory");
}

template <int DV, bool CAUSAL>
__device__ void attn_unit(const u16* __restrict__ qbase, const u16* __restrict__ kbase, const u16* __restrict__ vbase, int n, int dil, int res,
                          u16* __restrict__ obase, int ostride, float* __restrict__ lsebase, char* smem) {
  constexpr int VST = DV + 8;
  constexpr int NMT = DV / 32;
  constexpr int WMAX = CAUSAL ? (1 << 30) : 128;
  u16* Ks = (u16*)smem;
  u16* Vs = Ks + 2 * 64 * 72;
  const int tid = threadIdx.x, lane = tid & 63, w = tid >> 6, lr = lane & 31, lh = lane >> 5;
  const int kb0 = CAUSAL ? 0 : 128 * (n - 1);
  const int kt_begin = CAUSAL ? 0 : (n == 0 ? 2 : 0);
  const int kt_end = CAUSAL ? (2 * n + 2) : 4;
  const int mq = 128 * n + 32 * w + lr;
  const size_t tq = (size_t)mq * dil + res;
  bf16x8 qf[4];
  {
    const u16* qp = qbase + tq * 64 + lh * 8;
#pragma unroll
    for (int s = 0; s < 4; ++s) qf[s] = *(const bf16x8*)(qp + s * 16);
  }
  f32x16 o[NMT];
#pragma unroll
  for (int mt = 0; mt < NMT; ++mt)
#pragma unroll
    for (int r = 0; r < 16; ++r) o[mt][r] = 0.f;
  float m_run = NEG_INF, l_run = 0.f;
  uint4 rk0, rk1, rv0, rv1, rv2, rv3;
  rv2 = rv3 = make_uint4(0, 0, 0, 0);
  const int krow_ = tid >> 3, kkc = tid & 7;
  constexpr int VCPR = DV / 8;
  const int vrow = tid / VCPR, vkc = tid % VCPR;
  constexpr int VRSTEP = 256 / VCPR;
  const u16* kgp = kbase + ((size_t)(kb0 + krow_) * dil + res) * 64 + kkc * 8;
  const u16* vgp = vbase + ((size_t)(kb0 + vrow) * dil + res) * DV + vkc * 8;
  const size_t kstep32 = (size_t)32 * dil * 64, kstep64 = (size_t)64 * dil * 64;
  const size_t vstepr = (size_t)VRSTEP * dil * DV, vstep64 = (size_t)64 * dil * DV;
  u16* ksw = Ks + krow_ * 72 + kkc * 8;
  u16* vsw = Vs + vrow * VST + vkc * 8;
#define AGLOAD(kt) { const u16* kp_ = kgp + (size_t)(kt) * kstep64; rk0 = *(const uint4*)kp_; rk1 = *(const uint4*)(kp_ + kstep32); \
    const u16* vp_ = vgp + (size_t)(kt) * vstep64; rv0 = *(const uint4*)vp_; rv1 = *(const uint4*)(vp_ + vstepr); \
    if (NMT == 4) { rv2 = *(const uint4*)(vp_ + 2 * vstepr); rv3 = *(const uint4*)(vp_ + 3 * vstepr); } }
#define ASWRITE(buf) { *(uint4*)(ksw + (buf) * 64 * 72) = rk0; *(uint4*)(ksw + (buf) * 64 * 72 + 32 * 72) = rk1; \
    *(uint4*)(vsw + (buf) * 64 * VST) = rv0; *(uint4*)(vsw + (buf) * 64 * VST + VRSTEP * VST) = rv1; \
    if (NMT == 4) { *(uint4*)(vsw + (buf) * 64 * VST + 2 * VRSTEP * VST) = rv2; *(uint4*)(vsw + (buf) * 64 * VST + 3 * VRSTEP * VST) = rv3; } }
  AGLOAD(kt_begin); ASWRITE(0); __syncthreads();
  const int li = lane & 31, blk = li >> 4, tq_ = (li >> 2) & 3, tp = li & 3;
  for (int kt = kt_begin; kt < kt_end; ++kt) {
    const int buf = (kt - kt_begin) & 1;
    if (kt + 1 < kt_end) AGLOAD(kt + 1);
    const int k_lo = kb0 + 64 * kt, q_lo = 128 * n + 32 * w;
    const int dmin = q_lo - (k_lo + 63), dmax = q_lo + 31 - k_lo;
    const bool skip = (dmax < 0) || (dmin > WMAX);
    if (!skip) {
      const bool need_mask = (dmin < 0) || (dmax > WMAX);
      const u16* kb = Ks + (buf * 64 + lr) * 72 + lh * 8;
      f32x16 st[2];
#pragma unroll
      for (int kk = 0; kk < 2; ++kk) {
#pragma unroll
        for (int r = 0; r < 16; ++r) st[kk][r] = 0.f;
#pragma unroll
        for (int s = 0; s < 4; ++s) { const bf16x8 a = *(const bf16x8*)(kb + kk * 32 * 72 + s * 16); st[kk] = MFMA(a, qf[s], st[kk]); }
      }
      if (need_mask) {
#pragma unroll
        for (int kk = 0; kk < 2; ++kk)
#pragma unroll
          for (int r = 0; r < 16; ++r) {
            const int d = mq - (k_lo + 32 * kk + crow(r, lh));
            if (d < 0 || d > WMAX) st[kk][r] = NEG_INF;
          }
      }
      float mx = NEG_INF;
#pragma unroll
      for (int kk = 0; kk < 2; ++kk)
#pragma unroll
        for (int r = 0; r < 16; ++r) mx = fmaxf(mx, st[kk][r]);
      mx = fmaxf(mx, __shfl_xor(mx, 32));
      const float m_new = fmaxf(m_run, mx);
      const float m_use = (m_new == NEG_INF) ? 0.f : m_new;
      const float alpha = exp2f(m_run - m_use);
      float ls = 0.f;
#pragma unroll
      for (int kk = 0; kk < 2; ++kk)
#pragma unroll
        for (int r = 0; r < 16; ++r) { const float e = exp2f(st[kk][r] - m_use); st[kk][r] = e; ls += e; }
      l_run = l_run * alpha + ls; m_run = m_new;
#pragma unroll
      for (int mt = 0; mt < NMT; ++mt)
#pragma unroll
        for (int r = 0; r < 16; ++r) o[mt][r] *= alpha;
      bf16x8 pf[4];
#pragma unroll
      for (int ks = 0; ks < 4; ++ks) {
        const int kk = ks >> 1, s2 = ks & 1;
        u32x4 cv;
        cv[0] = pack2(st[kk][8 * s2 + 0], st[kk][8 * s2 + 1]); cv[1] = pack2(st[kk][8 * s2 + 2], st[kk][8 * s2 + 3]);
        cv[2] = pack2(st[kk][8 * s2 + 4], st[kk][8 * s2 + 5]); cv[3] = pack2(st[kk][8 * s2 + 6], st[kk][8 * s2 + 7]);
        pf[ks] = __builtin_bit_cast(bf16x8, cv);
      }
      const unsigned vaddr = (unsigned)(size_t)(Vs + (buf * 64 + 4 * lh + tq_) * VST + 16 * blk + 4 * tp);
#pragma unroll
      for (int mt = 0; mt < NMT; ++mt) {
        const unsigned a0 = vaddr + mt * 64;
        s16x4 l0 = tr_read<0 * 16 * VST * 2>(a0), h0 = tr_read<(0 * 16 + 8) * VST * 2>(a0);
        s16x4 l1 = tr_read<1 * 16 * VST * 2>(a0), h1 = tr_read<(1 * 16 + 8) * VST * 2>(a0);
        s16x4 l2 = tr_read<2 * 16 * VST * 2>(a0), h2 = tr_read<(2 * 16 + 8) * VST * 2>(a0);
        s16x4 l3 = tr_read<3 * 16 * VST * 2>(a0), h3 = tr_read<(3 * 16 + 8) * VST * 2>(a0);
        wait_tr8(l0, h0, l1, h1, l2, h2, l3, h3);
        o[mt] = MFMA(__builtin_shufflevector(l0, h0, 0, 1, 2, 3, 4, 5, 6, 7), pf[0], o[mt]);
        o[mt] = MFMA(__builtin_shufflevector(l1, h1, 0, 1, 2, 3, 4, 5, 6, 7), pf[1], o[mt]);
        o[mt] = MFMA(__builtin_shufflevector(l2, h2, 0, 1, 2, 3, 4, 5, 6, 7), pf[2], o[mt]);
        o[mt] = MFMA(__builtin_shufflevector(l3, h3, 0, 1, 2, 3, 4, 5, 6, 7), pf[3], o[mt]);
      }
    }
    if (kt + 1 < kt_end) ASWRITE(buf ^ 1);
    __syncthreads();
  }
#undef AGLOAD
#undef ASWRITE
  const float l_tot = l_run + __shfl_xor(l_run, 32);
  const float inv = 1.f / l_tot;
  u16* op = obase + tq * ostride;
#pragma unroll
  for (int mt = 0; mt < NMT; ++mt)
#pragma unroll
    for (int g = 0; g < 4; ++g) {
      const int dv0 = 32 * mt + 8 * g + 4 * lh;
      *(uint2*)(op + dv0) = make_uint2(pack2(o[mt][4 * g] * inv, o[mt][4 * g + 1] * inv), pack2(o[mt][4 * g + 2] * inv, o[mt][4 * g + 3] * inv));
    }
  if (!CAUSAL && lh == 0) lsebase[tq * 8] = m_run + log2f(l_tot);
}

constexpr int N_DIFF_UNITS = 2048, N_DIL_UNITS = 6144;
__device__ void phase2_unit(const Params& p, int u, char* smem) {
  if (u < N_DIFF_UNITS) {
    const int n = 31 - (u >> 6), rem = u & 63, b = rem >> 3, hc = rem & 7, h4 = hc >> 1;
    const u16* qb = (const u16*)(p.ws + OFF_QB) + (size_t)(b * 8 + hc) * 4096 * 64;
    const u16* kb = (const u16*)(p.ws + OFF_KB) + (size_t)(b * 8 + hc) * 4096 * 64;
    const u16* vb = (const u16*)(p.ws + OFF_VB) + (size_t)(b * 4 + h4) * 4096 * 128;
    u16* ob = (u16*)(p.ws + OFF_OBC) + (size_t)b * 4096 * 1024 + hc * 128;
    attn_unit<128, true>(qb, kb, vb, n, 1, 0, ob, 1024, nullptr, smem);
  } else {
    const int u2 = u - N_DIFF_UNITS, pidx = u2 >> 11, rem = u2 & 2047, b = rem >> 8, h = (rem >> 5) & 7, rn = rem & 31;
    const int sh = 2 * pidx, dil = 1 << sh, nb = 32 >> sh, res = rn >> (5 - sh), n = rn & (nb - 1);
    const u16* qb = (const u16*)(p.ws + OFF_QA) + (size_t)(b * 8 + h) * 4096 * 64;
    const u16* kb = (const u16*)(p.ws + OFF_KA) + (size_t)(b * 8 + h) * 4096 * 64;
    const u16* vb = (const u16*)(p.ws + OFF_VA) + (size_t)(b * 8 + h) * 4096 * 64;
    u16* ob = (u16*)(p.ws + OFF_OAP) + ((size_t)pidx * T_TOK + (size_t)b * 4096) * 512 + h * 64;
    float* lse = (float*)(p.ws + OFF_LSE) + ((size_t)pidx * T_TOK + (size_t)b * 4096) * 8 + h;
    attn_unit<64, false>(qb, kb, vb, n, dil, res, ob, 512, lse, smem);
  }
}
__device__ void phase2(const Params& p, char* smem, int slot = 1) {
  int* counter = (int*)(p.ws + OFF_MISC) + slot;
  int* s_unit = (int*)(smem + SMEM_BYTES - 16);
  while (true) {
    if (threadIdx.x == 0) *s_unit = atomicAdd(counter, 1);
    __syncthreads();
    const int u = *s_unit;
    __syncthreads();
    if (u >= N_DIFF_UNITS + N_DIL_UNITS) break;
    phase2_unit(p, u, smem);
  }
}

__device__ void phase3(const Params& p) {
  const int tid = threadIdx.x, lane = tid & 63, wid = tid >> 6;
  const int gw = blockIdx.x * 4 + wid, nw = gridDim.x * 4;
  const float lam = ((const float*)(p.ws + OFF_MISC))[0];
  const u16* oap = (const u16*)(p.ws + OFF_OAP);
  const u16* obc = (const u16*)(p.ws + OFF_OBC);
  const float* lse = (const float*)(p.ws + OFF_LSE);
  u16* mix = (u16*)(p.ws + OFF_XNB);
  for (int tok = gw; tok < T_TOK; tok += nw) {
    float o[16]; float ss = 0.f;
    if (lane < 32) {
      const int head = lane >> 2;
      float l0 = lse[(size_t)tok * 8 + head], l1 = lse[((size_t)T_TOK + tok) * 8 + head], l2 = lse[((size_t)2 * T_TOK + tok) * 8 + head];
      const float mx = fmaxf(l0, fmaxf(l1, l2));
      float w0 = exp2f(l0 - mx), w1 = exp2f(l1 - mx), w2 = exp2f(l2 - mx);
      const float inv = 1.f / (w0 + w1 + w2); w0 *= inv; w1 *= inv; w2 *= inv;
      const uint4* p0 = (const uint4*)(oap + (size_t)tok * 512 + lane * 16);
      const uint4* p1 = (const uint4*)(oap + ((size_t)T_TOK + tok) * 512 + lane * 16);
      const uint4* p2 = (const uint4*)(oap + ((size_t)2 * T_TOK + tok) * 512 + lane * 16);
#pragma unroll
      for (int c = 0; c < 2; ++c) {
        const uint4 a = p0[c], b = p1[c], d = p2[c];
        const unsigned au[4] = {a.x, a.y, a.z, a.w}, bu[4] = {b.x, b.y, b.z, b.w}, du[4] = {d.x, d.y, d.z, d.w};
#pragma unroll
        for (int k = 0; k < 4; ++k) {
          o[c * 8 + 2 * k] = w0 * bflo(au[k]) + w1 * bflo(bu[k]) + w2 * bflo(du[k]);
          o[c * 8 + 2 * k + 1] = w0 * bfhi(au[k]) + w1 * bfhi(bu[k]) + w2 * bfhi(du[k]);
        }
      }
    } else {
      const int l2 = lane - 32, head = l2 >> 3, cc = (l2 & 7) * 16;
      const uint4* p0 = (const uint4*)(obc + (size_t)tok * 1024 + (2 * head) * 128 + cc);
      const uint4* p1 = (const uint4*)(obc + (size_t)tok * 1024 + (2 * head + 1) * 128 + cc);
#pragma unroll
      for (int c = 0; c < 2; ++c) {
        const uint4 a = p0[c], b = p1[c];
        const unsigned au[4] = {a.x, a.y, a.z, a.w}, bu[4] = {b.x, b.y, b.z, b.w};
#pragma unroll
        for (int k = 0; k < 4; ++k) {
          o[c * 8 + 2 * k] = bflo(au[k]) - lam * bflo(bu[k]);
          o[c * 8 + 2 * k + 1] = bfhi(au[k]) - lam * bfhi(bu[k]);
        }
      }
    }
#pragma unroll
    for (int i = 0; i < 16; ++i) ss += o[i] * o[i];
    const float s1 = ss + __shfl_xor(ss, 1);
    const float s2 = s1 + __shfl_xor(s1, 2);
    const float s3 = s2 + __shfl_xor(s2, 4);
    float r; const float* g;
    if (lane < 32) { r = rsqrtf(s2 * (1.f / 64.f) + 1e-6f); g = p.ona + lane * 16; }
    else { r = rsqrtf(s3 * (1.f / 128.f) + 1e-6f) * 0.8f; g = p.onb + (lane - 32) * 16; }
    unsigned pk[8];
#pragma unroll
    for (int k = 0; k < 8; ++k) pk[k] = pack2(o[2 * k] * r * g[2 * k], o[2 * k + 1] * r * g[2 * k + 1]);
    uint4* dst = (uint4*)(mix + (size_t)tok * 1024 + lane * 16);
    dst[0] = make_uint4(pk[0], pk[1], pk[2], pk[3]); dst[1] = make_uint4(pk[4], pk[5], pk[6], pk[7]);
  }
}

__device__ void phase4_tile(const Params& p, int mtile, int j, char* smem) {
  f32x16 acc[2][2];
  const int m0 = mtile * 128, n0 = j * 128;
  gemm_mainloop((const u16*)(p.ws + OFF_XNB), (const u16*)(p.ws + OFF_WOUT), m0, n0, smem, acc);
  float* st = (float*)smem;
  stage_acc(acc, st);
  __syncthreads();
  const int tid = threadIdx.x, cgi = tid & 31, r0 = tid >> 5;
  float* hss = (float*)(p.ws + OFF_HSS);
  u16* hb = (u16*)(p.ws + OFF_OAP);
#pragma unroll 4
  for (int ps = 0; ps < 16; ++ps) {
    const int row = r0 + 8 * ps;
    const float4 a = *(const float4*)(st + row * 132 + cgi * 4);
    const size_t gi = (size_t)(m0 + row) * 1024 + n0 + cgi * 4;
    const float4 xv = *(const float4*)(p.x + gi);
    float4 hv; hv.x = xv.x + a.x; hv.y = xv.y + a.y; hv.z = xv.z + a.z; hv.w = xv.w + a.w;
    *(float4*)(p.out + gi) = hv;
    *(uint2*)(hb + gi) = make_uint2(pack2(hv.x, hv.y), pack2(hv.z, hv.w));
    float ss = hv.x * hv.x + hv.y * hv.y + hv.z * hv.z + hv.w * hv.w;
    ss += __shfl_xor(ss, 16); ss += __shfl_xor(ss, 8); ss += __shfl_xor(ss, 4); ss += __shfl_xor(ss, 2); ss += __shfl_xor(ss, 1);
    if (cgi == 0) atomicAdd(hss + m0 + row, ss);
  }
  __syncthreads();
}

#define TK_INSERT(xv, xi) { float x_ = (xv); int i_ = (xi); _Pragma("unroll") for (int q_ = 0; q_ < 16; ++q_) { const bool gt_ = x_ > tv[q_]; const float tvv = tv[q_]; const int tii = ti[q_]; tv[q_] = gt_ ? x_ : tvv; ti[q_] = gt_ ? i_ : tii; x_ = gt_ ? tvv : x_; i_ = gt_ ? tii : i_; } }
__device__ void phase5_tile(const Params& p, int mtile, int j, char* smem) {
  f32x16 acc[2][2];
  const int m0 = mtile * 128, n0 = j * 128;
  gemm_mainloop((const u16*)(p.ws + OFF_OAP), (const u16*)(p.ws + OFF_WPQ), m0, n0, smem, acc);
  const int tid = threadIdx.x, lane = tid & 63, w = tid >> 6, wm = w >> 1, wn = w & 1, lr = lane & 31, lh = lane >> 5;
  u16* Qs = (u16*)smem;
  u16* SKs = Qs + 128 * 136;
  float* rs = (float*)(smem + 2 * 128 * 136 * 2);
  const float* hss = (const float*)(p.ws + OFF_HSS);
  if (tid < 128) rs[tid] = rsqrtf(hss[m0 + tid] * (1.f / 1024.f) + 1e-6f);
  {
    const u16* sk = (const u16*)(p.ws + OFF_SUBK) + (size_t)j * 128 * 128;
#pragma unroll
    for (int i = 0; i < 8; ++i) { const int c = tid + 256 * i, row = c >> 4, kc = c & 15; *(uint4*)(SKs + row * 136 + kc * 8) = *(const uint4*)(sk + row * 128 + kc * 8); }
  }
  __syncthreads();
#pragma unroll
  for (int mt = 0; mt < 2; ++mt)
#pragma unroll
    for (int nt = 0; nt < 2; ++nt)
#pragma unroll
      for (int r = 0; r < 16; ++r) {
        const int row = wm * 64 + mt * 32 + crow(r, lh);
        Qs[row * 136 + wn * 64 + nt * 32 + lr] = f2bf(acc[mt][nt][r] * rs[row]);
      }
  __syncthreads();
#pragma unroll
  for (int a = 0; a < 2; ++a)
#pragma unroll
    for (int b = 0; b < 2; ++b)
#pragma unroll
      for (int r = 0; r < 16; ++r) acc[a][b][r] = 0.f;
  {
    const u16* ab = Qs + (wm * 64 + lr) * 136 + lh * 8;
    const u16* bb = SKs + (wn * 64 + lr) * 136 + lh * 8;
#pragma unroll
    for (int s = 0; s < 8; ++s) {
      const bf16x8 a0 = *(const bf16x8*)(ab + s * 16), a1 = *(const bf16x8*)(ab + 32 * 136 + s * 16);
      const bf16x8 b0 = *(const bf16x8*)(bb + s * 16), b1 = *(const bf16x8*)(bb + 32 * 136 + s * 16);
      acc[0][0] = MFMA(a0, b0, acc[0][0]); acc[0][1] = MFMA(a0, b1, acc[0][1]);
      acc[1][0] = MFMA(a1, b0, acc[1][0]); acc[1][1] = MFMA(a1, b1, acc[1][1]);
    }
  }
  __syncthreads();
  float* st = (float*)smem;
  stage_acc(acc, st);
  __syncthreads();
  const int row = tid & 127, half = tid >> 7;
  float tv[16]; int ti[16];
#pragma unroll
  for (int q = 0; q < 16; ++q) { tv[q] = NEG_INF; ti[q] = 0; }
#pragma unroll 2
  for (int c = 0; c < 16; ++c) {
    const float4 v4 = *(const float4*)(st + row * 132 + half * 64 + c * 4);
    const int bi = half * 64 + c * 4;
    TK_INSERT(v4.x, bi); TK_INSERT(v4.y, bi + 1); TK_INSERT(v4.z, bi + 2); TK_INSERT(v4.w, bi + 3);
  }
  __syncthreads();
  if (half == 1) {
#pragma unroll
    for (int q = 0; q < 16; ++q) { st[row * 132 + q] = tv[q]; st[row * 132 + 16 + q] = __int_as_float(ti[q]); }
  }
  __syncthreads();
  if (half == 0) {
#pragma unroll 2
    for (int q = 0; q < 16; ++q) { const float xv = st[row * 132 + q]; const int xi = __float_as_int(st[row * 132 + 16 + q]); TK_INSERT(xv, xi); }
    const size_t base = ((size_t)(m0 + row) * 16 + j) * 16;
    float* tops = (float*)(p.ws + OFF_TOPS) + base;
    u8* topi = (u8*)(p.ws + OFF_TOPI) + base;
#pragma unroll
    for (int c = 0; c < 4; ++c) ((float4*)tops)[c] = make_float4(tv[4 * c], tv[4 * c + 1], tv[4 * c + 2], tv[4 * c + 3]);
    unsigned pk[4];
#pragma unroll
    for (int c = 0; c < 4; ++c) pk[c] = (unsigned)ti[4 * c] | ((unsigned)ti[4 * c + 1] << 8) | ((unsigned)ti[4 * c + 2] << 16) | ((unsigned)ti[4 * c + 3] << 24);
    *(uint4*)topi = make_uint4(pk[0], pk[1], pk[2], pk[3]);
  }
  __syncthreads();
}

DI float dpp_xor1(float v) { return __builtin_bit_cast(float, __builtin_amdgcn_update_dpp(0, __builtin_bit_cast(int, v), 0xB1, 0xF, 0xF, true)); }
DI float dpp_xor2(float v) { return __builtin_bit_cast(float, __builtin_amdgcn_update_dpp(0, __builtin_bit_cast(int, v), 0x4E, 0xF, 0xF, true)); }
template <int PAT> DI float swz(float v) { return __builtin_bit_cast(float, __builtin_amdgcn_ds_swizzle(__builtin_bit_cast(int, v), PAT)); }
DI float treduce8(const float (&pp)[8], int lane) {
  const bool b0 = lane & 1, b1 = lane & 2, b2 = lane & 4;
  float q[4];
#pragma unroll
  for (int i = 0; i < 4; ++i) { const float keep = b0 ? pp[2 * i + 1] : pp[2 * i], send = b0 ? pp[2 * i] : pp[2 * i + 1]; q[i] = keep + dpp_xor1(send); }
  float r[2];
#pragma unroll
  for (int i = 0; i < 2; ++i) { const float keep = b1 ? q[2 * i + 1] : q[2 * i], send = b1 ? q[2 * i] : q[2 * i + 1]; r[i] = keep + dpp_xor2(send); }
  float t = (b2 ? r[1] : r[0]) + swz<0x101F>(b2 ? r[0] : r[1]);
  t += swz<0x201F>(t); t += swz<0x401F>(t); t += __shfl_xor(t, 32);
  return t;
}
DI float udot16(const uint4& w, const float (&h)[16]) {
  f32x2 acc = {0.f, 0.f};
  const int ww[4] = {(int)w.x, (int)w.y, (int)w.z, (int)w.w};
#pragma unroll
  for (int j = 0; j < 4; ++j) {
    const f32x2 lo = __builtin_amdgcn_cvt_pk_f32_fp8(ww[j], false), hi = __builtin_amdgcn_cvt_pk_f32_fp8(ww[j], true);
    const f32x2 h0 = {h[4 * j], h[4 * j + 1]}, h1 = {h[4 * j + 2], h[4 * j + 3]};
    acc += lo * h0; acc += hi * h1;
  }
  return acc.x + acc.y;
}
DI void vacc16(const uint4& w, float a, f32x2 (&acc)[8]) {
  const f32x2 a2 = {a, a};
  const int ww[4] = {(int)w.x, (int)w.y, (int)w.z, (int)w.w};
#pragma unroll
  for (int j = 0; j < 4; ++j) {
    acc[2 * j] += a2 * __builtin_amdgcn_cvt_pk_f32_fp8(ww[j], false);
    acc[2 * j + 1] += a2 * __builtin_amdgcn_cvt_pk_f32_fp8(ww[j], true);
  }
}
#define LOAD8(buf, tbl, bidx) { const uint4 i0_ = *(const uint4*)(ids + 8 * (bidx)), i1_ = *(const uint4*)(ids + 8 * (bidx) + 4); \
    const unsigned idv_[8] = {i0_.x, i0_.y, i0_.z, i0_.w, i1_.x, i1_.y, i1_.z, i1_.w}; \
    _Pragma("unroll") for (int k_ = 0; k_ < 8; ++k_) { const unsigned id_ = __builtin_amdgcn_readfirstlane(idv_[k_]); buf[k_] = *(const uint4*)((tbl) + (size_t)id_ * 1024 + lane * 16); } }

__device__ void phase6(const Params& p, char* smem, float* dstbase) {
  const int tid = threadIdx.x, lane = tid & 63, wid = tid >> 6;
  const int gw = blockIdx.x * 4 + wid, nw = gridDim.x * 4;
  int* ids = (int*)(smem + wid * 1024);
  float* gts = (float*)(smem + wid * 1024 + 512);
  const float* hss = (const float*)(p.ws + OFF_HSS);
  const float* tops = (const float*)(p.ws + OFF_TOPS);
  const u8* topi = (const u8*)(p.ws + OFF_TOPI);
  const u8* ub = (const u8*)(p.ws + OFF_PUB);
  const u8* vb = (const u8*)(p.ws + OFF_PVB);
  int ci, cj;
  {
    const int L = lane;
    if (L < 16) { ci = 0; cj = L; } else if (L < 24) { ci = 1; cj = L - 16; } else if (L < 29) { ci = 2; cj = L - 24; }
    else if (L < 33) { ci = 3; cj = L - 29; } else if (L < 36) { ci = 4; cj = L - 33; } else if (L < 38) { ci = 5; cj = L - 36; }
    else if (L < 40) { ci = 6; cj = L - 38; } else if (L < 42) { ci = 7; cj = L - 40; } else if (L < 50) { ci = L - 34; cj = 0; }
    else { ci = 0; cj = 0; }
  }
  for (int tok = gw; tok < T_TOK; tok += nw) {
    const float rstd = rsqrtf(hss[tok] * (1.f / 1024.f) + 1e-6f);
    float hres[16], hn[16];
    {
      const float4* hp = (const float4*)(p.out + (size_t)tok * 1024 + lane * 16);
      const float4* gp = (const float4*)(p.g_ffn + lane * 16);
#pragma unroll
      for (int c = 0; c < 4; ++c) {
        const float4 t4 = hp[c], g4 = gp[c];
        hres[4 * c] = t4.x; hres[4 * c + 1] = t4.y; hres[4 * c + 2] = t4.z; hres[4 * c + 3] = t4.w;
        hn[4 * c] = t4.x * rstd * g4.x; hn[4 * c + 1] = t4.y * rstd * g4.y; hn[4 * c + 2] = t4.z * rstd * g4.z; hn[4 * c + 3] = t4.w * rstd * g4.w;
      }
    }
#pragma unroll 1
    for (int head = 0; head < 8; ++head) {
      const size_t b1 = ((size_t)tok * 16 + head * 2) * 16, b2 = b1 + 16;
      float sum = NEG_INF; int eid = 0;
      if (lane < 50) { sum = tops[b1 + ci] + tops[b2 + cj]; eid = (int)topi[b1 + ci] * 128 + (int)topi[b2 + cj]; }
      int rank = 0;
#pragma unroll
      for (int m = 0; m < 50; ++m) {
        const float v = __builtin_bit_cast(float, __builtin_amdgcn_readlane(__builtin_bit_cast(int, sum), m));
        rank += (v > sum || (v == sum && m < lane)) ? 1 : 0;
      }
      const float mxa = __builtin_bit_cast(float, __builtin_amdgcn_readlane(__builtin_bit_cast(int, sum), 0));
      const bool sel = (lane < 50) && (rank < 16);
      const float e = sel ? __expf(sum - mxa) : 0.f;
      const float den = wave_sum(e);
      if (sel) { ids[head * 16 + rank] = eid; gts[head * 16 + rank] = e / den; }
    }
    __builtin_amdgcn_wave_barrier();
    asm volatile("s_waitcnt lgkmcnt(0)" ::: "memory");
    float dsel0 = 0.f, dsel1 = 0.f;
    {
      uint4 ba[8], bb[8];
      LOAD8(ba, ub, 0);
#pragma unroll 1
      for (int b = 0; b < 16; b += 2) {
        LOAD8(bb, ub, b + 1);
        {
          float pp[8];
#pragma unroll
          for (int k = 0; k < 8; ++k) pp[k] = udot16(ba[k], hn);
          const float t = treduce8(pp, lane);
          if ((lane >> 3) == (b & 7)) { if (b < 8) dsel0 = t; else dsel1 = t; }
        }
        if (b + 2 < 16) LOAD8(ba, ub, b + 2);
        {
          float pp[8];
#pragma unroll
          for (int k = 0; k < 8; ++k) pp[k] = udot16(bb[k], hn);
          const float t = treduce8(pp, lane);
          if ((lane >> 3) == ((b + 1) & 7)) { if (b < 8) dsel0 = t; else dsel1 = t; }
        }
      }
    }
    {
      const float d0 = dsel0 * (1.f / USCALE), d1 = dsel1 * (1.f / USCALE);
      const float a0 = 0.5f * d0 * (1.f + erff(d0 * 0.70710678118654752f)) * gts[lane] * (1.f / VSCALE);
      const float a1 = 0.5f * d1 * (1.f + erff(d1 * 0.70710678118654752f)) * gts[64 + lane] * (1.f / VSCALE);
      gts[lane] = a0; gts[64 + lane] = a1;
    }
    __builtin_amdgcn_wave_barrier();
    asm volatile("s_waitcnt lgkmcnt(0)" ::: "memory");
    f32x2 acc[8];
#pragma unroll
    for (int i = 0; i < 8; ++i) acc[i] = (f32x2){0.f, 0.f};
    {
      uint4 ba[8], bb[8];
      LOAD8(ba, vb, 0);
#pragma unroll 1
      for (int b = 0; b < 16; b += 2) {
        LOAD8(bb, vb, b + 1);
        {
          const float4 g0 = *(const float4*)(gts + 8 * b), g1 = *(const float4*)(gts + 8 * b + 4);
          vacc16(ba[0], g0.x, acc); vacc16(ba[1], g0.y, acc); vacc16(ba[2], g0.z, acc); vacc16(ba[3], g0.w, acc);
          vacc16(ba[4], g1.x, acc); vacc16(ba[5], g1.y, acc); vacc16(ba[6], g1.z, acc); vacc16(ba[7], g1.w, acc);
        }
        if (b + 2 < 16) LOAD8(ba, vb, b + 2);
        {
          const float4 g0 = *(const float4*)(gts + 8 * b + 8), g1 = *(const float4*)(gts + 8 * b + 12);
          vacc16(bb[0], g0.x, acc); vacc16(bb[1], g0.y, acc); vacc16(bb[2], g0.z, acc); vacc16(bb[3], g0.w, acc);
          vacc16(bb[4], g1.x, acc); vacc16(bb[5], g1.y, acc); vacc16(bb[6], g1.z, acc); vacc16(bb[7], g1.w, acc);
        }
      }
    }
    float4* op = (float4*)(dstbase + (size_t)tok * 1024 + lane * 16);
#pragma unroll
    for (int c = 0; c < 4; ++c) op[c] = make_float4(hres[4 * c] + acc[2 * c].x, hres[4 * c + 1] + acc[2 * c].y, hres[4 * c + 2] + acc[2 * c + 1].x, hres[4 * c + 3] + acc[2 * c + 1].y);
    __builtin_amdgcn_wave_barrier();
  }
}

#if FUSED
__global__ void __launch_bounds__(256, 2) fwd_megakernel(Params p) {
  __shared__ __attribute__((aligned(16))) char smem[SMEM_BYTES];
  cg::grid_group grid = cg::this_grid();
  phase0(p, smem);
  grid.sync();
  for (int t = blockIdx.x; t < 256 * 24; t += gridDim.x) phase1_tile(p, t / 24, t % 24, smem);
  grid.sync();
#if PROBE_DUP == 1
  for (int t = blockIdx.x; t < 256 * 24; t += gridDim.x) phase1_tile(p, t / 24, t % 24, smem);
  grid.sync();
#endif
#if PROBE_DUP == 2
  phase2(p, smem, 2);
  grid.sync();
#endif
  phase2(p, smem);
  grid.sync();
  phase3(p);
  grid.sync();
  for (int t = blockIdx.x; t < 256 * 8; t += gridDim.x) phase4_tile(p, t >> 3, t & 7, smem);
  grid.sync();
  for (int t = blockIdx.x; t < 256 * 16; t += gridDim.x) phase5_tile(p, t >> 4, t & 15, smem);
  grid.sync();
#if PROBE_DUP == 5
  for (int t = blockIdx.x; t < 256 * 16; t += gridDim.x) phase5_tile(p, t >> 4, t & 15, smem);
  grid.sync();
#endif
#if PROBE_DUP == 6
  phase6(p, smem, (float*)(p.ws + OFF_OAP));
  grid.sync();
#endif
  phase6(p, smem, p.out);
}
#else
__global__ void __launch_bounds__(256, 2) k_p0(Params p) { __shared__ __attribute__((aligned(16))) char smem[SMEM_BYTES]; phase0(p, smem); }
__global__ void __launch_bounds__(256, 2) k_p1(Params p) { __shared__ __attribute__((aligned(16))) char smem[SMEM_BYTES]; for (int t = blockIdx.x; t < 256 * 24; t += gridDim.x) phase1_tile(p, t / 24, t % 24, smem); }
__global__ void __launch_bounds__(256, 2) k_p2(Params p) { __shared__ __attribute__((aligned(16))) char smem[SMEM_BYTES]; phase2(p, smem); }
__global__ void __launch_bounds__(256, 2) k_p3(Params p) { phase3(p); }
__global__ void __launch_bounds__(256, 2) k_p4(Params p) { __shared__ __attribute__((aligned(16))) char smem[SMEM_BYTES]; for (int t = blockIdx.x; t < 256 * 8; t += gridDim.x) phase4_tile(p, t >> 3, t & 7, smem); }
__global__ void __launch_bounds__(256, 2) k_p5(Params p) { __shared__ __attribute__((aligned(16))) char smem[SMEM_BYTES]; for (int t = blockIdx.x; t < 256 * 16; t += gridDim.x) phase5_tile(p, t >> 4, t & 15, smem); }
__global__ void __launch_bounds__(256, 2) k_p6(Params p) { __shared__ __attribute__((aligned(16))) char smem[SMEM_BYTES]; phase6(p, smem, p.out); }
#endif

extern "C" void kernel_launch(void* const* d_in, const int* in_sizes, int n_in, void* d_out, int out_size, void* d_ws, size_t ws_size,
                              hipStream_t stream) {
  Params p{};
  p.x = (const float*)d_in[0]; p.g_attn = (const float*)d_in[1]; p.w_in = (const float*)d_in[2]; p.qna = (const float*)d_in[3];
  p.kna = (const float*)d_in[4]; p.ona = (const float*)d_in[5]; p.qnb = (const float*)d_in[6]; p.knb = (const float*)d_in[7];
  p.lq1 = (const float*)d_in[8]; p.lk1 = (const float*)d_in[9]; p.lq2 = (const float*)d_in[10]; p.lk2 = (const float*)d_in[11];
  p.onb = (const float*)d_in[12]; p.w_out = (const float*)d_in[13]; p.g_ffn = (const float*)d_in[14]; p.w_pq = (const float*)d_in[15];
  p.subk = (const float*)d_in[16]; p.pu = (const float*)d_in[17]; p.pv = (const float*)d_in[18];
  p.out = (float*)d_out; p.ws = (char*)d_ws;
#if FUSED
  static int grid_blocks = 0;
  if (!grid_blocks) {
    int dev = 0, cus = 0, per_cu = 0;
    hipGetDevice(&dev);
    hipDeviceGetAttribute(&cus, hipDeviceAttributeMultiprocessorCount, dev);
    hipOccupancyMaxActiveBlocksPerMultiprocessor(&per_cu, fwd_megakernel, 256, 0);
    if (per_cu > 2) per_cu = 2;
    if (per_cu < 1) per_cu = 1;
    grid_blocks = cus * per_cu;
  }
  void* args[] = {&p};
  hipError_t e = hipLaunchCooperativeKernel((void*)fwd_megakernel, dim3(grid_blocks), dim3(256), args, 0, stream);
  if (e != hipSuccess) fprintf(stderr, "cooperative launch failed: %s (grid %d)\n", hipGetErrorString(e), grid_blocks);
#else
  const int G = 512;
  k_p0<<<G, 256, 0, stream>>>(p);
  k_p1<<<G, 256, 0, stream>>>(p);
  k_p2<<<G, 256, 0, stream>>>(p);
  k_p3<<<G, 256, 0, stream>>>(p);
  k_p4<<<G, 256, 0, stream>>>(p);
  k_p5<<<G, 256, 0, stream>>>(p);
  k_p6<<<G, 256, 0, stream>>>(p);
#endif
}
```

```cpp
#include <hip/hip_runtime.h>
#include <hip/hip_cooperative_groups.h>
#include <cstdio>
#include <cstdint>
namespace cg = cooperative_groups;

#ifndef FUSED
#define FUSED 1
#endif
#ifndef PROBE_DUP
#define PROBE_DUP 0
#endif

typedef unsigned short u16;
typedef unsigned char u8;
typedef __attribute__((ext_vector_type(8))) short bf16x8;
typedef __attribute__((ext_vector_type(4))) short s16x4;
typedef __attribute__((ext_vector_type(16))) float f32x16;
typedef __attribute__((ext_vector_type(2))) __bf16 bf2_t;
typedef __attribute__((ext_vector_type(4))) unsigned u32x4;
#define DI __device__ __forceinline__
#define MFMA(a, b, c) __builtin_amdgcn_mfma_f32_32x32x16_bf16((a), (b), (c), 0, 0, 0)

constexpr int T_TOK = 32768;
constexpr int SEQ = 4096;
constexpr size_t MB = 1u << 20;
constexpr size_t OFF_XNB = 0;
constexpr size_t OFF_QA = 64 * MB, OFF_KA = 96 * MB, OFF_VA = 128 * MB, OFF_QB = 160 * MB, OFF_KB = 192 * MB, OFF_VB = 224 * MB;
constexpr size_t OFF_TOPS = 64 * MB;
constexpr size_t OFF_TOPI = 96 * MB;
constexpr size_t OFF_OAP = 256 * MB;
constexpr size_t OFF_OBC = 352 * MB;
constexpr size_t OFF_PUB = 416 * MB, OFF_PVB = 448 * MB;
constexpr size_t OFF_WIN = 480 * MB, OFF_WOUT = 486 * MB, OFF_WPQ = 488 * MB, OFF_SUBK = 492 * MB;
constexpr size_t OFF_ROPEC = 493 * MB, OFF_ROPES = 493 * MB + 128 * 1024;
constexpr size_t OFF_LSE = 494 * MB;
constexpr size_t OFF_HSS = 497 * MB;
constexpr size_t OFF_MISC = 497 * MB + 128 * 1024;

constexpr size_t OFF_BAR = 497 * MB + 256 * 1024;
constexpr int SMEM_BYTES = 73728;
#define XCD_BAR_WORDS 3456
constexpr float QSCALE = 0.125f * 1.4426950408889634f;
constexpr float NEG_INF = -__builtin_huge_valf();
constexpr float USCALE = 64.f, VSCALE = 16.f;
typedef float f32x2 __attribute__((ext_vector_type(2)));

struct Params {
  const float *x, *g_attn, *w_in, *qna, *kna, *ona, *qnb, *knb, *lq1, *lk1, *lq2, *lk2, *onb, *w_out, *g_ffn, *w_pq, *subk, *pu, *pv;
  float* out;
  char* ws;
};

DI u16 f2bf(float x) { unsigned u = __float_as_uint(x); u += 0x7fffu + ((u >> 16) & 1u); return (u16)(u >> 16); }
DI float bf2f(u16 b) { return __uint_as_float(((unsigned)b) << 16); }
DI unsigned pack2(float a, float b) { return (unsigned)f2bf(a) | ((unsigned)f2bf(b) << 16); }
DI float bflo(unsigned u) { return __uint_as_float(u << 16); }
DI float bfhi(unsigned u) { return __uint_as_float(u & 0xffff0000u); }
DI float wave_sum(float v) {
  v += __shfl_xor(v, 32); v += __shfl_xor(v, 16); v += __shfl_xor(v, 8); v += __shfl_xor(v, 4); v += __shfl_xor(v, 2); v += __shfl_xor(v, 1);
  return v;
}
DI int crow(int reg, int h) { return (reg & 3) + 8 * (reg >> 2) + 4 * h; }

__device__ void phase0(const Params& p, char* smem) {
  const int tid = threadIdx.x, lane = tid & 63, wid = tid >> 6;
  const int gw = blockIdx.x * 4 + wid, nw = gridDim.x * 4;
  const int gt = blockIdx.x * 256 + tid, nt = gridDim.x * 256;
  u16* xnb = (u16*)(p.ws + OFF_XNB);
  for (int row = gw; row < T_TOK; row += nw) {
    const float4* xr = (const float4*)(p.x + (size_t)row * 1024);
    float4 v[4]; float ss = 0.f;
#pragma unroll
    for (int i = 0; i < 4; ++i) { v[i] = xr[lane + 64 * i]; ss += v[i].x * v[i].x + v[i].y * v[i].y + v[i].z * v[i].z + v[i].w * v[i].w; }
    ss = wave_sum(ss);
    const float r = rsqrtf(ss * (1.f / 1024.f) + 1e-6f);
    uint2* dst = (uint2*)(xnb + (size_t)row * 1024);
#pragma unroll
    for (int i = 0; i < 4; ++i) dst[lane + 64 * i] = make_uint2(pack2(v[i].x * r, v[i].y * r), pack2(v[i].z * r, v[i].w * r));
  }
  float* tile = (float*)smem;
  for (int job = blockIdx.x; job < 1536; job += gridDim.x) {
    const float* W; const float* g; u16* outp; int N, j;
    if (job < 768) { W = p.w_in; g = p.g_attn; outp = (u16*)(p.ws + OFF_WIN); N = 3072; j = job; }
    else if (job < 1024) { W = p.w_out; g = nullptr; outp = (u16*)(p.ws + OFF_WOUT); N = 1024; j = job - 768; }
    else { W = p.w_pq; g = p.g_ffn; outp = (u16*)(p.ws + OFF_WPQ); N = 2048; j = job - 1024; }
    const int ntn = N >> 6, kt = j / ntn, ntile = j % ntn;
    const int tx = tid & 63, ty = tid >> 6;
#pragma unroll 4
    for (int r = 0; r < 16; ++r) {
      const int k = kt * 64 + ty + 4 * r;
      float v = W[(size_t)k * N + ntile * 64 + tx];
      if (g) v *= g[k];
      tile[(ty + 4 * r) * 65 + tx] = v;
    }
    __syncthreads();
#pragma unroll 4
    for (int r = 0; r < 16; ++r) {
      const int nl = ty + 4 * r;
      outp[(size_t)(ntile * 64 + nl) * 1024 + kt * 64 + tx] = f2bf(tile[tx * 65 + nl]);
    }
    __syncthreads();
  }
  {
    const float4* s = (const float4*)p.subk; uint2* d = (uint2*)(p.ws + OFF_SUBK);
    for (int i = gt; i < 262144 / 4; i += nt) { float4 v = s[i]; d[i] = make_uint2(pack2(v.x, v.y), pack2(v.z, v.w)); }
    const float4* su = (const float4*)p.pu; int* du = (int*)(p.ws + OFF_PUB);
    const float4* sv = (const float4*)p.pv; int* dv = (int*)(p.ws + OFF_PVB);
    for (int i = gt; i < 16384 * 1024 / 4; i += nt) {
      float4 a = su[i]; float4 b = sv[i];
      int ra = __builtin_amdgcn_cvt_pk_fp8_f32(a.x * USCALE, a.y * USCALE, 0, false);
      ra = __builtin_amdgcn_cvt_pk_fp8_f32(a.z * USCALE, a.w * USCALE, ra, true);
      int rb = __builtin_amdgcn_cvt_pk_fp8_f32(b.x * VSCALE, b.y * VSCALE, 0, false);
      rb = __builtin_amdgcn_cvt_pk_fp8_f32(b.z * VSCALE, b.w * VSCALE, rb, true);
      du[i] = ra; dv[i] = rb;
    }
  }
  {
    float* rc = (float*)(p.ws + OFF_ROPEC); float* rs = (float*)(p.ws + OFF_ROPES);
    for (int i = gt; i < SEQ * 8; i += nt) {
      const int pos = i >> 3, f = i & 7;
      const float invf = (float)pow(500000.0, -(double)f / 8.0);
      const float ang = (float)pos * invf;
      rc[i] = (float)cos((double)ang); rs[i] = (float)sin((double)ang);
    }
    float* hss = (float*)(p.ws + OFF_HSS);
    for (int i = gt; i < T_TOK; i += nt) hss[i] = 0.f;
    unsigned* barw = (unsigned*)(p.ws + OFF_BAR);
    for (int i = gt; i < XCD_BAR_WORDS; i += nt) barw[i] = 0u;
    if (gt == 0) {
      float a = 0.f, b = 0.f;
      for (int i = 0; i < 64; ++i) { a += p.lq1[i] * p.lk1[i]; b += p.lq2[i] * p.lk2[i]; }
      float* misc = (float*)(p.ws + OFF_MISC);
      misc[0] = expf(a) - expf(b) + 0.2f;
      ((int*)misc)[1] = 0; ((int*)misc)[2] = 0;
    }
  }
}

DI void gemm_mainloop(const u16* __restrict__ A, const u16* __restrict__ Bt, int m0, int n0, char* smem, f32x16 (&acc)[2][2]) {
  u16* As = (u16*)smem;
  u16* Bs = As + 2 * 128 * 72;
  const int tid = threadIdx.x, lane = tid & 63, w = tid >> 6, wm = w >> 1, wn = w & 1, lr = lane & 31, lh = lane >> 5;
#pragma unroll
  for (int a = 0; a < 2; ++a)
#pragma unroll
    for (int b = 0; b < 2; ++b)
#pragma unroll
      for (int r = 0; r < 16; ++r) acc[a][b][r] = 0.f;
  uint4 ra[4], rb[4];
  const int lrow = tid >> 3, lkc = tid & 7;
  const u16* Ag = A + (size_t)(m0 + lrow) * 1024 + lkc * 8;
  const u16* Bg = Bt + (size_t)(n0 + lrow) * 1024 + lkc * 8;
#define GLOAD(kt) { _Pragma("unroll") for (int i = 0; i < 4; ++i) { ra[i] = *(const uint4*)(Ag + (size_t)i * 32 * 1024 + (kt) * 64); rb[i] = *(const uint4*)(Bg + (size_t)i * 32 * 1024 + (kt) * 64); } }
#define SWRITE(buf) { _Pragma("unroll") for (int i = 0; i < 4; ++i) { *(uint4*)(As + ((buf) * 128 + lrow + 32 * i) * 72 + lkc * 8) = ra[i]; *(uint4*)(Bs + ((buf) * 128 + lrow + 32 * i) * 72 + lkc * 8) = rb[i]; } }
  GLOAD(0); SWRITE(0); __syncthreads();
  for (int kt = 0; kt < 16; ++kt) {
    if (kt < 15) GLOAD(kt + 1);
    const u16* ab = As + ((kt & 1) * 128 + wm * 64 + lr) * 72 + lh * 8;
    const u16* bb = Bs + ((kt & 1) * 128 + wn * 64 + lr) * 72 + lh * 8;
#pragma unroll
    for (int s = 0; s < 4; ++s) {
      const bf16x8 a0 = *(const bf16x8*)(ab + s * 16), a1 = *(const bf16x8*)(ab + 32 * 72 + s * 16);
      const bf16x8 b0 = *(const bf16x8*)(bb + s * 16), b1 = *(const bf16x8*)(bb + 32 * 72 + s * 16);
      acc[0][0] = MFMA(a0, b0, acc[0][0]); acc[0][1] = MFMA(a0, b1, acc[0][1]);
      acc[1][0] = MFMA(a1, b0, acc[1][0]); acc[1][1] = MFMA(a1, b1, acc[1][1]);
    }
    if (kt < 15) SWRITE((kt + 1) & 1);
    __syncthreads();
  }
#undef GLOAD
#undef SWRITE
}

DI void stage_acc(const f32x16 (&acc)[2][2], float* st) {
  const int tid = threadIdx.x, lane = tid & 63, w = tid >> 6, wm = w >> 1, wn = w & 1, lr = lane & 31, lh = lane >> 5;
#pragma unroll
  for (int mt = 0; mt < 2; ++mt)
#pragma unroll
    for (int nt = 0; nt < 2; ++nt)
#pragma unroll
      for (int r = 0; r < 16; ++r) st[(wm * 64 + mt * 32 + crow(r, lh)) * 132 + wn * 64 + nt * 32 + lr] = acc[mt][nt][r];
}

__device__ void phase1_tile(const Params& p, int mtile, int j, char* smem) {
  f32x16 acc[2][2];
  const int m0 = mtile * 128, n0 = j * 128;
  gemm_mainloop((const u16*)(p.ws + OFF_XNB), (const u16*)(p.ws + OFF_WIN), m0, n0, smem, acc);
  float* st = (float*)smem;
  stage_acc(acc, st);
  __syncthreads();
  const int tid = threadIdx.x, row = tid & 127, half = tid >> 7;
  const int sec = j >> 2;
  const int tok = m0 + row, b = tok >> 12, s = tok & 4095;
  float v[64];
#pragma unroll
  for (int c = 0; c < 16; ++c) { const float4 t4 = *(const float4*)(st + row * 132 + half * 64 + c * 4); v[4 * c] = t4.x; v[4 * c + 1] = t4.y; v[4 * c + 2] = t4.z; v[4 * c + 3] = t4.w; }
  if (sec != 2 && sec != 5) {
    const float* g = sec == 0 ? p.qna : sec == 1 ? p.kna : sec == 3 ? p.qnb : p.knb;
    float ss = 0.f;
#pragma unroll
    for (int i = 0; i < 64; ++i) ss += v[i] * v[i];
    float r = rsqrtf(ss * (1.f / 64.f) + 1e-6f);
    const float post = (sec == 0 || sec == 3) ? QSCALE : 1.f;
#pragma unroll
    for (int i = 0; i < 64; ++i) v[i] = v[i] * r * g[i];
    const float* rc = (const float*)(p.ws + OFF_ROPEC) + s * 8;
    const float* rs = (const float*)(p.ws + OFF_ROPES) + s * 8;
#pragma unroll
    for (int i = 0; i < 8; ++i) {
      const float c = rc[i], sn = rs[i], x1 = v[i], x2 = v[i + 8];
      v[i] = x1 * c - x2 * sn; v[i + 8] = x2 * c + x1 * sn;
    }
#pragma unroll
    for (int i = 0; i < 64; ++i) v[i] *= post;
  }
  u16* dst;
  if (sec == 5) {
    dst = (u16*)(p.ws + OFF_VB) + ((size_t)(b * 4 + (j & 3)) * 4096 + s) * 128 + half * 64;
  } else {
    const size_t off = sec == 0 ? OFF_QA : sec == 1 ? OFF_KA : sec == 2 ? OFF_VA : sec == 3 ? OFF_QB : OFF_KB;
    const int hc = (j & 3) * 2 + half;
    dst = (u16*)(p.ws + off) + ((size_t)(b * 8 + hc) * 4096 + s) * 64;
  }
#pragma unroll
  for (int c = 0; c < 8; ++c)
    ((uint4*)dst)[c] = make_uint4(pack2(v[8 * c], v[8 * c + 1]), pack2(v[8 * c + 2], v[8 * c + 3]), pack2(v[8 * c + 4], v[8 * c + 5]), pack2(v[8 * c + 6], v[8 * c + 7]));
  __syncthreads();
}

template <int OFF> DI s16x4 tr_read(unsigned addr) {
  s16x4 r; asm volatile("ds_read_b64_tr_b16 %0, %1 offset:%2" : "=v"(r) : "v"(addr), "n"(OFF) : "memory"); return r;
}
DI void wait_tr8(s16x4& a0, s16x4& a1, s16x4& a2, s16x4& a3, s16x4& a4, s16x4& a5, s16x4& a6, s16x4& a7) {
  asm volatile("s_waitcnt lgkmcnt(0)" : "+v"(a0), "+v"(a1), "+v"(a2), "+v"(a3), "+v"(a4), "+v"(a5), "+v"(a6), "+v"(a7) : : "memory");
}

template <int DV, bool CAUSAL>
__device__ void attn_unit(const u16* __restrict__ qbase, const u16* __restrict__ kbase, const u16* __restrict__ vbase, int n, int dil, int res,
                          u16* __restrict__ obase, int ostride, float* __restrict__ lsebase, char* smem) {
  constexpr int VST = DV + 8;
  constexpr int NMT = DV / 32;
  constexpr int WMAX = CAUSAL ? (1 << 30) : 128;
  u16* Ks = (u16*)smem;
  u16* Vs = Ks + 2 * 64 * 72;
  const int tid = threadIdx.x, lane = tid & 63, w = tid >> 6, lr = lane & 31, lh = lane >> 5;
  const int kb0 = CAUSAL ? 0 : 128 * (n - 1);
  const int kt_begin = CAUSAL ? 0 : (n == 0 ? 2 : 0);
  const int kt_end = CAUSAL ? (2 * n + 2) : 4;
  const int mq = 128 * n + 32 * w + lr;
  const size_t tq = (size_t)mq * dil + res;
  bf16x8 qf[4];
  {
    const u16* qp = qbase + tq * 64 + lh * 8;
#pragma unroll
    for (int s = 0; s < 4; ++s) qf[s] = *(const bf16x8*)(qp + s * 16);
  }
  f32x16 o[NMT];
#pragma unroll
  for (int mt = 0; mt < NMT; ++mt)
#pragma unroll
    for (int r = 0; r < 16; ++r) o[mt][r] = 0.f;
  float m_run = NEG_INF, l_run = 0.f;
  uint4 rk0, rk1, rv0, rv1, rv2, rv3;
  rv2 = rv3 = make_uint4(0, 0, 0, 0);
  const int krow_ = tid >> 3, kkc = tid & 7;
  constexpr int VCPR = DV / 8;
  const int vrow = tid / VCPR, vkc = tid % VCPR;
  constexpr int VRSTEP = 256 / VCPR;
  const u16* kgp = kbase + ((size_t)(kb0 + krow_) * dil + res) * 64 + kkc * 8;
  const u16* vgp = vbase + ((size_t)(kb0 + vrow) * dil + res) * DV + vkc * 8;
  const size_t kstep32 = (size_t)32 * dil * 64, kstep64 = (size_t)64 * dil * 64;
  const size_t vstepr = (size_t)VRSTEP * dil * DV, vstep64 = (size_t)64 * dil * DV;
  u16* ksw = Ks + krow_ * 72 + kkc * 8;
  u16* vsw = Vs + vrow * VST + vkc * 8;
#define AGLOAD(kt) { const u16* kp_ = kgp + (size_t)(kt) * kstep64; rk0 = *(const uint4*)kp_; rk1 = *(const uint4*)(kp_ + kstep32); \
    const u16* vp_ = vgp + (size_t)(kt) * vstep64; rv0 = *(const uint4*)vp_; rv1 = *(const uint4*)(vp_ + vstepr); \
    if (NMT == 4) { rv2 = *(const uint4*)(vp_ + 2 * vstepr); rv3 = *(const uint4*)(vp_ + 3 * vstepr); } }
#define ASWRITE(buf) { *(uint4*)(ksw + (buf) * 64 * 72) = rk0; *(uint4*)(ksw + (buf) * 64 * 72 + 32 * 72) = rk1; \
    *(uint4*)(vsw + (buf) * 64 * VST) = rv0; *(uint4*)(vsw + (buf) * 64 * VST + VRSTEP * VST) = rv1; \
    if (NMT == 4) { *(uint4*)(vsw + (buf) * 64 * VST + 2 * VRSTEP * VST) = rv2; *(uint4*)(vsw + (buf) * 64 * VST + 3 * VRSTEP * VST) = rv3; } }
  AGLOAD(kt_begin); ASWRITE(0); __syncthreads();
  const int li = lane & 31, blk = li >> 4, tq_ = (li >> 2) & 3, tp = li & 3;
  for (int kt = kt_begin; kt < kt_end; ++kt) {
    const int buf = (kt - kt_begin) & 1;
    if (kt + 1 < kt_end) AGLOAD(kt + 1);
    const int k_lo = kb0 + 64 * kt, q_lo = 128 * n + 32 * w;
    const int dmin = q_lo - (k_lo + 63), dmax = q_lo + 31 - k_lo;
    const bool skip = (dmax < 0) || (dmin > WMAX);
    if (!skip) {
      const bool need_mask = (dmin < 0) || (dmax > WMAX);
      const u16* kb = Ks + (buf * 64 + lr) * 72 + lh * 8;
      f32x16 st[2];
#pragma unroll
      for (int kk = 0; kk < 2; ++kk) {
#pragma unroll
        for (int r = 0; r < 16; ++r) st[kk][r] = 0.f;
#pragma unroll
        for (int s = 0; s < 4; ++s) { const bf16x8 a = *(const bf16x8*)(kb + kk * 32 * 72 + s * 16); st[kk] = MFMA(a, qf[s], st[kk]); }
      }
      if (need_mask) {
#pragma unroll
        for (int kk = 0; kk < 2; ++kk)
#pragma unroll
          for (int r = 0; r < 16; ++r) {
            const int d = mq - (k_lo + 32 * kk + crow(r, lh));
            if (d < 0 || d > WMAX) st[kk][r] = NEG_INF;
          }
      }
      float mx = NEG_INF;
#pragma unroll
      for (int kk = 0; kk < 2; ++kk)
#pragma unroll
        for (int r = 0; r < 16; ++r) mx = fmaxf(mx, st[kk][r]);
      mx = fmaxf(mx, __shfl_xor(mx, 32));
      const float m_new = fmaxf(m_run, mx);
      const float m_use = (m_new == NEG_INF) ? 0.f : m_new;
      const float alpha = exp2f(m_run - m_use);
      float ls = 0.f;
#pragma unroll
      for (int kk = 0; kk < 2; ++kk)
#pragma unroll
        for (int r = 0; r < 16; ++r) { const float e = exp2f(st[kk][r] - m_use); st[kk][r] = e; ls += e; }
      l_run = l_run * alpha + ls; m_run = m_new;
#pragma unroll
      for (int mt = 0; mt < NMT; ++mt)
#pragma unroll
        for (int r = 0; r < 16; ++r) o[mt][r] *= alpha;
      bf16x8 pf[4];
#pragma unroll
      for (int ks = 0; ks < 4; ++ks) {
        const int kk = ks >> 1, s2 = ks & 1;
        u32x4 cv;
        cv[0] = pack2(st[kk][8 * s2 + 0], st[kk][8 * s2 + 1]); cv[1] = pack2(st[kk][8 * s2 + 2], st[kk][8 * s2 + 3]);
        cv[2] = pack2(st[kk][8 * s2 + 4], st[kk][8 * s2 + 5]); cv[3] = pack2(st[kk][8 * s2 + 6], st[kk][8 * s2 + 7]);
        pf[ks] = __builtin_bit_cast(bf16x8, cv);
      }
      const unsigned vaddr = (unsigned)(size_t)(Vs + (buf * 64 + 4 * lh + tq_) * VST + 16 * blk + 4 * tp);
#pragma unroll
      for (int mt = 0; mt < NMT; ++mt) {
        const unsigned a0 = vaddr + mt * 64;
        s16x4 l0 = tr_read<0 * 16 * VST * 2>(a0), h0 = tr_read<(0 * 16 + 8) * VST * 2>(a0);
        s16x4 l1 = tr_read<1 * 16 * VST * 2>(a0), h1 = tr_read<(1 * 16 + 8) * VST * 2>(a0);
        s16x4 l2 = tr_read<2 * 16 * VST * 2>(a0), h2 = tr_read<(2 * 16 + 8) * VST * 2>(a0);
        s16x4 l3 = tr_read<3 * 16 * VST * 2>(a0), h3 = tr_read<(3 * 16 + 8) * VST * 2>(a0);
        wait_tr8(l0, h0, l1, h1, l2, h2, l3, h3);
        o[mt] = MFMA(__builtin_shufflevector(l0, h0, 0, 1, 2, 3, 4, 5, 6, 7), pf[0], o[mt]);
        o[mt] = MFMA(__builtin_shufflevector(l1, h1, 0, 1, 2, 3, 4, 5, 6, 7), pf[1], o[mt]);
        o[mt] = MFMA(__builtin_shufflevector(l2, h2, 0, 1, 2, 3, 4, 5, 6, 7), pf[2], o[mt]);
        o[mt] = MFMA(__builtin_shufflevector(l3, h3, 0, 1, 2, 3, 4, 5, 6, 7), pf[3], o[mt]);
      }
    }
    if (kt + 1 < kt_end) ASWRITE(buf ^ 1);
    __syncthreads();
  }
#undef AGLOAD
#undef ASWRITE
  const float l_tot = l_run + __shfl_xor(l_run, 32);
  const float inv = 1.f / l_tot;
  u16* op = obase + tq * ostride;
#pragma unroll
  for (int mt = 0; mt < NMT; ++mt)
#pragma unroll
    for (int g = 0; g < 4; ++g) {
      const int dv0 = 32 * mt + 8 * g + 4 * lh;
      *(uint2*)(op + dv0) = make_uint2(pack2(o[mt][4 * g] * inv, o[mt][4 * g + 1] * inv), pack2(o[mt][4 * g + 2] * inv, o[mt][4 * g + 3] * inv));
    }
  if (!CAUSAL && lh == 0) lsebase[tq * 8] = m_run + log2f(l_tot);
}

constexpr int N_DIFF_UNITS = 2048, N_DIL_UNITS = 6144;
__device__ void phase2_unit(const Params& p, int u, char* smem) {
  if (u < N_DIFF_UNITS) {
    const int n = 31 - (u >> 6), rem = u & 63, b = rem >> 3, hc = rem & 7, h4 = hc >> 1;
    const u16* qb = (const u16*)(p.ws + OFF_QB) + (size_t)(b * 8 + hc) * 4096 * 64;
    const u16* kb = (const u16*)(p.ws + OFF_KB) + (size_t)(b * 8 + hc) * 4096 * 64;
    const u16* vb = (const u16*)(p.ws + OFF_VB) + (size_t)(b * 4 + h4) * 4096 * 128;
    u16* ob = (u16*)(p.ws + OFF_OBC) + (size_t)b * 4096 * 1024 + hc * 128;
    attn_unit<128, true>(qb, kb, vb, n, 1, 0, ob, 1024, nullptr, smem);
  } else {
    const int u2 = u - N_DIFF_UNITS, pidx = u2 >> 11, rem = u2 & 2047, b = rem >> 8, h = (rem >> 5) & 7, rn = rem & 31;
    const int sh = 2 * pidx, dil = 1 << sh, nb = 32 >> sh, res = rn >> (5 - sh), n = rn & (nb - 1);
    const u16* qb = (const u16*)(p.ws + OFF_QA) + (size_t)(b * 8 + h) * 4096 * 64;
    const u16* kb = (const u16*)(p.ws + OFF_KA) + (size_t)(b * 8 + h) * 4096 * 64;
    const u16* vb = (const u16*)(p.ws + OFF_VA) + (size_t)(b * 8 + h) * 4096 * 64;
    u16* ob = (u16*)(p.ws + OFF_OAP) + ((size_t)pidx * T_TOK + (size_t)b * 4096) * 512 + h * 64;
    float* lse = (float*)(p.ws + OFF_LSE) + ((size_t)pidx * T_TOK + (size_t)b * 4096) * 8 + h;
    attn_unit<64, false>(qb, kb, vb, n, dil, res, ob, 512, lse, smem);
  }
}
__device__ void phase2(const Params& p, char* smem, int slot = 1) {
  int* counter = (int*)(p.ws + OFF_MISC) + slot;
  int* s_unit = (int*)(smem + SMEM_BYTES - 16);
  while (true) {
    if (threadIdx.x == 0) *s_unit = atomicAdd(counter, 1);
    __syncthreads();
    const int u = *s_unit;
    __syncthreads();
    if (u >= N_DIFF_UNITS + N_DIL_UNITS) break;
    phase2_unit(p, u, smem);
  }
}

__device__ void phase3(const Params& p) {
  const int tid = threadIdx.x, lane = tid & 63, wid = tid >> 6;
  const int gw = blockIdx.x * 4 + wid, nw = gridDim.x * 4;
  const float lam = ((const float*)(p.ws + OFF_MISC))[0];
  const u16* oap = (const u16*)(p.ws + OFF_OAP);
  const u16* obc = (const u16*)(p.ws + OFF_OBC);
  const float* lse = (const float*)(p.ws + OFF_LSE);
  u16* mix = (u16*)(p.ws + OFF_XNB);
  for (int tok = gw; tok < T_TOK; tok += nw) {
    float o[16]; float ss = 0.f;
    if (lane < 32) {
      const int head = lane >> 2;
      float l0 = lse[(size_t)tok * 8 + head], l1 = lse[((size_t)T_TOK + tok) * 8 + head], l2 = lse[((size_t)2 * T_TOK + tok) * 8 + head];
      const float mx = fmaxf(l0, fmaxf(l1, l2));
      float w0 = exp2f(l0 - mx), w1 = exp2f(l1 - mx), w2 = exp2f(l2 - mx);
      const float inv = 1.f / (w0 + w1 + w2); w0 *= inv; w1 *= inv; w2 *= inv;
      const uint4* p0 = (const uint4*)(oap + (size_t)tok * 512 + lane * 16);
      const uint4* p1 = (const uint4*)(oap + ((size_t)T_TOK + tok) * 512 + lane * 16);
      const uint4* p2 = (const uint4*)(oap + ((size_t)2 * T_TOK + tok) * 512 + lane * 16);
#pragma unroll
      for (int c = 0; c < 2; ++c) {
        const uint4 a = p0[c], b = p1[c], d = p2[c];
        const unsigned au[4] = {a.x, a.y, a.z, a.w}, bu[4] = {b.x, b.y, b.z, b.w}, du[4] = {d.x, d.y, d.z, d.w};
#pragma unroll
        for (int k = 0; k < 4; ++k) {
          o[c * 8 + 2 * k] = w0 * bflo(au[k]) + w1 * bflo(bu[k]) + w2 * bflo(du[k]);
          o[c * 8 + 2 * k + 1] = w0 * bfhi(au[k]) + w1 * bfhi(bu[k]) + w2 * bfhi(du[k]);
        }
      }
    } else {
      const int l2 = lane - 32, head = l2 >> 3, cc = (l2 & 7) * 16;
      const uint4* p0 = (const uint4*)(obc + (size_t)tok * 1024 + (2 * head) * 128 + cc);
      const uint4* p1 = (const uint4*)(obc + (size_t)tok * 1024 + (2 * head + 1) * 128 + cc);
#pragma unroll
      for (int c = 0; c < 2; ++c) {
        const uint4 a = p0[c], b = p1[c];
        const unsigned au[4] = {a.x, a.y, a.z, a.w}, bu[4] = {b.x, b.y, b.z, b.w};
#pragma unroll
        for (int k = 0; k < 4; ++k) {
          o[c * 8 + 2 * k] = bflo(au[k]) - lam * bflo(bu[k]);
          o[c * 8 + 2 * k + 1] = bfhi(au[k]) - lam * bfhi(bu[k]);
        }
      }
    }
#pragma unroll
    for (int i = 0; i < 16; ++i) ss += o[i] * o[i];
    const float s1 = ss + __shfl_xor(ss, 1);
    const float s2 = s1 + __shfl_xor(s1, 2);
    const float s3 = s2 + __shfl_xor(s2, 4);
    float r; const float* g;
    if (lane < 32) { r = rsqrtf(s2 * (1.f / 64.f) + 1e-6f); g = p.ona + lane * 16; }
    else { r = rsqrtf(s3 * (1.f / 128.f) + 1e-6f) * 0.8f; g = p.onb + (lane - 32) * 16; }
    unsigned pk[8];
#pragma unroll
    for (int k = 0; k < 8; ++k) pk[k] = pack2(o[2 * k] * r * g[2 * k], o[2 * k + 1] * r * g[2 * k + 1]);
    uint4* dst = (uint4*)(mix + (size_t)tok * 1024 + lane * 16);
    dst[0] = make_uint4(pk[0], pk[1], pk[2], pk[3]); dst[1] = make_uint4(pk[4], pk[5], pk[6], pk[7]);
  }
}

__device__ void phase4_tile(const Params& p, int mtile, int j, char* smem) {
  f32x16 acc[2][2];
  const int m0 = mtile * 128, n0 = j * 128;
  gemm_mainloop((const u16*)(p.ws + OFF_XNB), (const u16*)(p.ws + OFF_WOUT), m0, n0, smem, acc);
  float* st = (float*)smem;
  stage_acc(acc, st);
  __syncthreads();
  const int tid = threadIdx.x, cgi = tid & 31, r0 = tid >> 5;
  float* hss = (float*)(p.ws + OFF_HSS);
  u16* hb = (u16*)(p.ws + OFF_OAP);
#pragma unroll 4
  for (int ps = 0; ps < 16; ++ps) {
    const int row = r0 + 8 * ps;
    const float4 a = *(const float4*)(st + row * 132 + cgi * 4);
    const size_t gi = (size_t)(m0 + row) * 1024 + n0 + cgi * 4;
    const float4 xv = *(const float4*)(p.x + gi);
    float4 hv; hv.x = xv.x + a.x; hv.y = xv.y + a.y; hv.z = xv.z + a.z; hv.w = xv.w + a.w;
    *(float4*)(p.out + gi) = hv;
    *(uint2*)(hb + gi) = make_uint2(pack2(hv.x, hv.y), pack2(hv.z, hv.w));
    float ss = hv.x * hv.x + hv.y * hv.y + hv.z * hv.z + hv.w * hv.w;
    ss += __shfl_xor(ss, 16); ss += __shfl_xor(ss, 8); ss += __shfl_xor(ss, 4); ss += __shfl_xor(ss, 2); ss += __shfl_xor(ss, 1);
    if (cgi == 0) atomicAdd(hss + m0 + row, ss);
  }
  __syncthreads();
}

#define TK_INSERT(xv, xi) { float x_ = (xv); int i_ = (xi); _Pragma("unroll") for (int q_ = 0; q_ < 16; ++q_) { const bool gt_ = x_ > tv[q_]; const float tvv = tv[q_]; const int tii = ti[q_]; tv[q_] = gt_ ? x_ : tvv; ti[q_] = gt_ ? i_ : tii; x_ = gt_ ? tvv : x_; i_ = gt_ ? tii : i_; } }
__device__ void phase5_tile(const Params& p, int mtile, int j, char* smem) {
  f32x16 acc[2][2];
  const int m0 = mtile * 128, n0 = j * 128;
  gemm_mainloop((const u16*)(p.ws + OFF_OAP), (const u16*)(p.ws + OFF_WPQ), m0, n0, smem, acc);
  const int tid = threadIdx.x, lane = tid & 63, w = tid >> 6, wm = w >> 1, wn = w & 1, lr = lane & 31, lh = lane >> 5;
  u16* Qs = (u16*)smem;
  u16* SKs = Qs + 128 * 136;
  float* rs = (float*)(smem + 2 * 128 * 136 * 2);
  const float* hss = (const float*)(p.ws + OFF_HSS);
  if (tid < 128) rs[tid] = rsqrtf(hss[m0 + tid] * (1.f / 1024.f) + 1e-6f);
  {
    const u16* sk = (const u16*)(p.ws + OFF_SUBK) + (size_t)j * 128 * 128;
#pragma unroll
    for (int i = 0; i < 8; ++i) { const int c = tid + 256 * i, row = c >> 4, kc = c & 15; *(uint4*)(SKs + row * 136 + kc * 8) = *(const uint4*)(sk + row * 128 + kc * 8); }
  }
  __syncthreads();
#pragma unroll
  for (int mt = 0; mt < 2; ++mt)
#pragma unroll
    for (int nt = 0; nt < 2; ++nt)
#pragma unroll
      for (int r = 0; r < 16; ++r) {
        const int row = wm * 64 + mt * 32 + crow(r, lh);
        Qs[row * 136 + wn * 64 + nt * 32 + lr] = f2bf(acc[mt][nt][r] * rs[row]);
      }
  __syncthreads();
#pragma unroll
  for (int a = 0; a < 2; ++a)
#pragma unroll
    for (int b = 0; b < 2; ++b)
#pragma unroll
      for (int r = 0; r < 16; ++r) acc[a][b][r] = 0.f;
  {
    const u16* ab = Qs + (wm * 64 + lr) * 136 + lh * 8;
    const u16* bb = SKs + (wn * 64 + lr) * 136 + lh * 8;
#pragma unroll
    for (int s = 0; s < 8; ++s) {
      const bf16x8 a0 = *(const bf16x8*)(ab + s * 16), a1 = *(const bf16x8*)(ab + 32 * 136 + s * 16);
      const bf16x8 b0 = *(const bf16x8*)(bb + s * 16), b1 = *(const bf16x8*)(bb + 32 * 136 + s * 16);
      acc[0][0] = MFMA(a0, b0, acc[0][0]); acc[0][1] = MFMA(a0, b1, acc[0][1]);
      acc[1][0] = MFMA(a1, b0, acc[1][0]); acc[1][1] = MFMA(a1, b1, acc[1][1]);
    }
  }
  __syncthreads();
  float* st = (float*)smem;
  stage_acc(acc, st);
  __syncthreads();
  const int row = tid & 127, half = tid >> 7;
  float tv[16]; int ti[16];
#pragma unroll
  for (int q = 0; q < 16; ++q) { tv[q] = NEG_INF; ti[q] = 0; }
#pragma unroll 2
  for (int c = 0; c < 16; ++c) {
    const float4 v4 = *(const float4*)(st + row * 132 + half * 64 + c * 4);
    const int bi = half * 64 + c * 4;
    TK_INSERT(v4.x, bi); TK_INSERT(v4.y, bi + 1); TK_INSERT(v4.z, bi + 2); TK_INSERT(v4.w, bi + 3);
  }
  __syncthreads();
  if (half == 1) {
#pragma unroll
    for (int q = 0; q < 16; ++q) { st[row * 132 + q] = tv[q]; st[row * 132 + 16 + q] = __int_as_float(ti[q]); }
  }
  __syncthreads();
  if (half == 0) {
#pragma unroll 2
    for (int q = 0; q < 16; ++q) { const float xv = st[row * 132 + q]; const int xi = __float_as_int(st[row * 132 + 16 + q]); TK_INSERT(xv, xi); }
    const size_t base = ((size_t)(m0 + row) * 16 + j) * 16;
    float* tops = (float*)(p.ws + OFF_TOPS) + base;
    u8* topi = (u8*)(p.ws + OFF_TOPI) + base;
#pragma unroll
    for (int c = 0; c < 4; ++c) ((float4*)tops)[c] = make_float4(tv[4 * c], tv[4 * c + 1], tv[4 * c + 2], tv[4 * c + 3]);
    unsigned pk[4];
#pragma unroll
    for (int c = 0; c < 4; ++c) pk[c] = (unsigned)ti[4 * c] | ((unsigned)ti[4 * c + 1] << 8) | ((unsigned)ti[4 * c + 2] << 16) | ((unsigned)ti[4 * c + 3] << 24);
    *(uint4*)topi = make_uint4(pk[0], pk[1], pk[2], pk[3]);
  }
  __syncthreads();
}

DI float dpp_xor1(float v) { return __builtin_bit_cast(float, __builtin_amdgcn_update_dpp(0, __builtin_bit_cast(int, v), 0xB1, 0xF, 0xF, true)); }
DI float dpp_xor2(float v) { return __builtin_bit_cast(float, __builtin_amdgcn_update_dpp(0, __builtin_bit_cast(int, v), 0x4E, 0xF, 0xF, true)); }
template <int PAT> DI float swz(float v) { return __builtin_bit_cast(float, __builtin_amdgcn_ds_swizzle(__builtin_bit_cast(int, v), PAT)); }
DI float treduce8(const float (&pp)[8], int lane) {
  const bool b0 = lane & 1, b1 = lane & 2, b2 = lane & 4;
  float q[4];
#pragma unroll
  for (int i = 0; i < 4; ++i) { const float keep = b0 ? pp[2 * i + 1] : pp[2 * i], send = b0 ? pp[2 * i] : pp[2 * i + 1]; q[i] = keep + dpp_xor1(send); }
  float r[2];
#pragma unroll
  for (int i = 0; i < 2; ++i) { const float keep = b1 ? q[2 * i + 1] : q[2 * i], send = b1 ? q[2 * i] : q[2 * i + 1]; r[i] = keep + dpp_xor2(send); }
  float t = (b2 ? r[1] : r[0]) + swz<0x101F>(b2 ? r[0] : r[1]);
  t += swz<0x201F>(t); t += swz<0x401F>(t); t += __shfl_xor(t, 32);
  return t;
}
DI float udot16(const uint4& w, const float (&h)[16]) {
  f32x2 acc = {0.f, 0.f};
  const int ww[4] = {(int)w.x, (int)w.y, (int)w.z, (int)w.w};
#pragma unroll
  for (int j = 0; j < 4; ++j) {
    const f32x2 lo = __builtin_amdgcn_cvt_pk_f32_fp8(ww[j], false), hi = __builtin_amdgcn_cvt_pk_f32_fp8(ww[j], true);
    const f32x2 h0 = {h[4 * j], h[4 * j + 1]}, h1 = {h[4 * j + 2], h[4 * j + 3]};
    acc += lo * h0; acc += hi * h1;
  }
  return acc.x + acc.y;
}
DI void vacc16(const uint4& w, float a, f32x2 (&acc)[8]) {
  const f32x2 a2 = {a, a};
  const int ww[4] = {(int)w.x, (int)w.y, (int)w.z, (int)w.w};
#pragma unroll
  for (int j = 0; j < 4; ++j) {
    acc[2 * j] += a2 * __builtin_amdgcn_cvt_pk_f32_fp8(ww[j], false);
    acc[2 * j + 1] += a2 * __builtin_amdgcn_cvt_pk_f32_fp8(ww[j], true);
  }
}
#define LOAD8(buf, tbl, bidx) { const uint4 i0_ = *(const uint4*)(ids + 8 * (bidx)), i1_ = *(const uint4*)(ids + 8 * (bidx) + 4); \
    const unsigned idv_[8] = {i0_.x, i0_.y, i0_.z, i0_.w, i1_.x, i1_.y, i1_.z, i1_.w}; \
    _Pragma("unroll") for (int k_ = 0; k_ < 8; ++k_) { const unsigned id_ = __builtin_amdgcn_readfirstlane(idv_[k_]); buf[k_] = *(const uint4*)((tbl) + (size_t)id_ * 1024 + lane * 16); } }

__device__ void phase6(const Params& p, char* smem, float* dstbase) {
  const int tid = threadIdx.x, lane = tid & 63, wid = tid >> 6;
  const int gw = blockIdx.x * 4 + wid, nw = gridDim.x * 4;
  int* ids = (int*)(smem + wid * 1024);
  float* gts = (float*)(smem + wid * 1024 + 512);
  const float* hss = (const float*)(p.ws + OFF_HSS);
  const float* tops = (const float*)(p.ws + OFF_TOPS);
  const u8* topi = (const u8*)(p.ws + OFF_TOPI);
  const u8* ub = (const u8*)(p.ws + OFF_PUB);
  const u8* vb = (const u8*)(p.ws + OFF_PVB);
  int ci, cj;
  {
    const int L = lane;
    if (L < 16) { ci = 0; cj = L; } else if (L < 24) { ci = 1; cj = L - 16; } else if (L < 29) { ci = 2; cj = L - 24; }
    else if (L < 33) { ci = 3; cj = L - 29; } else if (L < 36) { ci = 4; cj = L - 33; } else if (L < 38) { ci = 5; cj = L - 36; }
    else if (L < 40) { ci = 6; cj = L - 38; } else if (L < 42) { ci = 7; cj = L - 40; } else if (L < 50) { ci = L - 34; cj = 0; }
    else { ci = 0; cj = 0; }
  }
  for (int tok = gw; tok < T_TOK; tok += nw) {
    const float rstd = rsqrtf(hss[tok] * (1.f / 1024.f) + 1e-6f);
    float hres[16], hn[16];
    {
      const float4* hp = (const float4*)(p.out + (size_t)tok * 1024 + lane * 16);
      const float4* gp = (const float4*)(p.g_ffn + lane * 16);
#pragma unroll
      for (int c = 0; c < 4; ++c) {
        const float4 t4 = hp[c], g4 = gp[c];
        hres[4 * c] = t4.x; hres[4 * c + 1] = t4.y; hres[4 * c + 2] = t4.z; hres[4 * c + 3] = t4.w;
        hn[4 * c] = t4.x * rstd * g4.x; hn[4 * c + 1] = t4.y * rstd * g4.y; hn[4 * c + 2] = t4.z * rstd * g4.z; hn[4 * c + 3] = t4.w * rstd * g4.w;
      }
    }
#pragma unroll 1
    for (int head = 0; head < 8; ++head) {
      const size_t b1 = ((size_t)tok * 16 + head * 2) * 16, b2 = b1 + 16;
      float sum = NEG_INF; int eid = 0;
      if (lane < 50) { sum = tops[b1 + ci] + tops[b2 + cj]; eid = (int)topi[b1 + ci] * 128 + (int)topi[b2 + cj]; }
      int rank = 0;
#pragma unroll
      for (int m = 0; m < 50; ++m) {
        const float v = __builtin_bit_cast(float, __builtin_amdgcn_readlane(__builtin_bit_cast(int, sum), m));
        rank += (v > sum || (v == sum && m < lane)) ? 1 : 0;
      }
      const float mxa = __builtin_bit_cast(float, __builtin_amdgcn_readlane(__builtin_bit_cast(int, sum), 0));
      const bool sel = (lane < 50) && (rank < 16);
      const float e = sel ? __expf(sum - mxa) : 0.f;
      const float den = wave_sum(e);
      if (sel) { ids[head * 16 + rank] = eid; gts[head * 16 + rank] = e / den; }
    }
    __builtin_amdgcn_wave_barrier();
    asm volatile("s_waitcnt lgkmcnt(0)" ::: "memory");
    float dsel0 = 0.f, dsel1 = 0.f;
    {
      uint4 ba[8], bb[8];
      LOAD8(ba, ub, 0);
#pragma unroll 1
      for (int b = 0; b < 16; b += 2) {
        LOAD8(bb, ub, b + 1);
        {
          float pp[8];
#pragma unroll
          for (int k = 0; k < 8; ++k) pp[k] = udot16(ba[k], hn);
          const float t = treduce8(pp, lane);
          if ((lane >> 3) == (b & 7)) { if (b < 8) dsel0 = t; else dsel1 = t; }
        }
        if (b + 2 < 16) LOAD8(ba, ub, b + 2);
        {
          float pp[8];
#pragma unroll
          for (int k = 0; k < 8; ++k) pp[k] = udot16(bb[k], hn);
          const float t = treduce8(pp, lane);
          if ((lane >> 3) == ((b + 1) & 7)) { if (b < 8) dsel0 = t; else dsel1 = t; }
        }
      }
    }
    {
      const float d0 = dsel0 * (1.f / USCALE), d1 = dsel1 * (1.f / USCALE);
      const float a0 = 0.5f * d0 * (1.f + erff(d0 * 0.70710678118654752f)) * gts[lane] * (1.f / VSCALE);
      const float a1 = 0.5f * d1 * (1.f + erff(d1 * 0.70710678118654752f)) * gts[64 + lane] * (1.f / VSCALE);
      gts[lane] = a0; gts[64 + lane] = a1;
    }
    __builtin_amdgcn_wave_barrier();
    asm volatile("s_waitcnt lgkmcnt(0)" ::: "memory");
    f32x2 acc[8];
#pragma unroll
    for (int i = 0; i < 8; ++i) acc[i] = (f32x2){0.f, 0.f};
    {
      uint4 ba[8], bb[8];
      LOAD8(ba, vb, 0);
#pragma unroll 1
      for (int b = 0; b < 16; b += 2) {
        LOAD8(bb, vb, b + 1);
        {
          const float4 g0 = *(const float4*)(gts + 8 * b), g1 = *(const float4*)(gts + 8 * b + 4);
          vacc16(ba[0], g0.x, acc); vacc16(ba[1], g0.y, acc); vacc16(ba[2], g0.z, acc); vacc16(ba[3], g0.w, acc);
          vacc16(ba[4], g1.x, acc); vacc16(ba[5], g1.y, acc); vacc16(ba[6], g1.z, acc); vacc16(ba[7], g1.w, acc);
        }
        if (b + 2 < 16) LOAD8(ba, vb, b + 2);
        {
          const float4 g0 = *(const float4*)(gts + 8 * b + 8), g1 = *(const float4*)(gts + 8 * b + 12);
          vacc16(bb[0], g0.x, acc); vacc16(bb[1], g0.y, acc); vacc16(bb[2], g0.z, acc); vacc16(bb[3], g0.w, acc);
          vacc16(bb[4], g1.x, acc); vacc16(bb[5], g1.y, acc); vacc16(bb[6], g1.z, acc); vacc16(bb[7], g1.w, acc);
        }
      }
    }
    float4* op = (float4*)(dstbase + (size_t)tok * 1024 + lane * 16);
#pragma unroll
    for (int c = 0; c < 4; ++c) op[c] = make_float4(hres[4 * c] + acc[2 * c].x, hres[4 * c + 1] + acc[2 * c].y, hres[4 * c + 2] + acc[2 * c + 1].x, hres[4 * c + 3] + acc[2 * c + 1].y);
    __builtin_amdgcn_wave_barrier();
  }
}


#define XB_TMO      128
#define XB_XCNT(j)  (256  + 64 * (j))
#define XB_XSUB(j)  (1280 + 64 * (j))
#define XB_XGEN(j)  (2304 + 64 * (j))
#define XB_TOP      3328
#define XB_TOPGEN   3392
#define XB_SPIN_CAP (1u << 22)
#define LAS __attribute__((address_space(3)))
DI unsigned xb_ld(unsigned* p) { return __hip_atomic_load(p, __ATOMIC_RELAXED, __HIP_MEMORY_SCOPE_AGENT); }
DI unsigned xb_add(unsigned* p, unsigned v) { return __hip_atomic_fetch_add(p, v, __ATOMIC_RELAXED, __HIP_MEMORY_SCOPE_AGENT); }
DI unsigned xb_xcc_id() { return (unsigned)__builtin_amdgcn_s_getreg((3 << 11) | 20) & 0xFu; }
#define XB_SPIN(cond, bar) do { unsigned _sp = 0; while (cond) { __builtin_amdgcn_s_sleep(1); \
    if ((++_sp & 255u) == 0u) { if (xb_ld(&(bar)[XB_TMO])) break; if (_sp > XB_SPIN_CAP) { atomicAdd(&(bar)[XB_TMO], 1u); break; } } } } while (0)
struct XcdBarrier { unsigned* bar; unsigned x; volatile LAS unsigned* st; };
DI XcdBarrier xcd_barrier_post(unsigned* bar, volatile LAS unsigned* st) {
  XcdBarrier b; b.bar = bar; b.x = xb_xcc_id(); b.st = st;
  if (threadIdx.x == 0) (void)xb_add(&bar[XB_XCNT(b.x)], 1u);
  return b;
}
DI void xcd_barrier_complete(unsigned* bar, unsigned x, unsigned& nloc, unsigned& nx) {
  const unsigned G = gridDim.x * gridDim.y * gridDim.z;
  unsigned sum, cnt, mine, sp = 0u;
  for (;;) {
    sum = 0u; cnt = 0u; mine = 0u;
#pragma unroll
    for (unsigned j = 0; j < 16; ++j) { const unsigned c = xb_ld(&bar[XB_XCNT(j)]); sum += c; cnt += (c > 0u) ? 1u : 0u; mine = (j == x) ? c : mine; }
    if (sum == G) break;
    __builtin_amdgcn_s_sleep(1);
    if ((++sp & 255u) == 0u) { if (xb_ld(&bar[XB_TMO])) break; if (sp > XB_SPIN_CAP) { atomicAdd(&bar[XB_TMO], 1u); break; } }
  }
  nloc = mine > 0u ? mine : 1u; nx = cnt > 0u ? cnt : 1u;
}
DI void xcd_barrier(const XcdBarrier& b) {
  asm volatile("s_waitcnt vmcnt(0)" ::: "memory");
  __syncthreads();
  if (threadIdx.x == 0) {
    unsigned* bar = b.bar;
    __builtin_amdgcn_s_waitcnt(0);
    unsigned nloc = b.st[0], nx = b.st[1];
    if (nloc == 0u) { xcd_barrier_complete(bar, b.x, nloc, nx); b.st[0] = nloc; b.st[1] = nx; }
    const unsigned old = xb_add(&bar[XB_XSUB(b.x)], 1u);
    const unsigned gen = old / nloc;
    if (old + 1u == (gen + 1u) * nloc) {
      __builtin_amdgcn_fence(__ATOMIC_RELEASE, "agent");
      asm volatile("s_waitcnt vmcnt(0)" ::: "memory");
      const unsigned og = xb_add(&bar[XB_TOP], 1u);
      const unsigned tg = og / nx;
      if (og + 1u == (tg + 1u) * nx) xb_add(&bar[XB_TOPGEN], 1u);
      else XB_SPIN(xb_ld(&bar[XB_TOPGEN]) == tg, bar);
      __builtin_amdgcn_fence(__ATOMIC_ACQUIRE, "agent");
      xb_add(&bar[XB_XGEN(b.x)], 1u);
      asm volatile("s_waitcnt vmcnt(0)" ::: "memory");
    } else {
      XB_SPIN(xb_ld(&bar[XB_XGEN(b.x)]) == gen, bar);
      __builtin_amdgcn_fence(__ATOMIC_ACQUIRE, "agent");
      asm volatile("s_waitcnt vmcnt(0)" ::: "memory");
    }
  }
  __syncthreads();
}

#if FUSED
__global__ void __launch_bounds__(256, 2) fwd_megakernel(Params p) {
  __shared__ __attribute__((aligned(16))) char smem[SMEM_BYTES];
  cg::grid_group grid = cg::this_grid();
  __shared__ uint4 xb_words;
  if (threadIdx.x == 0) xb_words = make_uint4(0u, 0u, 0u, 0u);
  phase0(p, smem);
  grid.sync();
  const XcdBarrier xb = xcd_barrier_post((unsigned*)(p.ws + OFF_BAR), (volatile LAS unsigned*)&xb_words);
  for (int t = blockIdx.x; t < 256 * 24; t += gridDim.x) phase1_tile(p, t / 24, t % 24, smem);
  xcd_barrier(xb);
#if PROBE_DUP == 1
  for (int t = blockIdx.x; t < 256 * 24; t += gridDim.x) phase1_tile(p, t / 24, t % 24, smem);
  xcd_barrier(xb);
#endif
#if PROBE_DUP == 2
  phase2(p, smem, 2);
  xcd_barrier(xb);
#endif
  phase2(p, smem);
  xcd_barrier(xb);
  phase3(p);
  xcd_barrier(xb);
  for (int t = blockIdx.x; t < 256 * 8; t += gridDim.x) phase4_tile(p, t >> 3, t & 7, smem);
  xcd_barrier(xb);
  for (int t = blockIdx.x; t < 256 * 16; t += gridDim.x) phase5_tile(p, t >> 4, t & 15, smem);
  xcd_barrier(xb);
#if PROBE_DUP == 5
  for (int t = blockIdx.x; t < 256 * 16; t += gridDim.x) phase5_tile(p, t >> 4, t & 15, smem);
  xcd_barrier(xb);
#endif
#if PROBE_DUP == 6
  phase6(p, smem, (float*)(p.ws + OFF_OAP));
  xcd_barrier(xb);
#endif
  phase6(p, smem, p.out);
}
#else
__global__ void __launch_bounds__(256, 2) k_p0(Params p) { __shared__ __attribute__((aligned(16))) char smem[SMEM_BYTES]; phase0(p, smem); }
__global__ void __launch_bounds__(256, 2) k_p1(Params p) { __shared__ __attribute__((aligned(16))) char smem[SMEM_BYTES]; for (int t = blockIdx.x; t < 256 * 24; t += gridDim.x) phase1_tile(p, t / 24, t % 24, smem); }
__global__ void __launch_bounds__(256, 2) k_p2(Params p) { __shared__ __attribute__((aligned(16))) char smem[SMEM_BYTES]; phase2(p, smem); }
__global__ void __launch_bounds__(256, 2) k_p3(Params p) { phase3(p); }
__global__ void __launch_bounds__(256, 2) k_p4(Params p) { __shared__ __attribute__((aligned(16))) char smem[SMEM_BYTES]; for (int t = blockIdx.x; t < 256 * 8; t += gridDim.x) phase4_tile(p, t >> 3, t & 7, smem); }
__global__ void __launch_bounds__(256, 2) k_p5(Params p) { __shared__ __attribute__((aligned(16))) char smem[SMEM_BYTES]; for (int t = blockIdx.x; t < 256 * 16; t += gridDim.x) phase5_tile(p, t >> 4, t & 15, smem); }
__global__ void __launch_bounds__(256, 2) k_p6(Params p) { __shared__ __attribute__((aligned(16))) char smem[SMEM_BYTES]; phase6(p, smem, p.out); }
#endif

extern "C" void kernel_launch(void* const* d_in, const int* in_sizes, int n_in, void* d_out, int out_size, void* d_ws, size_t ws_size,
                              hipStream_t stream) {
  Params p{};
  p.x = (const float*)d_in[0]; p.g_attn = (const float*)d_in[1]; p.w_in = (const float*)d_in[2]; p.qna = (const float*)d_in[3];
  p.kna = (const float*)d_in[4]; p.ona = (const float*)d_in[5]; p.qnb = (const float*)d_in[6]; p.knb = (const float*)d_in[7];
  p.lq1 = (const float*)d_in[8]; p.lk1 = (const float*)d_in[9]; p.lq2 = (const float*)d_in[10]; p.lk2 = (const float*)d_in[11];
  p.onb = (const float*)d_in[12]; p.w_out = (const float*)d_in[13]; p.g_ffn = (const float*)d_in[14]; p.w_pq = (const float*)d_in[15];
  p.subk = (const float*)d_in[16]; p.pu = (const float*)d_in[17]; p.pv = (const float*)d_in[18];
  p.out = (float*)d_out; p.ws = (char*)d_ws;
#if FUSED
  static int grid_blocks = 0;
  if (!grid_blocks) {
    int dev = 0, cus = 0, per_cu = 0;
    hipGetDevice(&dev);
    hipDeviceGetAttribute(&cus, hipDeviceAttributeMultiprocessorCount, dev);
    hipOccupancyMaxActiveBlocksPerMultiprocessor(&per_cu, fwd_megakernel, 256, 0);
    if (per_cu > 2) per_cu = 2;
    if (per_cu < 1) per_cu = 1;
    grid_blocks = cus * per_cu;
  }
  void* args[] = {&p};
  hipError_t e = hipLaunchCooperativeKernel((void*)fwd_megakernel, dim3(grid_blocks), dim3(256), args, 0, stream);
  if (e != hipSuccess) fprintf(stderr, "cooperative launch failed: %s (grid %d)\n", hipGetErrorString(e), grid_blocks);
#else
  const int G = 512;
  k_p0<<<G, 256, 0, stream>>>(p);
  k_p1<<<G, 256, 0, stream>>>(p);
  k_p2<<<G, 256, 0, stream>>>(p);
  k_p3<<<G, 256, 0, stream>>>(p);
  k_p4<<<G, 256, 0, stream>>>(p);
  k_p5<<<G, 256, 0, stream>>>(p);
  k_p6<<<G, 256, 0, stream>>>(p);
#endif
}
```

```cpp
#include <hip/hip_runtime.h>
#include <hip/hip_cooperative_groups.h>
#include <cstdio>
#include <cstdint>
namespace cg = cooperative_groups;

#ifndef FUSED
#define FUSED 1
#endif
#ifndef PROBE_DUP
#define PROBE_DUP 0
#endif

typedef unsigned short u16;
typedef unsigned char u8;
typedef __attribute__((ext_vector_type(8))) short bf16x8;
typedef __attribute__((ext_vector_type(4))) short s16x4;
typedef __attribute__((ext_vector_type(16))) float f32x16;
typedef __attribute__((ext_vector_type(2))) __bf16 bf2_t;
typedef __attribute__((ext_vector_type(4))) unsigned u32x4;
#define DI __device__ __forceinline__
#define MFMA(a, b, c) __builtin_amdgcn_mfma_f32_32x32x16_bf16((a), (b), (c), 0, 0, 0)

constexpr int T_TOK = 32768;
constexpr int SEQ = 4096;
constexpr size_t MB = 1u << 20;
constexpr size_t OFF_XNB = 0;
constexpr size_t OFF_QA = 64 * MB, OFF_KA = 96 * MB, OFF_VA = 128 * MB, OFF_QB = 160 * MB, OFF_KB = 192 * MB, OFF_VB = 224 * MB;
constexpr size_t OFF_TOPS = 64 * MB;
constexpr size_t OFF_TOPI = 96 * MB;
constexpr size_t OFF_OAP = 256 * MB;
constexpr size_t OFF_OBC = 352 * MB;
constexpr size_t OFF_PUB = 416 * MB, OFF_PVB = 448 * MB;
constexpr size_t OFF_WIN = 480 * MB, OFF_WOUT = 486 * MB, OFF_WPQ = 488 * MB, OFF_SUBK = 492 * MB;
constexpr size_t OFF_ROPEC = 493 * MB, OFF_ROPES = 493 * MB + 128 * 1024;
constexpr size_t OFF_LSE = 494 * MB;
constexpr size_t OFF_HSS = 497 * MB;
constexpr size_t OFF_MISC = 497 * MB + 128 * 1024;

constexpr size_t OFF_BAR = 497 * MB + 256 * 1024;
constexpr int SMEM_BYTES = 73728;
#define XCD_BAR_WORDS 3456
constexpr float QSCALE = 0.125f * 1.4426950408889634f;
constexpr float NEG_INF = -__builtin_huge_valf();
constexpr float USCALE = 64.f, VSCALE = 16.f;
typedef float f32x2 __attribute__((ext_vector_type(2)));

struct Params {
  const float *x, *g_attn, *w_in, *qna, *kna, *ona, *qnb, *knb, *lq1, *lk1, *lq2, *lk2, *onb, *w_out, *g_ffn, *w_pq, *subk, *pu, *pv;
  float* out;
  char* ws;
};

DI u16 f2bf(float x) { unsigned u = __float_as_uint(x); u += 0x7fffu + ((u >> 16) & 1u); return (u16)(u >> 16); }
DI float bf2f(u16 b) { return __uint_as_float(((unsigned)b) << 16); }
DI unsigned pack2(float a, float b) { return (unsigned)f2bf(a) | ((unsigned)f2bf(b) << 16); }
DI float bflo(unsigned u) { return __uint_as_float(u << 16); }
DI float bfhi(unsigned u) { return __uint_as_float(u & 0xffff0000u); }
DI float wave_sum(float v) {
  v += __shfl_xor(v, 32); v += __shfl_xor(v, 16); v += __shfl_xor(v, 8); v += __shfl_xor(v, 4); v += __shfl_xor(v, 2); v += __shfl_xor(v, 1);
  return v;
}
DI void gld16(u32x4& dst, const void* ptr) { asm volatile("global_load_dwordx4 %0, %1, off" : "=v"(dst) : "v"(ptr) : "memory"); }
DI void vm_wait8(u32x4& a, u32x4& b, u32x4& c, u32x4& d, u32x4& e, u32x4& f, u32x4& g, u32x4& h) {
  asm volatile("s_waitcnt vmcnt(0)" : "+v"(a), "+v"(b), "+v"(c), "+v"(d), "+v"(e), "+v"(f), "+v"(g), "+v"(h) : : "memory");
}
template <int N> DI void vm_wait8n(u32x4& a, u32x4& b, u32x4& c, u32x4& d, u32x4& e, u32x4& f, u32x4& g, u32x4& h) {
  asm volatile("s_waitcnt vmcnt(%8)" : "+v"(a), "+v"(b), "+v"(c), "+v"(d), "+v"(e), "+v"(f), "+v"(g), "+v"(h) : "n"(N) : "memory");
}
DI void vm_wait6(u32x4& a, u32x4& b, u32x4& c, u32x4& d, u32x4& e, u32x4& f) {
  asm volatile("s_waitcnt vmcnt(0)" : "+v"(a), "+v"(b), "+v"(c), "+v"(d), "+v"(e), "+v"(f) : : "memory");
}
DI int opaque_tid() { int t = threadIdx.x; asm volatile("" : "+v"(t)); return t; }
DI int crow(int reg, int h) { return (reg & 3) + 8 * (reg >> 2) + 4 * h; }

__device__ void phase0(const Params& p, char* smem) {
  const int tid = threadIdx.x, lane = tid & 63, wid = tid >> 6;
  const int gw = blockIdx.x * 4 + wid, nw = gridDim.x * 4;
  const int gt = blockIdx.x * 256 + tid, nt = gridDim.x * 256;
  u16* xnb = (u16*)(p.ws + OFF_XNB);
  for (int row = gw; row < T_TOK; row += nw) {
    const float4* xr = (const float4*)(p.x + (size_t)row * 1024);
    float4 v[4]; float ss = 0.f;
#pragma unroll
    for (int i = 0; i < 4; ++i) { v[i] = xr[lane + 64 * i]; ss += v[i].x * v[i].x + v[i].y * v[i].y + v[i].z * v[i].z + v[i].w * v[i].w; }
    ss = wave_sum(ss);
    const float r = rsqrtf(ss * (1.f / 1024.f) + 1e-6f);
    uint2* dst = (uint2*)(xnb + (size_t)row * 1024);
#pragma unroll
    for (int i = 0; i < 4; ++i) dst[lane + 64 * i] = make_uint2(pack2(v[i].x * r, v[i].y * r), pack2(v[i].z * r, v[i].w * r));
  }
  float* tile = (float*)smem;
  for (int job = blockIdx.x; job < 1536; job += gridDim.x) {
    const float* W; const float* g; u16* outp; int N, j;
    if (job < 768) { W = p.w_in; g = p.g_attn; outp = (u16*)(p.ws + OFF_WIN); N = 3072; j = job; }
    else if (job < 1024) { W = p.w_out; g = nullptr; outp = (u16*)(p.ws + OFF_WOUT); N = 1024; j = job - 768; }
    else { W = p.w_pq; g = p.g_ffn; outp = (u16*)(p.ws + OFF_WPQ); N = 2048; j = job - 1024; }
    const int ntn = N >> 6, kt = j / ntn, ntile = j % ntn;
    const int tx = tid & 63, ty = tid >> 6;
#pragma unroll 4
    for (int r = 0; r < 16; ++r) {
      const int k = kt * 64 + ty + 4 * r;
      float v = W[(size_t)k * N + ntile * 64 + tx];
      if (g) v *= g[k];
      tile[(ty + 4 * r) * 65 + tx] = v;
    }
    __syncthreads();
#pragma unroll 4
    for (int r = 0; r < 16; ++r) {
      const int nl = ty + 4 * r;
      outp[(size_t)(ntile * 64 + nl) * 1024 + kt * 64 + tx] = f2bf(tile[tx * 65 + nl]);
    }
    __syncthreads();
  }
  {
    const float4* s = (const float4*)p.subk; uint2* d = (uint2*)(p.ws + OFF_SUBK);
    for (int i = gt; i < 262144 / 4; i += nt) { float4 v = s[i]; d[i] = make_uint2(pack2(v.x, v.y), pack2(v.z, v.w)); }
    const float4* su = (const float4*)p.pu; int* du = (int*)(p.ws + OFF_PUB);
    const float4* sv = (const float4*)p.pv; int* dv = (int*)(p.ws + OFF_PVB);
    for (int i = gt; i < 16384 * 1024 / 4; i += nt) {
      float4 a = su[i]; float4 b = sv[i];
      int ra = __builtin_amdgcn_cvt_pk_fp8_f32(a.x * USCALE, a.y * USCALE, 0, false);
      ra = __builtin_amdgcn_cvt_pk_fp8_f32(a.z * USCALE, a.w * USCALE, ra, true);
      int rb = __builtin_amdgcn_cvt_pk_fp8_f32(b.x * VSCALE, b.y * VSCALE, 0, false);
      rb = __builtin_amdgcn_cvt_pk_fp8_f32(b.z * VSCALE, b.w * VSCALE, rb, true);
      du[i] = ra; dv[i] = rb;
    }
  }
  {
    float* rc = (float*)(p.ws + OFF_ROPEC); float* rs = (float*)(p.ws + OFF_ROPES);
    for (int i = gt; i < SEQ * 8; i += nt) {
      const int pos = i >> 3, f = i & 7;
      const float invf = (float)pow(500000.0, -(double)f / 8.0);
      const float ang = (float)pos * invf;
      rc[i] = (float)cos((double)ang); rs[i] = (float)sin((double)ang);
    }
    float* hss = (float*)(p.ws + OFF_HSS);
    for (int i = gt; i < T_TOK; i += nt) hss[i] = 0.f;
    unsigned* barw = (unsigned*)(p.ws + OFF_BAR);
    for (int i = gt; i < XCD_BAR_WORDS; i += nt) barw[i] = 0u;
    if (gt == 0) {
      float a = 0.f, b = 0.f;
      for (int i = 0; i < 64; ++i) { a += p.lq1[i] * p.lk1[i]; b += p.lq2[i] * p.lk2[i]; }
      float* misc = (float*)(p.ws + OFF_MISC);
      misc[0] = expf(a) - expf(b) + 0.2f;
      ((int*)misc)[1] = 0; ((int*)misc)[2] = 0;
    }
  }
}

DI void gemm_mainloop(const u16* __restrict__ A, const u16* __restrict__ Bt, int m0, int n0, char* smem, f32x16 (&acc)[2][2]) {
  u16* As = (u16*)smem;
  u16* Bs = As + 2 * 128 * 72;
  const int tid = opaque_tid(), lane = tid & 63, w = tid >> 6, wm = w >> 1, wn = w & 1, lr = lane & 31, lh = lane >> 5;
#pragma unroll
  for (int a = 0; a < 2; ++a)
#pragma unroll
    for (int b = 0; b < 2; ++b)
#pragma unroll
      for (int r = 0; r < 16; ++r) acc[a][b][r] = 0.f;
  u32x4 raA[4], rbA[4], raB[4], rbB[4];
  const int lrow = tid >> 3, lkc = tid & 7;
  const u16* Ag = A + (size_t)(m0 + lrow) * 1024 + lkc * 8;
  const u16* Bg = Bt + (size_t)(n0 + lrow) * 1024 + lkc * 8;
#define GLOAD(S_, kt) { _Pragma("unroll") for (int i = 0; i < 4; ++i) { gld16(ra##S_[i], Ag + (size_t)i * 32 * 1024 + (kt) * 64); gld16(rb##S_[i], Bg + (size_t)i * 32 * 1024 + (kt) * 64); } }
#define SWRITE(S_, buf, NW_) { vm_wait8n<NW_>(ra##S_[0], ra##S_[1], ra##S_[2], ra##S_[3], rb##S_[0], rb##S_[1], rb##S_[2], rb##S_[3]); \
    _Pragma("unroll") for (int i = 0; i < 4; ++i) { *(u32x4*)(As + ((buf) * 128 + lrow + 32 * i) * 72 + lkc * 8) = ra##S_[i]; *(u32x4*)(Bs + ((buf) * 128 + lrow + 32 * i) * 72 + lkc * 8) = rb##S_[i]; } }
#define GCOMPUTE(buf) { \
    const u16* ab = As + ((buf) * 128 + wm * 64 + lr) * 72 + lh * 8; \
    const u16* bb = Bs + ((buf) * 128 + wn * 64 + lr) * 72 + lh * 8; \
    _Pragma("unroll") for (int s = 0; s < 4; ++s) { \
      const bf16x8 a0 = *(const bf16x8*)(ab + s * 16), a1 = *(const bf16x8*)(ab + 32 * 72 + s * 16); \
      const bf16x8 b0 = *(const bf16x8*)(bb + s * 16), b1 = *(const bf16x8*)(bb + 32 * 72 + s * 16); \
      acc[0][0] = MFMA(a0, b0, acc[0][0]); acc[0][1] = MFMA(a0, b1, acc[0][1]); \
      acc[1][0] = MFMA(a1, b0, acc[1][0]); acc[1][1] = MFMA(a1, b1, acc[1][1]); } }
  GLOAD(A, 0); SWRITE(A, 0, 0); GLOAD(A, 1); __syncthreads();
  for (int kt = 0; kt < 14; kt += 2) {
    GLOAD(B, kt + 2);
    GCOMPUTE(0);
    SWRITE(A, 1, 8);
    __syncthreads();
    GLOAD(A, kt + 3);
    GCOMPUTE(1);
    SWRITE(B, 0, 8);
    __syncthreads();
  }
  GCOMPUTE(0);
  SWRITE(A, 1, 0);
  __syncthreads();
  GCOMPUTE(1);
  __syncthreads();
#undef GCOMPUTE
#undef GLOAD
#undef SWRITE
}

DI void stage_acc(const f32x16 (&acc)[2][2], float* st) {
  const int tid = threadIdx.x, lane = tid & 63, w = tid >> 6, wm = w >> 1, wn = w & 1, lr = lane & 31, lh = lane >> 5;
#pragma unroll
  for (int mt = 0; mt < 2; ++mt)
#pragma unroll
    for (int nt = 0; nt < 2; ++nt)
#pragma unroll
      for (int r = 0; r < 16; ++r) st[(wm * 64 + mt * 32 + crow(r, lh)) * 132 + wn * 64 + nt * 32 + lr] = acc[mt][nt][r];
}

__device__ void phase1_tile(const Params& p, int mtile, int j, char* smem) {
  f32x16 acc[2][2];
  const int m0 = mtile * 128, n0 = j * 128;
  gemm_mainloop((const u16*)(p.ws + OFF_XNB), (const u16*)(p.ws + OFF_WIN), m0, n0, smem, acc);
  float* st = (float*)smem;
  stage_acc(acc, st);
  __syncthreads();
  const int tid = threadIdx.x, row = tid & 127, half = tid >> 7;
  const int sec = j >> 2;
  const int tok = m0 + row, b = tok >> 12, s = tok & 4095;
  float v[64];
#pragma unroll
  for (int c = 0; c < 16; ++c) { const float4 t4 = *(const float4*)(st + row * 132 + half * 64 + c * 4); v[4 * c] = t4.x; v[4 * c + 1] = t4.y; v[4 * c + 2] = t4.z; v[4 * c + 3] = t4.w; }
  if (sec != 2 && sec != 5) {
    const float* g = sec == 0 ? p.qna : sec == 1 ? p.kna : sec == 3 ? p.qnb : p.knb;
    float ss = 0.f;
#pragma unroll
    for (int i = 0; i < 64; ++i) ss += v[i] * v[i];
    float r = rsqrtf(ss * (1.f / 64.f) + 1e-6f);
    const float post = (sec == 0 || sec == 3) ? QSCALE : 1.f;
#pragma unroll
    for (int i = 0; i < 64; ++i) v[i] = v[i] * r * g[i];
    const float* rc = (const float*)(p.ws + OFF_ROPEC) + s * 8;
    const float* rs = (const float*)(p.ws + OFF_ROPES) + s * 8;
#pragma unroll
    for (int i = 0; i < 8; ++i) {
      const float c = rc[i], sn = rs[i], x1 = v[i], x2 = v[i + 8];
      v[i] = x1 * c - x2 * sn; v[i + 8] = x2 * c + x1 * sn;
    }
#pragma unroll
    for (int i = 0; i < 64; ++i) v[i] *= post;
  }
  u16* dst;
  if (sec == 5) {
    dst = (u16*)(p.ws + OFF_VB) + ((size_t)(b * 4 + (j & 3)) * 4096 + s) * 128 + half * 64;
  } else {
    const size_t off = sec == 0 ? OFF_QA : sec == 1 ? OFF_KA : sec == 2 ? OFF_VA : sec == 3 ? OFF_QB : OFF_KB;
    const int hc = (j & 3) * 2 + half;
    dst = (u16*)(p.ws + off) + ((size_t)(b * 8 + hc) * 4096 + s) * 64;
  }
#pragma unroll
  for (int c = 0; c < 8; ++c)
    ((uint4*)dst)[c] = make_uint4(pack2(v[8 * c], v[8 * c + 1]), pack2(v[8 * c + 2], v[8 * c + 3]), pack2(v[8 * c + 4], v[8 * c + 5]), pack2(v[8 * c + 6], v[8 * c + 7]));
  __syncthreads();
}

template <int OFF> DI s16x4 tr_read(unsigned addr) {
  s16x4 r; asm volatile("ds_read_b64_tr_b16 %0, %1 offset:%2" : "=v"(r) : "v"(addr), "n"(OFF) : "memory"); return r;
}
DI void wait_tr8(s16x4& a0, s16x4& a1, s16x4& a2, s16x4& a3, s16x4& a4, s16x4& a5, s16x4& a6, s16x4& a7) {
  asm volatile("s_waitcnt lgkmcnt(0)" : "+v"(a0), "+v"(a1), "+v"(a2), "+v"(a3), "+v"(a4), "+v"(a5), "+v"(a6), "+v"(a7) : : "memory");
}

#define TR_ISSUE(S_, MT_) { const unsigned a0_ = vaddr + (MT_) * 64; \
        S_##0 = tr_read<0 * 16 * VST * 2>(a0_); S_##1 = tr_read<(0 * 16 + 8) * VST * 2>(a0_); S_##2 = tr_read<1 * 16 * VST * 2>(a0_); S_##3 = tr_read<(1 * 16 + 8) * VST * 2>(a0_); \
        S_##4 = tr_read<2 * 16 * VST * 2>(a0_); S_##5 = tr_read<(2 * 16 + 8) * VST * 2>(a0_); S_##6 = tr_read<3 * 16 * VST * 2>(a0_); S_##7 = tr_read<(3 * 16 + 8) * VST * 2>(a0_); }
#define TR_MFMA(S_, MT_) { \
        o[MT_] = MFMA(__builtin_shufflevector(S_##0, S_##1, 0, 1, 2, 3, 4, 5, 6, 7), pf[0], o[MT_]); o[MT_] = MFMA(__builtin_shufflevector(S_##2, S_##3, 0, 1, 2, 3, 4, 5, 6, 7), pf[1], o[MT_]); \
        o[MT_] = MFMA(__builtin_shufflevector(S_##4, S_##5, 0, 1, 2, 3, 4, 5, 6, 7), pf[2], o[MT_]); o[MT_] = MFMA(__builtin_shufflevector(S_##6, S_##7, 0, 1, 2, 3, 4, 5, 6, 7), pf[3], o[MT_]); }
template <int DV, bool CAUSAL>
__device__ void attn_unit(const u16* __restrict__ qbase, const u16* __restrict__ kbase, const u16* __restrict__ vbase, int n, int dil, int res,
                          u16* __restrict__ obase, int ostride, float* __restrict__ lsebase, char* smem) {
  constexpr int VST = DV + 8;
  constexpr int NMT = DV / 32;
  constexpr int WMAX = CAUSAL ? (1 << 30) : 128;
  u16* Ks = (u16*)smem;
  u16* Vs = Ks + 2 * 64 * 72;
  const int tid = opaque_tid(), lane = tid & 63, w = tid >> 6, lr = lane & 31, lh = lane >> 5;
  const int kb0 = CAUSAL ? 0 : 128 * (n - 1);
  const int kt_begin = CAUSAL ? 0 : (n == 0 ? 2 : 0);
  const int kt_end = CAUSAL ? (2 * n + 2) : 4;
  const int mq = 128 * n + 32 * w + lr;
  const size_t tq = (size_t)mq * dil + res;
  bf16x8 qf[4];
  {
    const u16* qp = qbase + tq * 64 + lh * 8;
#pragma unroll
    for (int s = 0; s < 4; ++s) qf[s] = *(const bf16x8*)(qp + s * 16);
  }
  f32x16 o[NMT];
#pragma unroll
  for (int mt = 0; mt < NMT; ++mt)
#pragma unroll
    for (int r = 0; r < 16; ++r) o[mt][r] = 0.f;
  float m_run = NEG_INF, l_run = 0.f;
  u32x4 rk0, rk1, rv0, rv1, rv2, rv3;
  rv2 = rv3 = (u32x4){0u, 0u, 0u, 0u};
  const int krow_ = tid >> 3, kkc = tid & 7;
  constexpr int VCPR = DV / 8;
  const int vrow = tid / VCPR, vkc = tid % VCPR;
  constexpr int VRSTEP = 256 / VCPR;
  const u16* kgp = kbase + ((size_t)(kb0 + krow_) * dil + res) * 64 + kkc * 8;
  const u16* vgp = vbase + ((size_t)(kb0 + vrow) * dil + res) * DV + vkc * 8;
  const size_t kstep32 = (size_t)32 * dil * 64, kstep64 = (size_t)64 * dil * 64;
  const size_t vstepr = (size_t)VRSTEP * dil * DV, vstep64 = (size_t)64 * dil * DV;
  u16* ksw = Ks + krow_ * 72 + kkc * 8;
  u16* vsw = Vs + vrow * VST + vkc * 8;
#define AGLOAD(kt) { const u16* kp_ = kgp + (size_t)(kt) * kstep64; gld16(rk0, kp_); gld16(rk1, kp_ + kstep32); \
    const u16* vp_ = vgp + (size_t)(kt) * vstep64; gld16(rv0, vp_); gld16(rv1, vp_ + vstepr); \
    if (NMT == 4) { gld16(rv2, vp_ + 2 * vstepr); gld16(rv3, vp_ + 3 * vstepr); } }
#define ASWRITE(buf) { vm_wait6(rk0, rk1, rv0, rv1, rv2, rv3); *(u32x4*)(ksw + (buf) * 64 * 72) = rk0; *(u32x4*)(ksw + (buf) * 64 * 72 + 32 * 72) = rk1; \
    *(u32x4*)(vsw + (buf) * 64 * VST) = rv0; *(u32x4*)(vsw + (buf) * 64 * VST + VRSTEP * VST) = rv1; \
    if (NMT == 4) { *(u32x4*)(vsw + (buf) * 64 * VST + 2 * VRSTEP * VST) = rv2; *(u32x4*)(vsw + (buf) * 64 * VST + 3 * VRSTEP * VST) = rv3; } }
  AGLOAD(kt_begin); ASWRITE(0); __syncthreads();
  const int li = lane & 31, blk = li >> 4, tq_ = (li >> 2) & 3, tp = li & 3;
  for (int kt = kt_begin; kt < kt_end; ++kt) {
    const int buf = (kt - kt_begin) & 1;
    if (kt + 1 < kt_end) AGLOAD(kt + 1);
    __builtin_amdgcn_sched_barrier(0);
    const int k_lo = kb0 + 64 * kt, q_lo = 128 * n + 32 * w;
    const int dmin = q_lo - (k_lo + 63), dmax = q_lo + 31 - k_lo;
    const bool skip = (dmax < 0) || (dmin > WMAX);
    if (!skip) {
      const bool need_mask = (dmin < 0) || (dmax > WMAX);
      const unsigned vaddr = (unsigned)(size_t)(Vs + (buf * 64 + 4 * lh + tq_) * VST + 16 * blk + 4 * tp);
      s16x4 va0, va1, va2, va3, va4, va5, va6, va7;
      const u16* kb = Ks + (buf * 64 + lr) * 72 + lh * 8;
      f32x16 st[2];
#pragma unroll
      for (int kk = 0; kk < 2; ++kk) {
#pragma unroll
        for (int r = 0; r < 16; ++r) st[kk][r] = 0.f;
#pragma unroll
        for (int s = 0; s < 4; ++s) { const bf16x8 a = *(const bf16x8*)(kb + kk * 32 * 72 + s * 16); st[kk] = MFMA(a, qf[s], st[kk]); }
      }
      if (need_mask) {
#pragma unroll
        for (int kk = 0; kk < 2; ++kk)
#pragma unroll
          for (int r = 0; r < 16; ++r) {
            const int d = mq - (k_lo + 32 * kk + crow(r, lh));
            if (d < 0 || d > WMAX) st[kk][r] = NEG_INF;
          }
      }
      TR_ISSUE(va, 0);
      float mx = NEG_INF;
#pragma unroll
      for (int kk = 0; kk < 2; ++kk)
#pragma unroll
        for (int r = 0; r < 16; ++r) mx = fmaxf(mx, st[kk][r]);
      mx = fmaxf(mx, __shfl_xor(mx, 32));
      const float m_new = fmaxf(m_run, mx);
      const float m_use = (m_new == NEG_INF) ? 0.f : m_new;
      const float alpha = exp2f(m_run - m_use);
      float ls = 0.f;
#pragma unroll
      for (int kk = 0; kk < 2; ++kk)
#pragma unroll
        for (int r = 0; r < 16; ++r) { const float e = exp2f(st[kk][r] - m_use); st[kk][r] = e; ls += e; }
      l_run = l_run * alpha + ls; m_run = m_new;
#pragma unroll
      for (int mt = 0; mt < NMT; ++mt)
#pragma unroll
        for (int r = 0; r < 16; ++r) o[mt][r] *= alpha;
      bf16x8 pf[4];
#pragma unroll
      for (int ks = 0; ks < 4; ++ks) {
        const int kk = ks >> 1, s2 = ks & 1;
        u32x4 cv;
        cv[0] = pack2(st[kk][8 * s2 + 0], st[kk][8 * s2 + 1]); cv[1] = pack2(st[kk][8 * s2 + 2], st[kk][8 * s2 + 3]);
        cv[2] = pack2(st[kk][8 * s2 + 4], st[kk][8 * s2 + 5]); cv[3] = pack2(st[kk][8 * s2 + 6], st[kk][8 * s2 + 7]);
        pf[ks] = __builtin_bit_cast(bf16x8, cv);
      }
      wait_tr8(va0, va1, va2, va3, va4, va5, va6, va7);
      TR_MFMA(va, 0);
      TR_ISSUE(va, 1);
      wait_tr8(va0, va1, va2, va3, va4, va5, va6, va7);
      TR_MFMA(va, 1);
      if (NMT == 4) {
        TR_ISSUE(va, 2);
        wait_tr8(va0, va1, va2, va3, va4, va5, va6, va7);
        TR_MFMA(va, 2 % NMT);
        TR_ISSUE(va, 3);
        wait_tr8(va0, va1, va2, va3, va4, va5, va6, va7);
        TR_MFMA(va, 3 % NMT);
      }
    }
    if (kt + 1 < kt_end) ASWRITE(buf ^ 1);
    __syncthreads();
  }
#undef AGLOAD
#undef ASWRITE
  const float l_tot = l_run + __shfl_xor(l_run, 32);
  const float inv = 1.f / l_tot;
  u16* op = obase + tq * ostride;
#pragma unroll
  for (int mt = 0; mt < NMT; ++mt)
#pragma unroll
    for (int g = 0; g < 4; ++g) {
      const int dv0 = 32 * mt + 8 * g + 4 * lh;
      *(uint2*)(op + dv0) = make_uint2(pack2(o[mt][4 * g] * inv, o[mt][4 * g + 1] * inv), pack2(o[mt][4 * g + 2] * inv, o[mt][4 * g + 3] * inv));
    }
  if (!CAUSAL && lh == 0) lsebase[tq * 8] = m_run + log2f(l_tot);
}

constexpr int N_DIFF_UNITS = 2048, N_DIL_UNITS = 6144;
__device__ void phase2_unit(const Params& p, int u, char* smem) {
  if (u < N_DIFF_UNITS) {
    const int n = 31 - (u >> 6), rem = u & 63, b = rem >> 3, hc = rem & 7, h4 = hc >> 1;
    const u16* qb = (const u16*)(p.ws + OFF_QB) + (size_t)(b * 8 + hc) * 4096 * 64;
    const u16* kb = (const u16*)(p.ws + OFF_KB) + (size_t)(b * 8 + hc) * 4096 * 64;
    const u16* vb = (const u16*)(p.ws + OFF_VB) + (size_t)(b * 4 + h4) * 4096 * 128;
    u16* ob = (u16*)(p.ws + OFF_OBC) + (size_t)b * 4096 * 1024 + hc * 128;
    attn_unit<128, true>(qb, kb, vb, n, 1, 0, ob, 1024, nullptr, smem);
  } else {
    const int u2 = u - N_DIFF_UNITS, pidx = u2 >> 11, rem = u2 & 2047, b = rem >> 8, h = (rem >> 5) & 7, rn = rem & 31;
    const int sh = 2 * pidx, dil = 1 << sh, nb = 32 >> sh, res = rn >> (5 - sh), n = rn & (nb - 1);
    const u16* qb = (const u16*)(p.ws + OFF_QA) + (size_t)(b * 8 + h) * 4096 * 64;
    const u16* kb = (const u16*)(p.ws + OFF_KA) + (size_t)(b * 8 + h) * 4096 * 64;
    const u16* vb = (const u16*)(p.ws + OFF_VA) + (size_t)(b * 8 + h) * 4096 * 64;
    u16* ob = (u16*)(p.ws + OFF_OAP) + ((size_t)pidx * T_TOK + (size_t)b * 4096) * 512 + h * 64;
    float* lse = (float*)(p.ws + OFF_LSE) + ((size_t)pidx * T_TOK + (size_t)b * 4096) * 8 + h;
    attn_unit<64, false>(qb, kb, vb, n, dil, res, ob, 512, lse, smem);
  }
}
__device__ void phase2(const Params& p, char* smem, int slot = 1) {
  int* counter = (int*)(p.ws + OFF_MISC) + slot;
  int* s_unit = (int*)(smem + SMEM_BYTES - 16);
  while (true) {
    if (threadIdx.x == 0) *s_unit = atomicAdd(counter, 1);
    __syncthreads();
    const int u = *s_unit;
    __syncthreads();
    if (u >= N_DIFF_UNITS + N_DIL_UNITS) break;
    phase2_unit(p, u, smem);
  }
}

__device__ void phase3(const Params& p) {
  const int tid = threadIdx.x, lane = tid & 63, wid = tid >> 6;
  const int gw = blockIdx.x * 4 + wid, nw = gridDim.x * 4;
  const float lam = ((const float*)(p.ws + OFF_MISC))[0];
  const u16* oap = (const u16*)(p.ws + OFF_OAP);
  const u16* obc = (const u16*)(p.ws + OFF_OBC);
  const float* lse = (const float*)(p.ws + OFF_LSE);
  u16* mix = (u16*)(p.ws + OFF_XNB);
  for (int tok = gw; tok < T_TOK; tok += nw) {
    float o[16]; float ss = 0.f;
    if (lane < 32) {
      const int head = lane >> 2;
      float l0 = lse[(size_t)tok * 8 + head], l1 = lse[((size_t)T_TOK + tok) * 8 + head], l2 = lse[((size_t)2 * T_TOK + tok) * 8 + head];
      const float mx = fmaxf(l0, fmaxf(l1, l2));
      float w0 = exp2f(l0 - mx), w1 = exp2f(l1 - mx), w2 = exp2f(l2 - mx);
      const float inv = 1.f / (w0 + w1 + w2); w0 *= inv; w1 *= inv; w2 *= inv;
      const uint4* p0 = (const uint4*)(oap + (size_t)tok * 512 + lane * 16);
      const uint4* p1 = (const uint4*)(oap + ((size_t)T_TOK + tok) * 512 + lane * 16);
      const uint4* p2 = (const uint4*)(oap + ((size_t)2 * T_TOK + tok) * 512 + lane * 16);
#pragma unroll
      for (int c = 0; c < 2; ++c) {
        const uint4 a = p0[c], b = p1[c], d = p2[c];
        const unsigned au[4] = {a.x, a.y, a.z, a.w}, bu[4] = {b.x, b.y, b.z, b.w}, du[4] = {d.x, d.y, d.z, d.w};
#pragma unroll
        for (int k = 0; k < 4; ++k) {
          o[c * 8 + 2 * k] = w0 * bflo(au[k]) + w1 * bflo(bu[k]) + w2 * bflo(du[k]);
          o[c * 8 + 2 * k + 1] = w0 * bfhi(au[k]) + w1 * bfhi(bu[k]) + w2 * bfhi(du[k]);
        }
      }
    } else {
      const int l2 = lane - 32, head = l2 >> 3, cc = (l2 & 7) * 16;
      const uint4* p0 = (const uint4*)(obc + (size_t)tok * 1024 + (2 * head) * 128 + cc);
      const uint4* p1 = (const uint4*)(obc + (size_t)tok * 1024 + (2 * head + 1) * 128 + cc);
#pragma unroll
      for (int c = 0; c < 2; ++c) {
        const uint4 a = p0[c], b = p1[c];
        const unsigned au[4] = {a.x, a.y, a.z, a.w}, bu[4] = {b.x, b.y, b.z, b.w};
#pragma unroll
        for (int k = 0; k < 4; ++k) {
          o[c * 8 + 2 * k] = bflo(au[k]) - lam * bflo(bu[k]);
          o[c * 8 + 2 * k + 1] = bfhi(au[k]) - lam * bfhi(bu[k]);
        }
      }
    }
#pragma unroll
    for (int i = 0; i < 16; ++i) ss += o[i] * o[i];
    const float s1 = ss + __shfl_xor(ss, 1);
    const float s2 = s1 + __shfl_xor(s1, 2);
    const float s3 = s2 + __shfl_xor(s2, 4);
    float r; const float* g;
    if (lane < 32) { r = rsqrtf(s2 * (1.f / 64.f) + 1e-6f); g = p.ona + lane * 16; }
    else { r = rsqrtf(s3 * (1.f / 128.f) + 1e-6f) * 0.8f; g = p.onb + (lane - 32) * 16; }
    unsigned pk[8];
#pragma unroll
    for (int k = 0; k < 8; ++k) pk[k] = pack2(o[2 * k] * r * g[2 * k], o[2 * k + 1] * r * g[2 * k + 1]);
    uint4* dst = (uint4*)(mix + (size_t)tok * 1024 + lane * 16);
    dst[0] = make_uint4(pk[0], pk[1], pk[2], pk[3]); dst[1] = make_uint4(pk[4], pk[5], pk[6], pk[7]);
  }
}

__device__ void phase4_tile(const Params& p, int mtile, int j, char* smem) {
  f32x16 acc[2][2];
  const int m0 = mtile * 128, n0 = j * 128;
  gemm_mainloop((const u16*)(p.ws + OFF_XNB), (const u16*)(p.ws + OFF_WOUT), m0, n0, smem, acc);
  float* st = (float*)smem;
  stage_acc(acc, st);
  __syncthreads();
  const int tid = threadIdx.x, cgi = tid & 31, r0 = tid >> 5;
  float* hss = (float*)(p.ws + OFF_HSS);
  u16* hb = (u16*)(p.ws + OFF_OAP);
#pragma unroll 4
  for (int ps = 0; ps < 16; ++ps) {
    const int row = r0 + 8 * ps;
    const float4 a = *(const float4*)(st + row * 132 + cgi * 4);
    const size_t gi = (size_t)(m0 + row) * 1024 + n0 + cgi * 4;
    const float4 xv = *(const float4*)(p.x + gi);
    float4 hv; hv.x = xv.x + a.x; hv.y = xv.y + a.y; hv.z = xv.z + a.z; hv.w = xv.w + a.w;
    *(float4*)(p.out + gi) = hv;
    *(uint2*)(hb + gi) = make_uint2(pack2(hv.x, hv.y), pack2(hv.z, hv.w));
    float ss = hv.x * hv.x + hv.y * hv.y + hv.z * hv.z + hv.w * hv.w;
    ss += __shfl_xor(ss, 16); ss += __shfl_xor(ss, 8); ss += __shfl_xor(ss, 4); ss += __shfl_xor(ss, 2); ss += __shfl_xor(ss, 1);
    if (cgi == 0) atomicAdd(hss + m0 + row, ss);
  }
  __syncthreads();
}

#define TK_INSERT(xv, xi) { float x_ = (xv); int i_ = (xi); _Pragma("unroll") for (int q_ = 0; q_ < 16; ++q_) { const bool gt_ = x_ > tv[q_]; const float tvv = tv[q_]; const int tii = ti[q_]; tv[q_] = gt_ ? x_ : tvv; ti[q_] = gt_ ? i_ : tii; x_ = gt_ ? tvv : x_; i_ = gt_ ? tii : i_; } }
__device__ void phase5_tile(const Params& p, int mtile, int j, char* smem) {
  f32x16 acc[2][2];
  const int m0 = mtile * 128, n0 = j * 128;
  gemm_mainloop((const u16*)(p.ws + OFF_OAP), (const u16*)(p.ws + OFF_WPQ), m0, n0, smem, acc);
  const int tid = threadIdx.x, lane = tid & 63, w = tid >> 6, wm = w >> 1, wn = w & 1, lr = lane & 31, lh = lane >> 5;
  u16* Qs = (u16*)smem;
  u16* SKs = Qs + 128 * 136;
  float* rs = (float*)(smem + 2 * 128 * 136 * 2);
  const float* hss = (const float*)(p.ws + OFF_HSS);
  if (tid < 128) rs[tid] = rsqrtf(hss[m0 + tid] * (1.f / 1024.f) + 1e-6f);
  {
    const u16* sk = (const u16*)(p.ws + OFF_SUBK) + (size_t)j * 128 * 128;
#pragma unroll
    for (int i = 0; i < 8; ++i) { const int c = tid + 256 * i, row = c >> 4, kc = c & 15; *(uint4*)(SKs + row * 136 + kc * 8) = *(const uint4*)(sk + row * 128 + kc * 8); }
  }
  __syncthreads();
#pragma unroll
  for (int mt = 0; mt < 2; ++mt)
#pragma unroll
    for (int nt = 0; nt < 2; ++nt)
#pragma unroll
      for (int r = 0; r < 16; ++r) {
        const int row = wm * 64 + mt * 32 + crow(r, lh);
        Qs[row * 136 + wn * 64 + nt * 32 + lr] = f2bf(acc[mt][nt][r] * rs[row]);
      }
  __syncthreads();
#pragma unroll
  for (int a = 0; a < 2; ++a)
#pragma unroll
    for (int b = 0; b < 2; ++b)
#pragma unroll
      for (int r = 0; r < 16; ++r) acc[a][b][r] = 0.f;
  {
    const u16* ab = Qs + (wm * 64 + lr) * 136 + lh * 8;
    const u16* bb = SKs + (wn * 64 + lr) * 136 + lh * 8;
#pragma unroll
    for (int s = 0; s < 8; ++s) {
      const bf16x8 a0 = *(const bf16x8*)(ab + s * 16), a1 = *(const bf16x8*)(ab + 32 * 136 + s * 16);
      const bf16x8 b0 = *(const bf16x8*)(bb + s * 16), b1 = *(const bf16x8*)(bb + 32 * 136 + s * 16);
      acc[0][0] = MFMA(a0, b0, acc[0][0]); acc[0][1] = MFMA(a0, b1, acc[0][1]);
      acc[1][0] = MFMA(a1, b0, acc[1][0]); acc[1][1] = MFMA(a1, b1, acc[1][1]);
    }
  }
  __syncthreads();
  float* st = (float*)smem;
  stage_acc(acc, st);
  __syncthreads();
  const int row = tid & 127, half = tid >> 7;
  float tv[16]; int ti[16];
#pragma unroll
  for (int q = 0; q < 16; ++q) { tv[q] = NEG_INF; ti[q] = 0; }
#pragma unroll 2
  for (int c = 0; c < 16; ++c) {
    const float4 v4 = *(const float4*)(st + row * 132 + half * 64 + c * 4);
    const int bi = half * 64 + c * 4;
    TK_INSERT(v4.x, bi); TK_INSERT(v4.y, bi + 1); TK_INSERT(v4.z, bi + 2); TK_INSERT(v4.w, bi + 3);
  }
  __syncthreads();
  if (half == 1) {
#pragma unroll
    for (int q = 0; q < 16; ++q) { st[row * 132 + q] = tv[q]; st[row * 132 + 16 + q] = __int_as_float(ti[q]); }
  }
  __syncthreads();
  if (half == 0) {
#pragma unroll 2
    for (int q = 0; q < 16; ++q) { const float xv = st[row * 132 + q]; const int xi = __float_as_int(st[row * 132 + 16 + q]); TK_INSERT(xv, xi); }
    const size_t base = ((size_t)(m0 + row) * 16 + j) * 16;
    float* tops = (float*)(p.ws + OFF_TOPS) + base;
    u8* topi = (u8*)(p.ws + OFF_TOPI) + base;
#pragma unroll
    for (int c = 0; c < 4; ++c) ((float4*)tops)[c] = make_float4(tv[4 * c], tv[4 * c + 1], tv[4 * c + 2], tv[4 * c + 3]);
    unsigned pk[4];
#pragma unroll
    for (int c = 0; c < 4; ++c) pk[c] = (unsigned)ti[4 * c] | ((unsigned)ti[4 * c + 1] << 8) | ((unsigned)ti[4 * c + 2] << 16) | ((unsigned)ti[4 * c + 3] << 24);
    *(uint4*)topi = make_uint4(pk[0], pk[1], pk[2], pk[3]);
  }
  __syncthreads();
}

DI float dpp_xor1(float v) { return __builtin_bit_cast(float, __builtin_amdgcn_update_dpp(0, __builtin_bit_cast(int, v), 0xB1, 0xF, 0xF, true)); }
DI float dpp_xor2(float v) { return __builtin_bit_cast(float, __builtin_amdgcn_update_dpp(0, __builtin_bit_cast(int, v), 0x4E, 0xF, 0xF, true)); }
template <int PAT> DI float swz(float v) { return __builtin_bit_cast(float, __builtin_amdgcn_ds_swizzle(__builtin_bit_cast(int, v), PAT)); }
DI float treduce8(const float (&pp)[8], int lane) {
  const bool b0 = lane & 1, b1 = lane & 2, b2 = lane & 4;
  float q[4];
#pragma unroll
  for (int i = 0; i < 4; ++i) { const float keep = b0 ? pp[2 * i + 1] : pp[2 * i], send = b0 ? pp[2 * i] : pp[2 * i + 1]; q[i] = keep + dpp_xor1(send); }
  float r[2];
#pragma unroll
  for (int i = 0; i < 2; ++i) { const float keep = b1 ? q[2 * i + 1] : q[2 * i], send = b1 ? q[2 * i] : q[2 * i + 1]; r[i] = keep + dpp_xor2(send); }
  float t = (b2 ? r[1] : r[0]) + swz<0x101F>(b2 ? r[0] : r[1]);
  t += swz<0x201F>(t); t += swz<0x401F>(t); t += __shfl_xor(t, 32);
  return t;
}
DI float udot16(const uint4& w, const float (&h)[16]) {
  f32x2 acc = {0.f, 0.f};
  const int ww[4] = {(int)w.x, (int)w.y, (int)w.z, (int)w.w};
#pragma unroll
  for (int j = 0; j < 4; ++j) {
    const f32x2 lo = __builtin_amdgcn_cvt_pk_f32_fp8(ww[j], false), hi = __builtin_amdgcn_cvt_pk_f32_fp8(ww[j], true);
    const f32x2 h0 = {h[4 * j], h[4 * j + 1]}, h1 = {h[4 * j + 2], h[4 * j + 3]};
    acc += lo * h0; acc += hi * h1;
  }
  return acc.x + acc.y;
}
DI void vacc16(const uint4& w, float a, f32x2 (&acc)[8]) {
  const f32x2 a2 = {a, a};
  const int ww[4] = {(int)w.x, (int)w.y, (int)w.z, (int)w.w};
#pragma unroll
  for (int j = 0; j < 4; ++j) {
    acc[2 * j] += a2 * __builtin_amdgcn_cvt_pk_f32_fp8(ww[j], false);
    acc[2 * j + 1] += a2 * __builtin_amdgcn_cvt_pk_f32_fp8(ww[j], true);
  }
}
#define LOAD8(buf, tbl, bidx) { const uint4 i0_ = *(const uint4*)(ids + 8 * (bidx)), i1_ = *(const uint4*)(ids + 8 * (bidx) + 4); \
    const unsigned idv_[8] = {i0_.x, i0_.y, i0_.z, i0_.w, i1_.x, i1_.y, i1_.z, i1_.w}; \
    _Pragma("unroll") for (int k_ = 0; k_ < 8; ++k_) { const unsigned id_ = __builtin_amdgcn_readfirstlane(idv_[k_]); buf[k_] = *(const uint4*)((tbl) + (size_t)id_ * 1024 + lane * 16); } }

__device__ void phase6(const Params& p, char* smem, float* dstbase) {
  const int tid = opaque_tid(), lane = tid & 63, wid = tid >> 6;
  const int gw = blockIdx.x * 4 + wid, nw = gridDim.x * 4;
  int* ids = (int*)(smem + wid * 1024);
  float* gts = (float*)(smem + wid * 1024 + 512);
  const float* hss = (const float*)(p.ws + OFF_HSS);
  const float* tops = (const float*)(p.ws + OFF_TOPS);
  const u8* topi = (const u8*)(p.ws + OFF_TOPI);
  const u8* ub = (const u8*)(p.ws + OFF_PUB);
  const u8* vb = (const u8*)(p.ws + OFF_PVB);
  int ci, cj;
  {
    const int L = lane;
    if (L < 16) { ci = 0; cj = L; } else if (L < 24) { ci = 1; cj = L - 16; } else if (L < 29) { ci = 2; cj = L - 24; }
    else if (L < 33) { ci = 3; cj = L - 29; } else if (L < 36) { ci = 4; cj = L - 33; } else if (L < 38) { ci = 5; cj = L - 36; }
    else if (L < 40) { ci = 6; cj = L - 38; } else if (L < 42) { ci = 7; cj = L - 40; } else if (L < 50) { ci = L - 34; cj = 0; }
    else { ci = 0; cj = 0; }
  }
  for (int tok = gw; tok < T_TOK; tok += nw) {
    const float rstd = rsqrtf(hss[tok] * (1.f / 1024.f) + 1e-6f);
    float hres[16], hn[16];
    {
      const float4* hp = (const float4*)(p.out + (size_t)tok * 1024 + lane * 16);
      const float4* gp = (const float4*)(p.g_ffn + lane * 16);
#pragma unroll
      for (int c = 0; c < 4; ++c) {
        const float4 t4 = hp[c], g4 = gp[c];
        hres[4 * c] = t4.x; hres[4 * c + 1] = t4.y; hres[4 * c + 2] = t4.z; hres[4 * c + 3] = t4.w;
        hn[4 * c] = t4.x * rstd * g4.x; hn[4 * c + 1] = t4.y * rstd * g4.y; hn[4 * c + 2] = t4.z * rstd * g4.z; hn[4 * c + 3] = t4.w * rstd * g4.w;
      }
    }
#pragma unroll 1
    for (int head = 0; head < 8; ++head) {
      const size_t b1 = ((size_t)tok * 16 + head * 2) * 16, b2 = b1 + 16;
      float sum = NEG_INF; int eid = 0;
      if (lane < 50) { sum = tops[b1 + ci] + tops[b2 + cj]; eid = (int)topi[b1 + ci] * 128 + (int)topi[b2 + cj]; }
      int rank = 0;
#pragma unroll
      for (int m = 0; m < 50; ++m) {
        const float v = __builtin_bit_cast(float, __builtin_amdgcn_readlane(__builtin_bit_cast(int, sum), m));
        rank += (v > sum || (v == sum && m < lane)) ? 1 : 0;
      }
      const float mxa = __builtin_bit_cast(float, __builtin_amdgcn_readlane(__builtin_bit_cast(int, sum), 0));
      const bool sel = (lane < 50) && (rank < 16);
      const float e = sel ? __expf(sum - mxa) : 0.f;
      const float den = wave_sum(e);
      if (sel) { ids[head * 16 + rank] = eid; gts[head * 16 + rank] = e / den; }
    }
    __builtin_amdgcn_wave_barrier();
    asm volatile("s_waitcnt lgkmcnt(0)" ::: "memory");
    float dsel0 = 0.f, dsel1 = 0.f;
    {
      uint4 ba[8], bb[8];
      LOAD8(ba, ub, 0);
#pragma unroll 1
      for (int b = 0; b < 16; b += 2) {
        LOAD8(bb, ub, b + 1);
        {
          float pp[8];
#pragma unroll
          for (int k = 0; k < 8; ++k) pp[k] = udot16(ba[k], hn);
          const float t = treduce8(pp, lane);
          if ((lane >> 3) == (b & 7)) { if (b < 8) dsel0 = t; else dsel1 = t; }
        }
        if (b + 2 < 16) LOAD8(ba, ub, b + 2);
        {
          float pp[8];
#pragma unroll
          for (int k = 0; k < 8; ++k) pp[k] = udot16(bb[k], hn);
          const float t = treduce8(pp, lane);
          if ((lane >> 3) == ((b + 1) & 7)) { if (b < 8) dsel0 = t; else dsel1 = t; }
        }
      }
    }
    {
      const float d0 = dsel0 * (1.f / USCALE), d1 = dsel1 * (1.f / USCALE);
      const float a0 = 0.5f * d0 * (1.f + erff(d0 * 0.70710678118654752f)) * gts[lane] * (1.f / VSCALE);
      const float a1 = 0.5f * d1 * (1.f + erff(d1 * 0.70710678118654752f)) * gts[64 + lane] * (1.f / VSCALE);
      gts[lane] = a0; gts[64 + lane] = a1;
    }
    __builtin_amdgcn_wave_barrier();
    asm volatile("s_waitcnt lgkmcnt(0)" ::: "memory");
    f32x2 acc[8];
#pragma unroll
    for (int i = 0; i < 8; ++i) acc[i] = (f32x2){0.f, 0.f};
    {
      uint4 ba[8], bb[8];
      LOAD8(ba, vb, 0);
#pragma unroll 1
      for (int b = 0; b < 16; b += 2) {
        LOAD8(bb, vb, b + 1);
        {
          const float4 g0 = *(const float4*)(gts + 8 * b), g1 = *(const float4*)(gts + 8 * b + 4);
          vacc16(ba[0], g0.x, acc); vacc16(ba[1], g0.y, acc); vacc16(ba[2], g0.z, acc); vacc16(ba[3], g0.w, acc);
          vacc16(ba[4], g1.x, acc); vacc16(ba[5], g1.y, acc); vacc16(ba[6], g1.z, acc); vacc16(ba[7], g1.w, acc);
        }
        if (b + 2 < 16) LOAD8(ba, vb, b + 2);
        {
          const float4 g0 = *(const float4*)(gts + 8 * b + 8), g1 = *(const float4*)(gts + 8 * b + 12);
          vacc16(bb[0], g0.x, acc); vacc16(bb[1], g0.y, acc); vacc16(bb[2], g0.z, acc); vacc16(bb[3], g0.w, acc);
          vacc16(bb[4], g1.x, acc); vacc16(bb[5], g1.y, acc); vacc16(bb[6], g1.z, acc); vacc16(bb[7], g1.w, acc);
        }
      }
    }
    float4* op = (float4*)(dstbase + (size_t)tok * 1024 + lane * 16);
#pragma unroll
    for (int c = 0; c < 4; ++c) op[c] = make_float4(hres[4 * c] + acc[2 * c].x, hres[4 * c + 1] + acc[2 * c].y, hres[4 * c + 2] + acc[2 * c + 1].x, hres[4 * c + 3] + acc[2 * c + 1].y);
    __builtin_amdgcn_wave_barrier();
  }
}


#define XB_TMO      128
#define XB_XCNT(j)  (256  + 64 * (j))
#define XB_XSUB(j)  (1280 + 64 * (j))
#define XB_XGEN(j)  (2304 + 64 * (j))
#define XB_TOP      3328
#define XB_TOPGEN   3392
#define XB_SPIN_CAP (1u << 22)
#define LAS __attribute__((address_space(3)))
DI unsigned xb_ld(unsigned* p) { return __hip_atomic_load(p, __ATOMIC_RELAXED, __HIP_MEMORY_SCOPE_AGENT); }
DI unsigned xb_add(unsigned* p, unsigned v) { return __hip_atomic_fetch_add(p, v, __ATOMIC_RELAXED, __HIP_MEMORY_SCOPE_AGENT); }
DI unsigned xb_xcc_id() { return (unsigned)__builtin_amdgcn_s_getreg((3 << 11) | 20) & 0xFu; }
#define XB_SPIN(cond, bar) do { unsigned _sp = 0; while (cond) { __builtin_amdgcn_s_sleep(1); \
    if ((++_sp & 255u) == 0u) { if (xb_ld(&(bar)[XB_TMO])) break; if (_sp > XB_SPIN_CAP) { atomicAdd(&(bar)[XB_TMO], 1u); break; } } } } while (0)
struct XcdBarrier { unsigned* bar; unsigned x; volatile LAS unsigned* st; };
DI XcdBarrier xcd_barrier_post(unsigned* bar, volatile LAS unsigned* st) {
  XcdBarrier b; b.bar = bar; b.x = xb_xcc_id(); b.st = st;
  if (threadIdx.x == 0) (void)xb_add(&bar[XB_XCNT(b.x)], 1u);
  return b;
}
DI void xcd_barrier_complete(unsigned* bar, unsigned x, unsigned& nloc, unsigned& nx) {
  const unsigned G = gridDim.x * gridDim.y * gridDim.z;
  unsigned sum, cnt, mine, sp = 0u;
  for (;;) {
    sum = 0u; cnt = 0u; mine = 0u;
#pragma unroll
    for (unsigned j = 0; j < 16; ++j) { const unsigned c = xb_ld(&bar[XB_XCNT(j)]); sum += c; cnt += (c > 0u) ? 1u : 0u; mine = (j == x) ? c : mine; }
    if (sum == G) break;
    __builtin_amdgcn_s_sleep(1);
    if ((++sp & 255u) == 0u) { if (xb_ld(&bar[XB_TMO])) break; if (sp > XB_SPIN_CAP) { atomicAdd(&bar[XB_TMO], 1u); break; } }
  }
  nloc = mine > 0u ? mine : 1u; nx = cnt > 0u ? cnt : 1u;
}
DI void xcd_barrier(const XcdBarrier& b) {
  asm volatile("s_waitcnt vmcnt(0)" ::: "memory");
  __syncthreads();
  if (threadIdx.x == 0) {
    unsigned* bar = b.bar;
    __builtin_amdgcn_s_waitcnt(0);
    unsigned nloc = b.st[0], nx = b.st[1];
    if (nloc == 0u) { xcd_barrier_complete(bar, b.x, nloc, nx); b.st[0] = nloc; b.st[1] = nx; }
    const unsigned old = xb_add(&bar[XB_XSUB(b.x)], 1u);
    const unsigned gen = old / nloc;
    if (old + 1u == (gen + 1u) * nloc) {
      __builtin_amdgcn_fence(__ATOMIC_RELEASE, "agent");
      asm volatile("s_waitcnt vmcnt(0)" ::: "memory");
      const unsigned og = xb_add(&bar[XB_TOP], 1u);
      const unsigned tg = og / nx;
      if (og + 1u == (tg + 1u) * nx) xb_add(&bar[XB_TOPGEN], 1u);
      else XB_SPIN(xb_ld(&bar[XB_TOPGEN]) == tg, bar);
      __builtin_amdgcn_fence(__ATOMIC_ACQUIRE, "agent");
      xb_add(&bar[XB_XGEN(b.x)], 1u);
      asm volatile("s_waitcnt vmcnt(0)" ::: "memory");
    } else {
      XB_SPIN(xb_ld(&bar[XB_XGEN(b.x)]) == gen, bar);
      __builtin_amdgcn_fence(__ATOMIC_ACQUIRE, "agent");
      asm volatile("s_waitcnt vmcnt(0)" ::: "memory");
    }
  }
  __syncthreads();
}

#if FUSED
__global__ void __launch_bounds__(256, 2) fwd_megakernel(Params p) {
  __shared__ __attribute__((aligned(16))) char smem[SMEM_BYTES];
  cg::grid_group grid = cg::this_grid();
  __shared__ uint4 xb_words;
  if (threadIdx.x == 0) xb_words = make_uint4(0u, 0u, 0u, 0u);
  phase0(p, smem);
  grid.sync();
  const XcdBarrier xb = xcd_barrier_post((unsigned*)(p.ws + OFF_BAR), (volatile LAS unsigned*)&xb_words);
  for (int t = blockIdx.x; t < 256 * 24; t += gridDim.x) phase1_tile(p, t / 24, t % 24, smem);
  xcd_barrier(xb);
#if PROBE_DUP == 1
  for (int t = blockIdx.x; t < 256 * 24; t += gridDim.x) phase1_tile(p, t / 24, t % 24, smem);
  xcd_barrier(xb);
#endif
#if PROBE_DUP == 2
  phase2(p, smem, 2);
  xcd_barrier(xb);
#endif
  phase2(p, smem);
  xcd_barrier(xb);
  phase3(p);
  xcd_barrier(xb);
  for (int t = blockIdx.x; t < 256 * 8; t += gridDim.x) phase4_tile(p, t >> 3, t & 7, smem);
  xcd_barrier(xb);
  for (int t = blockIdx.x; t < 256 * 16; t += gridDim.x) phase5_tile(p, t >> 4, t & 15, smem);
  xcd_barrier(xb);
#if PROBE_DUP == 5
  for (int t = blockIdx.x; t < 256 * 16; t += gridDim.x) phase5_tile(p, t >> 4, t & 15, smem);
  xcd_barrier(xb);
#endif
#if PROBE_DUP == 6
  phase6(p, smem, (float*)(p.ws + OFF_OAP));
  xcd_barrier(xb);
#endif
  phase6(p, smem, p.out);
}
#else
__global__ void __launch_bounds__(256, 2) k_p0(Params p) { __shared__ __attribute__((aligned(16))) char smem[SMEM_BYTES]; phase0(p, smem); }
__global__ void __launch_bounds__(256, 2) k_p1(Params p) { __shared__ __attribute__((aligned(16))) char smem[SMEM_BYTES]; for (int t = blockIdx.x; t < 256 * 24; t += gridDim.x) phase1_tile(p, t / 24, t % 24, smem); }
__global__ void __launch_bounds__(256, 2) k_p2(Params p) { __shared__ __attribute__((aligned(16))) char smem[SMEM_BYTES]; phase2(p, smem); }
__global__ void __launch_bounds__(256, 2) k_p3(Params p) { phase3(p); }
__global__ void __launch_bounds__(256, 2) k_p4(Params p) { __shared__ __attribute__((aligned(16))) char smem[SMEM_BYTES]; for (int t = blockIdx.x; t < 256 * 8; t += gridDim.x) phase4_tile(p, t >> 3, t & 7, smem); }
__global__ void __launch_bounds__(256, 2) k_p5(Params p) { __shared__ __attribute__((aligned(16))) char smem[SMEM_BYTES]; for (int t = blockIdx.x; t < 256 * 16; t += gridDim.x) phase5_tile(p, t >> 4, t & 15, smem); }
__global__ void __launch_bounds__(256, 2) k_p6(Params p) { __shared__ __attribute__((aligned(16))) char smem[SMEM_BYTES]; phase6(p, smem, p.out); }
#endif

extern "C" void kernel_launch(void* const* d_in, const int* in_sizes, int n_in, void* d_out, int out_size, void* d_ws, size_t ws_size,
                              hipStream_t stream) {
  Params p{};
  p.x = (const float*)d_in[0]; p.g_attn = (const float*)d_in[1]; p.w_in = (const float*)d_in[2]; p.qna = (const float*)d_in[3];
  p.kna = (const float*)d_in[4]; p.ona = (const float*)d_in[5]; p.qnb = (const float*)d_in[6]; p.knb = (const float*)d_in[7];
  p.lq1 = (const float*)d_in[8]; p.lk1 = (const float*)d_in[9]; p.lq2 = (const float*)d_in[10]; p.lk2 = (const float*)d_in[11];
  p.onb = (const float*)d_in[12]; p.w_out = (const float*)d_in[13]; p.g_ffn = (const float*)d_in[14]; p.w_pq = (const float*)d_in[15];
  p.subk = (const float*)d_in[16]; p.pu = (const float*)d_in[17]; p.pv = (const float*)d_in[18];
  p.out = (float*)d_out; p.ws = (char*)d_ws;
#if FUSED
  static int grid_blocks = 0;
  if (!grid_blocks) {
    int dev = 0, cus = 0, per_cu = 0;
    hipGetDevice(&dev);
    hipDeviceGetAttribute(&cus, hipDeviceAttributeMultiprocessorCount, dev);
    hipOccupancyMaxActiveBlocksPerMultiprocessor(&per_cu, fwd_megakernel, 256, 0);
    if (per_cu > 2) per_cu = 2;
    if (per_cu < 1) per_cu = 1;
    grid_blocks = cus * per_cu;
  }
  void* args[] = {&p};
  hipError_t e = hipLaunchCooperativeKernel((void*)fwd_megakernel, dim3(grid_blocks), dim3(256), args, 0, stream);
  if (e != hipSuccess) fprintf(stderr, "cooperative launch failed: %s (grid %d)\n", hipGetErrorString(e), grid_blocks);
#else
  const int G = 512;
  k_p0<<<G, 256, 0, stream>>>(p);
  k_p1<<<G, 256, 0, stream>>>(p);
  k_p2<<<G, 256, 0, stream>>>(p);
  k_p3<<<G, 256, 0, stream>>>(p);
  k_p4<<<G, 256, 0, stream>>>(p);
  k_p5<<<G, 256, 0, stream>>>(p);
  k_p6<<<G, 256, 0, stream>>>(p);
#endif
}
```

```cpp
#include <hip/hip_runtime.h>
#include <hip/hip_cooperative_groups.h>
#include <cstdio>
#include <cstdint>
namespace cg = cooperative_groups;

#ifndef FUSED
#define FUSED 1
#endif
#ifndef PROBE_DUP
#define PROBE_DUP 0
#endif

typedef unsigned short u16;
typedef unsigned char u8;
typedef __attribute__((ext_vector_type(8))) short bf16x8;
typedef __attribute__((ext_vector_type(4))) short s16x4;
typedef __attribute__((ext_vector_type(16))) float f32x16;
typedef __attribute__((ext_vector_type(2))) __bf16 bf2_t;
typedef __attribute__((ext_vector_type(4))) unsigned u32x4;
#define DI __device__ __forceinline__
#define MFMA(a, b, c) __builtin_amdgcn_mfma_f32_32x32x16_bf16((a), (b), (c), 0, 0, 0)

constexpr int T_TOK = 32768;
constexpr int SEQ = 4096;
constexpr size_t MB = 1u << 20;
constexpr size_t OFF_XNB = 0;
constexpr size_t OFF_QA = 64 * MB, OFF_KA = 96 * MB, OFF_VA = 128 * MB, OFF_QB = 160 * MB, OFF_KB = 192 * MB, OFF_VB = 224 * MB;
constexpr size_t OFF_TOPS = 64 * MB;
constexpr size_t OFF_TOPI = 96 * MB;
constexpr size_t OFF_OAP = 256 * MB;
constexpr size_t OFF_OBC = 352 * MB;
constexpr size_t OFF_PUB = 416 * MB, OFF_PVB = 448 * MB;
constexpr size_t OFF_WIN = 480 * MB, OFF_WOUT = 486 * MB, OFF_WPQ = 488 * MB, OFF_SUBK = 492 * MB;
constexpr size_t OFF_ROPEC = 493 * MB, OFF_ROPES = 493 * MB + 128 * 1024;
constexpr size_t OFF_LSE = 494 * MB;
constexpr size_t OFF_HSS = 497 * MB;
constexpr size_t OFF_MISC = 497 * MB + 128 * 1024;

constexpr size_t OFF_BAR = 497 * MB + 256 * 1024;
constexpr int SMEM_BYTES = 73728;
#define XCD_BAR_WORDS 3456
constexpr float QSCALE = 0.125f * 1.4426950408889634f;
constexpr float NEG_INF = -__builtin_huge_valf();
constexpr float USCALE = 64.f, VSCALE = 16.f;
typedef float f32x2 __attribute__((ext_vector_type(2)));

struct Params {
  const float *x, *g_attn, *w_in, *qna, *kna, *ona, *qnb, *knb, *lq1, *lk1, *lq2, *lk2, *onb, *w_out, *g_ffn, *w_pq, *subk, *pu, *pv;
  float* out;
  char* ws;
};

DI u16 f2bf(float x) { unsigned u = __float_as_uint(x); u += 0x7fffu + ((u >> 16) & 1u); return (u16)(u >> 16); }
DI float bf2f(u16 b) { return __uint_as_float(((unsigned)b) << 16); }
DI unsigned pack2(float a, float b) { return (unsigned)f2bf(a) | ((unsigned)f2bf(b) << 16); }
DI float bflo(unsigned u) { return __uint_as_float(u << 16); }
DI float bfhi(unsigned u) { return __uint_as_float(u & 0xffff0000u); }
DI float wave_sum(float v) {
  v += __shfl_xor(v, 32); v += __shfl_xor(v, 16); v += __shfl_xor(v, 8); v += __shfl_xor(v, 4); v += __shfl_xor(v, 2); v += __shfl_xor(v, 1);
  return v;
}
DI void gld16(u32x4& dst, const void* ptr) { asm volatile("global_load_dwordx4 %0, %1, off" : "=v"(dst) : "v"(ptr) : "memory"); }
DI void vm_wait8(u32x4& a, u32x4& b, u32x4& c, u32x4& d, u32x4& e, u32x4& f, u32x4& g, u32x4& h) {
  asm volatile("s_waitcnt vmcnt(0)" : "+v"(a), "+v"(b), "+v"(c), "+v"(d), "+v"(e), "+v"(f), "+v"(g), "+v"(h) : : "memory");
}
template <int N> DI void vm_wait8n(u32x4& a, u32x4& b, u32x4& c, u32x4& d, u32x4& e, u32x4& f, u32x4& g, u32x4& h) {
  asm volatile("s_waitcnt vmcnt(%8)" : "+v"(a), "+v"(b), "+v"(c), "+v"(d), "+v"(e), "+v"(f), "+v"(g), "+v"(h) : "n"(N) : "memory");
}
DI void vm_wait6(u32x4& a, u32x4& b, u32x4& c, u32x4& d, u32x4& e, u32x4& f) {
  asm volatile("s_waitcnt vmcnt(0)" : "+v"(a), "+v"(b), "+v"(c), "+v"(d), "+v"(e), "+v"(f) : : "memory");
}
DI int opaque_tid() { int t = threadIdx.x; asm volatile("" : "+v"(t)); return t; }
DI int crow(int reg, int h) { return (reg & 3) + 8 * (reg >> 2) + 4 * h; }

__device__ void phase0(const Params& p, char* smem) {
  const int tid = threadIdx.x, lane = tid & 63, wid = tid >> 6;
  const int gw = blockIdx.x * 4 + wid, nw = gridDim.x * 4;
  const int gt = blockIdx.x * 256 + tid, nt = gridDim.x * 256;
  u16* xnb = (u16*)(p.ws + OFF_XNB);
  for (int row = gw; row < T_TOK; row += nw) {
    const float4* xr = (const float4*)(p.x + (size_t)row * 1024);
    float4 v[4]; float ss = 0.f;
#pragma unroll
    for (int i = 0; i < 4; ++i) { v[i] = xr[lane + 64 * i]; ss += v[i].x * v[i].x + v[i].y * v[i].y + v[i].z * v[i].z + v[i].w * v[i].w; }
    ss = wave_sum(ss);
    const float r = rsqrtf(ss * (1.f / 1024.f) + 1e-6f);
    uint2* dst = (uint2*)(xnb + (size_t)row * 1024);
#pragma unroll
    for (int i = 0; i < 4; ++i) dst[lane + 64 * i] = make_uint2(pack2(v[i].x * r, v[i].y * r), pack2(v[i].z * r, v[i].w * r));
  }
  float* tile = (float*)smem;
  for (int job = blockIdx.x; job < 1536; job += gridDim.x) {
    const float* W; const float* g; u16* outp; int N, j;
    if (job < 768) { W = p.w_in; g = p.g_attn; outp = (u16*)(p.ws + OFF_WIN); N = 3072; j = job; }
    else if (job < 1024) { W = p.w_out; g = nullptr; outp = (u16*)(p.ws + OFF_WOUT); N = 1024; j = job - 768; }
    else { W = p.w_pq; g = p.g_ffn; outp = (u16*)(p.ws + OFF_WPQ); N = 2048; j = job - 1024; }
    const int ntn = N >> 6, kt = j / ntn, ntile = j % ntn;
    const int tx = tid & 63, ty = tid >> 6;
#pragma unroll 4
    for (int r = 0; r < 16; ++r) {
      const int k = kt * 64 + ty + 4 * r;
      float v = W[(size_t)k * N + ntile * 64 + tx];
      if (g) v *= g[k];
      tile[(ty + 4 * r) * 65 + tx] = v;
    }
    __syncthreads();
#pragma unroll 4
    for (int r = 0; r < 16; ++r) {
      const int nl = ty + 4 * r;
      outp[(size_t)(ntile * 64 + nl) * 1024 + kt * 64 + tx] = f2bf(tile[tx * 65 + nl]);
    }
    __syncthreads();
  }
  {
    const float4* s = (const float4*)p.subk; uint2* d = (uint2*)(p.ws + OFF_SUBK);
    for (int i = gt; i < 262144 / 4; i += nt) { float4 v = s[i]; d[i] = make_uint2(pack2(v.x, v.y), pack2(v.z, v.w)); }
    const float4* su = (const float4*)p.pu; int* du = (int*)(p.ws + OFF_PUB);
    const float4* sv = (const float4*)p.pv; int* dv = (int*)(p.ws + OFF_PVB);
    for (int i = gt; i < 16384 * 1024 / 4; i += nt) {
      float4 a = su[i]; float4 b = sv[i];
      int ra = __builtin_amdgcn_cvt_pk_fp8_f32(a.x * USCALE, a.y * USCALE, 0, false);
      ra = __builtin_amdgcn_cvt_pk_fp8_f32(a.z * USCALE, a.w * USCALE, ra, true);
      int rb = __builtin_amdgcn_cvt_pk_fp8_f32(b.x * VSCALE, b.y * VSCALE, 0, false);
      rb = __builtin_amdgcn_cvt_pk_fp8_f32(b.z * VSCALE, b.w * VSCALE, rb, true);
      du[i] = ra; dv[i] = rb;
    }
  }
  {
    float* rc = (float*)(p.ws + OFF_ROPEC); float* rs = (float*)(p.ws + OFF_ROPES);
    for (int i = gt; i < SEQ * 8; i += nt) {
      const int pos = i >> 3, f = i & 7;
      const float invf = (float)pow(500000.0, -(double)f / 8.0);
      const float ang = (float)pos * invf;
      rc[i] = (float)cos((double)ang); rs[i] = (float)sin((double)ang);
    }
    float* hss = (float*)(p.ws + OFF_HSS);
    for (int i = gt; i < T_TOK; i += nt) hss[i] = 0.f;
    unsigned* barw = (unsigned*)(p.ws + OFF_BAR);
    for (int i = gt; i < XCD_BAR_WORDS; i += nt) barw[i] = 0u;
    if (gt == 0) {
      float a = 0.f, b = 0.f;
      for (int i = 0; i < 64; ++i) { a += p.lq1[i] * p.lk1[i]; b += p.lq2[i] * p.lk2[i]; }
      float* misc = (float*)(p.ws + OFF_MISC);
      misc[0] = expf(a) - expf(b) + 0.2f;
      ((int*)misc)[1] = 0; ((int*)misc)[2] = 0;
    }
  }
}

DI void gemm_mainloop(const u16* __restrict__ A, const u16* __restrict__ Bt, int m0, int n0, char* smem, f32x16 (&acc)[2][2]) {
  u16* As = (u16*)smem;
  u16* Bs = As + 2 * 128 * 72;
  const int tid = opaque_tid(), lane = tid & 63, w = tid >> 6, wm = w >> 1, wn = w & 1, lr = lane & 31, lh = lane >> 5;
#pragma unroll
  for (int a = 0; a < 2; ++a)
#pragma unroll
    for (int b = 0; b < 2; ++b)
#pragma unroll
      for (int r = 0; r < 16; ++r) acc[a][b][r] = 0.f;
  u32x4 raA[4], rbA[4], raB[4], rbB[4];
  const int lrow = tid >> 3, lkc = tid & 7;
  const u16* Ag = A + (size_t)(m0 + lrow) * 1024 + lkc * 8;
  const u16* Bg = Bt + (size_t)(n0 + lrow) * 1024 + lkc * 8;
#define GLOAD(S_, kt) { _Pragma("unroll") for (int i = 0; i < 4; ++i) { gld16(ra##S_[i], Ag + (size_t)i * 32 * 1024 + (kt) * 64); gld16(rb##S_[i], Bg + (size_t)i * 32 * 1024 + (kt) * 64); } }
#define SWRITE(S_, buf, NW_) { vm_wait8n<NW_>(ra##S_[0], ra##S_[1], ra##S_[2], ra##S_[3], rb##S_[0], rb##S_[1], rb##S_[2], rb##S_[3]); \
    _Pragma("unroll") for (int i = 0; i < 4; ++i) { *(u32x4*)(As + ((buf) * 128 + lrow + 32 * i) * 72 + lkc * 8) = ra##S_[i]; *(u32x4*)(Bs + ((buf) * 128 + lrow + 32 * i) * 72 + lkc * 8) = rb##S_[i]; } }
#define GCOMPUTE(buf) { \
    const u16* ab = As + ((buf) * 128 + wm * 64 + lr) * 72 + lh * 8; \
    const u16* bb = Bs + ((buf) * 128 + wn * 64 + lr) * 72 + lh * 8; \
    _Pragma("unroll") for (int s = 0; s < 4; ++s) { \
      const bf16x8 a0 = *(const bf16x8*)(ab + s * 16), a1 = *(const bf16x8*)(ab + 32 * 72 + s * 16); \
      const bf16x8 b0 = *(const bf16x8*)(bb + s * 16), b1 = *(const bf16x8*)(bb + 32 * 72 + s * 16); \
      acc[0][0] = MFMA(a0, b0, acc[0][0]); acc[0][1] = MFMA(a0, b1, acc[0][1]); \
      acc[1][0] = MFMA(a1, b0, acc[1][0]); acc[1][1] = MFMA(a1, b1, acc[1][1]); } }
  GLOAD(A, 0); SWRITE(A, 0, 0); GLOAD(A, 1); __syncthreads();
  for (int kt = 0; kt < 14; kt += 2) {
    GLOAD(B, kt + 2);
    GCOMPUTE(0);
    SWRITE(A, 1, 8);
    __syncthreads();
    GLOAD(A, kt + 3);
    GCOMPUTE(1);
    SWRITE(B, 0, 8);
    __syncthreads();
  }
  GCOMPUTE(0);
  SWRITE(A, 1, 0);
  __syncthreads();
  GCOMPUTE(1);
  __syncthreads();
#undef GCOMPUTE
#undef GLOAD
#undef SWRITE
}

DI void stage_acc(const f32x16 (&acc)[2][2], float* st) {
  const int tid = threadIdx.x, lane = tid & 63, w = tid >> 6, wm = w >> 1, wn = w & 1, lr = lane & 31, lh = lane >> 5;
#pragma unroll
  for (int mt = 0; mt < 2; ++mt)
#pragma unroll
    for (int nt = 0; nt < 2; ++nt)
#pragma unroll
      for (int r = 0; r < 16; ++r) st[(wm * 64 + mt * 32 + crow(r, lh)) * 132 + wn * 64 + nt * 32 + lr] = acc[mt][nt][r];
}

__device__ void phase1_tile(const Params& p, int mtile, int j, char* smem) {
  f32x16 acc[2][2];
  const int m0 = mtile * 128, n0 = j * 128;
  gemm_mainloop((const u16*)(p.ws + OFF_XNB), (const u16*)(p.ws + OFF_WIN), m0, n0, smem, acc);
  float* st = (float*)smem;
  stage_acc(acc, st);
  __syncthreads();
  const int tid = threadIdx.x, row = tid & 127, half = tid >> 7;
  const int sec = j >> 2;
  const int tok = m0 + row, b = tok >> 12, s = tok & 4095;
  float v[64];
#pragma unroll
  for (int c = 0; c < 16; ++c) { const float4 t4 = *(const float4*)(st + row * 132 + half * 64 + c * 4); v[4 * c] = t4.x; v[4 * c + 1] = t4.y; v[4 * c + 2] = t4.z; v[4 * c + 3] = t4.w; }
  if (sec != 2 && sec != 5) {
    const float* g = sec == 0 ? p.qna : sec == 1 ? p.kna : sec == 3 ? p.qnb : p.knb;
    float ss = 0.f;
#pragma unroll
    for (int i = 0; i < 64; ++i) ss += v[i] * v[i];
    float r = rsqrtf(ss * (1.f / 64.f) + 1e-6f);
    const float post = (sec == 0 || sec == 3) ? QSCALE : 1.f;
#pragma unroll
    for (int i = 0; i < 64; ++i) v[i] = v[i] * r * g[i];
    const float* rc = (const float*)(p.ws + OFF_ROPEC) + s * 8;
    const float* rs = (const float*)(p.ws + OFF_ROPES) + s * 8;
#pragma unroll
    for (int i = 0; i < 8; ++i) {
      const float c = rc[i], sn = rs[i], x1 = v[i], x2 = v[i + 8];
      v[i] = x1 * c - x2 * sn; v[i + 8] = x2 * c + x1 * sn;
    }
#pragma unroll
    for (int i = 0; i < 64; ++i) v[i] *= post;
  }
  u16* dst;
  if (sec == 5) {
    dst = (u16*)(p.ws + OFF_VB) + ((size_t)(b * 4 + (j & 3)) * 4096 + s) * 128 + half * 64;
  } else {
    const size_t off = sec == 0 ? OFF_QA : sec == 1 ? OFF_KA : sec == 2 ? OFF_VA : sec == 3 ? OFF_QB : OFF_KB;
    const int hc = (j & 3) * 2 + half;
    dst = (u16*)(p.ws + off) + ((size_t)(b * 8 + hc) * 4096 + s) * 64;
  }
#pragma unroll
  for (int c = 0; c < 8; ++c)
    ((uint4*)dst)[c] = make_uint4(pack2(v[8 * c], v[8 * c + 1]), pack2(v[8 * c + 2], v[8 * c + 3]), pack2(v[8 * c + 4], v[8 * c + 5]), pack2(v[8 * c + 6], v[8 * c + 7]));
  __syncthreads();
}

template <int OFF> DI s16x4 tr_read(unsigned addr) {
  s16x4 r; asm volatile("ds_read_b64_tr_b16 %0, %1 offset:%2" : "=v"(r) : "v"(addr), "n"(OFF) : "memory"); return r;
}
DI void wait_tr8(s16x4& a0, s16x4& a1, s16x4& a2, s16x4& a3, s16x4& a4, s16x4& a5, s16x4& a6, s16x4& a7) {
  asm volatile("s_waitcnt lgkmcnt(0)" : "+v"(a0), "+v"(a1), "+v"(a2), "+v"(a3), "+v"(a4), "+v"(a5), "+v"(a6), "+v"(a7) : : "memory");
}

#define TR_ISSUE(S_, MT_) { const unsigned a0_ = vaddr + (MT_) * 64; \
        S_##0 = tr_read<0 * 16 * VST * 2>(a0_); S_##1 = tr_read<(0 * 16 + 8) * VST * 2>(a0_); S_##2 = tr_read<1 * 16 * VST * 2>(a0_); S_##3 = tr_read<(1 * 16 + 8) * VST * 2>(a0_); \
        S_##4 = tr_read<2 * 16 * VST * 2>(a0_); S_##5 = tr_read<(2 * 16 + 8) * VST * 2>(a0_); S_##6 = tr_read<3 * 16 * VST * 2>(a0_); S_##7 = tr_read<(3 * 16 + 8) * VST * 2>(a0_); }
#define TR_MFMA(S_, MT_) { \
        o[MT_] = MFMA(__builtin_shufflevector(S_##0, S_##1, 0, 1, 2, 3, 4, 5, 6, 7), pf[0], o[MT_]); o[MT_] = MFMA(__builtin_shufflevector(S_##2, S_##3, 0, 1, 2, 3, 4, 5, 6, 7), pf[1], o[MT_]); \
        o[MT_] = MFMA(__builtin_shufflevector(S_##4, S_##5, 0, 1, 2, 3, 4, 5, 6, 7), pf[2], o[MT_]); o[MT_] = MFMA(__builtin_shufflevector(S_##6, S_##7, 0, 1, 2, 3, 4, 5, 6, 7), pf[3], o[MT_]); }
template <int DV, bool CAUSAL>
__device__ void attn_unit(const u16* __restrict__ qbase, const u16* __restrict__ kbase, const u16* __restrict__ vbase, int n, int dil, int res,
                          u16* __restrict__ obase, int ostride, float* __restrict__ lsebase, char* smem) {
  constexpr int VST = DV + 8;
  constexpr int NMT = DV / 32;
  constexpr int WMAX = CAUSAL ? (1 << 30) : 128;
  u16* Ks = (u16*)smem;
  u16* Vs = Ks + 2 * 64 * 72;
  const int tid = opaque_tid(), lane = tid & 63, w = tid >> 6, lr = lane & 31, lh = lane >> 5;
  const int kb0 = CAUSAL ? 0 : 128 * (n - 1);
  const int kt_begin = CAUSAL ? 0 : (n == 0 ? 2 : 0);
  const int kt_end = CAUSAL ? (2 * n + 2) : 4;
  const int mq = 128 * n + 32 * w + lr;
  const size_t tq = (size_t)mq * dil + res;
  bf16x8 qf[4];
  {
    const u16* qp = qbase + tq * 64 + lh * 8;
#pragma unroll
    for (int s = 0; s < 4; ++s) qf[s] = *(const bf16x8*)(qp + s * 16);
  }
  f32x16 o[NMT];
#pragma unroll
  for (int mt = 0; mt < NMT; ++mt)
#pragma unroll
    for (int r = 0; r < 16; ++r) o[mt][r] = 0.f;
  float m_run = NEG_INF, l_run = 0.f;
  u32x4 rk0, rk1, rv0, rv1, rv2, rv3;
  rv2 = rv3 = (u32x4){0u, 0u, 0u, 0u};
  const int krow_ = tid >> 3, kkc = tid & 7;
  constexpr int VCPR = DV / 8;
  const int vrow = tid / VCPR, vkc = tid % VCPR;
  constexpr int VRSTEP = 256 / VCPR;
  const u16* kgp = kbase + ((size_t)(kb0 + krow_) * dil + res) * 64 + kkc * 8;
  const u16* vgp = vbase + ((size_t)(kb0 + vrow) * dil + res) * DV + vkc * 8;
  const size_t kstep32 = (size_t)32 * dil * 64, kstep64 = (size_t)64 * dil * 64;
  const size_t vstepr = (size_t)VRSTEP * dil * DV, vstep64 = (size_t)64 * dil * DV;
  u16* ksw = Ks + krow_ * 72 + kkc * 8;
  u16* vsw = Vs + vrow * VST + vkc * 8;
#define AGLOAD(kt) { const u16* kp_ = kgp + (size_t)(kt) * kstep64; gld16(rk0, kp_); gld16(rk1, kp_ + kstep32); \
    const u16* vp_ = vgp + (size_t)(kt) * vstep64; gld16(rv0, vp_); gld16(rv1, vp_ + vstepr); \
    if (NMT == 4) { gld16(rv2, vp_ + 2 * vstepr); gld16(rv3, vp_ + 3 * vstepr); } }
#define ASWRITE(buf) { vm_wait6(rk0, rk1, rv0, rv1, rv2, rv3); *(u32x4*)(ksw + (buf) * 64 * 72) = rk0; *(u32x4*)(ksw + (buf) * 64 * 72 + 32 * 72) = rk1; \
    *(u32x4*)(vsw + (buf) * 64 * VST) = rv0; *(u32x4*)(vsw + (buf) * 64 * VST + VRSTEP * VST) = rv1; \
    if (NMT == 4) { *(u32x4*)(vsw + (buf) * 64 * VST + 2 * VRSTEP * VST) = rv2; *(u32x4*)(vsw + (buf) * 64 * VST + 3 * VRSTEP * VST) = rv3; } }
  AGLOAD(kt_begin); ASWRITE(0); __syncthreads();
  const int li = lane & 31, blk = li >> 4, tq_ = (li >> 2) & 3, tp = li & 3;
  for (int kt = kt_begin; kt < kt_end; ++kt) {
    const int buf = (kt - kt_begin) & 1;
    if (kt + 1 < kt_end) AGLOAD(kt + 1);
    __builtin_amdgcn_sched_barrier(0);
    const int k_lo = kb0 + 64 * kt, q_lo = 128 * n + 32 * w;
    const int dmin = q_lo - (k_lo + 63), dmax = q_lo + 31 - k_lo;
    const bool skip = (dmax < 0) || (dmin > WMAX);
    if (!skip) {
      const bool need_mask = (dmin < 0) || (dmax > WMAX);
      const unsigned vaddr = (unsigned)(size_t)(Vs + (buf * 64 + 4 * lh + tq_) * VST + 16 * blk + 4 * tp);
      s16x4 va0, va1, va2, va3, va4, va5, va6, va7;
      const u16* kb = Ks + (buf * 64 + lr) * 72 + lh * 8;
      f32x16 st[2];
#pragma unroll
      for (int kk = 0; kk < 2; ++kk) {
#pragma unroll
        for (int r = 0; r < 16; ++r) st[kk][r] = 0.f;
#pragma unroll
        for (int s = 0; s < 4; ++s) { const bf16x8 a = *(const bf16x8*)(kb + kk * 32 * 72 + s * 16); st[kk] = MFMA(a, qf[s], st[kk]); }
      }
      if (need_mask) {
#pragma unroll
        for (int kk = 0; kk < 2; ++kk)
#pragma unroll
          for (int r = 0; r < 16; ++r) {
            const int d = mq - (k_lo + 32 * kk + crow(r, lh));
            if (d < 0 || d > WMAX) st[kk][r] = NEG_INF;
          }
      }
      TR_ISSUE(va, 0);
      float mx = NEG_INF;
#pragma unroll
      for (int kk = 0; kk < 2; ++kk)
#pragma unroll
        for (int r = 0; r < 16; ++r) mx = fmaxf(mx, st[kk][r]);
      mx = fmaxf(mx, __shfl_xor(mx, 32));
      const float m_new = fmaxf(m_run, mx);
      const float m_use = (m_new == NEG_INF) ? 0.f : m_new;
      const float alpha = exp2f(m_run - m_use);
      float ls = 0.f;
#pragma unroll
      for (int kk = 0; kk < 2; ++kk)
#pragma unroll
        for (int r = 0; r < 16; ++r) { const float e = exp2f(st[kk][r] - m_use); st[kk][r] = e; ls += e; }
      l_run = l_run * alpha + ls; m_run = m_new;
#pragma unroll
      for (int mt = 0; mt < NMT; ++mt)
#pragma unroll
        for (int r = 0; r < 16; ++r) o[mt][r] *= alpha;
      bf16x8 pf[4];
#pragma unroll
      for (int ks = 0; ks < 4; ++ks) {
        const int kk = ks >> 1, s2 = ks & 1;
        u32x4 cv;
        cv[0] = pack2(st[kk][8 * s2 + 0], st[kk][8 * s2 + 1]); cv[1] = pack2(st[kk][8 * s2 + 2], st[kk][8 * s2 + 3]);
        cv[2] = pack2(st[kk][8 * s2 + 4], st[kk][8 * s2 + 5]); cv[3] = pack2(st[kk][8 * s2 + 6], st[kk][8 * s2 + 7]);
        pf[ks] = __builtin_bit_cast(bf16x8, cv);
      }
      wait_tr8(va0, va1, va2, va3, va4, va5, va6, va7);
      TR_MFMA(va, 0);
      TR_ISSUE(va, 1);
      wait_tr8(va0, va1, va2, va3, va4, va5, va6, va7);
      TR_MFMA(va, 1);
      if (NMT == 4) {
        TR_ISSUE(va, 2);
        wait_tr8(va0, va1, va2, va3, va4, va5, va6, va7);
        TR_MFMA(va, 2 % NMT);
        TR_ISSUE(va, 3);
        wait_tr8(va0, va1, va2, va3, va4, va5, va6, va7);
        TR_MFMA(va, 3 % NMT);
      }
    }
    if (kt + 1 < kt_end) ASWRITE(buf ^ 1);
    __syncthreads();
  }
#undef AGLOAD
#undef ASWRITE
  const float l_tot = l_run + __shfl_xor(l_run, 32);
  const float inv = 1.f / l_tot;
  u16* op = obase + tq * ostride;
#pragma unroll
  for (int mt = 0; mt < NMT; ++mt)
#pragma unroll
    for (int g = 0; g < 4; ++g) {
      const int dv0 = 32 * mt + 8 * g + 4 * lh;
      *(uint2*)(op + dv0) = make_uint2(pack2(o[mt][4 * g] * inv, o[mt][4 * g + 1] * inv), pack2(o[mt][4 * g + 2] * inv, o[mt][4 * g + 3] * inv));
    }
  if (!CAUSAL && lh == 0) lsebase[tq * 8] = m_run + log2f(l_tot);
}

constexpr int N_DIFF_UNITS = 2048, N_DIL_UNITS = 6144;
__device__ void phase2_unit(const Params& p, int u, char* smem) {
  if (u < N_DIFF_UNITS) {
    const int n = 31 - (u >> 6), rem = u & 63, b = rem >> 3, hc = rem & 7, h4 = hc >> 1;
    const u16* qb = (const u16*)(p.ws + OFF_QB) + (size_t)(b * 8 + hc) * 4096 * 64;
    const u16* kb = (const u16*)(p.ws + OFF_KB) + (size_t)(b * 8 + hc) * 4096 * 64;
    const u16* vb = (const u16*)(p.ws + OFF_VB) + (size_t)(b * 4 + h4) * 4096 * 128;
    u16* ob = (u16*)(p.ws + OFF_OBC) + (size_t)b * 4096 * 1024 + hc * 128;
    attn_unit<128, true>(qb, kb, vb, n, 1, 0, ob, 1024, nullptr, smem);
  } else {
    const int u2 = u - N_DIFF_UNITS, pidx = u2 >> 11, rem = u2 & 2047, b = rem >> 8, h = (rem >> 5) & 7, rn = rem & 31;
    const int sh = 2 * pidx, dil = 1 << sh, nb = 32 >> sh, res = rn >> (5 - sh), n = rn & (nb - 1);
    const u16* qb = (const u16*)(p.ws + OFF_QA) + (size_t)(b * 8 + h) * 4096 * 64;
    const u16* kb = (const u16*)(p.ws + OFF_KA) + (size_t)(b * 8 + h) * 4096 * 64;
    const u16* vb = (const u16*)(p.ws + OFF_VA) + (size_t)(b * 8 + h) * 4096 * 64;
    u16* ob = (u16*)(p.ws + OFF_OAP) + ((size_t)pidx * T_TOK + (size_t)b * 4096) * 512 + h * 64;
    float* lse = (float*)(p.ws + OFF_LSE) + ((size_t)pidx * T_TOK + (size_t)b * 4096) * 8 + h;
    attn_unit<64, false>(qb, kb, vb, n, dil, res, ob, 512, lse, smem);
  }
}
__device__ void phase2(const Params& p, char* smem, int slot = 1) {
  int* counter = (int*)(p.ws + OFF_MISC) + slot;
  int* s_unit = (int*)(smem + SMEM_BYTES - 16);
  while (true) {
    if (threadIdx.x == 0) *s_unit = atomicAdd(counter, 1);
    __syncthreads();
    const int u = *s_unit;
    __syncthreads();
    if (u >= N_DIFF_UNITS + N_DIL_UNITS) break;
    phase2_unit(p, u, smem);
  }
}

__device__ void phase3(const Params& p) {
  const int tid = threadIdx.x, lane = tid & 63, wid = tid >> 6;
  const int gw = blockIdx.x * 4 + wid, nw = gridDim.x * 4;
  const float lam = ((const float*)(p.ws + OFF_MISC))[0];
  const u16* oap = (const u16*)(p.ws + OFF_OAP);
  const u16* obc = (const u16*)(p.ws + OFF_OBC);
  const float* lse = (const float*)(p.ws + OFF_LSE);
  u16* mix = (u16*)(p.ws + OFF_XNB);
  for (int tok = gw; tok < T_TOK; tok += nw) {
    float o[16]; float ss = 0.f;
    if (lane < 32) {
      const int head = lane >> 2;
      float l0 = lse[(size_t)tok * 8 + head], l1 = lse[((size_t)T_TOK + tok) * 8 + head], l2 = lse[((size_t)2 * T_TOK + tok) * 8 + head];
      const float mx = fmaxf(l0, fmaxf(l1, l2));
      float w0 = exp2f(l0 - mx), w1 = exp2f(l1 - mx), w2 = exp2f(l2 - mx);
      const float inv = 1.f / (w0 + w1 + w2); w0 *= inv; w1 *= inv; w2 *= inv;
      const uint4* p0 = (const uint4*)(oap + (size_t)tok * 512 + lane * 16);
      const uint4* p1 = (const uint4*)(oap + ((size_t)T_TOK + tok) * 512 + lane * 16);
      const uint4* p2 = (const uint4*)(oap + ((size_t)2 * T_TOK + tok) * 512 + lane * 16);
#pragma unroll
      for (int c = 0; c < 2; ++c) {
        const uint4 a = p0[c], b = p1[c], d = p2[c];
        const unsigned au[4] = {a.x, a.y, a.z, a.w}, bu[4] = {b.x, b.y, b.z, b.w}, du[4] = {d.x, d.y, d.z, d.w};
#pragma unroll
        for (int k = 0; k < 4; ++k) {
          o[c * 8 + 2 * k] = w0 * bflo(au[k]) + w1 * bflo(bu[k]) + w2 * bflo(du[k]);
          o[c * 8 + 2 * k + 1] = w0 * bfhi(au[k]) + w1 * bfhi(bu[k]) + w2 * bfhi(du[k]);
        }
      }
    } else {
      const int l2 = lane - 32, head = l2 >> 3, cc = (l2 & 7) * 16;
      const uint4* p0 = (const uint4*)(obc + (size_t)tok * 1024 + (2 * head) * 128 + cc);
      const uint4* p1 = (const uint4*)(obc + (size_t)tok * 1024 + (2 * head + 1) * 128 + cc);
#pragma unroll
      for (int c = 0; c < 2; ++c) {
        const uint4 a = p0[c], b = p1[c];
        const unsigned au[4] = {a.x, a.y, a.z, a.w}, bu[4] = {b.x, b.y, b.z, b.w};
#pragma unroll
        for (int k = 0; k < 4; ++k) {
          o[c * 8 + 2 * k] = bflo(au[k]) - lam * bflo(bu[k]);
          o[c * 8 + 2 * k + 1] = bfhi(au[k]) - lam * bfhi(bu[k]);
        }
      }
    }
#pragma unroll
    for (int i = 0; i < 16; ++i) ss += o[i] * o[i];
    const float s1 = ss + __shfl_xor(ss, 1);
    const float s2 = s1 + __shfl_xor(s1, 2);
    const float s3 = s2 + __shfl_xor(s2, 4);
    float r; const float* g;
    if (lane < 32) { r = rsqrtf(s2 * (1.f / 64.f) + 1e-6f); g = p.ona + lane * 16; }
    else { r = rsqrtf(s3 * (1.f / 128.f) + 1e-6f) * 0.8f; g = p.onb + (lane - 32) * 16; }
    unsigned pk[8];
#pragma unroll
    for (int k = 0; k < 8; ++k) pk[k] = pack2(o[2 * k] * r * g[2 * k], o[2 * k + 1] * r * g[2 * k + 1]);
    uint4* dst = (uint4*)(mix + (size_t)tok * 1024 + lane * 16);
    dst[0] = make_uint4(pk[0], pk[1], pk[2], pk[3]); dst[1] = make_uint4(pk[4], pk[5], pk[6], pk[7]);
  }
}

__device__ void phase4_tile(const Params& p, int mtile, int j, char* smem) {
  f32x16 acc[2][2];
  const int m0 = mtile * 128, n0 = j * 128;
  gemm_mainloop((const u16*)(p.ws + OFF_XNB), (const u16*)(p.ws + OFF_WOUT), m0, n0, smem, acc);
  float* st = (float*)smem;
  stage_acc(acc, st);
  __syncthreads();
  const int tid = threadIdx.x, cgi = tid & 31, r0 = tid >> 5;
  float* hss = (float*)(p.ws + OFF_HSS);
  u16* hb = (u16*)(p.ws + OFF_OAP);
#pragma unroll 4
  for (int ps = 0; ps < 16; ++ps) {
    const int row = r0 + 8 * ps;
    const float4 a = *(const float4*)(st + row * 132 + cgi * 4);
    const size_t gi = (size_t)(m0 + row) * 1024 + n0 + cgi * 4;
    const float4 xv = *(const float4*)(p.x + gi);
    float4 hv; hv.x = xv.x + a.x; hv.y = xv.y + a.y; hv.z = xv.z + a.z; hv.w = xv.w + a.w;
    *(float4*)(p.out + gi) = hv;
    *(uint2*)(hb + gi) = make_uint2(pack2(hv.x, hv.y), pack2(hv.z, hv.w));
    float ss = hv.x * hv.x + hv.y * hv.y + hv.z * hv.z + hv.w * hv.w;
    ss += __shfl_xor(ss, 16); ss += __shfl_xor(ss, 8); ss += __shfl_xor(ss, 4); ss += __shfl_xor(ss, 2); ss += __shfl_xor(ss, 1);
    if (cgi == 0) atomicAdd(hss + m0 + row, ss);
  }
  __syncthreads();
}

#define TK_INSERT(xv, xi) { float x_ = (xv); int i_ = (xi); _Pragma("unroll") for (int q_ = 0; q_ < 16; ++q_) { const bool gt_ = x_ > tv[q_]; const float tvv = tv[q_]; const int tii = ti[q_]; tv[q_] = gt_ ? x_ : tvv; ti[q_] = gt_ ? i_ : tii; x_ = gt_ ? tvv : x_; i_ = gt_ ? tii : i_; } }
__device__ void phase5_tile(const Params& p, int mtile, int j, char* smem) {
  f32x16 acc[2][2];
  const int m0 = mtile * 128, n0 = j * 128;
  gemm_mainloop((const u16*)(p.ws + OFF_OAP), (const u16*)(p.ws + OFF_WPQ), m0, n0, smem, acc);
  const int tid = threadIdx.x, lane = tid & 63, w = tid >> 6, wm = w >> 1, wn = w & 1, lr = lane & 31, lh = lane >> 5;
  u16* Qs = (u16*)smem;
  u16* SKs = Qs + 128 * 136;
  float* rs = (float*)(smem + 2 * 128 * 136 * 2);
  const float* hss = (const float*)(p.ws + OFF_HSS);
  if (tid < 128) rs[tid] = rsqrtf(hss[m0 + tid] * (1.f / 1024.f) + 1e-6f);
  {
    const u16* sk = (const u16*)(p.ws + OFF_SUBK) + (size_t)j * 128 * 128;
#pragma unroll
    for (int i = 0; i < 8; ++i) { const int c = tid + 256 * i, row = c >> 4, kc = c & 15; *(uint4*)(SKs + row * 136 + kc * 8) = *(const uint4*)(sk + row * 128 + kc * 8); }
  }
  __syncthreads();
#pragma unroll
  for (int mt = 0; mt < 2; ++mt)
#pragma unroll
    for (int nt = 0; nt < 2; ++nt)
#pragma unroll
      for (int r = 0; r < 16; ++r) {
        const int row = wm * 64 + mt * 32 + crow(r, lh);
        Qs[row * 136 + wn * 64 + nt * 32 + lr] = f2bf(acc[mt][nt][r] * rs[row]);
      }
  __syncthreads();
#pragma unroll
  for (int a = 0; a < 2; ++a)
#pragma unroll
    for (int b = 0; b < 2; ++b)
#pragma unroll
      for (int r = 0; r < 16; ++r) acc[a][b][r] = 0.f;
  {
    const u16* ab = Qs + (wm * 64 + lr) * 136 + lh * 8;
    const u16* bb = SKs + (wn * 64 + lr) * 136 + lh * 8;
#pragma unroll
    for (int s = 0; s < 8; ++s) {
      const bf16x8 a0 = *(const bf16x8*)(ab + s * 16), a1 = *(const bf16x8*)(ab + 32 * 136 + s * 16);
      const bf16x8 b0 = *(const bf16x8*)(bb + s * 16), b1 = *(const bf16x8*)(bb + 32 * 136 + s * 16);
      acc[0][0] = MFMA(a0, b0, acc[0][0]); acc[0][1] = MFMA(a0, b1, acc[0][1]);
      acc[1][0] = MFMA(a1, b0, acc[1][0]); acc[1][1] = MFMA(a1, b1, acc[1][1]);
    }
  }
  __syncthreads();
  float* st = (float*)smem;
  stage_acc(acc, st);
  __syncthreads();
  const int row = tid & 127, half = tid >> 7;
  unsigned tk[16];
#pragma unroll
  for (int q = 0; q < 16; ++q) tk[q] = 0u;
#define TK_KEY(xv, xi) ({ const unsigned u_ = __float_as_uint(xv); const unsigned o_ = (u_ & 0x80000000u) ? ~u_ : (u_ | 0x80000000u); (o_ & 0xFFFFFF80u) | (unsigned)(127 - (xi)); })
#define TK_INS(kv) { unsigned k_ = (kv); _Pragma("unroll") for (int q_ = 0; q_ < 16; ++q_) { const unsigned hi_ = k_ > tk[q_] ? k_ : tk[q_]; k_ = k_ > tk[q_] ? tk[q_] : k_; tk[q_] = hi_; } }
#pragma unroll 2
  for (int c = 0; c < 16; ++c) {
    const float4 v4 = *(const float4*)(st + row * 132 + half * 64 + c * 4);
    const int bi = half * 64 + c * 4;
    TK_INS(TK_KEY(v4.x, bi)); TK_INS(TK_KEY(v4.y, bi + 1)); TK_INS(TK_KEY(v4.z, bi + 2)); TK_INS(TK_KEY(v4.w, bi + 3));
  }
  __syncthreads();
  if (half == 1) {
#pragma unroll
    for (int q = 0; q < 16; ++q) st[row * 132 + q] = __uint_as_float(tk[q]);
  }
  __syncthreads();
  if (half == 0) {
#pragma unroll 4
    for (int q = 0; q < 16; ++q) TK_INS(__float_as_uint(st[row * 132 + q]));
    const size_t base = ((size_t)(m0 + row) * 16 + j) * 16;
    float* tops = (float*)(p.ws + OFF_TOPS) + base;
    u8* topi = (u8*)(p.ws + OFF_TOPI) + base;
    float tv[16]; unsigned ti[16];
#pragma unroll
    for (int q = 0; q < 16; ++q) {
      const unsigned o = tk[q] & 0xFFFFFF80u;
      tv[q] = __uint_as_float((o & 0x80000000u) ? (o & 0x7FFFFFFFu) : ~o);
      ti[q] = 127u - (tk[q] & 127u);
    }
#pragma unroll
    for (int c = 0; c < 4; ++c) ((float4*)tops)[c] = make_float4(tv[4 * c], tv[4 * c + 1], tv[4 * c + 2], tv[4 * c + 3]);
    unsigned pk[4];
#pragma unroll
    for (int c = 0; c < 4; ++c) pk[c] = ti[4 * c] | (ti[4 * c + 1] << 8) | (ti[4 * c + 2] << 16) | (ti[4 * c + 3] << 24);
    *(uint4*)topi = make_uint4(pk[0], pk[1], pk[2], pk[3]);
  }
  __syncthreads();
#undef TK_KEY
#undef TK_INS
}

DI float dpp_xor1(float v) { return __builtin_bit_cast(float, __builtin_amdgcn_update_dpp(0, __builtin_bit_cast(int, v), 0xB1, 0xF, 0xF, true)); }
DI float dpp_xor2(float v) { return __builtin_bit_cast(float, __builtin_amdgcn_update_dpp(0, __builtin_bit_cast(int, v), 0x4E, 0xF, 0xF, true)); }
template <int PAT> DI float swz(float v) { return __builtin_bit_cast(float, __builtin_amdgcn_ds_swizzle(__builtin_bit_cast(int, v), PAT)); }
DI float treduce8(const float (&pp)[8], int lane) {
  const bool b0 = lane & 1, b1 = lane & 2, b2 = lane & 4;
  float q[4];
#pragma unroll
  for (int i = 0; i < 4; ++i) { const float keep = b0 ? pp[2 * i + 1] : pp[2 * i], send = b0 ? pp[2 * i] : pp[2 * i + 1]; q[i] = keep + dpp_xor1(send); }
  float r[2];
#pragma unroll
  for (int i = 0; i < 2; ++i) { const float keep = b1 ? q[2 * i + 1] : q[2 * i], send = b1 ? q[2 * i] : q[2 * i + 1]; r[i] = keep + dpp_xor2(send); }
  float t = (b2 ? r[1] : r[0]) + swz<0x101F>(b2 ? r[0] : r[1]);
  t += swz<0x201F>(t); t += swz<0x401F>(t); t += __shfl_xor(t, 32);
  return t;
}
DI float udot16(const uint4& w, const float (&h)[16]) {
  f32x2 acc = {0.f, 0.f};
  const int ww[4] = {(int)w.x, (int)w.y, (int)w.z, (int)w.w};
#pragma unroll
  for (int j = 0; j < 4; ++j) {
    const f32x2 lo = __builtin_amdgcn_cvt_pk_f32_fp8(ww[j], false), hi = __builtin_amdgcn_cvt_pk_f32_fp8(ww[j], true);
    const f32x2 h0 = {h[4 * j], h[4 * j + 1]}, h1 = {h[4 * j + 2], h[4 * j + 3]};
    acc += lo * h0; acc += hi * h1;
  }
  return acc.x + acc.y;
}
DI void vacc16(const uint4& w, float a, f32x2 (&acc)[8]) {
  const f32x2 a2 = {a, a};
  const int ww[4] = {(int)w.x, (int)w.y, (int)w.z, (int)w.w};
#pragma unroll
  for (int j = 0; j < 4; ++j) {
    acc[2 * j] += a2 * __builtin_amdgcn_cvt_pk_f32_fp8(ww[j], false);
    acc[2 * j + 1] += a2 * __builtin_amdgcn_cvt_pk_f32_fp8(ww[j], true);
  }
}
#define LOAD8(buf, tbl, bidx) { const uint4 i0_ = *(const uint4*)(ids + 8 * (bidx)), i1_ = *(const uint4*)(ids + 8 * (bidx) + 4); \
    const unsigned idv_[8] = {i0_.x, i0_.y, i0_.z, i0_.w, i1_.x, i1_.y, i1_.z, i1_.w}; \
    _Pragma("unroll") for (int k_ = 0; k_ < 8; ++k_) { const unsigned id_ = __builtin_amdgcn_readfirstlane(idv_[k_]); buf[k_] = *(const uint4*)((tbl) + (size_t)id_ * 1024 + lane * 16); } }

__device__ void phase6(const Params& p, char* smem, float* dstbase) {
  const int tid = opaque_tid(), lane = tid & 63, wid = tid >> 6;
  const int gw = blockIdx.x * 4 + wid, nw = gridDim.x * 4;
  int* ids = (int*)(smem + wid * 1024);
  float* gts = (float*)(smem + wid * 1024 + 512);
  const float* hss = (const float*)(p.ws + OFF_HSS);
  const float* tops = (const float*)(p.ws + OFF_TOPS);
  const u8* topi = (const u8*)(p.ws + OFF_TOPI);
  const u8* ub = (const u8*)(p.ws + OFF_PUB);
  const u8* vb = (const u8*)(p.ws + OFF_PVB);
  int ci, cj;
  {
    const int L = lane;
    if (L < 16) { ci = 0; cj = L; } else if (L < 24) { ci = 1; cj = L - 16; } else if (L < 29) { ci = 2; cj = L - 24; }
    else if (L < 33) { ci = 3; cj = L - 29; } else if (L < 36) { ci = 4; cj = L - 33; } else if (L < 38) { ci = 5; cj = L - 36; }
    else if (L < 40) { ci = 6; cj = L - 38; } else if (L < 42) { ci = 7; cj = L - 40; } else if (L < 50) { ci = L - 34; cj = 0; }
    else { ci = 0; cj = 0; }
  }
  for (int tok = gw; tok < T_TOK; tok += nw) {
    const float rstd = rsqrtf(hss[tok] * (1.f / 1024.f) + 1e-6f);
    float hres[16], hn[16];
    {
      const float4* hp = (const float4*)(p.out + (size_t)tok * 1024 + lane * 16);
      const float4* gp = (const float4*)(p.g_ffn + lane * 16);
#pragma unroll
      for (int c = 0; c < 4; ++c) {
        const float4 t4 = hp[c], g4 = gp[c];
        hres[4 * c] = t4.x; hres[4 * c + 1] = t4.y; hres[4 * c + 2] = t4.z; hres[4 * c + 3] = t4.w;
        hn[4 * c] = t4.x * rstd * g4.x; hn[4 * c + 1] = t4.y * rstd * g4.y; hn[4 * c + 2] = t4.z * rstd * g4.z; hn[4 * c + 3] = t4.w * rstd * g4.w;
      }
    }
#pragma unroll 1
    for (int head = 0; head < 8; ++head) {
      const size_t b1 = ((size_t)tok * 16 + head * 2) * 16, b2 = b1 + 16;
      float sum = NEG_INF; int eid = 0;
      if (lane < 50) { sum = tops[b1 + ci] + tops[b2 + cj]; eid = (int)topi[b1 + ci] * 128 + (int)topi[b2 + cj]; }
      unsigned key;
      {
        const unsigned u_ = __float_as_uint(sum); const unsigned o_ = (u_ & 0x80000000u) ? ~u_ : (u_ | 0x80000000u);
        key = (o_ & 0xFFFFFFC0u) | (unsigned)(63 - lane);
      }
#define BSTEP(K_, J_, SHF_) { const unsigned pr_ = (SHF_); const bool tmx_ = ((lane & (J_)) == 0) == ((lane & (K_)) == 0); \
        const unsigned mx_ = key > pr_ ? key : pr_, mn_ = key > pr_ ? pr_ : key; key = tmx_ ? mx_ : mn_; }
#define SX1 ((unsigned)__builtin_amdgcn_update_dpp(0, (int)key, 0xB1, 0xF, 0xF, true))
#define SX2 ((unsigned)__builtin_amdgcn_update_dpp(0, (int)key, 0x4E, 0xF, 0xF, true))
#define SX4 ((unsigned)__builtin_amdgcn_ds_swizzle((int)key, 0x101F))
#define SX8 ((unsigned)__builtin_amdgcn_ds_swizzle((int)key, 0x201F))
#define SX16 ((unsigned)__builtin_amdgcn_ds_swizzle((int)key, 0x401F))
#define SX32 ((unsigned)__shfl_xor((int)key, 32))
      BSTEP(2, 1, SX1);
      BSTEP(4, 2, SX2); BSTEP(4, 1, SX1);
      BSTEP(8, 4, SX4); BSTEP(8, 2, SX2); BSTEP(8, 1, SX1);
      BSTEP(16, 8, SX8); BSTEP(16, 4, SX4); BSTEP(16, 2, SX2); BSTEP(16, 1, SX1);
      BSTEP(32, 16, SX16); BSTEP(32, 8, SX8); BSTEP(32, 4, SX4); BSTEP(32, 2, SX2); BSTEP(32, 1, SX1);
      BSTEP(64, 32, SX32); BSTEP(64, 16, SX16); BSTEP(64, 8, SX8); BSTEP(64, 4, SX4); BSTEP(64, 2, SX2); BSTEP(64, 1, SX1);
#undef BSTEP
#undef SX1
#undef SX2
#undef SX4
#undef SX8
#undef SX16
#undef SX32
      const int src = 63 - (int)(key & 63u);
      const float sumv = __shfl(sum, src);
      const int eidv = __shfl(eid, src);
      const float mxa = __builtin_bit_cast(float, __builtin_amdgcn_readlane(__builtin_bit_cast(int, sumv), 0));
      const float e = (lane < 16) ? __expf(sumv - mxa) : 0.f;
      float den = e;
      den += dpp_xor1(den); den += dpp_xor2(den); den += swz<0x101F>(den); den += swz<0x201F>(den);
      if (lane < 16) { ids[head * 16 + lane] = eidv; gts[head * 16 + lane] = e / den; }
    }
    __builtin_amdgcn_wave_barrier();
    asm volatile("s_waitcnt lgkmcnt(0)" ::: "memory");
    float dsel0 = 0.f, dsel1 = 0.f;
    {
      uint4 ba[8], bb[8];
      LOAD8(ba, ub, 0);
#pragma unroll 1
      for (int b = 0; b < 16; b += 2) {
        LOAD8(bb, ub, b + 1);
        {
          float pp[8];
#pragma unroll
          for (int k = 0; k < 8; ++k) pp[k] = udot16(ba[k], hn);
          const float t = treduce8(pp, lane);
          if ((lane >> 3) == (b & 7)) { if (b < 8) dsel0 = t; else dsel1 = t; }
        }
        if (b + 2 < 16) LOAD8(ba, ub, b + 2);
        {
          float pp[8];
#pragma unroll
          for (int k = 0; k < 8; ++k) pp[k] = udot16(bb[k], hn);
          const float t = treduce8(pp, lane);
          if ((lane >> 3) == ((b + 1) & 7)) { if (b < 8) dsel0 = t; else dsel1 = t; }
        }
      }
    }
    {
      const float d0 = dsel0 * (1.f / USCALE), d1 = dsel1 * (1.f / USCALE);
      const float a0 = 0.5f * d0 * (1.f + erff(d0 * 0.70710678118654752f)) * gts[lane] * (1.f / VSCALE);
      const float a1 = 0.5f * d1 * (1.f + erff(d1 * 0.70710678118654752f)) * gts[64 + lane] * (1.f / VSCALE);
      gts[lane] = a0; gts[64 + lane] = a1;
    }
    __builtin_amdgcn_wave_barrier();
    asm volatile("s_waitcnt lgkmcnt(0)" ::: "memory");
    f32x2 acc[8];
#pragma unroll
    for (int i = 0; i < 8; ++i) acc[i] = (f32x2){0.f, 0.f};
    {
      uint4 ba[8], bb[8];
      LOAD8(ba, vb, 0);
#pragma unroll 1
      for (int b = 0; b < 16; b += 2) {
        LOAD8(bb, vb, b + 1);
        {
          const float4 g0 = *(const float4*)(gts + 8 * b), g1 = *(const float4*)(gts + 8 * b + 4);
          vacc16(ba[0], g0.x, acc); vacc16(ba[1], g0.y, acc); vacc16(ba[2], g0.z, acc); vacc16(ba[3], g0.w, acc);
          vacc16(ba[4], g1.x, acc); vacc16(ba[5], g1.y, acc); vacc16(ba[6], g1.z, acc); vacc16(ba[7], g1.w, acc);
        }
        if (b + 2 < 16) LOAD8(ba, vb, b + 2);
        {
          const float4 g0 = *(const float4*)(gts + 8 * b + 8), g1 = *(const float4*)(gts + 8 * b + 12);
          vacc16(bb[0], g0.x, acc); vacc16(bb[1], g0.y, acc); vacc16(bb[2], g0.z, acc); vacc16(bb[3], g0.w, acc);
          vacc16(bb[4], g1.x, acc); vacc16(bb[5], g1.y, acc); vacc16(bb[6], g1.z, acc); vacc16(bb[7], g1.w, acc);
        }
      }
    }
    float4* op = (float4*)(dstbase + (size_t)tok * 1024 + lane * 16);
#pragma unroll
    for (int c = 0; c < 4; ++c) op[c] = make_float4(hres[4 * c] + acc[2 * c].x, hres[4 * c + 1] + acc[2 * c].y, hres[4 * c + 2] + acc[2 * c + 1].x, hres[4 * c + 3] + acc[2 * c + 1].y);
    __builtin_amdgcn_wave_barrier();
  }
}


#define XB_TMO      128
#define XB_XCNT(j)  (256  + 64 * (j))
#define XB_XSUB(j)  (1280 + 64 * (j))
#define XB_XGEN(j)  (2304 + 64 * (j))
#define XB_TOP      3328
#define XB_TOPGEN   3392
#define XB_SPIN_CAP (1u << 22)
#define LAS __attribute__((address_space(3)))
DI unsigned xb_ld(unsigned* p) { return __hip_atomic_load(p, __ATOMIC_RELAXED, __HIP_MEMORY_SCOPE_AGENT); }
DI unsigned xb_add(unsigned* p, unsigned v) { return __hip_atomic_fetch_add(p, v, __ATOMIC_RELAXED, __HIP_MEMORY_SCOPE_AGENT); }
DI unsigned xb_xcc_id() { return (unsigned)__builtin_amdgcn_s_getreg((3 << 11) | 20) & 0xFu; }
#define XB_SPIN(cond, bar) do { unsigned _sp = 0; while (cond) { __builtin_amdgcn_s_sleep(1); \
    if ((++_sp & 255u) == 0u) { if (xb_ld(&(bar)[XB_TMO])) break; if (_sp > XB_SPIN_CAP) { atomicAdd(&(bar)[XB_TMO], 1u); break; } } } } while (0)
struct XcdBarrier { unsigned* bar; unsigned x; volatile LAS unsigned* st; };
DI XcdBarrier xcd_barrier_post(unsigned* bar, volatile LAS unsigned* st) {
  XcdBarrier b; b.bar = bar; b.x = xb_xcc_id(); b.st = st;
  if (threadIdx.x == 0) (void)xb_add(&bar[XB_XCNT(b.x)], 1u);
  return b;
}
DI void xcd_barrier_complete(unsigned* bar, unsigned x, unsigned& nloc, unsigned& nx) {
  const unsigned G = gridDim.x * gridDim.y * gridDim.z;
  unsigned sum, cnt, mine, sp = 0u;
  for (;;) {
    sum = 0u; cnt = 0u; mine = 0u;
#pragma unroll
    for (unsigned j = 0; j < 16; ++j) { const unsigned c = xb_ld(&bar[XB_XCNT(j)]); sum += c; cnt += (c > 0u) ? 1u : 0u; mine = (j == x) ? c : mine; }
    if (sum == G) break;
    __builtin_amdgcn_s_sleep(1);
    if ((++sp & 255u) == 0u) { if (xb_ld(&bar[XB_TMO])) break; if (sp > XB_SPIN_CAP) { atomicAdd(&bar[XB_TMO], 1u); break; } }
  }
  nloc = mine > 0u ? mine : 1u; nx = cnt > 0u ? cnt : 1u;
}
DI void xcd_barrier(const XcdBarrier& b) {
  asm volatile("s_waitcnt vmcnt(0)" ::: "memory");
  __syncthreads();
  if (threadIdx.x == 0) {
    unsigned* bar = b.bar;
    __builtin_amdgcn_s_waitcnt(0);
    unsigned nloc = b.st[0], nx = b.st[1];
    if (nloc == 0u) { xcd_barrier_complete(bar, b.x, nloc, nx); b.st[0] = nloc; b.st[1] = nx; }
    const unsigned old = xb_add(&bar[XB_XSUB(b.x)], 1u);
    const unsigned gen = old / nloc;
    if (old + 1u == (gen + 1u) * nloc) {
      __builtin_amdgcn_fence(__ATOMIC_RELEASE, "agent");
      asm volatile("s_waitcnt vmcnt(0)" ::: "memory");
      const unsigned og = xb_add(&bar[XB_TOP], 1u);
      const unsigned tg = og / nx;
      if (og + 1u == (tg + 1u) * nx) xb_add(&bar[XB_TOPGEN], 1u);
      else XB_SPIN(xb_ld(&bar[XB_TOPGEN]) == tg, bar);
      __builtin_amdgcn_fence(__ATOMIC_ACQUIRE, "agent");
      xb_add(&bar[XB_XGEN(b.x)], 1u);
      asm volatile("s_waitcnt vmcnt(0)" ::: "memory");
    } else {
      XB_SPIN(xb_ld(&bar[XB_XGEN(b.x)]) == gen, bar);
      __builtin_amdgcn_fence(__ATOMIC_ACQUIRE, "agent");
      asm volatile("s_waitcnt vmcnt(0)" ::: "memory");
    }
  }
  __syncthreads();
}

#if FUSED
__global__ void __launch_bounds__(256, 2) fwd_megakernel(Params p) {
  __shared__ __attribute__((aligned(16))) char smem[SMEM_BYTES];
  cg::grid_group grid = cg::this_grid();
  __shared__ uint4 xb_words;
  if (threadIdx.x == 0) xb_words = make_uint4(0u, 0u, 0u, 0u);
  phase0(p, smem);
  grid.sync();
  const XcdBarrier xb = xcd_barrier_post((unsigned*)(p.ws + OFF_BAR), (volatile LAS unsigned*)&xb_words);
  for (int t = blockIdx.x; t < 256 * 24; t += gridDim.x) phase1_tile(p, t / 24, t % 24, smem);
  xcd_barrier(xb);
#if PROBE_DUP == 1
  for (int t = blockIdx.x; t < 256 * 24; t += gridDim.x) phase1_tile(p, t / 24, t % 24, smem);
  xcd_barrier(xb);
#endif
#if PROBE_DUP == 2
  phase2(p, smem, 2);
  xcd_barrier(xb);
#endif
  phase2(p, smem);
  xcd_barrier(xb);
  phase3(p);
  xcd_barrier(xb);
  for (int t = blockIdx.x; t < 256 * 8; t += gridDim.x) phase4_tile(p, t >> 3, t & 7, smem);
  xcd_barrier(xb);
  for (int t = blockIdx.x; t < 256 * 16; t += gridDim.x) phase5_tile(p, t >> 4, t & 15, smem);
  xcd_barrier(xb);
#if PROBE_DUP == 5
  for (int t = blockIdx.x; t < 256 * 16; t += gridDim.x) phase5_tile(p, t >> 4, t & 15, smem);
  xcd_barrier(xb);
#endif
#if PROBE_DUP == 6
  phase6(p, smem, (float*)(p.ws + OFF_OAP));
  xcd_barrier(xb);
#endif
  phase6(p, smem, p.out);
}
#else
__global__ void __launch_bounds__(256, 2) k_p0(Params p) { __shared__ __attribute__((aligned(16))) char smem[SMEM_BYTES]; phase0(p, smem); }
__global__ void __launch_bounds__(256, 2) k_p1(Params p) { __shared__ __attribute__((aligned(16))) char smem[SMEM_BYTES]; for (int t = blockIdx.x; t < 256 * 24; t += gridDim.x) phase1_tile(p, t / 24, t % 24, smem); }
__global__ void __launch_bounds__(256, 2) k_p2(Params p) { __shared__ __attribute__((aligned(16))) char smem[SMEM_BYTES]; phase2(p, smem); }
__global__ void __launch_bounds__(256, 2) k_p3(Params p) { phase3(p); }
__global__ void __launch_bounds__(256, 2) k_p4(Params p) { __shared__ __attribute__((aligned(16))) char smem[SMEM_BYTES]; for (int t = blockIdx.x; t < 256 * 8; t += gridDim.x) phase4_tile(p, t >> 3, t & 7, smem); }
__global__ void __launch_bounds__(256, 2) k_p5(Params p) { __shared__ __attribute__((aligned(16))) char smem[SMEM_BYTES]; for (int t = blockIdx.x; t < 256 * 16; t += gridDim.x) phase5_tile(p, t >> 4, t & 15, smem); }
__global__ void __launch_bounds__(256, 2) k_p6(Params p) { __shared__ __attribute__((aligned(16))) char smem[SMEM_BYTES]; phase6(p, smem, p.out); }
#endif

extern "C" void kernel_launch(void* const* d_in, const int* in_sizes, int n_in, void* d_out, int out_size, void* d_ws, size_t ws_size,
                              hipStream_t stream) {
  Params p{};
  p.x = (const float*)d_in[0]; p.g_attn = (const float*)d_in[1]; p.w_in = (const float*)d_in[2]; p.qna = (const float*)d_in[3];
  p.kna = (const float*)d_in[4]; p.ona = (const float*)d_in[5]; p.qnb = (const float*)d_in[6]; p.knb = (const float*)d_in[7];
  p.lq1 = (const float*)d_in[8]; p.lk1 = (const float*)d_in[9]; p.lq2 = (const float*)d_in[10]; p.lk2 = (const float*)d_in[11];
  p.onb = (const float*)d_in[12]; p.w_out = (const float*)d_in[13]; p.g_ffn = (const float*)d_in[14]; p.w_pq = (const float*)d_in[15];
  p.subk = (const float*)d_in[16]; p.pu = (const float*)d_in[17]; p.pv = (const float*)d_in[18];
  p.out = (float*)d_out; p.ws = (char*)d_ws;
#if FUSED
  static int grid_blocks = 0;
  if (!grid_blocks) {
    int dev = 0, cus = 0, per_cu = 0;
    hipGetDevice(&dev);
    hipDeviceGetAttribute(&cus, hipDeviceAttributeMultiprocessorCount, dev);
    hipOccupancyMaxActiveBlocksPerMultiprocessor(&per_cu, fwd_megakernel, 256, 0);
    if (per_cu > 2) per_cu = 2;
    if (per_cu < 1) per_cu = 1;
    grid_blocks = cus * per_cu;
  }
  void* args[] = {&p};
  hipError_t e = hipLaunchCooperativeKernel((void*)fwd_megakernel, dim3(grid_blocks), dim3(256), args, 0, stream);
  if (e != hipSuccess) fprintf(stderr, "cooperative launch failed: %s (grid %d)\n", hipGetErrorString(e), grid_blocks);
#else
  const int G = 512;
  k_p0<<<G, 256, 0, stream>>>(p);
  k_p1<<<G, 256, 0, stream>>>(p);
  k_p2<<<G, 256, 0, stream>>>(p);
  k_p3<<<G, 256, 0, stream>>>(p);
  k_p4<<<G, 256, 0, stream>>>(p);
  k_p5<<<G, 256, 0, stream>>>(p);
  k_p6<<<G, 256, 0, stream>>>(p);
#endif
}
```

```cpp
#include <hip/hip_runtime.h>
#include <hip/hip_cooperative_groups.h>
#include <cstdio>
#include <cstdint>
namespace cg = cooperative_groups;

#ifndef FUSED
#define FUSED 1
#endif
#ifndef PROBE_DUP
#define PROBE_DUP 0
#endif

typedef unsigned short u16;
typedef unsigned char u8;
typedef __attribute__((ext_vector_type(8))) short bf16x8;
typedef __attribute__((ext_vector_type(4))) short s16x4;
typedef __attribute__((ext_vector_type(16))) float f32x16;
typedef __attribute__((ext_vector_type(2))) __bf16 bf2_t;
typedef __attribute__((ext_vector_type(4))) unsigned u32x4;
#define DI __device__ __forceinline__
#define MFMA(a, b, c) __builtin_amdgcn_mfma_f32_32x32x16_bf16((a), (b), (c), 0, 0, 0)

constexpr int T_TOK = 32768;
constexpr int SEQ = 4096;
constexpr size_t MB = 1u << 20;
constexpr size_t OFF_XNB = 0;
constexpr size_t OFF_QA = 64 * MB, OFF_KA = 96 * MB, OFF_VA = 128 * MB, OFF_QB = 160 * MB, OFF_KB = 192 * MB, OFF_VB = 224 * MB;
constexpr size_t OFF_TOPS = 64 * MB;
constexpr size_t OFF_TOPI = 96 * MB;
constexpr size_t OFF_OAP = 256 * MB;
constexpr size_t OFF_OBC = 352 * MB;
constexpr size_t OFF_PUB = 416 * MB, OFF_PVB = 448 * MB;
constexpr size_t OFF_WIN = 480 * MB, OFF_WOUT = 486 * MB, OFF_WPQ = 488 * MB, OFF_SUBK = 492 * MB;
constexpr size_t OFF_ROPEC = 493 * MB, OFF_ROPES = 493 * MB + 128 * 1024;
constexpr size_t OFF_LSE = 494 * MB;
constexpr size_t OFF_HSS = 497 * MB;
constexpr size_t OFF_MISC = 497 * MB + 128 * 1024;

constexpr size_t OFF_BAR = 497 * MB + 256 * 1024;
constexpr int SMEM_BYTES = 73728;
#define XCD_BAR_WORDS 3456
constexpr float QSCALE = 0.125f * 1.4426950408889634f;
constexpr float NEG_INF = -__builtin_huge_valf();
constexpr float USCALE = 64.f, VSCALE = 16.f;
typedef float f32x2 __attribute__((ext_vector_type(2)));

struct Params {
  const float *x, *g_attn, *w_in, *qna, *kna, *ona, *qnb, *knb, *lq1, *lk1, *lq2, *lk2, *onb, *w_out, *g_ffn, *w_pq, *subk, *pu, *pv;
  float* out;
  char* ws;
};

DI u16 f2bf(float x) { unsigned u = __float_as_uint(x); u += 0x7fffu + ((u >> 16) & 1u); return (u16)(u >> 16); }
DI float bf2f(u16 b) { return __uint_as_float(((unsigned)b) << 16); }
typedef __bf16 bf16x2_t __attribute__((ext_vector_type(2)));
DI unsigned pack2(float a, float b) { bf16x2_t v = {(__bf16)a, (__bf16)b}; return __builtin_bit_cast(unsigned, v); }
DI float bflo(unsigned u) { return __uint_as_float(u << 16); }
DI float bfhi(unsigned u) { return __uint_as_float(u & 0xffff0000u); }
DI float wave_sum(float v) {
  v += __shfl_xor(v, 32); v += __shfl_xor(v, 16); v += __shfl_xor(v, 8); v += __shfl_xor(v, 4); v += __shfl_xor(v, 2); v += __shfl_xor(v, 1);
  return v;
}
DI void gld16(u32x4& dst, const void* ptr) { asm volatile("global_load_dwordx4 %0, %1, off" : "=v"(dst) : "v"(ptr) : "memory"); }
DI void vm_wait8(u32x4& a, u32x4& b, u32x4& c, u32x4& d, u32x4& e, u32x4& f, u32x4& g, u32x4& h) {
  asm volatile("s_waitcnt vmcnt(0)" : "+v"(a), "+v"(b), "+v"(c), "+v"(d), "+v"(e), "+v"(f), "+v"(g), "+v"(h) : : "memory");
}
template <int N> DI void vm_wait8n(u32x4& a, u32x4& b, u32x4& c, u32x4& d, u32x4& e, u32x4& f, u32x4& g, u32x4& h) {
  asm volatile("s_waitcnt vmcnt(%8)" : "+v"(a), "+v"(b), "+v"(c), "+v"(d), "+v"(e), "+v"(f), "+v"(g), "+v"(h) : "n"(N) : "memory");
}
DI void vm_wait6(u32x4& a, u32x4& b, u32x4& c, u32x4& d, u32x4& e, u32x4& f) {
  asm volatile("s_waitcnt vmcnt(0)" : "+v"(a), "+v"(b), "+v"(c), "+v"(d), "+v"(e), "+v"(f) : : "memory");
}
DI int opaque_tid() { int t = threadIdx.x; asm volatile("" : "+v"(t)); return t; }
DI int crow(int reg, int h) { return (reg & 3) + 8 * (reg >> 2) + 4 * h; }

__device__ void phase0(const Params& p, char* smem) {
  const int tid = threadIdx.x, lane = tid & 63, wid = tid >> 6;
  const int gw = blockIdx.x * 4 + wid, nw = gridDim.x * 4;
  const int gt = blockIdx.x * 256 + tid, nt = gridDim.x * 256;
  u16* xnb = (u16*)(p.ws + OFF_XNB);
  for (int row = gw; row < T_TOK; row += nw) {
    const float4* xr = (const float4*)(p.x + (size_t)row * 1024);
    float4 v[4]; float ss = 0.f;
#pragma unroll
    for (int i = 0; i < 4; ++i) { v[i] = xr[lane + 64 * i]; ss += v[i].x * v[i].x + v[i].y * v[i].y + v[i].z * v[i].z + v[i].w * v[i].w; }
    ss = wave_sum(ss);
    const float r = rsqrtf(ss * (1.f / 1024.f) + 1e-6f);
    uint2* dst = (uint2*)(xnb + (size_t)row * 1024);
#pragma unroll
    for (int i = 0; i < 4; ++i) dst[lane + 64 * i] = make_uint2(pack2(v[i].x * r, v[i].y * r), pack2(v[i].z * r, v[i].w * r));
  }
  float* tile = (float*)smem;
  for (int job = blockIdx.x; job < 1536; job += gridDim.x) {
    const float* W; const float* g; u16* outp; int N, j;
    if (job < 768) { W = p.w_in; g = p.g_attn; outp = (u16*)(p.ws + OFF_WIN); N = 3072; j = job; }
    else if (job < 1024) { W = p.w_out; g = nullptr; outp = (u16*)(p.ws + OFF_WOUT); N = 1024; j = job - 768; }
    else { W = p.w_pq; g = p.g_ffn; outp = (u16*)(p.ws + OFF_WPQ); N = 2048; j = job - 1024; }
    const int ntn = N >> 6, kt = j / ntn, ntile = j % ntn;
    const int tx = tid & 63, ty = tid >> 6;
#pragma unroll 4
    for (int r = 0; r < 16; ++r) {
      const int k = kt * 64 + ty + 4 * r;
      float v = W[(size_t)k * N + ntile * 64 + tx];
      if (g) v *= g[k];
      tile[(ty + 4 * r) * 65 + tx] = v;
    }
    __syncthreads();
#pragma unroll 4
    for (int r = 0; r < 16; ++r) {
      const int nl = ty + 4 * r;
      outp[(size_t)(ntile * 64 + nl) * 1024 + kt * 64 + tx] = f2bf(tile[tx * 65 + nl]);
    }
    __syncthreads();
  }
  {
    const float4* s = (const float4*)p.subk; uint2* d = (uint2*)(p.ws + OFF_SUBK);
    for (int i = gt; i < 262144 / 4; i += nt) { float4 v = s[i]; d[i] = make_uint2(pack2(v.x, v.y), pack2(v.z, v.w)); }
    const float4* su = (const float4*)p.pu; int* du = (int*)(p.ws + OFF_PUB);
    const float4* sv = (const float4*)p.pv; int* dv = (int*)(p.ws + OFF_PVB);
    for (int i = gt; i < 16384 * 1024 / 4; i += nt) {
      float4 a = su[i]; float4 b = sv[i];
      int ra = __builtin_amdgcn_cvt_pk_fp8_f32(a.x * USCALE, a.y * USCALE, 0, false);
      ra = __builtin_amdgcn_cvt_pk_fp8_f32(a.z * USCALE, a.w * USCALE, ra, true);
      int rb = __builtin_amdgcn_cvt_pk_fp8_f32(b.x * VSCALE, b.y * VSCALE, 0, false);
      rb = __builtin_amdgcn_cvt_pk_fp8_f32(b.z * VSCALE, b.w * VSCALE, rb, true);
      du[i] = ra; dv[i] = rb;
    }
  }
  {
    float* rc = (float*)(p.ws + OFF_ROPEC); float* rs = (float*)(p.ws + OFF_ROPES);
    for (int i = gt; i < SEQ * 8; i += nt) {
      const int pos = i >> 3, f = i & 7;
      const float invf = (float)pow(500000.0, -(double)f / 8.0);
      const float ang = (float)pos * invf;
      rc[i] = (float)cos((double)ang); rs[i] = (float)sin((double)ang);
    }
    float* hss = (float*)(p.ws + OFF_HSS);
    for (int i = gt; i < T_TOK; i += nt) hss[i] = 0.f;
    unsigned* barw = (unsigned*)(p.ws + OFF_BAR);
    for (int i = gt; i < XCD_BAR_WORDS; i += nt) barw[i] = 0u;
    if (gt == 0) {
      float a = 0.f, b = 0.f;
      for (int i = 0; i < 64; ++i) { a += p.lq1[i] * p.lk1[i]; b += p.lq2[i] * p.lk2[i]; }
      float* misc = (float*)(p.ws + OFF_MISC);
      misc[0] = expf(a) - expf(b) + 0.2f;
      ((int*)misc)[1] = 0; ((int*)misc)[2] = 0;
    }
  }
}

DI void gemm_mainloop(const u16* __restrict__ A, const u16* __restrict__ Bt, int m0, int n0, char* smem, f32x16 (&acc)[2][2]) {
  u16* As = (u16*)smem;
  u16* Bs = As + 2 * 128 * 72;
  const int tid = opaque_tid(), lane = tid & 63, w = tid >> 6, wm = w >> 1, wn = w & 1, lr = lane & 31, lh = lane >> 5;
#pragma unroll
  for (int a = 0; a < 2; ++a)
#pragma unroll
    for (int b = 0; b < 2; ++b)
#pragma unroll
      for (int r = 0; r < 16; ++r) acc[a][b][r] = 0.f;
  u32x4 raA[4], rbA[4], raB[4], rbB[4];
  const int lrow = tid >> 3, lkc = tid & 7;
  const u16* Ag = A + (size_t)(m0 + lrow) * 1024 + lkc * 8;
  const u16* Bg = Bt + (size_t)(n0 + lrow) * 1024 + lkc * 8;
#define GLOAD(S_, kt) { _Pragma("unroll") for (int i = 0; i < 4; ++i) { gld16(ra##S_[i], Ag + (size_t)i * 32 * 1024 + (kt) * 64); gld16(rb##S_[i], Bg + (size_t)i * 32 * 1024 + (kt) * 64); } }
#define SWRITE(S_, buf, NW_) { vm_wait8n<NW_>(ra##S_[0], ra##S_[1], ra##S_[2], ra##S_[3], rb##S_[0], rb##S_[1], rb##S_[2], rb##S_[3]); \
    _Pragma("unroll") for (int i = 0; i < 4; ++i) { *(u32x4*)(As + ((buf) * 128 + lrow + 32 * i) * 72 + lkc * 8) = ra##S_[i]; *(u32x4*)(Bs + ((buf) * 128 + lrow + 32 * i) * 72 + lkc * 8) = rb##S_[i]; } }
#define GCOMPUTE(buf) { \
    const u16* ab = As + ((buf) * 128 + wm * 64 + lr) * 72 + lh * 8; \
    const u16* bb = Bs + ((buf) * 128 + wn * 64 + lr) * 72 + lh * 8; \
    _Pragma("unroll") for (int s = 0; s < 4; ++s) { \
      const bf16x8 a0 = *(const bf16x8*)(ab + s * 16), a1 = *(const bf16x8*)(ab + 32 * 72 + s * 16); \
      const bf16x8 b0 = *(const bf16x8*)(bb + s * 16), b1 = *(const bf16x8*)(bb + 32 * 72 + s * 16); \
      acc[0][0] = MFMA(a0, b0, acc[0][0]); acc[0][1] = MFMA(a0, b1, acc[0][1]); \
      acc[1][0] = MFMA(a1, b0, acc[1][0]); acc[1][1] = MFMA(a1, b1, acc[1][1]); } }
  GLOAD(A, 0); SWRITE(A, 0, 0); GLOAD(A, 1); __syncthreads();
  for (int kt = 0; kt < 14; kt += 2) {
    GLOAD(B, kt + 2);
    GCOMPUTE(0);
    SWRITE(A, 1, 8);
    __syncthreads();
    GLOAD(A, kt + 3);
    GCOMPUTE(1);
    SWRITE(B, 0, 8);
    __syncthreads();
  }
  GCOMPUTE(0);
  SWRITE(A, 1, 0);
  __syncthreads();
  GCOMPUTE(1);
  __syncthreads();
#undef GCOMPUTE
#undef GLOAD
#undef SWRITE
}

DI void stage_acc(const f32x16 (&acc)[2][2], float* st) {
  const int tid = threadIdx.x, lane = tid & 63, w = tid >> 6, wm = w >> 1, wn = w & 1, lr = lane & 31, lh = lane >> 5;
#pragma unroll
  for (int mt = 0; mt < 2; ++mt)
#pragma unroll
    for (int nt = 0; nt < 2; ++nt)
#pragma unroll
      for (int r = 0; r < 16; ++r) st[(wm * 64 + mt * 32 + crow(r, lh)) * 132 + wn * 64 + nt * 32 + lr] = acc[mt][nt][r];
}

__device__ void phase1_tile(const Params& p, int mtile, int j, char* smem) {
  f32x16 acc[2][2];
  const int m0 = mtile * 128, n0 = j * 128;
  gemm_mainloop((const u16*)(p.ws + OFF_XNB), (const u16*)(p.ws + OFF_WIN), m0, n0, smem, acc);
  float* st = (float*)smem;
  stage_acc(acc, st);
  __syncthreads();
  const int tid = threadIdx.x, row = tid & 127, half = tid >> 7;
  const int sec = j >> 2;
  const int tok = m0 + row, b = tok >> 12, s = tok & 4095;
  float v[64];
#pragma unroll
  for (int c = 0; c < 16; ++c) { const float4 t4 = *(const float4*)(st + row * 132 + half * 64 + c * 4); v[4 * c] = t4.x; v[4 * c + 1] = t4.y; v[4 * c + 2] = t4.z; v[4 * c + 3] = t4.w; }
  if (sec != 2 && sec != 5) {
    const float* g = sec == 0 ? p.qna : sec == 1 ? p.kna : sec == 3 ? p.qnb : p.knb;
    float ss = 0.f;
#pragma unroll
    for (int i = 0; i < 64; ++i) ss += v[i] * v[i];
    float r = rsqrtf(ss * (1.f / 64.f) + 1e-6f);
    const float post = (sec == 0 || sec == 3) ? QSCALE : 1.f;
#pragma unroll
    for (int i = 0; i < 64; ++i) v[i] = v[i] * r * g[i];
    const float* rc = (const float*)(p.ws + OFF_ROPEC) + s * 8;
    const float* rs = (const float*)(p.ws + OFF_ROPES) + s * 8;
#pragma unroll
    for (int i = 0; i < 8; ++i) {
      const float c = rc[i], sn = rs[i], x1 = v[i], x2 = v[i + 8];
      v[i] = x1 * c - x2 * sn; v[i + 8] = x2 * c + x1 * sn;
    }
#pragma unroll
    for (int i = 0; i < 64; ++i) v[i] *= post;
  }
  u16* dst;
  if (sec == 5) {
    dst = (u16*)(p.ws + OFF_VB) + ((size_t)(b * 4 + (j & 3)) * 4096 + s) * 128 + half * 64;
  } else {
    const size_t off = sec == 0 ? OFF_QA : sec == 1 ? OFF_KA : sec == 2 ? OFF_VA : sec == 3 ? OFF_QB : OFF_KB;
    const int hc = (j & 3) * 2 + half;
    dst = (u16*)(p.ws + off) + ((size_t)(b * 8 + hc) * 4096 + s) * 64;
  }
#pragma unroll
  for (int c = 0; c < 8; ++c)
    ((uint4*)dst)[c] = make_uint4(pack2(v[8 * c], v[8 * c + 1]), pack2(v[8 * c + 2], v[8 * c + 3]), pack2(v[8 * c + 4], v[8 * c + 5]), pack2(v[8 * c + 6], v[8 * c + 7]));
  __syncthreads();
}

template <int OFF> DI s16x4 tr_read(unsigned addr) {
  s16x4 r; asm volatile("ds_read_b64_tr_b16 %0, %1 offset:%2" : "=v"(r) : "v"(addr), "n"(OFF) : "memory"); return r;
}
DI void wait_tr8(s16x4& a0, s16x4& a1, s16x4& a2, s16x4& a3, s16x4& a4, s16x4& a5, s16x4& a6, s16x4& a7) {
  asm volatile("s_waitcnt lgkmcnt(0)" : "+v"(a0), "+v"(a1), "+v"(a2), "+v"(a3), "+v"(a4), "+v"(a5), "+v"(a6), "+v"(a7) : : "memory");
}

#define TR_ISSUE(S_, MT_) { const unsigned a0_ = vaddr + (MT_) * 64; \
        S_##0 = tr_read<0 * 16 * VST * 2>(a0_); S_##1 = tr_read<(0 * 16 + 8) * VST * 2>(a0_); S_##2 = tr_read<1 * 16 * VST * 2>(a0_); S_##3 = tr_read<(1 * 16 + 8) * VST * 2>(a0_); \
        S_##4 = tr_read<2 * 16 * VST * 2>(a0_); S_##5 = tr_read<(2 * 16 + 8) * VST * 2>(a0_); S_##6 = tr_read<3 * 16 * VST * 2>(a0_); S_##7 = tr_read<(3 * 16 + 8) * VST * 2>(a0_); }
#define TR_MFMA(S_, MT_) { \
        o[MT_] = MFMA(__builtin_shufflevector(S_##0, S_##1, 0, 1, 2, 3, 4, 5, 6, 7), pf[0], o[MT_]); o[MT_] = MFMA(__builtin_shufflevector(S_##2, S_##3, 0, 1, 2, 3, 4, 5, 6, 7), pf[1], o[MT_]); \
        o[MT_] = MFMA(__builtin_shufflevector(S_##4, S_##5, 0, 1, 2, 3, 4, 5, 6, 7), pf[2], o[MT_]); o[MT_] = MFMA(__builtin_shufflevector(S_##6, S_##7, 0, 1, 2, 3, 4, 5, 6, 7), pf[3], o[MT_]); }
template <int DV, bool CAUSAL>
__device__ void attn_unit(const u16* __restrict__ qbase, const u16* __restrict__ kbase, const u16* __restrict__ vbase, int n, int dil, int res,
                          u16* __restrict__ obase, int ostride, float* __restrict__ lsebase, char* smem) {
  constexpr int VST = DV + 8;
  constexpr int NMT = DV / 32;
  constexpr int WMAX = CAUSAL ? (1 << 30) : 128;
  u16* Ks = (u16*)smem;
  u16* Vs = Ks + 2 * 64 * 72;
  const int tid = opaque_tid(), lane = tid & 63, w = tid >> 6, lr = lane & 31, lh = lane >> 5;
  const int kb0 = CAUSAL ? 0 : 128 * (n - 1);
  const int kt_begin = CAUSAL ? 0 : (n == 0 ? 2 : 0);
  const int kt_end = CAUSAL ? (2 * n + 2) : 4;
  const int mq = 128 * n + 32 * w + lr;
  const size_t tq = (size_t)mq * dil + res;
  bf16x8 qf[4];
  {
    const u16* qp = qbase + tq * 64 + lh * 8;
#pragma unroll
    for (int s = 0; s < 4; ++s) qf[s] = *(const bf16x8*)(qp + s * 16);
  }
  f32x16 o[NMT];
#pragma unroll
  for (int mt = 0; mt < NMT; ++mt)
#pragma unroll
    for (int r = 0; r < 16; ++r) o[mt][r] = 0.f;
  float m_run = NEG_INF, l_run = 0.f;
  u32x4 rk0, rk1, rv0, rv1, rv2, rv3;
  rv2 = rv3 = (u32x4){0u, 0u, 0u, 0u};
  const int krow_ = tid >> 3, kkc = tid & 7;
  constexpr int VCPR = DV / 8;
  const int vrow = tid / VCPR, vkc = tid % VCPR;
  constexpr int VRSTEP = 256 / VCPR;
  const u16* kgp = kbase + ((size_t)(kb0 + krow_) * dil + res) * 64 + kkc * 8;
  const u16* vgp = vbase + ((size_t)(kb0 + vrow) * dil + res) * DV + vkc * 8;
  const size_t kstep32 = (size_t)32 * dil * 64, kstep64 = (size_t)64 * dil * 64;
  const size_t vstepr = (size_t)VRSTEP * dil * DV, vstep64 = (size_t)64 * dil * DV;
  u16* ksw = Ks + krow_ * 72 + kkc * 8;
  u16* vsw = Vs + vrow * VST + vkc * 8;
#define AGLOAD(kt) { const u16* kp_ = kgp + (size_t)(kt) * kstep64; gld16(rk0, kp_); gld16(rk1, kp_ + kstep32); \
    const u16* vp_ = vgp + (size_t)(kt) * vstep64; gld16(rv0, vp_); gld16(rv1, vp_ + vstepr); \
    if (NMT == 4) { gld16(rv2, vp_ + 2 * vstepr); gld16(rv3, vp_ + 3 * vstepr); } }
#define ASWRITE(buf) { vm_wait6(rk0, rk1, rv0, rv1, rv2, rv3); *(u32x4*)(ksw + (buf) * 64 * 72) = rk0; *(u32x4*)(ksw + (buf) * 64 * 72 + 32 * 72) = rk1; \
    *(u32x4*)(vsw + (buf) * 64 * VST) = rv0; *(u32x4*)(vsw + (buf) * 64 * VST + VRSTEP * VST) = rv1; \
    if (NMT == 4) { *(u32x4*)(vsw + (buf) * 64 * VST + 2 * VRSTEP * VST) = rv2; *(u32x4*)(vsw + (buf) * 64 * VST + 3 * VRSTEP * VST) = rv3; } }
  AGLOAD(kt_begin); ASWRITE(0); __syncthreads();
  const int li = lane & 31, blk = li >> 4, tq_ = (li >> 2) & 3, tp = li & 3;
  for (int kt = kt_begin; kt < kt_end; ++kt) {
    const int buf = (kt - kt_begin) & 1;
    if (kt + 1 < kt_end) AGLOAD(kt + 1);
    __builtin_amdgcn_sched_barrier(0);
    const int k_lo = kb0 + 64 * kt, q_lo = 128 * n + 32 * w;
    const int dmin = q_lo - (k_lo + 63), dmax = q_lo + 31 - k_lo;
    const bool skip = (dmax < 0) || (dmin > WMAX);
    if (!skip) {
      const bool need_mask = (dmin < 0) || (dmax > WMAX);
      const unsigned vaddr = (unsigned)(size_t)(Vs + (buf * 64 + 4 * lh + tq_) * VST + 16 * blk + 4 * tp);
      s16x4 va0, va1, va2, va3, va4, va5, va6, va7;
      const u16* kb = Ks + (buf * 64 + lr) * 72 + lh * 8;
      f32x16 st[2];
#pragma unroll
      for (int kk = 0; kk < 2; ++kk) {
#pragma unroll
        for (int r = 0; r < 16; ++r) st[kk][r] = 0.f;
#pragma unroll
        for (int s = 0; s < 4; ++s) { const bf16x8 a = *(const bf16x8*)(kb + kk * 32 * 72 + s * 16); st[kk] = MFMA(a, qf[s], st[kk]); }
      }
      if (need_mask) {
#pragma unroll
        for (int kk = 0; kk < 2; ++kk)
#pragma unroll
          for (int r = 0; r < 16; ++r) {
            const int d = mq - (k_lo + 32 * kk + crow(r, lh));
            if (d < 0 || d > WMAX) st[kk][r] = NEG_INF;
          }
      }
      TR_ISSUE(va, 0);
      float mx = NEG_INF;
#pragma unroll
      for (int kk = 0; kk < 2; ++kk)
#pragma unroll
        for (int r = 0; r < 16; ++r) mx = fmaxf(mx, st[kk][r]);
      mx = fmaxf(mx, __shfl_xor(mx, 32));
      const float m_new = fmaxf(m_run, mx);
      const float m_use = (m_new == NEG_INF) ? 0.f : m_new;
      const float alpha = __builtin_amdgcn_exp2f(m_run - m_use);
      float ls = 0.f;
#pragma unroll
      for (int kk = 0; kk < 2; ++kk)
#pragma unroll
        for (int r = 0; r < 16; ++r) { const float e = __builtin_amdgcn_exp2f(st[kk][r] - m_use); st[kk][r] = e; ls += e; }
      l_run = l_run * alpha + ls; m_run = m_new;
#pragma unroll
      for (int mt = 0; mt < NMT; ++mt)
#pragma unroll
        for (int r = 0; r < 16; ++r) o[mt][r] *= alpha;
      bf16x8 pf[4];
#pragma unroll
      for (int ks = 0; ks < 4; ++ks) {
        const int kk = ks >> 1, s2 = ks & 1;
        u32x4 cv;
        cv[0] = pack2(st[kk][8 * s2 + 0], st[kk][8 * s2 + 1]); cv[1] = pack2(st[kk][8 * s2 + 2], st[kk][8 * s2 + 3]);
        cv[2] = pack2(st[kk][8 * s2 + 4], st[kk][8 * s2 + 5]); cv[3] = pack2(st[kk][8 * s2 + 6], st[kk][8 * s2 + 7]);
        pf[ks] = __builtin_bit_cast(bf16x8, cv);
      }
      wait_tr8(va0, va1, va2, va3, va4, va5, va6, va7);
      TR_MFMA(va, 0);
      TR_ISSUE(va, 1);
      wait_tr8(va0, va1, va2, va3, va4, va5, va6, va7);
      TR_MFMA(va, 1);
      if (NMT == 4) {
        TR_ISSUE(va, 2);
        wait_tr8(va0, va1, va2, va3, va4, va5, va6, va7);
        TR_MFMA(va, 2 % NMT);
        TR_ISSUE(va, 3);
        wait_tr8(va0, va1, va2, va3, va4, va5, va6, va7);
        TR_MFMA(va, 3 % NMT);
      }
    }
    if (kt + 1 < kt_end) ASWRITE(buf ^ 1);
    __syncthreads();
  }
#undef AGLOAD
#undef ASWRITE
  const float l_tot = l_run + __shfl_xor(l_run, 32);
  const float inv = 1.f / l_tot;
  u16* op = obase + tq * ostride;
#pragma unroll
  for (int mt = 0; mt < NMT; ++mt)
#pragma unroll
    for (int g = 0; g < 4; ++g) {
      const int dv0 = 32 * mt + 8 * g + 4 * lh;
      *(uint2*)(op + dv0) = make_uint2(pack2(o[mt][4 * g] * inv, o[mt][4 * g + 1] * inv), pack2(o[mt][4 * g + 2] * inv, o[mt][4 * g + 3] * inv));
    }
  if (!CAUSAL && lh == 0) lsebase[tq * 8] = m_run + log2f(l_tot);
}

constexpr int N_DIFF_UNITS = 2048, N_DIL_UNITS = 6144;
__device__ void phase2_unit(const Params& p, int u, char* smem) {
  if (u < N_DIFF_UNITS) {
    const int n = 31 - (u >> 6), rem = u & 63, b = rem >> 3, hc = rem & 7, h4 = hc >> 1;
    const u16* qb = (const u16*)(p.ws + OFF_QB) + (size_t)(b * 8 + hc) * 4096 * 64;
    const u16* kb = (const u16*)(p.ws + OFF_KB) + (size_t)(b * 8 + hc) * 4096 * 64;
    const u16* vb = (const u16*)(p.ws + OFF_VB) + (size_t)(b * 4 + h4) * 4096 * 128;
    u16* ob = (u16*)(p.ws + OFF_OBC) + (size_t)b * 4096 * 1024 + hc * 128;
    attn_unit<128, true>(qb, kb, vb, n, 1, 0, ob, 1024, nullptr, smem);
  } else {
    const int u2 = u - N_DIFF_UNITS, pidx = u2 >> 11, rem = u2 & 2047, b = rem >> 8, h = (rem >> 5) & 7, rn = rem & 31;
    const int sh = 2 * pidx, dil = 1 << sh, nb = 32 >> sh, res = rn >> (5 - sh), n = rn & (nb - 1);
    const u16* qb = (const u16*)(p.ws + OFF_QA) + (size_t)(b * 8 + h) * 4096 * 64;
    const u16* kb = (const u16*)(p.ws + OFF_KA) + (size_t)(b * 8 + h) * 4096 * 64;
    const u16* vb = (const u16*)(p.ws + OFF_VA) + (size_t)(b * 8 + h) * 4096 * 64;
    u16* ob = (u16*)(p.ws + OFF_OAP) + ((size_t)pidx * T_TOK + (size_t)b * 4096) * 512 + h * 64;
    float* lse = (float*)(p.ws + OFF_LSE) + ((size_t)pidx * T_TOK + (size_t)b * 4096) * 8 + h;
    attn_unit<64, false>(qb, kb, vb, n, dil, res, ob, 512, lse, smem);
  }
}
__device__ void phase2(const Params& p, char* smem, int slot = 1) {
  int* counter = (int*)(p.ws + OFF_MISC) + slot;
  int* s_unit = (int*)(smem + SMEM_BYTES - 16);
  while (true) {
    if (threadIdx.x == 0) *s_unit = atomicAdd(counter, 1);
    __syncthreads();
    const int u = *s_unit;
    __syncthreads();
    if (u >= N_DIFF_UNITS + N_DIL_UNITS) break;
    phase2_unit(p, u, smem);
  }
}

__device__ void phase3(const Params& p) {
  const int tid = threadIdx.x, lane = tid & 63, wid = tid >> 6;
  const int gw = blockIdx.x * 4 + wid, nw = gridDim.x * 4;
  const float lam = ((const float*)(p.ws + OFF_MISC))[0];
  const u16* oap = (const u16*)(p.ws + OFF_OAP);
  const u16* obc = (const u16*)(p.ws + OFF_OBC);
  const float* lse = (const float*)(p.ws + OFF_LSE);
  u16* mix = (u16*)(p.ws + OFF_XNB);
  for (int tok = gw; tok < T_TOK; tok += nw) {
    float o[16]; float ss = 0.f;
    if (lane < 32) {
      const int head = lane >> 2;
      float l0 = lse[(size_t)tok * 8 + head], l1 = lse[((size_t)T_TOK + tok) * 8 + head], l2 = lse[((size_t)2 * T_TOK + tok) * 8 + head];
      const float mx = fmaxf(l0, fmaxf(l1, l2));
      float w0 = exp2f(l0 - mx), w1 = exp2f(l1 - mx), w2 = exp2f(l2 - mx);
      const float inv = 1.f / (w0 + w1 + w2); w0 *= inv; w1 *= inv; w2 *= inv;
      const uint4* p0 = (const uint4*)(oap + (size_t)tok * 512 + lane * 16);
      const uint4* p1 = (const uint4*)(oap + ((size_t)T_TOK + tok) * 512 + lane * 16);
      const uint4* p2 = (const uint4*)(oap + ((size_t)2 * T_TOK + tok) * 512 + lane * 16);
#pragma unroll
      for (int c = 0; c < 2; ++c) {
        const uint4 a = p0[c], b = p1[c], d = p2[c];
        const unsigned au[4] = {a.x, a.y, a.z, a.w}, bu[4] = {b.x, b.y, b.z, b.w}, du[4] = {d.x, d.y, d.z, d.w};
#pragma unroll
        for (int k = 0; k < 4; ++k) {
          o[c * 8 + 2 * k] = w0 * bflo(au[k]) + w1 * bflo(bu[k]) + w2 * bflo(du[k]);
          o[c * 8 + 2 * k + 1] = w0 * bfhi(au[k]) + w1 * bfhi(bu[k]) + w2 * bfhi(du[k]);
        }
      }
    } else {
      const int l2 = lane - 32, head = l2 >> 3, cc = (l2 & 7) * 16;
      const uint4* p0 = (const uint4*)(obc + (size_t)tok * 1024 + (2 * head) * 128 + cc);
      const uint4* p1 = (const uint4*)(obc + (size_t)tok * 1024 + (2 * head + 1) * 128 + cc);
#pragma unroll
      for (int c = 0; c < 2; ++c) {
        const uint4 a = p0[c], b = p1[c];
        const unsigned au[4] = {a.x, a.y, a.z, a.w}, bu[4] = {b.x, b.y, b.z, b.w};
#pragma unroll
        for (int k = 0; k < 4; ++k) {
          o[c * 8 + 2 * k] = bflo(au[k]) - lam * bflo(bu[k]);
          o[c * 8 + 2 * k + 1] = bfhi(au[k]) - lam * bfhi(bu[k]);
        }
      }
    }
#pragma unroll
    for (int i = 0; i < 16; ++i) ss += o[i] * o[i];
    const float s1 = ss + __shfl_xor(ss, 1);
    const float s2 = s1 + __shfl_xor(s1, 2);
    const float s3 = s2 + __shfl_xor(s2, 4);
    float r; const float* g;
    if (lane < 32) { r = rsqrtf(s2 * (1.f / 64.f) + 1e-6f); g = p.ona + lane * 16; }
    else { r = rsqrtf(s3 * (1.f / 128.f) + 1e-6f) * 0.8f; g = p.onb + (lane - 32) * 16; }
    unsigned pk[8];
#pragma unroll
    for (int k = 0; k < 8; ++k) pk[k] = pack2(o[2 * k] * r * g[2 * k], o[2 * k + 1] * r * g[2 * k + 1]);
    uint4* dst = (uint4*)(mix + (size_t)tok * 1024 + lane * 16);
    dst[0] = make_uint4(pk[0], pk[1], pk[2], pk[3]); dst[1] = make_uint4(pk[4], pk[5], pk[6], pk[7]);
  }
}

__device__ void phase4_tile(const Params& p, int mtile, int j, char* smem) {
  f32x16 acc[2][2];
  const int m0 = mtile * 128, n0 = j * 128;
  gemm_mainloop((const u16*)(p.ws + OFF_XNB), (const u16*)(p.ws + OFF_WOUT), m0, n0, smem, acc);
  float* st = (float*)smem;
  stage_acc(acc, st);
  __syncthreads();
  const int tid = threadIdx.x, cgi = tid & 31, r0 = tid >> 5;
  float* hss = (float*)(p.ws + OFF_HSS);
  u16* hb = (u16*)(p.ws + OFF_OAP);
#pragma unroll 4
  for (int ps = 0; ps < 16; ++ps) {
    const int row = r0 + 8 * ps;
    const float4 a = *(const float4*)(st + row * 132 + cgi * 4);
    const size_t gi = (size_t)(m0 + row) * 1024 + n0 + cgi * 4;
    const float4 xv = *(const float4*)(p.x + gi);
    float4 hv; hv.x = xv.x + a.x; hv.y = xv.y + a.y; hv.z = xv.z + a.z; hv.w = xv.w + a.w;
    *(float4*)(p.out + gi) = hv;
    *(uint2*)(hb + gi) = make_uint2(pack2(hv.x, hv.y), pack2(hv.z, hv.w));
    float ss = hv.x * hv.x + hv.y * hv.y + hv.z * hv.z + hv.w * hv.w;
    ss += __shfl_xor(ss, 16); ss += __shfl_xor(ss, 8); ss += __shfl_xor(ss, 4); ss += __shfl_xor(ss, 2); ss += __shfl_xor(ss, 1);
    if (cgi == 0) atomicAdd(hss + m0 + row, ss);
  }
  __syncthreads();
}

#define TK_INSERT(xv, xi) { float x_ = (xv); int i_ = (xi); _Pragma("unroll") for (int q_ = 0; q_ < 16; ++q_) { const bool gt_ = x_ > tv[q_]; const float tvv = tv[q_]; const int tii = ti[q_]; tv[q_] = gt_ ? x_ : tvv; ti[q_] = gt_ ? i_ : tii; x_ = gt_ ? tvv : x_; i_ = gt_ ? tii : i_; } }
__device__ void phase5_tile(const Params& p, int mtile, int j, char* smem) {
  f32x16 acc[2][2];
  const int m0 = mtile * 128, n0 = j * 128;
  gemm_mainloop((const u16*)(p.ws + OFF_OAP), (const u16*)(p.ws + OFF_WPQ), m0, n0, smem, acc);
  const int tid = threadIdx.x, lane = tid & 63, w = tid >> 6, wm = w >> 1, wn = w & 1, lr = lane & 31, lh = lane >> 5;
  u16* Qs = (u16*)smem;
  u16* SKs = Qs + 128 * 136;
  float* rs = (float*)(smem + 2 * 128 * 136 * 2);
  const float* hss = (const float*)(p.ws + OFF_HSS);
  if (tid < 128) rs[tid] = rsqrtf(hss[m0 + tid] * (1.f / 1024.f) + 1e-6f);
  {
    const u16* sk = (const u16*)(p.ws + OFF_SUBK) + (size_t)j * 128 * 128;
#pragma unroll
    for (int i = 0; i < 8; ++i) { const int c = tid + 256 * i, row = c >> 4, kc = c & 15; *(uint4*)(SKs + row * 136 + kc * 8) = *(const uint4*)(sk + row * 128 + kc * 8); }
  }
  __syncthreads();
#pragma unroll
  for (int mt = 0; mt < 2; ++mt)
#pragma unroll
    for (int nt = 0; nt < 2; ++nt)
#pragma unroll
      for (int r = 0; r < 16; ++r) {
        const int row = wm * 64 + mt * 32 + crow(r, lh);
        Qs[row * 136 + wn * 64 + nt * 32 + lr] = f2bf(acc[mt][nt][r] * rs[row]);
      }
  __syncthreads();
#pragma unroll
  for (int a = 0; a < 2; ++a)
#pragma unroll
    for (int b = 0; b < 2; ++b)
#pragma unroll
      for (int r = 0; r < 16; ++r) acc[a][b][r] = 0.f;
  {
    const u16* ab = Qs + (wm * 64 + lr) * 136 + lh * 8;
    const u16* bb = SKs + (wn * 64 + lr) * 136 + lh * 8;
#pragma unroll
    for (int s = 0; s < 8; ++s) {
      const bf16x8 a0 = *(const bf16x8*)(ab + s * 16), a1 = *(const bf16x8*)(ab + 32 * 136 + s * 16);
      const bf16x8 b0 = *(const bf16x8*)(bb + s * 16), b1 = *(const bf16x8*)(bb + 32 * 136 + s * 16);
      acc[0][0] = MFMA(a0, b0, acc[0][0]); acc[0][1] = MFMA(a0, b1, acc[0][1]);
      acc[1][0] = MFMA(a1, b0, acc[1][0]); acc[1][1] = MFMA(a1, b1, acc[1][1]);
    }
  }
  __syncthreads();
  float* st = (float*)smem;
  stage_acc(acc, st);
  __syncthreads();
  const int row = tid & 127, half = tid >> 7;
  unsigned tk[16];
#pragma unroll
  for (int q = 0; q < 16; ++q) tk[q] = 0u;
#define TK_KEY(xv, xi) ({ const unsigned u_ = __float_as_uint(xv); const unsigned o_ = (u_ & 0x80000000u) ? ~u_ : (u_ | 0x80000000u); (o_ & 0xFFFFFF80u) | (unsigned)(127 - (xi)); })
#define TK_INS(kv) { unsigned k_ = (kv); _Pragma("unroll") for (int q_ = 0; q_ < 16; ++q_) { const unsigned hi_ = k_ > tk[q_] ? k_ : tk[q_]; k_ = k_ > tk[q_] ? tk[q_] : k_; tk[q_] = hi_; } }
#pragma unroll 2
  for (int c = 0; c < 16; ++c) {
    const float4 v4 = *(const float4*)(st + row * 132 + half * 64 + c * 4);
    const int bi = half * 64 + c * 4;
    TK_INS(TK_KEY(v4.x, bi)); TK_INS(TK_KEY(v4.y, bi + 1)); TK_INS(TK_KEY(v4.z, bi + 2)); TK_INS(TK_KEY(v4.w, bi + 3));
  }
  __syncthreads();
  if (half == 1) {
#pragma unroll
    for (int q = 0; q < 16; ++q) st[row * 132 + q] = __uint_as_float(tk[q]);
  }
  __syncthreads();
  if (half == 0) {
#pragma unroll 4
    for (int q = 0; q < 16; ++q) TK_INS(__float_as_uint(st[row * 132 + q]));
    const size_t base = ((size_t)(m0 + row) * 16 + j) * 16;
    float* tops = (float*)(p.ws + OFF_TOPS) + base;
    u8* topi = (u8*)(p.ws + OFF_TOPI) + base;
    float tv[16]; unsigned ti[16];
#pragma unroll
    for (int q = 0; q < 16; ++q) {
      const unsigned o = tk[q] & 0xFFFFFF80u;
      tv[q] = __uint_as_float((o & 0x80000000u) ? (o & 0x7FFFFFFFu) : ~o);
      ti[q] = 127u - (tk[q] & 127u);
    }
#pragma unroll
    for (int c = 0; c < 4; ++c) ((float4*)tops)[c] = make_float4(tv[4 * c], tv[4 * c + 1], tv[4 * c + 2], tv[4 * c + 3]);
    unsigned pk[4];
#pragma unroll
    for (int c = 0; c < 4; ++c) pk[c] = ti[4 * c] | (ti[4 * c + 1] << 8) | (ti[4 * c + 2] << 16) | (ti[4 * c + 3] << 24);
    *(uint4*)topi = make_uint4(pk[0], pk[1], pk[2], pk[3]);
  }
  __syncthreads();
#undef TK_KEY
#undef TK_INS
}

DI float dpp_xor1(float v) { return __builtin_bit_cast(float, __builtin_amdgcn_update_dpp(0, __builtin_bit_cast(int, v), 0xB1, 0xF, 0xF, true)); }
DI float dpp_xor2(float v) { return __builtin_bit_cast(float, __builtin_amdgcn_update_dpp(0, __builtin_bit_cast(int, v), 0x4E, 0xF, 0xF, true)); }
template <int PAT> DI float swz(float v) { return __builtin_bit_cast(float, __builtin_amdgcn_ds_swizzle(__builtin_bit_cast(int, v), PAT)); }
DI float treduce8(const float (&pp)[8], int lane) {
  const bool b0 = lane & 1, b1 = lane & 2, b2 = lane & 4;
  float q[4];
#pragma unroll
  for (int i = 0; i < 4; ++i) { const float keep = b0 ? pp[2 * i + 1] : pp[2 * i], send = b0 ? pp[2 * i] : pp[2 * i + 1]; q[i] = keep + dpp_xor1(send); }
  float r[2];
#pragma unroll
  for (int i = 0; i < 2; ++i) { const float keep = b1 ? q[2 * i + 1] : q[2 * i], send = b1 ? q[2 * i] : q[2 * i + 1]; r[i] = keep + dpp_xor2(send); }
  float t = (b2 ? r[1] : r[0]) + swz<0x101F>(b2 ? r[0] : r[1]);
  t += swz<0x201F>(t); t += swz<0x401F>(t); t += __shfl_xor(t, 32);
  return t;
}
DI float udot16(const uint4& w, const float (&h)[16]) {
  f32x2 acc = {0.f, 0.f};
  const int ww[4] = {(int)w.x, (int)w.y, (int)w.z, (int)w.w};
#pragma unroll
  for (int j = 0; j < 4; ++j) {
    const f32x2 lo = __builtin_amdgcn_cvt_pk_f32_fp8(ww[j], false), hi = __builtin_amdgcn_cvt_pk_f32_fp8(ww[j], true);
    const f32x2 h0 = {h[4 * j], h[4 * j + 1]}, h1 = {h[4 * j + 2], h[4 * j + 3]};
    acc += lo * h0; acc += hi * h1;
  }
  return acc.x + acc.y;
}
DI void vacc16(const uint4& w, float a, f32x2 (&acc)[8]) {
  const f32x2 a2 = {a, a};
  const int ww[4] = {(int)w.x, (int)w.y, (int)w.z, (int)w.w};
#pragma unroll
  for (int j = 0; j < 4; ++j) {
    acc[2 * j] += a2 * __builtin_amdgcn_cvt_pk_f32_fp8(ww[j], false);
    acc[2 * j + 1] += a2 * __builtin_amdgcn_cvt_pk_f32_fp8(ww[j], true);
  }
}
#define LOAD8(buf, tbl, bidx) { const uint4 i0_ = *(const uint4*)(ids + 8 * (bidx)), i1_ = *(const uint4*)(ids + 8 * (bidx) + 4); \
    const unsigned idv_[8] = {i0_.x, i0_.y, i0_.z, i0_.w, i1_.x, i1_.y, i1_.z, i1_.w}; \
    _Pragma("unroll") for (int k_ = 0; k_ < 8; ++k_) { const unsigned id_ = __builtin_amdgcn_readfirstlane(idv_[k_]); buf[k_] = *(const uint4*)((tbl) + (size_t)id_ * 1024 + lane * 16); } }

__device__ void phase6(const Params& p, char* smem, float* dstbase) {
  const int tid = opaque_tid(), lane = tid & 63, wid = tid >> 6;
  const int gw = blockIdx.x * 4 + wid, nw = gridDim.x * 4;
  int* ids = (int*)(smem + wid * 1024);
  float* gts = (float*)(smem + wid * 1024 + 512);
  const float* hss = (const float*)(p.ws + OFF_HSS);
  const float* tops = (const float*)(p.ws + OFF_TOPS);
  const u8* topi = (const u8*)(p.ws + OFF_TOPI);
  const u8* ub = (const u8*)(p.ws + OFF_PUB);
  const u8* vb = (const u8*)(p.ws + OFF_PVB);
  int ci, cj;
  {
    const int L = lane;
    if (L < 16) { ci = 0; cj = L; } else if (L < 24) { ci = 1; cj = L - 16; } else if (L < 29) { ci = 2; cj = L - 24; }
    else if (L < 33) { ci = 3; cj = L - 29; } else if (L < 36) { ci = 4; cj = L - 33; } else if (L < 38) { ci = 5; cj = L - 36; }
    else if (L < 40) { ci = 6; cj = L - 38; } else if (L < 42) { ci = 7; cj = L - 40; } else if (L < 50) { ci = L - 34; cj = 0; }
    else { ci = 0; cj = 0; }
  }
  for (int tok = gw; tok < T_TOK; tok += nw) {
    const float rstd = rsqrtf(hss[tok] * (1.f / 1024.f) + 1e-6f);
    float hres[16], hn[16];
    {
      const float4* hp = (const float4*)(p.out + (size_t)tok * 1024 + lane * 16);
      const float4* gp = (const float4*)(p.g_ffn + lane * 16);
#pragma unroll
      for (int c = 0; c < 4; ++c) {
        const float4 t4 = hp[c], g4 = gp[c];
        hres[4 * c] = t4.x; hres[4 * c + 1] = t4.y; hres[4 * c + 2] = t4.z; hres[4 * c + 3] = t4.w;
        hn[4 * c] = t4.x * rstd * g4.x; hn[4 * c + 1] = t4.y * rstd * g4.y; hn[4 * c + 2] = t4.z * rstd * g4.z; hn[4 * c + 3] = t4.w * rstd * g4.w;
      }
    }
#pragma unroll 1
    for (int head = 0; head < 8; ++head) {
      const size_t b1 = ((size_t)tok * 16 + head * 2) * 16, b2 = b1 + 16;
      float sum = NEG_INF; int eid = 0;
      if (lane < 50) { sum = tops[b1 + ci] + tops[b2 + cj]; eid = (int)topi[b1 + ci] * 128 + (int)topi[b2 + cj]; }
      unsigned key;
      {
        const unsigned u_ = __float_as_uint(sum); const unsigned o_ = (u_ & 0x80000000u) ? ~u_ : (u_ | 0x80000000u);
        key = (o_ & 0xFFFFFFC0u) | (unsigned)(63 - lane);
      }
#define BSTEP(K_, J_, SHF_) { const unsigned pr_ = (SHF_); const bool tmx_ = ((lane & (J_)) == 0) == ((lane & (K_)) == 0); \
        const unsigned mx_ = key > pr_ ? key : pr_, mn_ = key > pr_ ? pr_ : key; key = tmx_ ? mx_ : mn_; }
#define SX1 ((unsigned)__builtin_amdgcn_update_dpp(0, (int)key, 0xB1, 0xF, 0xF, true))
#define SX2 ((unsigned)__builtin_amdgcn_update_dpp(0, (int)key, 0x4E, 0xF, 0xF, true))
#define SX4 ((unsigned)__builtin_amdgcn_ds_swizzle((int)key, 0x101F))
#define SX8 ((unsigned)__builtin_amdgcn_ds_swizzle((int)key, 0x201F))
#define SX16 ((unsigned)__builtin_amdgcn_ds_swizzle((int)key, 0x401F))
#define SX32 ((unsigned)__shfl_xor((int)key, 32))
      BSTEP(2, 1, SX1);
      BSTEP(4, 2, SX2); BSTEP(4, 1, SX1);
      BSTEP(8, 4, SX4); BSTEP(8, 2, SX2); BSTEP(8, 1, SX1);
      BSTEP(16, 8, SX8); BSTEP(16, 4, SX4); BSTEP(16, 2, SX2); BSTEP(16, 1, SX1);
      BSTEP(32, 16, SX16); BSTEP(32, 8, SX8); BSTEP(32, 4, SX4); BSTEP(32, 2, SX2); BSTEP(32, 1, SX1);
      BSTEP(64, 32, SX32); BSTEP(64, 16, SX16); BSTEP(64, 8, SX8); BSTEP(64, 4, SX4); BSTEP(64, 2, SX2); BSTEP(64, 1, SX1);
#undef BSTEP
#undef SX1
#undef SX2
#undef SX4
#undef SX8
#undef SX16
#undef SX32
      const int src = 63 - (int)(key & 63u);
      const float sumv = __shfl(sum, src);
      const int eidv = __shfl(eid, src);
      const float mxa = __builtin_bit_cast(float, __builtin_amdgcn_readlane(__builtin_bit_cast(int, sumv), 0));
      const float e = (lane < 16) ? __expf(sumv - mxa) : 0.f;
      float den = e;
      den += dpp_xor1(den); den += dpp_xor2(den); den += swz<0x101F>(den); den += swz<0x201F>(den);
      if (lane < 16) { ids[head * 16 + lane] = eidv; gts[head * 16 + lane] = e / den; }
    }
    __builtin_amdgcn_wave_barrier();
    asm volatile("s_waitcnt lgkmcnt(0)" ::: "memory");
    float dsel0 = 0.f, dsel1 = 0.f;
    {
      uint4 ba[8], bb[8];
      LOAD8(ba, ub, 0);
#pragma unroll 1
      for (int b = 0; b < 16; b += 2) {
        LOAD8(bb, ub, b + 1);
        {
          float pp[8];
#pragma unroll
          for (int k = 0; k < 8; ++k) pp[k] = udot16(ba[k], hn);
          const float t = treduce8(pp, lane);
          if ((lane >> 3) == (b & 7)) { if (b < 8) dsel0 = t; else dsel1 = t; }
        }
        if (b + 2 < 16) LOAD8(ba, ub, b + 2);
        {
          float pp[8];
#pragma unroll
          for (int k = 0; k < 8; ++k) pp[k] = udot16(bb[k], hn);
          const float t = treduce8(pp, lane);
          if ((lane >> 3) == ((b + 1) & 7)) { if (b < 8) dsel0 = t; else dsel1 = t; }
        }
      }
    }
    {
      const float d0 = dsel0 * (1.f / USCALE), d1 = dsel1 * (1.f / USCALE);
      const float a0 = 0.5f * d0 * (1.f + erff(d0 * 0.70710678118654752f)) * gts[lane] * (1.f / VSCALE);
      const float a1 = 0.5f * d1 * (1.f + erff(d1 * 0.70710678118654752f)) * gts[64 + lane] * (1.f / VSCALE);
      gts[lane] = a0; gts[64 + lane] = a1;
    }
    __builtin_amdgcn_wave_barrier();
    asm volatile("s_waitcnt lgkmcnt(0)" ::: "memory");
    f32x2 acc[8];
#pragma unroll
    for (int i = 0; i < 8; ++i) acc[i] = (f32x2){0.f, 0.f};
    {
      uint4 ba[8], bb[8];
      LOAD8(ba, vb, 0);
#pragma unroll 1
      for (int b = 0; b < 16; b += 2) {
        LOAD8(bb, vb, b + 1);
        {
          const float4 g0 = *(const float4*)(gts + 8 * b), g1 = *(const float4*)(gts + 8 * b + 4);
          vacc16(ba[0], g0.x, acc); vacc16(ba[1], g0.y, acc); vacc16(ba[2], g0.z, acc); vacc16(ba[3], g0.w, acc);
          vacc16(ba[4], g1.x, acc); vacc16(ba[5], g1.y, acc); vacc16(ba[6], g1.z, acc); vacc16(ba[7], g1.w, acc);
        }
        if (b + 2 < 16) LOAD8(ba, vb, b + 2);
        {
          const float4 g0 = *(const float4*)(gts + 8 * b + 8), g1 = *(const float4*)(gts + 8 * b + 12);
          vacc16(bb[0], g0.x, acc); vacc16(bb[1], g0.y, acc); vacc16(bb[2], g0.z, acc); vacc16(bb[3], g0.w, acc);
          vacc16(bb[4], g1.x, acc); vacc16(bb[5], g1.y, acc); vacc16(bb[6], g1.z, acc); vacc16(bb[7], g1.w, acc);
        }
      }
    }
    float4* op = (float4*)(dstbase + (size_t)tok * 1024 + lane * 16);
#pragma unroll
    for (int c = 0; c < 4; ++c) op[c] = make_float4(hres[4 * c] + acc[2 * c].x, hres[4 * c + 1] + acc[2 * c].y, hres[4 * c + 2] + acc[2 * c + 1].x, hres[4 * c + 3] + acc[2 * c + 1].y);
    __builtin_amdgcn_wave_barrier();
  }
}


#define XB_TMO      128
#define XB_XCNT(j)  (256  + 64 * (j))
#define XB_XSUB(j)  (1280 + 64 * (j))
#define XB_XGEN(j)  (2304 + 64 * (j))
#define XB_TOP      3328
#define XB_TOPGEN   3392
#define XB_SPIN_CAP (1u << 22)
#define LAS __attribute__((address_space(3)))
DI unsigned xb_ld(unsigned* p) { return __hip_atomic_load(p, __ATOMIC_RELAXED, __HIP_MEMORY_SCOPE_AGENT); }
DI unsigned xb_add(unsigned* p, unsigned v) { return __hip_atomic_fetch_add(p, v, __ATOMIC_RELAXED, __HIP_MEMORY_SCOPE_AGENT); }
DI unsigned xb_xcc_id() { return (unsigned)__builtin_amdgcn_s_getreg((3 << 11) | 20) & 0xFu; }
#define XB_SPIN(cond, bar) do { unsigned _sp = 0; while (cond) { __builtin_amdgcn_s_sleep(1); \
    if ((++_sp & 255u) == 0u) { if (xb_ld(&(bar)[XB_TMO])) break; if (_sp > XB_SPIN_CAP) { atomicAdd(&(bar)[XB_TMO], 1u); break; } } } } while (0)
struct XcdBarrier { unsigned* bar; unsigned x; volatile LAS unsigned* st; };
DI XcdBarrier xcd_barrier_post(unsigned* bar, volatile LAS unsigned* st) {
  XcdBarrier b; b.bar = bar; b.x = xb_xcc_id(); b.st = st;
  if (threadIdx.x == 0) (void)xb_add(&bar[XB_XCNT(b.x)], 1u);
  return b;
}
DI void xcd_barrier_complete(unsigned* bar, unsigned x, unsigned& nloc, unsigned& nx) {
  const unsigned G = gridDim.x * gridDim.y * gridDim.z;
  unsigned sum, cnt, mine, sp = 0u;
  for (;;) {
    sum = 0u; cnt = 0u; mine = 0u;
#pragma unroll
    for (unsigned j = 0; j < 16; ++j) { const unsigned c = xb_ld(&bar[XB_XCNT(j)]); sum += c; cnt += (c > 0u) ? 1u : 0u; mine = (j == x) ? c : mine; }
    if (sum == G) break;
    __builtin_amdgcn_s_sleep(1);
    if ((++sp & 255u) == 0u) { if (xb_ld(&bar[XB_TMO])) break; if (sp > XB_SPIN_CAP) { atomicAdd(&bar[XB_TMO], 1u); break; } }
  }
  nloc = mine > 0u ? mine : 1u; nx = cnt > 0u ? cnt : 1u;
}
DI void xcd_barrier(const XcdBarrier& b) {
  asm volatile("s_waitcnt vmcnt(0)" ::: "memory");
  __syncthreads();
  if (threadIdx.x == 0) {
    unsigned* bar = b.bar;
    __builtin_amdgcn_s_waitcnt(0);
    unsigned nloc = b.st[0], nx = b.st[1];
    if (nloc == 0u) { xcd_barrier_complete(bar, b.x, nloc, nx); b.st[0] = nloc; b.st[1] = nx; }
    const unsigned old = xb_add(&bar[XB_XSUB(b.x)], 1u);
    const unsigned gen = old / nloc;
    if (old + 1u == (gen + 1u) * nloc) {
      __builtin_amdgcn_fence(__ATOMIC_RELEASE, "agent");
      asm volatile("s_waitcnt vmcnt(0)" ::: "memory");
      const unsigned og = xb_add(&bar[XB_TOP], 1u);
      const unsigned tg = og / nx;
      if (og + 1u == (tg + 1u) * nx) xb_add(&bar[XB_TOPGEN], 1u);
      else XB_SPIN(xb_ld(&bar[XB_TOPGEN]) == tg, bar);
      __builtin_amdgcn_fence(__ATOMIC_ACQUIRE, "agent");
      xb_add(&bar[XB_XGEN(b.x)], 1u);
      asm volatile("s_waitcnt vmcnt(0)" ::: "memory");
    } else {
      XB_SPIN(xb_ld(&bar[XB_XGEN(b.x)]) == gen, bar);
      __builtin_amdgcn_fence(__ATOMIC_ACQUIRE, "agent");
      asm volatile("s_waitcnt vmcnt(0)" ::: "memory");
    }
  }
  __syncthreads();
}

#if FUSED
__global__ void __launch_bounds__(256, 2) fwd_megakernel(Params p) {
  __shared__ __attribute__((aligned(16))) char smem[SMEM_BYTES];
  cg::grid_group grid = cg::this_grid();
  __shared__ uint4 xb_words;
  if (threadIdx.x == 0) xb_words = make_uint4(0u, 0u, 0u, 0u);
  phase0(p, smem);
  grid.sync();
  const XcdBarrier xb = xcd_barrier_post((unsigned*)(p.ws + OFF_BAR), (volatile LAS unsigned*)&xb_words);
  for (int t = blockIdx.x; t < 256 * 24; t += gridDim.x) phase1_tile(p, t / 24, t % 24, smem);
  xcd_barrier(xb);
#if PROBE_DUP == 1
  for (int t = blockIdx.x; t < 256 * 24; t += gridDim.x) phase1_tile(p, t / 24, t % 24, smem);
  xcd_barrier(xb);
#endif
#if PROBE_DUP == 2
  phase2(p, smem, 2);
  xcd_barrier(xb);
#endif
  phase2(p, smem);
  xcd_barrier(xb);
  phase3(p);
  xcd_barrier(xb);
  for (int t = blockIdx.x; t < 256 * 8; t += gridDim.x) phase4_tile(p, t >> 3, t & 7, smem);
  xcd_barrier(xb);
  for (int t = blockIdx.x; t < 256 * 16; t += gridDim.x) phase5_tile(p, t >> 4, t & 15, smem);
  xcd_barrier(xb);
#if PROBE_DUP == 5
  for (int t = blockIdx.x; t < 256 * 16; t += gridDim.x) phase5_tile(p, t >> 4, t & 15, smem);
  xcd_barrier(xb);
#endif
#if PROBE_DUP == 6
  phase6(p, smem, (float*)(p.ws + OFF_OAP));
  xcd_barrier(xb);
#endif
  phase6(p, smem, p.out);
}
#else
__global__ void __launch_bounds__(256, 2) k_p0(Params p) { __shared__ __attribute__((aligned(16))) char smem[SMEM_BYTES]; phase0(p, smem); }
__global__ void __launch_bounds__(256, 2) k_p1(Params p) { __shared__ __attribute__((aligned(16))) char smem[SMEM_BYTES]; for (int t = blockIdx.x; t < 256 * 24; t += gridDim.x) phase1_tile(p, t / 24, t % 24, smem); }
__global__ void __launch_bounds__(256, 2) k_p2(Params p) { __shared__ __attribute__((aligned(16))) char smem[SMEM_BYTES]; phase2(p, smem); }
__global__ void __launch_bounds__(256, 2) k_p3(Params p) { phase3(p); }
__global__ void __launch_bounds__(256, 2) k_p4(Params p) { __shared__ __attribute__((aligned(16))) char smem[SMEM_BYTES]; for (int t = blockIdx.x; t < 256 * 8; t += gridDim.x) phase4_tile(p, t >> 3, t & 7, smem); }
__global__ void __launch_bounds__(256, 2) k_p5(Params p) { __shared__ __attribute__((aligned(16))) char smem[SMEM_BYTES]; for (int t = blockIdx.x; t < 256 * 16; t += gridDim.x) phase5_tile(p, t >> 4, t & 15, smem); }
__global__ void __launch_bounds__(256, 2) k_p6(Params p) { __shared__ __attribute__((aligned(16))) char smem[SMEM_BYTES]; phase6(p, smem, p.out); }
#endif

extern "C" void kernel_launch(void* const* d_in, const int* in_sizes, int n_in, void* d_out, int out_size, void* d_ws, size_t ws_size,
                              hipStream_t stream) {
  Params p{};
  p.x = (const float*)d_in[0]; p.g_attn = (const float*)d_in[1]; p.w_in = (const float*)d_in[2]; p.qna = (const float*)d_in[3];
  p.kna = (const float*)d_in[4]; p.ona = (const float*)d_in[5]; p.qnb = (const float*)d_in[6]; p.knb = (const float*)d_in[7];
  p.lq1 = (const float*)d_in[8]; p.lk1 = (const float*)d_in[9]; p.lq2 = (const float*)d_in[10]; p.lk2 = (const float*)d_in[11];
  p.onb = (const float*)d_in[12]; p.w_out = (const float*)d_in[13]; p.g_ffn = (const float*)d_in[14]; p.w_pq = (const float*)d_in[15];
  p.subk = (const float*)d_in[16]; p.pu = (const float*)d_in[17]; p.pv = (const float*)d_in[18];
  p.out = (float*)d_out; p.ws = (char*)d_ws;
#if FUSED
  static int grid_blocks = 0;
  if (!grid_blocks) {
    int dev = 0, cus = 0, per_cu = 0;
    hipGetDevice(&dev);
    hipDeviceGetAttribute(&cus, hipDeviceAttributeMultiprocessorCount, dev);
    hipOccupancyMaxActiveBlocksPerMultiprocessor(&per_cu, fwd_megakernel, 256, 0);
    if (per_cu > 2) per_cu = 2;
    if (per_cu < 1) per_cu = 1;
    grid_blocks = cus * per_cu;
  }
  void* args[] = {&p};
  hipError_t e = hipLaunchCooperativeKernel((void*)fwd_megakernel, dim3(grid_blocks), dim3(256), args, 0, stream);
  if (e != hipSuccess) fprintf(stderr, "cooperative launch failed: %s (grid %d)\n", hipGetErrorString(e), grid_blocks);
#else
  const int G = 512;
  k_p0<<<G, 256, 0, stream>>>(p);
  k_p1<<<G, 256, 0, stream>>>(p);
  k_p2<<<G, 256, 0, stream>>>(p);
  k_p3<<<G, 256, 0, stream>>>(p);
  k_p4<<<G, 256, 0, stream>>>(p);
  k_p5<<<G, 256, 0, stream>>>(p);
  k_p6<<<G, 256, 0, stream>>>(p);
#endif
}
```

```cpp
#include <hip/hip_runtime.h>
#include <hip/hip_cooperative_groups.h>
#include <cstdio>
#include <cstdint>
namespace cg = cooperative_groups;

#ifndef FUSED
#define FUSED 1
#endif
#ifndef PROBE_DUP
#define PROBE_DUP 0
#endif

typedef unsigned short u16;
typedef unsigned char u8;
typedef __attribute__((ext_vector_type(8))) short bf16x8;
typedef __attribute__((ext_vector_type(4))) short s16x4;
typedef __attribute__((ext_vector_type(16))) float f32x16;
typedef __attribute__((ext_vector_type(2))) __bf16 bf2_t;
typedef __attribute__((ext_vector_type(4))) unsigned u32x4;
#define DI __device__ __forceinline__
#define MFMA(a, b, c) __builtin_amdgcn_mfma_f32_32x32x16_bf16((a), (b), (c), 0, 0, 0)

constexpr int T_TOK = 32768;
constexpr int SEQ = 4096;
constexpr size_t MB = 1u << 20;
constexpr size_t OFF_XNB = 0;
constexpr size_t OFF_QA = 64 * MB, OFF_KA = 96 * MB, OFF_VA = 128 * MB, OFF_QB = 160 * MB, OFF_KB = 192 * MB, OFF_VB = 224 * MB;
constexpr size_t OFF_TOPS = 64 * MB;
constexpr size_t OFF_TOPI = 96 * MB;
constexpr size_t OFF_OAP = 256 * MB;
constexpr size_t OFF_OBC = 352 * MB;
constexpr size_t OFF_PUB = 416 * MB, OFF_PVB = 448 * MB;
constexpr size_t OFF_WIN = 480 * MB, OFF_WOUT = 486 * MB, OFF_WPQ = 488 * MB, OFF_SUBK = 492 * MB;
constexpr size_t OFF_ROPEC = 493 * MB, OFF_ROPES = 493 * MB + 128 * 1024;
constexpr size_t OFF_LSE = 494 * MB;
constexpr size_t OFF_HSS = 497 * MB;
constexpr size_t OFF_MISC = 497 * MB + 128 * 1024;

constexpr size_t OFF_BAR = 497 * MB + 256 * 1024;
constexpr int SMEM_BYTES = 73728;
#define XCD_BAR_WORDS 3456
constexpr float QSCALE = 0.125f * 1.4426950408889634f;
constexpr float NEG_INF = -__builtin_huge_valf();
constexpr float USCALE = 64.f, VSCALE = 16.f;
typedef float f32x2 __attribute__((ext_vector_type(2)));

struct Params {
  const float *x, *g_attn, *w_in, *qna, *kna, *ona, *qnb, *knb, *lq1, *lk1, *lq2, *lk2, *onb, *w_out, *g_ffn, *w_pq, *subk, *pu, *pv;
  float* out;
  char* ws;
};

DI u16 f2bf(float x) { unsigned u = __float_as_uint(x); u += 0x7fffu + ((u >> 16) & 1u); return (u16)(u >> 16); }
DI float bf2f(u16 b) { return __uint_as_float(((unsigned)b) << 16); }
typedef __bf16 bf16x2_t __attribute__((ext_vector_type(2)));
DI unsigned pack2(float a, float b) { bf16x2_t v = {(__bf16)a, (__bf16)b}; return __builtin_bit_cast(unsigned, v); }
DI float bflo(unsigned u) { return __uint_as_float(u << 16); }
DI float bfhi(unsigned u) { return __uint_as_float(u & 0xffff0000u); }
DI float wave_sum(float v) {
  v += __shfl_xor(v, 32); v += __shfl_xor(v, 16); v += __shfl_xor(v, 8); v += __shfl_xor(v, 4); v += __shfl_xor(v, 2); v += __shfl_xor(v, 1);
  return v;
}
DI void gld16(u32x4& dst, const void* ptr) { asm volatile("global_load_dwordx4 %0, %1, off" : "=v"(dst) : "v"(ptr) : "memory"); }
DI void vm_wait8(u32x4& a, u32x4& b, u32x4& c, u32x4& d, u32x4& e, u32x4& f, u32x4& g, u32x4& h) {
  asm volatile("s_waitcnt vmcnt(0)" : "+v"(a), "+v"(b), "+v"(c), "+v"(d), "+v"(e), "+v"(f), "+v"(g), "+v"(h) : : "memory");
}
template <int N> DI void vm_wait8n(u32x4& a, u32x4& b, u32x4& c, u32x4& d, u32x4& e, u32x4& f, u32x4& g, u32x4& h) {
  asm volatile("s_waitcnt vmcnt(%8)" : "+v"(a), "+v"(b), "+v"(c), "+v"(d), "+v"(e), "+v"(f), "+v"(g), "+v"(h) : "n"(N) : "memory");
}
DI void vm_wait6(u32x4& a, u32x4& b, u32x4& c, u32x4& d, u32x4& e, u32x4& f) {
  asm volatile("s_waitcnt vmcnt(0)" : "+v"(a), "+v"(b), "+v"(c), "+v"(d), "+v"(e), "+v"(f) : : "memory");
}
DI int opaque_tid() { int t = threadIdx.x; asm volatile("" : "+v"(t)); return t; }
DI int crow(int reg, int h) { return (reg & 3) + 8 * (reg >> 2) + 4 * h; }

__device__ void phase0(const Params& p, char* smem) {
  const int tid = threadIdx.x, lane = tid & 63, wid = tid >> 6;
  const int gw = blockIdx.x * 4 + wid, nw = gridDim.x * 4;
  const int gt = blockIdx.x * 256 + tid, nt = gridDim.x * 256;
  u16* xnb = (u16*)(p.ws + OFF_XNB);
  for (int row = gw; row < T_TOK; row += nw) {
    const float4* xr = (const float4*)(p.x + (size_t)row * 1024);
    float4 v[4]; float ss = 0.f;
#pragma unroll
    for (int i = 0; i < 4; ++i) { v[i] = xr[lane + 64 * i]; ss += v[i].x * v[i].x + v[i].y * v[i].y + v[i].z * v[i].z + v[i].w * v[i].w; }
    ss = wave_sum(ss);
    const float r = rsqrtf(ss * (1.f / 1024.f) + 1e-6f);
    uint2* dst = (uint2*)(xnb + (size_t)row * 1024);
#pragma unroll
    for (int i = 0; i < 4; ++i) dst[lane + 64 * i] = make_uint2(pack2(v[i].x * r, v[i].y * r), pack2(v[i].z * r, v[i].w * r));
  }
  float* tile = (float*)smem;
  for (int job = blockIdx.x; job < 1536; job += gridDim.x) {
    const float* W; const float* g; u16* outp; int N, j;
    if (job < 768) { W = p.w_in; g = p.g_attn; outp = (u16*)(p.ws + OFF_WIN); N = 3072; j = job; }
    else if (job < 1024) { W = p.w_out; g = nullptr; outp = (u16*)(p.ws + OFF_WOUT); N = 1024; j = job - 768; }
    else { W = p.w_pq; g = p.g_ffn; outp = (u16*)(p.ws + OFF_WPQ); N = 2048; j = job - 1024; }
    const int ntn = N >> 6, kt = j / ntn, ntile = j % ntn;
    const int tx = tid & 63, ty = tid >> 6;
#pragma unroll 4
    for (int r = 0; r < 16; ++r) {
      const int k = kt * 64 + ty + 4 * r;
      float v = W[(size_t)k * N + ntile * 64 + tx];
      if (g) v *= g[k];
      tile[(ty + 4 * r) * 65 + tx] = v;
    }
    __syncthreads();
#pragma unroll 4
    for (int r = 0; r < 16; ++r) {
      const int nl = ty + 4 * r;
      outp[(size_t)(ntile * 64 + nl) * 1024 + kt * 64 + tx] = f2bf(tile[tx * 65 + nl]);
    }
    __syncthreads();
  }
  {
    const float4* s = (const float4*)p.subk; uint2* d = (uint2*)(p.ws + OFF_SUBK);
    for (int i = gt; i < 262144 / 4; i += nt) { float4 v = s[i]; d[i] = make_uint2(pack2(v.x, v.y), pack2(v.z, v.w)); }
    const float4* su = (const float4*)p.pu; int* du = (int*)(p.ws + OFF_PUB);
    const float4* sv = (const float4*)p.pv; int* dv = (int*)(p.ws + OFF_PVB);
    for (int i = gt; i < 16384 * 1024 / 4; i += nt) {
      float4 a = su[i]; float4 b = sv[i];
      int ra = __builtin_amdgcn_cvt_pk_fp8_f32(a.x * USCALE, a.y * USCALE, 0, false);
      ra = __builtin_amdgcn_cvt_pk_fp8_f32(a.z * USCALE, a.w * USCALE, ra, true);
      int rb = __builtin_amdgcn_cvt_pk_fp8_f32(b.x * VSCALE, b.y * VSCALE, 0, false);
      rb = __builtin_amdgcn_cvt_pk_fp8_f32(b.z * VSCALE, b.w * VSCALE, rb, true);
      du[i] = ra; dv[i] = rb;
    }
  }
  {
    float* rc = (float*)(p.ws + OFF_ROPEC); float* rs = (float*)(p.ws + OFF_ROPES);
    for (int i = gt; i < SEQ * 8; i += nt) {
      const int pos = i >> 3, f = i & 7;
      const float invf = (float)pow(500000.0, -(double)f / 8.0);
      const float ang = (float)pos * invf;
      rc[i] = (float)cos((double)ang); rs[i] = (float)sin((double)ang);
    }
    float* hss = (float*)(p.ws + OFF_HSS);
    for (int i = gt; i < T_TOK; i += nt) hss[i] = 0.f;
    unsigned* barw = (unsigned*)(p.ws + OFF_BAR);
    for (int i = gt; i < XCD_BAR_WORDS; i += nt) barw[i] = 0u;
    if (gt == 0) {
      float a = 0.f, b = 0.f;
      for (int i = 0; i < 64; ++i) { a += p.lq1[i] * p.lk1[i]; b += p.lq2[i] * p.lk2[i]; }
      float* misc = (float*)(p.ws + OFF_MISC);
      misc[0] = expf(a) - expf(b) + 0.2f;
      ((int*)misc)[1] = 0; ((int*)misc)[2] = 0;
    }
  }
}

DI void gemm_mainloop(const u16* __restrict__ A, const u16* __restrict__ Bt, int m0, int n0, char* smem, f32x16 (&acc)[2][2]) {
  u16* As = (u16*)smem;
  u16* Bs = As + 2 * 128 * 72;
  const int tid = opaque_tid(), lane = tid & 63, w = tid >> 6, wm = w >> 1, wn = w & 1, lr = lane & 31, lh = lane >> 5;
#pragma unroll
  for (int a = 0; a < 2; ++a)
#pragma unroll
    for (int b = 0; b < 2; ++b)
#pragma unroll
      for (int r = 0; r < 16; ++r) acc[a][b][r] = 0.f;
  u32x4 raA[4], rbA[4], raB[4], rbB[4];
  const int lrow = tid >> 3, lkc = tid & 7;
  const u16* Ag = A + (size_t)(m0 + lrow) * 1024 + lkc * 8;
  const u16* Bg = Bt + (size_t)(n0 + lrow) * 1024 + lkc * 8;
#define GLOAD(S_, kt) { _Pragma("unroll") for (int i = 0; i < 4; ++i) { gld16(ra##S_[i], Ag + (size_t)i * 32 * 1024 + (kt) * 64); gld16(rb##S_[i], Bg + (size_t)i * 32 * 1024 + (kt) * 64); } }
#define SWRITE(S_, buf, NW_) { vm_wait8n<NW_>(ra##S_[0], ra##S_[1], ra##S_[2], ra##S_[3], rb##S_[0], rb##S_[1], rb##S_[2], rb##S_[3]); \
    _Pragma("unroll") for (int i = 0; i < 4; ++i) { *(u32x4*)(As + ((buf) * 128 + lrow + 32 * i) * 72 + lkc * 8) = ra##S_[i]; *(u32x4*)(Bs + ((buf) * 128 + lrow + 32 * i) * 72 + lkc * 8) = rb##S_[i]; } }
#define GCOMPUTE(buf) { \
    const u16* ab = As + ((buf) * 128 + wm * 64 + lr) * 72 + lh * 8; \
    const u16* bb = Bs + ((buf) * 128 + wn * 64 + lr) * 72 + lh * 8; \
    _Pragma("unroll") for (int s = 0; s < 4; ++s) { \
      const bf16x8 a0 = *(const bf16x8*)(ab + s * 16), a1 = *(const bf16x8*)(ab + 32 * 72 + s * 16); \
      const bf16x8 b0 = *(const bf16x8*)(bb + s * 16), b1 = *(const bf16x8*)(bb + 32 * 72 + s * 16); \
      acc[0][0] = MFMA(a0, b0, acc[0][0]); acc[0][1] = MFMA(a0, b1, acc[0][1]); \
      acc[1][0] = MFMA(a1, b0, acc[1][0]); acc[1][1] = MFMA(a1, b1, acc[1][1]); } }
  GLOAD(A, 0); SWRITE(A, 0, 0); GLOAD(A, 1); __syncthreads();
  for (int kt = 0; kt < 14; kt += 2) {
    GLOAD(B, kt + 2);
    GCOMPUTE(0);
    SWRITE(A, 1, 8);
    __syncthreads();
    GLOAD(A, kt + 3);
    GCOMPUTE(1);
    SWRITE(B, 0, 8);
    __syncthreads();
  }
  GCOMPUTE(0);
  SWRITE(A, 1, 0);
  __syncthreads();
  GCOMPUTE(1);
  __syncthreads();
#undef GCOMPUTE
#undef GLOAD
#undef SWRITE
}

DI void stage_acc(const f32x16 (&acc)[2][2], float* st) {
  const int tid = threadIdx.x, lane = tid & 63, w = tid >> 6, wm = w >> 1, wn = w & 1, lr = lane & 31, lh = lane >> 5;
#pragma unroll
  for (int mt = 0; mt < 2; ++mt)
#pragma unroll
    for (int nt = 0; nt < 2; ++nt)
#pragma unroll
      for (int r = 0; r < 16; ++r) st[(wm * 64 + mt * 32 + crow(r, lh)) * 132 + wn * 64 + nt * 32 + lr] = acc[mt][nt][r];
}

__device__ void phase1_tile(const Params& p, int mtile, int j, char* smem) {
  f32x16 acc[2][2];
  const int m0 = mtile * 128, n0 = j * 128;
  gemm_mainloop((const u16*)(p.ws + OFF_XNB), (const u16*)(p.ws + OFF_WIN), m0, n0, smem, acc);
  float* st = (float*)smem;
  stage_acc(acc, st);
  __syncthreads();
  const int tid = threadIdx.x, row = tid & 127, half = tid >> 7;
  const int sec = j >> 2;
  const int tok = m0 + row, b = tok >> 12, s = tok & 4095;
  float v[64];
#pragma unroll
  for (int c = 0; c < 16; ++c) { const float4 t4 = *(const float4*)(st + row * 132 + half * 64 + c * 4); v[4 * c] = t4.x; v[4 * c + 1] = t4.y; v[4 * c + 2] = t4.z; v[4 * c + 3] = t4.w; }
  if (sec != 2 && sec != 5) {
    const float* g = sec == 0 ? p.qna : sec == 1 ? p.kna : sec == 3 ? p.qnb : p.knb;
    float ss = 0.f;
#pragma unroll
    for (int i = 0; i < 64; ++i) ss += v[i] * v[i];
    float r = rsqrtf(ss * (1.f / 64.f) + 1e-6f);
    const float post = (sec == 0 || sec == 3) ? QSCALE : 1.f;
#pragma unroll
    for (int i = 0; i < 64; ++i) v[i] = v[i] * r * g[i];
    const float* rc = (const float*)(p.ws + OFF_ROPEC) + s * 8;
    const float* rs = (const float*)(p.ws + OFF_ROPES) + s * 8;
#pragma unroll
    for (int i = 0; i < 8; ++i) {
      const float c = rc[i], sn = rs[i], x1 = v[i], x2 = v[i + 8];
      v[i] = x1 * c - x2 * sn; v[i + 8] = x2 * c + x1 * sn;
    }
#pragma unroll
    for (int i = 0; i < 64; ++i) v[i] *= post;
  }
  u16* dst;
  if (sec == 5) {
    dst = (u16*)(p.ws + OFF_VB) + ((size_t)(b * 4 + (j & 3)) * 4096 + s) * 128 + half * 64;
  } else {
    const size_t off = sec == 0 ? OFF_QA : sec == 1 ? OFF_KA : sec == 2 ? OFF_VA : sec == 3 ? OFF_QB : OFF_KB;
    const int hc = (j & 3) * 2 + half;
    dst = (u16*)(p.ws + off) + ((size_t)(b * 8 + hc) * 4096 + s) * 64;
  }
#pragma unroll
  for (int c = 0; c < 8; ++c)
    ((uint4*)dst)[c] = make_uint4(pack2(v[8 * c], v[8 * c + 1]), pack2(v[8 * c + 2], v[8 * c + 3]), pack2(v[8 * c + 4], v[8 * c + 5]), pack2(v[8 * c + 6], v[8 * c + 7]));
  __syncthreads();
}

template <int OFF> DI s16x4 tr_read(unsigned addr) {
  s16x4 r; asm volatile("ds_read_b64_tr_b16 %0, %1 offset:%2" : "=v"(r) : "v"(addr), "n"(OFF) : "memory"); return r;
}
DI void wait_tr8(s16x4& a0, s16x4& a1, s16x4& a2, s16x4& a3, s16x4& a4, s16x4& a5, s16x4& a6, s16x4& a7) {
  asm volatile("s_waitcnt lgkmcnt(0)" : "+v"(a0), "+v"(a1), "+v"(a2), "+v"(a3), "+v"(a4), "+v"(a5), "+v"(a6), "+v"(a7) : : "memory");
}

#define TR_ISSUE(S_, MT_) { const unsigned a0_ = vaddr + (MT_) * 64; \
        S_##0 = tr_read<0 * 16 * VST * 2>(a0_); S_##1 = tr_read<(0 * 16 + 8) * VST * 2>(a0_); S_##2 = tr_read<1 * 16 * VST * 2>(a0_); S_##3 = tr_read<(1 * 16 + 8) * VST * 2>(a0_); \
        S_##4 = tr_read<2 * 16 * VST * 2>(a0_); S_##5 = tr_read<(2 * 16 + 8) * VST * 2>(a0_); S_##6 = tr_read<3 * 16 * VST * 2>(a0_); S_##7 = tr_read<(3 * 16 + 8) * VST * 2>(a0_); }
#define TR_MFMA(S_, MT_) { \
        o[MT_] = MFMA(__builtin_shufflevector(S_##0, S_##1, 0, 1, 2, 3, 4, 5, 6, 7), pf[0], o[MT_]); o[MT_] = MFMA(__builtin_shufflevector(S_##2, S_##3, 0, 1, 2, 3, 4, 5, 6, 7), pf[1], o[MT_]); \
        o[MT_] = MFMA(__builtin_shufflevector(S_##4, S_##5, 0, 1, 2, 3, 4, 5, 6, 7), pf[2], o[MT_]); o[MT_] = MFMA(__builtin_shufflevector(S_##6, S_##7, 0, 1, 2, 3, 4, 5, 6, 7), pf[3], o[MT_]); }
template <int DV, bool CAUSAL>
__device__ void attn_unit(const u16* __restrict__ qbase, const u16* __restrict__ kbase, const u16* __restrict__ vbase, int n, int dil, int res,
                          u16* __restrict__ obase, int ostride, float* __restrict__ lsebase, char* smem) {
  constexpr int VST = DV + 8;
  constexpr int NMT = DV / 32;
  constexpr int WMAX = CAUSAL ? (1 << 30) : 128;
  u16* Ks = (u16*)smem;
  u16* Vs = Ks + 2 * 64 * 72;
  const int tid = opaque_tid(), lane = tid & 63, w = tid >> 6, lr = lane & 31, lh = lane >> 5;
  const int kb0 = CAUSAL ? 0 : 128 * (n - 1);
  const int kt_begin = CAUSAL ? 0 : (n == 0 ? 2 : 0);
  const int kt_end = CAUSAL ? (2 * n + 2) : 4;
  const int mq = 128 * n + 32 * w + lr;
  const size_t tq = (size_t)mq * dil + res;
  bf16x8 qf[4];
  {
    const u16* qp = qbase + tq * 64 + lh * 8;
#pragma unroll
    for (int s = 0; s < 4; ++s) qf[s] = *(const bf16x8*)(qp + s * 16);
  }
  f32x16 o[NMT];
#pragma unroll
  for (int mt = 0; mt < NMT; ++mt)
#pragma unroll
    for (int r = 0; r < 16; ++r) o[mt][r] = 0.f;
  float m_run = NEG_INF, l_run = 0.f;
  u32x4 rk0, rk1, rv0, rv1, rv2, rv3;
  rv2 = rv3 = (u32x4){0u, 0u, 0u, 0u};
  const int krow_ = tid >> 3, kkc = tid & 7;
  constexpr int VCPR = DV / 8;
  const int vrow = tid / VCPR, vkc = tid % VCPR;
  constexpr int VRSTEP = 256 / VCPR;
  const u16* kgp = kbase + ((size_t)(kb0 + krow_) * dil + res) * 64 + kkc * 8;
  const u16* vgp = vbase + ((size_t)(kb0 + vrow) * dil + res) * DV + vkc * 8;
  const size_t kstep32 = (size_t)32 * dil * 64, kstep64 = (size_t)64 * dil * 64;
  const size_t vstepr = (size_t)VRSTEP * dil * DV, vstep64 = (size_t)64 * dil * DV;
  u16* ksw = Ks + krow_ * 72 + kkc * 8;
  u16* vsw = Vs + vrow * VST + vkc * 8;
#define AGLOAD(kt) { const u16* kp_ = kgp + (size_t)(kt) * kstep64; gld16(rk0, kp_); gld16(rk1, kp_ + kstep32); \
    const u16* vp_ = vgp + (size_t)(kt) * vstep64; gld16(rv0, vp_); gld16(rv1, vp_ + vstepr); \
    if (NMT == 4) { gld16(rv2, vp_ + 2 * vstepr); gld16(rv3, vp_ + 3 * vstepr); } }
#define ASWRITE(buf) { vm_wait6(rk0, rk1, rv0, rv1, rv2, rv3); *(u32x4*)(ksw + (buf) * 64 * 72) = rk0; *(u32x4*)(ksw + (buf) * 64 * 72 + 32 * 72) = rk1; \
    *(u32x4*)(vsw + (buf) * 64 * VST) = rv0; *(u32x4*)(vsw + (buf) * 64 * VST + VRSTEP * VST) = rv1; \
    if (NMT == 4) { *(u32x4*)(vsw + (buf) * 64 * VST + 2 * VRSTEP * VST) = rv2; *(u32x4*)(vsw + (buf) * 64 * VST + 3 * VRSTEP * VST) = rv3; } }
  AGLOAD(kt_begin); ASWRITE(0); __syncthreads();
  const int li = lane & 31, blk = li >> 4, tq_ = (li >> 2) & 3, tp = li & 3;
  for (int kt = kt_begin; kt < kt_end; ++kt) {
    const int buf = (kt - kt_begin) & 1;
    if (kt + 1 < kt_end) AGLOAD(kt + 1);
    __builtin_amdgcn_sched_barrier(0);
    const int k_lo = kb0 + 64 * kt, q_lo = 128 * n + 32 * w;
    const int dmin = q_lo - (k_lo + 63), dmax = q_lo + 31 - k_lo;
    const bool skip = (dmax < 0) || (dmin > WMAX);
    if (!skip) {
      const bool need_mask = (dmin < 0) || (dmax > WMAX);
      const unsigned vaddr = (unsigned)(size_t)(Vs + (buf * 64 + 4 * lh + tq_) * VST + 16 * blk + 4 * tp);
      s16x4 va0, va1, va2, va3, va4, va5, va6, va7;
      const u16* kb = Ks + (buf * 64 + lr) * 72 + lh * 8;
      f32x16 st[2];
#pragma unroll
      for (int kk = 0; kk < 2; ++kk) {
#pragma unroll
        for (int r = 0; r < 16; ++r) st[kk][r] = 0.f;
#pragma unroll
        for (int s = 0; s < 4; ++s) { const bf16x8 a = *(const bf16x8*)(kb + kk * 32 * 72 + s * 16); st[kk] = MFMA(a, qf[s], st[kk]); }
      }
      if (need_mask) {
#pragma unroll
        for (int kk = 0; kk < 2; ++kk)
#pragma unroll
          for (int r = 0; r < 16; ++r) {
            const int d = mq - (k_lo + 32 * kk + crow(r, lh));
            if (d < 0 || d > WMAX) st[kk][r] = NEG_INF;
          }
      }
      TR_ISSUE(va, 0);
      float mx = NEG_INF;
#pragma unroll
      for (int kk = 0; kk < 2; ++kk)
#pragma unroll
        for (int r = 0; r < 16; ++r) mx = fmaxf(mx, st[kk][r]);
      mx = fmaxf(mx, __shfl_xor(mx, 32));
      const float m_new = fmaxf(m_run, mx);
      const float m_use = (m_new == NEG_INF) ? 0.f : m_new;
      const float alpha = __builtin_amdgcn_exp2f(m_run - m_use);
      float ls = 0.f;
#pragma unroll
      for (int kk = 0; kk < 2; ++kk)
#pragma unroll
        for (int r = 0; r < 16; ++r) { const float e = __builtin_amdgcn_exp2f(st[kk][r] - m_use); st[kk][r] = e; ls += e; }
      l_run = l_run * alpha + ls; m_run = m_new;
      if (__builtin_amdgcn_ballot_w64(alpha != 1.f)) {
#pragma unroll
        for (int mt = 0; mt < NMT; ++mt)
#pragma unroll
          for (int r = 0; r < 16; ++r) o[mt][r] *= alpha;
      }
      bf16x8 pf[4];
#pragma unroll
      for (int ks = 0; ks < 4; ++ks) {
        const int kk = ks >> 1, s2 = ks & 1;
        u32x4 cv;
        cv[0] = pack2(st[kk][8 * s2 + 0], st[kk][8 * s2 + 1]); cv[1] = pack2(st[kk][8 * s2 + 2], st[kk][8 * s2 + 3]);
        cv[2] = pack2(st[kk][8 * s2 + 4], st[kk][8 * s2 + 5]); cv[3] = pack2(st[kk][8 * s2 + 6], st[kk][8 * s2 + 7]);
        pf[ks] = __builtin_bit_cast(bf16x8, cv);
      }
      wait_tr8(va0, va1, va2, va3, va4, va5, va6, va7);
      TR_MFMA(va, 0);
      TR_ISSUE(va, 1);
      wait_tr8(va0, va1, va2, va3, va4, va5, va6, va7);
      TR_MFMA(va, 1);
      if (NMT == 4) {
        TR_ISSUE(va, 2);
        wait_tr8(va0, va1, va2, va3, va4, va5, va6, va7);
        TR_MFMA(va, 2 % NMT);
        TR_ISSUE(va, 3);
        wait_tr8(va0, va1, va2, va3, va4, va5, va6, va7);
        TR_MFMA(va, 3 % NMT);
      }
    }
    if (kt + 1 < kt_end) ASWRITE(buf ^ 1);
    __syncthreads();
  }
#undef AGLOAD
#undef ASWRITE
  const float l_tot = l_run + __shfl_xor(l_run, 32);
  const float inv = 1.f / l_tot;
  u16* op = obase + tq * ostride;
#pragma unroll
  for (int mt = 0; mt < NMT; ++mt)
#pragma unroll
    for (int g = 0; g < 4; ++g) {
      const int dv0 = 32 * mt + 8 * g + 4 * lh;
      *(uint2*)(op + dv0) = make_uint2(pack2(o[mt][4 * g] * inv, o[mt][4 * g + 1] * inv), pack2(o[mt][4 * g + 2] * inv, o[mt][4 * g + 3] * inv));
    }
  if (!CAUSAL && lh == 0) lsebase[tq * 8] = m_run + log2f(l_tot);
}

constexpr int N_DIFF_UNITS = 2048, N_DIL_UNITS = 6144;
__device__ void phase2_unit(const Params& p, int u, char* smem) {
  if (u < N_DIFF_UNITS) {
    const int n = 31 - (u >> 6), rem = u & 63, b = rem >> 3, hc = rem & 7, h4 = hc >> 1;
    const u16* qb = (const u16*)(p.ws + OFF_QB) + (size_t)(b * 8 + hc) * 4096 * 64;
    const u16* kb = (const u16*)(p.ws + OFF_KB) + (size_t)(b * 8 + hc) * 4096 * 64;
    const u16* vb = (const u16*)(p.ws + OFF_VB) + (size_t)(b * 4 + h4) * 4096 * 128;
    u16* ob = (u16*)(p.ws + OFF_OBC) + (size_t)b * 4096 * 1024 + hc * 128;
    attn_unit<128, true>(qb, kb, vb, n, 1, 0, ob, 1024, nullptr, smem);
  } else {
    const int u2 = u - N_DIFF_UNITS, pidx = u2 >> 11, rem = u2 & 2047, b = rem >> 8, h = (rem >> 5) & 7, rn = rem & 31;
    const int sh = 2 * pidx, dil = 1 << sh, nb = 32 >> sh, res = rn >> (5 - sh), n = rn & (nb - 1);
    const u16* qb = (const u16*)(p.ws + OFF_QA) + (size_t)(b * 8 + h) * 4096 * 64;
    const u16* kb = (const u16*)(p.ws + OFF_KA) + (size_t)(b * 8 + h) * 4096 * 64;
    const u16* vb = (const u16*)(p.ws + OFF_VA) + (size_t)(b * 8 + h) * 4096 * 64;
    u16* ob = (u16*)(p.ws + OFF_OAP) + ((size_t)pidx * T_TOK + (size_t)b * 4096) * 512 + h * 64;
    float* lse = (float*)(p.ws + OFF_LSE) + ((size_t)pidx * T_TOK + (size_t)b * 4096) * 8 + h;
    attn_unit<64, false>(qb, kb, vb, n, dil, res, ob, 512, lse, smem);
  }
}
__device__ void phase2(const Params& p, char* smem, int slot = 1) {
  int* counter = (int*)(p.ws + OFF_MISC) + slot;
  int* s_unit = (int*)(smem + SMEM_BYTES - 16);
  while (true) {
    if (threadIdx.x == 0) *s_unit = atomicAdd(counter, 1);
    __syncthreads();
    const int u = *s_unit;
    __syncthreads();
    if (u >= N_DIFF_UNITS + N_DIL_UNITS) break;
    phase2_unit(p, u, smem);
  }
}

__device__ void phase3(const Params& p) {
  const int tid = threadIdx.x, lane = tid & 63, wid = tid >> 6;
  const int gw = blockIdx.x * 4 + wid, nw = gridDim.x * 4;
  const float lam = ((const float*)(p.ws + OFF_MISC))[0];
  const u16* oap = (const u16*)(p.ws + OFF_OAP);
  const u16* obc = (const u16*)(p.ws + OFF_OBC);
  const float* lse = (const float*)(p.ws + OFF_LSE);
  u16* mix = (u16*)(p.ws + OFF_XNB);
  for (int tok = gw; tok < T_TOK; tok += nw) {
    float o[16]; float ss = 0.f;
    if (lane < 32) {
      const int head = lane >> 2;
      float l0 = lse[(size_t)tok * 8 + head], l1 = lse[((size_t)T_TOK + tok) * 8 + head], l2 = lse[((size_t)2 * T_TOK + tok) * 8 + head];
      const float mx = fmaxf(l0, fmaxf(l1, l2));
      float w0 = exp2f(l0 - mx), w1 = exp2f(l1 - mx), w2 = exp2f(l2 - mx);
      const float inv = 1.f / (w0 + w1 + w2); w0 *= inv; w1 *= inv; w2 *= inv;
      const uint4* p0 = (const uint4*)(oap + (size_t)tok * 512 + lane * 16);
      const uint4* p1 = (const uint4*)(oap + ((size_t)T_TOK + tok) * 512 + lane * 16);
      const uint4* p2 = (const uint4*)(oap + ((size_t)2 * T_TOK + tok) * 512 + lane * 16);
#pragma unroll
      for (int c = 0; c < 2; ++c) {
        const uint4 a = p0[c], b = p1[c], d = p2[c];
        const unsigned au[4] = {a.x, a.y, a.z, a.w}, bu[4] = {b.x, b.y, b.z, b.w}, du[4] = {d.x, d.y, d.z, d.w};
#pragma unroll
        for (int k = 0; k < 4; ++k) {
          o[c * 8 + 2 * k] = w0 * bflo(au[k]) + w1 * bflo(bu[k]) + w2 * bflo(du[k]);
          o[c * 8 + 2 * k + 1] = w0 * bfhi(au[k]) + w1 * bfhi(bu[k]) + w2 * bfhi(du[k]);
        }
      }
    } else {
      const int l2 = lane - 32, head = l2 >> 3, cc = (l2 & 7) * 16;
      const uint4* p0 = (const uint4*)(obc + (size_t)tok * 1024 + (2 * head) * 128 + cc);
      const uint4* p1 = (const uint4*)(obc + (size_t)tok * 1024 + (2 * head + 1) * 128 + cc);
#pragma unroll
      for (int c = 0; c < 2; ++c) {
        const uint4 a = p0[c], b = p1[c];
        const unsigned au[4] = {a.x, a.y, a.z, a.w}, bu[4] = {b.x, b.y, b.z, b.w};
#pragma unroll
        for (int k = 0; k < 4; ++k) {
          o[c * 8 + 2 * k] = bflo(au[k]) - lam * bflo(bu[k]);
          o[c * 8 + 2 * k + 1] = bfhi(au[k]) - lam * bfhi(bu[k]);
        }
      }
    }
#pragma unroll
    for (int i = 0; i < 16; ++i) ss += o[i] * o[i];
    const float s1 = ss + __shfl_xor(ss, 1);
    const float s2 = s1 + __shfl_xor(s1, 2);
    const float s3 = s2 + __shfl_xor(s2, 4);
    float r; const float* g;
    if (lane < 32) { r = rsqrtf(s2 * (1.f / 64.f) + 1e-6f); g = p.ona + lane * 16; }
    else { r = rsqrtf(s3 * (1.f / 128.f) + 1e-6f) * 0.8f; g = p.onb + (lane - 32) * 16; }
    unsigned pk[8];
#pragma unroll
    for (int k = 0; k < 8; ++k) pk[k] = pack2(o[2 * k] * r * g[2 * k], o[2 * k + 1] * r * g[2 * k + 1]);
    uint4* dst = (uint4*)(mix + (size_t)tok * 1024 + lane * 16);
    dst[0] = make_uint4(pk[0], pk[1], pk[2], pk[3]); dst[1] = make_uint4(pk[4], pk[5], pk[6], pk[7]);
  }
}

__device__ void phase4_tile(const Params& p, int mtile, int j, char* smem) {
  f32x16 acc[2][2];
  const int m0 = mtile * 128, n0 = j * 128;
  gemm_mainloop((const u16*)(p.ws + OFF_XNB), (const u16*)(p.ws + OFF_WOUT), m0, n0, smem, acc);
  float* st = (float*)smem;
  stage_acc(acc, st);
  __syncthreads();
  const int tid = threadIdx.x, cgi = tid & 31, r0 = tid >> 5;
  float* hss = (float*)(p.ws + OFF_HSS);
  u16* hb = (u16*)(p.ws + OFF_OAP);
#pragma unroll 4
  for (int ps = 0; ps < 16; ++ps) {
    const int row = r0 + 8 * ps;
    const float4 a = *(const float4*)(st + row * 132 + cgi * 4);
    const size_t gi = (size_t)(m0 + row) * 1024 + n0 + cgi * 4;
    const float4 xv = *(const float4*)(p.x + gi);
    float4 hv; hv.x = xv.x + a.x; hv.y = xv.y + a.y; hv.z = xv.z + a.z; hv.w = xv.w + a.w;
    *(float4*)(p.out + gi) = hv;
    *(uint2*)(hb + gi) = make_uint2(pack2(hv.x, hv.y), pack2(hv.z, hv.w));
    float ss = hv.x * hv.x + hv.y * hv.y + hv.z * hv.z + hv.w * hv.w;
    ss += __shfl_xor(ss, 16); ss += __shfl_xor(ss, 8); ss += __shfl_xor(ss, 4); ss += __shfl_xor(ss, 2); ss += __shfl_xor(ss, 1);
    if (cgi == 0) atomicAdd(hss + m0 + row, ss);
  }
  __syncthreads();
}

#define TK_INSERT(xv, xi) { float x_ = (xv); int i_ = (xi); _Pragma("unroll") for (int q_ = 0; q_ < 16; ++q_) { const bool gt_ = x_ > tv[q_]; const float tvv = tv[q_]; const int tii = ti[q_]; tv[q_] = gt_ ? x_ : tvv; ti[q_] = gt_ ? i_ : tii; x_ = gt_ ? tvv : x_; i_ = gt_ ? tii : i_; } }
__device__ void phase5_tile(const Params& p, int mtile, int j, char* smem) {
  f32x16 acc[2][2];
  const int m0 = mtile * 128, n0 = j * 128;
  gemm_mainloop((const u16*)(p.ws + OFF_OAP), (const u16*)(p.ws + OFF_WPQ), m0, n0, smem, acc);
  const int tid = threadIdx.x, lane = tid & 63, w = tid >> 6, wm = w >> 1, wn = w & 1, lr = lane & 31, lh = lane >> 5;
  u16* Qs = (u16*)smem;
  u16* SKs = Qs + 128 * 136;
  float* rs = (float*)(smem + 2 * 128 * 136 * 2);
  const float* hss = (const float*)(p.ws + OFF_HSS);
  if (tid < 128) rs[tid] = rsqrtf(hss[m0 + tid] * (1.f / 1024.f) + 1e-6f);
  {
    const u16* sk = (const u16*)(p.ws + OFF_SUBK) + (size_t)j * 128 * 128;
#pragma unroll
    for (int i = 0; i < 8; ++i) { const int c = tid + 256 * i, row = c >> 4, kc = c & 15; *(uint4*)(SKs + row * 136 + kc * 8) = *(const uint4*)(sk + row * 128 + kc * 8); }
  }
  __syncthreads();
#pragma unroll
  for (int mt = 0; mt < 2; ++mt)
#pragma unroll
    for (int nt = 0; nt < 2; ++nt)
#pragma unroll
      for (int r = 0; r < 16; ++r) {
        const int row = wm * 64 + mt * 32 + crow(r, lh);
        Qs[row * 136 + wn * 64 + nt * 32 + lr] = f2bf(acc[mt][nt][r] * rs[row]);
      }
  __syncthreads();
#pragma unroll
  for (int a = 0; a < 2; ++a)
#pragma unroll
    for (int b = 0; b < 2; ++b)
#pragma unroll
      for (int r = 0; r < 16; ++r) acc[a][b][r] = 0.f;
  {
    const u16* ab = Qs + (wm * 64 + lr) * 136 + lh * 8;
    const u16* bb = SKs + (wn * 64 + lr) * 136 + lh * 8;
#pragma unroll
    for (int s = 0; s < 8; ++s) {
      const bf16x8 a0 = *(const bf16x8*)(ab + s * 16), a1 = *(const bf16x8*)(ab + 32 * 136 + s * 16);
      const bf16x8 b0 = *(const bf16x8*)(bb + s * 16), b1 = *(const bf16x8*)(bb + 32 * 136 + s * 16);
      acc[0][0] = MFMA(a0, b0, acc[0][0]); acc[0][1] = MFMA(a0, b1, acc[0][1]);
      acc[1][0] = MFMA(a1, b0, acc[1][0]); acc[1][1] = MFMA(a1, b1, acc[1][1]);
    }
  }
  __syncthreads();
  float* st = (float*)smem;
  stage_acc(acc, st);
  __syncthreads();
  const int row = tid & 127, half = tid >> 7;
  unsigned tk[16];
#pragma unroll
  for (int q = 0; q < 16; ++q) tk[q] = 0u;
#define TK_KEY(xv, xi) ({ const unsigned u_ = __float_as_uint(xv); const unsigned o_ = (u_ & 0x80000000u) ? ~u_ : (u_ | 0x80000000u); (o_ & 0xFFFFFF80u) | (unsigned)(127 - (xi)); })
#define TK_INS(kv) { unsigned k_ = (kv); _Pragma("unroll") for (int q_ = 0; q_ < 16; ++q_) { const unsigned hi_ = k_ > tk[q_] ? k_ : tk[q_]; k_ = k_ > tk[q_] ? tk[q_] : k_; tk[q_] = hi_; } }
#pragma unroll 2
  for (int c = 0; c < 16; ++c) {
    const float4 v4 = *(const float4*)(st + row * 132 + half * 64 + c * 4);
    const int bi = half * 64 + c * 4;
    TK_INS(TK_KEY(v4.x, bi)); TK_INS(TK_KEY(v4.y, bi + 1)); TK_INS(TK_KEY(v4.z, bi + 2)); TK_INS(TK_KEY(v4.w, bi + 3));
  }
  __syncthreads();
  if (half == 1) {
#pragma unroll
    for (int q = 0; q < 16; ++q) st[row * 132 + q] = __uint_as_float(tk[q]);
  }
  __syncthreads();
  if (half == 0) {
#pragma unroll 4
    for (int q = 0; q < 16; ++q) TK_INS(__float_as_uint(st[row * 132 + q]));
    const size_t base = ((size_t)(m0 + row) * 16 + j) * 16;
    float* tops = (float*)(p.ws + OFF_TOPS) + base;
    u8* topi = (u8*)(p.ws + OFF_TOPI) + base;
    float tv[16]; unsigned ti[16];
#pragma unroll
    for (int q = 0; q < 16; ++q) {
      const unsigned o = tk[q] & 0xFFFFFF80u;
      tv[q] = __uint_as_float((o & 0x80000000u) ? (o & 0x7FFFFFFFu) : ~o);
      ti[q] = 127u - (tk[q] & 127u);
    }
#pragma unroll
    for (int c = 0; c < 4; ++c) ((float4*)tops)[c] = make_float4(tv[4 * c], tv[4 * c + 1], tv[4 * c + 2], tv[4 * c + 3]);
    unsigned pk[4];
#pragma unroll
    for (int c = 0; c < 4; ++c) pk[c] = ti[4 * c] | (ti[4 * c + 1] << 8) | (ti[4 * c + 2] << 16) | (ti[4 * c + 3] << 24);
    *(uint4*)topi = make_uint4(pk[0], pk[1], pk[2], pk[3]);
  }
  __syncthreads();
#undef TK_KEY
#undef TK_INS
}

DI float dpp_xor1(float v) { return __builtin_bit_cast(float, __builtin_amdgcn_update_dpp(0, __builtin_bit_cast(int, v), 0xB1, 0xF, 0xF, true)); }
DI float dpp_xor2(float v) { return __builtin_bit_cast(float, __builtin_amdgcn_update_dpp(0, __builtin_bit_cast(int, v), 0x4E, 0xF, 0xF, true)); }
template <int PAT> DI float swz(float v) { return __builtin_bit_cast(float, __builtin_amdgcn_ds_swizzle(__builtin_bit_cast(int, v), PAT)); }
DI float treduce8(const float (&pp)[8], int lane) {
  const bool b0 = lane & 1, b1 = lane & 2, b2 = lane & 4;
  float q[4];
#pragma unroll
  for (int i = 0; i < 4; ++i) { const float keep = b0 ? pp[2 * i + 1] : pp[2 * i], send = b0 ? pp[2 * i] : pp[2 * i + 1]; q[i] = keep + dpp_xor1(send); }
  float r[2];
#pragma unroll
  for (int i = 0; i < 2; ++i) { const float keep = b1 ? q[2 * i + 1] : q[2 * i], send = b1 ? q[2 * i] : q[2 * i + 1]; r[i] = keep + dpp_xor2(send); }
  float t = (b2 ? r[1] : r[0]) + swz<0x101F>(b2 ? r[0] : r[1]);
  t += swz<0x201F>(t); t += swz<0x401F>(t); t += __shfl_xor(t, 32);
  return t;
}
DI float udot16(const uint4& w, const float (&h)[16]) {
  f32x2 acc = {0.f, 0.f};
  const int ww[4] = {(int)w.x, (int)w.y, (int)w.z, (int)w.w};
#pragma unroll
  for (int j = 0; j < 4; ++j) {
    const f32x2 lo = __builtin_amdgcn_cvt_pk_f32_fp8(ww[j], false), hi = __builtin_amdgcn_cvt_pk_f32_fp8(ww[j], true);
    const f32x2 h0 = {h[4 * j], h[4 * j + 1]}, h1 = {h[4 * j + 2], h[4 * j + 3]};
    acc += lo * h0; acc += hi * h1;
  }
  return acc.x + acc.y;
}
DI void vacc16(const uint4& w, float a, f32x2 (&acc)[8]) {
  const f32x2 a2 = {a, a};
  const int ww[4] = {(int)w.x, (int)w.y, (int)w.z, (int)w.w};
#pragma unroll
  for (int j = 0; j < 4; ++j) {
    acc[2 * j] += a2 * __builtin_amdgcn_cvt_pk_f32_fp8(ww[j], false);
    acc[2 * j + 1] += a2 * __builtin_amdgcn_cvt_pk_f32_fp8(ww[j], true);
  }
}
#define LOAD8(buf, tbl, bidx) { const uint4 i0_ = *(const uint4*)(ids + 8 * (bidx)), i1_ = *(const uint4*)(ids + 8 * (bidx) + 4); \
    const unsigned idv_[8] = {i0_.x, i0_.y, i0_.z, i0_.w, i1_.x, i1_.y, i1_.z, i1_.w}; \
    _Pragma("unroll") for (int k_ = 0; k_ < 8; ++k_) { const unsigned id_ = __builtin_amdgcn_readfirstlane(idv_[k_]); buf[k_] = *(const uint4*)((tbl) + (size_t)id_ * 1024 + lane * 16); } }

__device__ void phase6(const Params& p, char* smem, float* dstbase) {
  const int tid = opaque_tid(), lane = tid & 63, wid = tid >> 6;
  const int gw = blockIdx.x * 4 + wid, nw = gridDim.x * 4;
  int* ids = (int*)(smem + wid * 1024);
  float* gts = (float*)(smem + wid * 1024 + 512);
  const float* hss = (const float*)(p.ws + OFF_HSS);
  const float* tops = (const float*)(p.ws + OFF_TOPS);
  const u8* topi = (const u8*)(p.ws + OFF_TOPI);
  const u8* ub = (const u8*)(p.ws + OFF_PUB);
  const u8* vb = (const u8*)(p.ws + OFF_PVB);
  int ci, cj;
  {
    const int L = lane;
    if (L < 16) { ci = 0; cj = L; } else if (L < 24) { ci = 1; cj = L - 16; } else if (L < 29) { ci = 2; cj = L - 24; }
    else if (L < 33) { ci = 3; cj = L - 29; } else if (L < 36) { ci = 4; cj = L - 33; } else if (L < 38) { ci = 5; cj = L - 36; }
    else if (L < 40) { ci = 6; cj = L - 38; } else if (L < 42) { ci = 7; cj = L - 40; } else if (L < 50) { ci = L - 34; cj = 0; }
    else { ci = 0; cj = 0; }
  }
  for (int tok = gw; tok < T_TOK; tok += nw) {
    const float rstd = rsqrtf(hss[tok] * (1.f / 1024.f) + 1e-6f);
    float hres[16], hn[16];
    {
      const float4* hp = (const float4*)(p.out + (size_t)tok * 1024 + lane * 16);
      const float4* gp = (const float4*)(p.g_ffn + lane * 16);
#pragma unroll
      for (int c = 0; c < 4; ++c) {
        const float4 t4 = hp[c], g4 = gp[c];
        hres[4 * c] = t4.x; hres[4 * c + 1] = t4.y; hres[4 * c + 2] = t4.z; hres[4 * c + 3] = t4.w;
        hn[4 * c] = t4.x * rstd * g4.x; hn[4 * c + 1] = t4.y * rstd * g4.y; hn[4 * c + 2] = t4.z * rstd * g4.z; hn[4 * c + 3] = t4.w * rstd * g4.w;
      }
    }
    float sums[8]; int eids[8];
#pragma unroll
    for (int head = 0; head < 8; ++head) {
      const size_t b1 = ((size_t)tok * 16 + head * 2) * 16, b2 = b1 + 16;
      sums[head] = NEG_INF; eids[head] = 0;
      if (lane < 50) { sums[head] = tops[b1 + ci] + tops[b2 + cj]; eids[head] = (int)topi[b1 + ci] * 128 + (int)topi[b2 + cj]; }
    }
#pragma unroll
    for (int head = 0; head < 8; ++head) {
      const float sum = sums[head]; const int eid = eids[head];
      unsigned key;
      {
        const unsigned u_ = __float_as_uint(sum); const unsigned o_ = (u_ & 0x80000000u) ? ~u_ : (u_ | 0x80000000u);
        key = (o_ & 0xFFFFFFC0u) | (unsigned)(63 - lane);
      }
#define BSTEP(K_, J_, SHF_) { const unsigned pr_ = (SHF_); const bool tmx_ = ((lane & (J_)) == 0) == ((lane & (K_)) == 0); \
        const unsigned mx_ = key > pr_ ? key : pr_, mn_ = key > pr_ ? pr_ : key; key = tmx_ ? mx_ : mn_; }
#define SX1 ((unsigned)__builtin_amdgcn_update_dpp(0, (int)key, 0xB1, 0xF, 0xF, true))
#define SX2 ((unsigned)__builtin_amdgcn_update_dpp(0, (int)key, 0x4E, 0xF, 0xF, true))
#define SX4 ((unsigned)__builtin_amdgcn_ds_swizzle((int)key, 0x101F))
#define SX8 ((unsigned)__builtin_amdgcn_ds_swizzle((int)key, 0x201F))
#define SX16 ((unsigned)__builtin_amdgcn_ds_swizzle((int)key, 0x401F))
#define SX32 ((unsigned)__shfl_xor((int)key, 32))
      BSTEP(2, 1, SX1);
      BSTEP(4, 2, SX2); BSTEP(4, 1, SX1);
      BSTEP(8, 4, SX4); BSTEP(8, 2, SX2); BSTEP(8, 1, SX1);
      BSTEP(16, 8, SX8); BSTEP(16, 4, SX4); BSTEP(16, 2, SX2); BSTEP(16, 1, SX1);
      BSTEP(32, 16, SX16); BSTEP(32, 8, SX8); BSTEP(32, 4, SX4); BSTEP(32, 2, SX2); BSTEP(32, 1, SX1);
      BSTEP(64, 32, SX32); BSTEP(64, 16, SX16); BSTEP(64, 8, SX8); BSTEP(64, 4, SX4); BSTEP(64, 2, SX2); BSTEP(64, 1, SX1);
#undef BSTEP
#undef SX1
#undef SX2
#undef SX4
#undef SX8
#undef SX16
#undef SX32
      const int src = 63 - (int)(key & 63u);
      const float sumv = __shfl(sum, src);
      const int eidv = __shfl(eid, src);
      const float mxa = __builtin_bit_cast(float, __builtin_amdgcn_readlane(__builtin_bit_cast(int, sumv), 0));
      const float e = (lane < 16) ? __expf(sumv - mxa) : 0.f;
      float den = e;
      den += dpp_xor1(den); den += dpp_xor2(den); den += swz<0x101F>(den); den += swz<0x201F>(den);
      if (lane < 16) { ids[head * 16 + lane] = eidv; gts[head * 16 + lane] = e / den; }
    }
    __builtin_amdgcn_wave_barrier();
    asm volatile("s_waitcnt lgkmcnt(0)" ::: "memory");
    float dsel0 = 0.f, dsel1 = 0.f;
    {
      uint4 ba[8], bb[8];
      LOAD8(ba, ub, 0);
#pragma unroll 1
      for (int b = 0; b < 16; b += 2) {
        LOAD8(bb, ub, b + 1);
        {
          float pp[8];
#pragma unroll
          for (int k = 0; k < 8; ++k) pp[k] = udot16(ba[k], hn);
          const float t = treduce8(pp, lane);
          if ((lane >> 3) == (b & 7)) { if (b < 8) dsel0 = t; else dsel1 = t; }
        }
        if (b + 2 < 16) LOAD8(ba, ub, b + 2);
        {
          float pp[8];
#pragma unroll
          for (int k = 0; k < 8; ++k) pp[k] = udot16(bb[k], hn);
          const float t = treduce8(pp, lane);
          if ((lane >> 3) == ((b + 1) & 7)) { if (b < 8) dsel0 = t; else dsel1 = t; }
        }
      }
    }
    {
      const float d0 = dsel0 * (1.f / USCALE), d1 = dsel1 * (1.f / USCALE);
      const float a0 = 0.5f * d0 * (1.f + erff(d0 * 0.70710678118654752f)) * gts[lane] * (1.f / VSCALE);
      const float a1 = 0.5f * d1 * (1.f + erff(d1 * 0.70710678118654752f)) * gts[64 + lane] * (1.f / VSCALE);
      gts[lane] = a0; gts[64 + lane] = a1;
    }
    __builtin_amdgcn_wave_barrier();
    asm volatile("s_waitcnt lgkmcnt(0)" ::: "memory");
    f32x2 acc[8];
#pragma unroll
    for (int i = 0; i < 8; ++i) acc[i] = (f32x2){0.f, 0.f};
    {
      uint4 ba[8], bb[8];
      LOAD8(ba, vb, 0);
#pragma unroll 1
      for (int b = 0; b < 16; b += 2) {
        LOAD8(bb, vb, b + 1);
        {
          const float4 g0 = *(const float4*)(gts + 8 * b), g1 = *(const float4*)(gts + 8 * b + 4);
          vacc16(ba[0], g0.x, acc); vacc16(ba[1], g0.y, acc); vacc16(ba[2], g0.z, acc); vacc16(ba[3], g0.w, acc);
          vacc16(ba[4], g1.x, acc); vacc16(ba[5], g1.y, acc); vacc16(ba[6], g1.z, acc); vacc16(ba[7], g1.w, acc);
        }
        if (b + 2 < 16) LOAD8(ba, vb, b + 2);
        {
          const float4 g0 = *(const float4*)(gts + 8 * b + 8), g1 = *(const float4*)(gts + 8 * b + 12);
          vacc16(bb[0], g0.x, acc); vacc16(bb[1], g0.y, acc); vacc16(bb[2], g0.z, acc); vacc16(bb[3], g0.w, acc);
          vacc16(bb[4], g1.x, acc); vacc16(bb[5], g1.y, acc); vacc16(bb[6], g1.z, acc); vacc16(bb[7], g1.w, acc);
        }
      }
    }
    float4* op = (float4*)(dstbase + (size_t)tok * 1024 + lane * 16);
#pragma unroll
    for (int c = 0; c < 4; ++c) op[c] = make_float4(hres[4 * c] + acc[2 * c].x, hres[4 * c + 1] + acc[2 * c].y, hres[4 * c + 2] + acc[2 * c + 1].x, hres[4 * c + 3] + acc[2 * c + 1].y);
    __builtin_amdgcn_wave_barrier();
  }
}


#define XB_TMO      128
#define XB_XCNT(j)  (256  + 64 * (j))
#define XB_XSUB(j)  (1280 + 64 * (j))
#define XB_XGEN(j)  (2304 + 64 * (j))
#define XB_TOP      3328
#define XB_TOPGEN   3392
#define XB_SPIN_CAP (1u << 22)
#define LAS __attribute__((address_space(3)))
DI unsigned xb_ld(unsigned* p) { return __hip_atomic_load(p, __ATOMIC_RELAXED, __HIP_MEMORY_SCOPE_AGENT); }
DI unsigned xb_add(unsigned* p, unsigned v) { return __hip_atomic_fetch_add(p, v, __ATOMIC_RELAXED, __HIP_MEMORY_SCOPE_AGENT); }
DI unsigned xb_xcc_id() { return (unsigned)__builtin_amdgcn_s_getreg((3 << 11) | 20) & 0xFu; }
#define XB_SPIN(cond, bar) do { unsigned _sp = 0; while (cond) { __builtin_amdgcn_s_sleep(1); \
    if ((++_sp & 255u) == 0u) { if (xb_ld(&(bar)[XB_TMO])) break; if (_sp > XB_SPIN_CAP) { atomicAdd(&(bar)[XB_TMO], 1u); break; } } } } while (0)
struct XcdBarrier { unsigned* bar; unsigned x; volatile LAS unsigned* st; };
DI XcdBarrier xcd_barrier_post(unsigned* bar, volatile LAS unsigned* st) {
  XcdBarrier b; b.bar = bar; b.x = xb_xcc_id(); b.st = st;
  if (threadIdx.x == 0) (void)xb_add(&bar[XB_XCNT(b.x)], 1u);
  return b;
}
DI void xcd_barrier_complete(unsigned* bar, unsigned x, unsigned& nloc, unsigned& nx) {
  const unsigned G = gridDim.x * gridDim.y * gridDim.z;
  unsigned sum, cnt, mine, sp = 0u;
  for (;;) {
    sum = 0u; cnt = 0u; mine = 0u;
#pragma unroll
    for (unsigned j = 0; j < 16; ++j) { const unsigned c = xb_ld(&bar[XB_XCNT(j)]); sum += c; cnt += (c > 0u) ? 1u : 0u; mine = (j == x) ? c : mine; }
    if (sum == G) break;
    __builtin_amdgcn_s_sleep(1);
    if ((++sp & 255u) == 0u) { if (xb_ld(&bar[XB_TMO])) break; if (sp > XB_SPIN_CAP) { atomicAdd(&bar[XB_TMO], 1u); break; } }
  }
  nloc = mine > 0u ? mine : 1u; nx = cnt > 0u ? cnt : 1u;
}
DI void xcd_barrier(const XcdBarrier& b) {
  asm volatile("s_waitcnt vmcnt(0)" ::: "memory");
  __syncthreads();
  if (threadIdx.x == 0) {
    unsigned* bar = b.bar;
    __builtin_amdgcn_s_waitcnt(0);
    unsigned nloc = b.st[0], nx = b.st[1];
    if (nloc == 0u) { xcd_barrier_complete(bar, b.x, nloc, nx); b.st[0] = nloc; b.st[1] = nx; }
    const unsigned old = xb_add(&bar[XB_XSUB(b.x)], 1u);
    const unsigned gen = old / nloc;
    if (old + 1u == (gen + 1u) * nloc) {
      __builtin_amdgcn_fence(__ATOMIC_RELEASE, "agent");
      asm volatile("s_waitcnt vmcnt(0)" ::: "memory");
      const unsigned og = xb_add(&bar[XB_TOP], 1u);
      const unsigned tg = og / nx;
      if (og + 1u == (tg + 1u) * nx) xb_add(&bar[XB_TOPGEN], 1u);
      else XB_SPIN(xb_ld(&bar[XB_TOPGEN]) == tg, bar);
      __builtin_amdgcn_fence(__ATOMIC_ACQUIRE, "agent");
      xb_add(&bar[XB_XGEN(b.x)], 1u);
      asm volatile("s_waitcnt vmcnt(0)" ::: "memory");
    } else {
      XB_SPIN(xb_ld(&bar[XB_XGEN(b.x)]) == gen, bar);
      __builtin_amdgcn_fence(__ATOMIC_ACQUIRE, "agent");
      asm volatile("s_waitcnt vmcnt(0)" ::: "memory");
    }
  }
  __syncthreads();
}

#if FUSED
__global__ void __launch_bounds__(256, 2) fwd_megakernel(Params p) {
  __shared__ __attribute__((aligned(16))) char smem[SMEM_BYTES];
  cg::grid_group grid = cg::this_grid();
  __shared__ uint4 xb_words;
  if (threadIdx.x == 0) xb_words = make_uint4(0u, 0u, 0u, 0u);
  phase0(p, smem);
  grid.sync();
  const XcdBarrier xb = xcd_barrier_post((unsigned*)(p.ws + OFF_BAR), (volatile LAS unsigned*)&xb_words);
  for (int t = blockIdx.x; t < 256 * 24; t += gridDim.x) phase1_tile(p, t / 24, t % 24, smem);
  xcd_barrier(xb);
#if PROBE_DUP == 1
  for (int t = blockIdx.x; t < 256 * 24; t += gridDim.x) phase1_tile(p, t / 24, t % 24, smem);
  xcd_barrier(xb);
#endif
#if PROBE_DUP == 2
  phase2(p, smem, 2);
  xcd_barrier(xb);
#endif
  phase2(p, smem);
  xcd_barrier(xb);
  phase3(p);
  xcd_barrier(xb);
  for (int t = blockIdx.x; t < 256 * 8; t += gridDim.x) phase4_tile(p, t >> 3, t & 7, smem);
  xcd_barrier(xb);
  for (int t = blockIdx.x; t < 256 * 16; t += gridDim.x) phase5_tile(p, t >> 4, t & 15, smem);
  xcd_barrier(xb);
#if PROBE_DUP == 5
  for (int t = blockIdx.x; t < 256 * 16; t += gridDim.x) phase5_tile(p, t >> 4, t & 15, smem);
  xcd_barrier(xb);
#endif
#if PROBE_DUP == 6
  phase6(p, smem, (float*)(p.ws + OFF_OAP));
  xcd_barrier(xb);
#endif
  phase6(p, smem, p.out);
}
#else
__global__ void __launch_bounds__(256, 2) k_p0(Params p) { __shared__ __attribute__((aligned(16))) char smem[SMEM_BYTES]; phase0(p, smem); }
__global__ void __launch_bounds__(256, 2) k_p1(Params p) { __shared__ __attribute__((aligned(16))) char smem[SMEM_BYTES]; for (int t = blockIdx.x; t < 256 * 24; t += gridDim.x) phase1_tile(p, t / 24, t % 24, smem); }
__global__ void __launch_bounds__(256, 2) k_p2(Params p) { __shared__ __attribute__((aligned(16))) char smem[SMEM_BYTES]; phase2(p, smem); }
__global__ void __launch_bounds__(256, 2) k_p3(Params p) { phase3(p); }
__global__ void __launch_bounds__(256, 2) k_p4(Params p) { __shared__ __attribute__((aligned(16))) char smem[SMEM_BYTES]; for (int t = blockIdx.x; t < 256 * 8; t += gridDim.x) phase4_tile(p, t >> 3, t & 7, smem); }
__global__ void __launch_bounds__(256, 2) k_p5(Params p) { __shared__ __attribute__((aligned(16))) char smem[SMEM_BYTES]; for (int t = blockIdx.x; t < 256 * 16; t += gridDim.x) phase5_tile(p, t >> 4, t & 15, smem); }
__global__ void __launch_bounds__(256, 2) k_p6(Params p) { __shared__ __attribute__((aligned(16))) char smem[SMEM_BYTES]; phase6(p, smem, p.out); }
#endif

extern "C" void kernel_launch(void* const* d_in, const int* in_sizes, int n_in, void* d_out, int out_size, void* d_ws, size_t ws_size,
                              hipStream_t stream) {
  Params p{};
  p.x = (const float*)d_in[0]; p.g_attn = (const float*)d_in[1]; p.w_in = (const float*)d_in[2]; p.qna = (const float*)d_in[3];
  p.kna = (const float*)d_in[4]; p.ona = (const float*)d_in[5]; p.qnb = (const float*)d_in[6]; p.knb = (const float*)d_in[7];
  p.lq1 = (const float*)d_in[8]; p.lk1 = (const float*)d_in[9]; p.lq2 = (const float*)d_in[10]; p.lk2 = (const float*)d_in[11];
  p.onb = (const float*)d_in[12]; p.w_out = (const float*)d_in[13]; p.g_ffn = (const float*)d_in[14]; p.w_pq = (const float*)d_in[15];
  p.subk = (const float*)d_in[16]; p.pu = (const float*)d_in[17]; p.pv = (const float*)d_in[18];
  p.out = (float*)d_out; p.ws = (char*)d_ws;
#if FUSED
  static int grid_blocks = 0;
  if (!grid_blocks) {
    int dev = 0, cus = 0, per_cu = 0;
    hipGetDevice(&dev);
    hipDeviceGetAttribute(&cus, hipDeviceAttributeMultiprocessorCount, dev);
    hipOccupancyMaxActiveBlocksPerMultiprocessor(&per_cu, fwd_megakernel, 256, 0);
    if (per_cu > 2) per_cu = 2;
    if (per_cu < 1) per_cu = 1;
    grid_blocks = cus * per_cu;
  }
  void* args[] = {&p};
  hipError_t e = hipLaunchCooperativeKernel((void*)fwd_megakernel, dim3(grid_blocks), dim3(256), args, 0, stream);
  if (e != hipSuccess) fprintf(stderr, "cooperative launch failed: %s (grid %d)\n", hipGetErrorString(e), grid_blocks);
#else
  const int G = 512;
  k_p0<<<G, 256, 0, stream>>>(p);
  k_p1<<<G, 256, 0, stream>>>(p);
  k_p2<<<G, 256, 0, stream>>>(p);
  k_p3<<<G, 256, 0, stream>>>(p);
  k_p4<<<G, 256, 0, stream>>>(p);
  k_p5<<<G, 256, 0, stream>>>(p);
  k_p6<<<G, 256, 0, stream>>>(p);
#endif
}
```

```cpp
#include <hip/hip_runtime.h>
#include <hip/hip_cooperative_groups.h>
#include <cstdio>
#include <cstdint>
namespace cg = cooperative_groups;

#ifndef FUSED
#define FUSED 1
#endif
#ifndef PROBE_DUP
#define PROBE_DUP 0
#endif

typedef unsigned short u16;
typedef unsigned char u8;
typedef __attribute__((ext_vector_type(8))) short bf16x8;
typedef __attribute__((ext_vector_type(4))) short s16x4;
typedef __attribute__((ext_vector_type(16))) float f32x16;
typedef __attribute__((ext_vector_type(2))) __bf16 bf2_t;
typedef __attribute__((ext_vector_type(4))) unsigned u32x4;
#define DI __device__ __forceinline__
#define MFMA(a, b, c) __builtin_amdgcn_mfma_f32_32x32x16_bf16((a), (b), (c), 0, 0, 0)

constexpr int T_TOK = 32768;
constexpr int SEQ = 4096;
constexpr size_t MB = 1u << 20;
constexpr size_t OFF_XNB = 0;
constexpr size_t OFF_QA = 64 * MB, OFF_KA = 96 * MB, OFF_VA = 128 * MB, OFF_QB = 160 * MB, OFF_KB = 192 * MB, OFF_VB = 224 * MB;
constexpr size_t OFF_TOPS = 64 * MB;
constexpr size_t OFF_TOPI = 96 * MB;
constexpr size_t OFF_OAP = 256 * MB;
constexpr size_t OFF_OBC = 352 * MB;
constexpr size_t OFF_PUB = 416 * MB, OFF_PVB = 448 * MB;
constexpr size_t OFF_WIN = 480 * MB, OFF_WOUT = 486 * MB, OFF_WPQ = 488 * MB, OFF_SUBK = 492 * MB;
constexpr size_t OFF_ROPEC = 493 * MB, OFF_ROPES = 493 * MB + 128 * 1024;
constexpr size_t OFF_LSE = 494 * MB;
constexpr size_t OFF_HSS = 497 * MB;
constexpr size_t OFF_MISC = 497 * MB + 128 * 1024;

constexpr size_t OFF_BAR = 497 * MB + 256 * 1024;
constexpr int SMEM_BYTES = 73728;
constexpr int NTHR = 512, NWAVE = 8;
constexpr int DYN_LDS = 155648;
#define XCD_BAR_WORDS 3456
constexpr float QSCALE = 0.125f * 1.4426950408889634f;
constexpr float NEG_INF = -__builtin_huge_valf();
constexpr float SM_THR = 8.f;
constexpr float USCALE = 64.f, VSCALE = 16.f;
typedef float f32x2 __attribute__((ext_vector_type(2)));

struct Params {
  const float *x, *g_attn, *w_in, *qna, *kna, *ona, *qnb, *knb, *lq1, *lk1, *lq2, *lk2, *onb, *w_out, *g_ffn, *w_pq, *subk, *pu, *pv;
  float* out;
  char* ws;
};

DI u16 f2bf(float x) { unsigned u = __float_as_uint(x); u += 0x7fffu + ((u >> 16) & 1u); return (u16)(u >> 16); }
DI float bf2f(u16 b) { return __uint_as_float(((unsigned)b) << 16); }
typedef __bf16 bf16x2_t __attribute__((ext_vector_type(2)));
DI unsigned pack2(float a, float b) { bf16x2_t v = {(__bf16)a, (__bf16)b}; return __builtin_bit_cast(unsigned, v); }
DI float bflo(unsigned u) { return __uint_as_float(u << 16); }
DI float bfhi(unsigned u) { return __uint_as_float(u & 0xffff0000u); }
DI float wave_sum(float v) {
  v += __shfl_xor(v, 32); v += __shfl_xor(v, 16); v += __shfl_xor(v, 8); v += __shfl_xor(v, 4); v += __shfl_xor(v, 2); v += __shfl_xor(v, 1);
  return v;
}
DI void gld16(u32x4& dst, const void* ptr) { asm volatile("global_load_dwordx4 %0, %1, off" : "=v"(dst) : "v"(ptr) : "memory"); }
DI void vm_wait8(u32x4& a, u32x4& b, u32x4& c, u32x4& d, u32x4& e, u32x4& f, u32x4& g, u32x4& h) {
  asm volatile("s_waitcnt vmcnt(0)" : "+v"(a), "+v"(b), "+v"(c), "+v"(d), "+v"(e), "+v"(f), "+v"(g), "+v"(h) : : "memory");
}
template <int N> DI void vm_wait8n(u32x4& a, u32x4& b, u32x4& c, u32x4& d, u32x4& e, u32x4& f, u32x4& g, u32x4& h) {
  asm volatile("s_waitcnt vmcnt(%8)" : "+v"(a), "+v"(b), "+v"(c), "+v"(d), "+v"(e), "+v"(f), "+v"(g), "+v"(h) : "n"(N) : "memory");
}
template <int N> DI void vm_wait3n(u32x4& a, u32x4& b, u32x4& c) { asm volatile("s_waitcnt vmcnt(%3)" : "+v"(a), "+v"(b), "+v"(c) : "n"(N) : "memory"); }
DI void vm_wait3(u32x4& a, u32x4& b, u32x4& c) { asm volatile("s_waitcnt vmcnt(0)" : "+v"(a), "+v"(b), "+v"(c) : : "memory"); }
DI void vm_wait6(u32x4& a, u32x4& b, u32x4& c, u32x4& d, u32x4& e, u32x4& f) {
  asm volatile("s_waitcnt vmcnt(0)" : "+v"(a), "+v"(b), "+v"(c), "+v"(d), "+v"(e), "+v"(f) : : "memory");
}
DI int opaque_tid() { int t = threadIdx.x; asm volatile("" : "+v"(t)); return t; }
DI int crow(int reg, int h) { return (reg & 3) + 8 * (reg >> 2) + 4 * h; }

__device__ void phase0(const Params& p, char* smem) {
  const int tid = threadIdx.x, lane = tid & 63, wid = tid >> 6;
  const int gw = blockIdx.x * NWAVE + wid, nw = gridDim.x * NWAVE;
  const int gt = blockIdx.x * NTHR + tid, nt = gridDim.x * NTHR;
  u16* xnb = (u16*)(p.ws + OFF_XNB);
  for (int row = gw; row < T_TOK; row += nw) {
    const float4* xr = (const float4*)(p.x + (size_t)row * 1024);
    float4 v[4]; float ss = 0.f;
#pragma unroll
    for (int i = 0; i < 4; ++i) { v[i] = xr[lane + 64 * i]; ss += v[i].x * v[i].x + v[i].y * v[i].y + v[i].z * v[i].z + v[i].w * v[i].w; }
    ss = wave_sum(ss);
    const float r = rsqrtf(ss * (1.f / 1024.f) + 1e-6f);
    uint2* dst = (uint2*)(xnb + (size_t)row * 1024);
#pragma unroll
    for (int i = 0; i < 4; ++i) dst[lane + 64 * i] = make_uint2(pack2(v[i].x * r, v[i].y * r), pack2(v[i].z * r, v[i].w * r));
  }
  float* tile = (float*)smem;
  for (int job = blockIdx.x; job < 1536; job += gridDim.x) {
    const float* W; const float* g; u16* outp; int N, j;
    if (job < 768) { W = p.w_in; g = p.g_attn; outp = (u16*)(p.ws + OFF_WIN); N = 3072; j = job; }
    else if (job < 1024) { W = p.w_out; g = nullptr; outp = (u16*)(p.ws + OFF_WOUT); N = 1024; j = job - 768; }
    else { W = p.w_pq; g = p.g_ffn; outp = (u16*)(p.ws + OFF_WPQ); N = 2048; j = job - 1024; }
    const int ntn = N >> 6, kt = j / ntn, ntile = j % ntn;
    const int tx = tid & 63, ty = tid >> 6;
#pragma unroll 4
    for (int r = 0; r < 8; ++r) {
      const int k = kt * 64 + ty + 8 * r;
      float v = W[(size_t)k * N + ntile * 64 + tx];
      if (g) v *= g[k];
      tile[(ty + 8 * r) * 65 + tx] = v;
    }
    __syncthreads();
#pragma unroll 4
    for (int r = 0; r < 8; ++r) {
      const int nl = ty + 8 * r;
      int drow = ntile * 64 + nl;
      if (job < 768) {
        const int pos = nl < 16 ? ((nl & 3) | ((nl & 4) << 1) | ((nl & 8) >> 1)) : nl;
        drow = 256 * (ntile >> 2) + 128 * (pos >> 5) + 32 * (ntile & 3) + (pos & 31);
      }
      outp[(size_t)drow * 1024 + kt * 64 + tx] = f2bf(tile[tx * 65 + nl]);
    }
    __syncthreads();
  }
  {
    const float4* s = (const float4*)p.subk; uint2* d = (uint2*)(p.ws + OFF_SUBK);
    for (int i = gt; i < 262144 / 4; i += nt) { float4 v = s[i]; d[i] = make_uint2(pack2(v.x, v.y), pack2(v.z, v.w)); }
    const float4* su = (const float4*)p.pu; int* du = (int*)(p.ws + OFF_PUB);
    const float4* sv = (const float4*)p.pv; int* dv = (int*)(p.ws + OFF_PVB);
    for (int i = gt; i < 16384 * 1024 / 4; i += nt) {
      float4 a = su[i]; float4 b = sv[i];
      int ra = __builtin_amdgcn_cvt_pk_fp8_f32(a.x * USCALE, a.y * USCALE, 0, false);
      ra = __builtin_amdgcn_cvt_pk_fp8_f32(a.z * USCALE, a.w * USCALE, ra, true);
      int rb = __builtin_amdgcn_cvt_pk_fp8_f32(b.x * VSCALE, b.y * VSCALE, 0, false);
      rb = __builtin_amdgcn_cvt_pk_fp8_f32(b.z * VSCALE, b.w * VSCALE, rb, true);
      du[i] = ra; dv[i] = rb;
    }
  }
  {
    float* rc = (float*)(p.ws + OFF_ROPEC); float* rs = (float*)(p.ws + OFF_ROPES);
    for (int i = gt; i < SEQ * 8; i += nt) {
      const int pos = i >> 3, f = i & 7;
      const float invf = (float)pow(500000.0, -(double)f / 8.0);
      const float ang = (float)pos * invf;
      rc[i] = (float)cos((double)ang); rs[i] = (float)sin((double)ang);
    }
    float* hss = (float*)(p.ws + OFF_HSS);
    for (int i = gt; i < T_TOK; i += nt) hss[i] = 0.f;
    if (gt < 256) {
      float* gtab = (float*)(p.ws + OFF_MISC + 1024);
      gtab[gt] = gt < 64 ? p.qna[gt] : gt < 128 ? p.kna[gt - 64] : gt < 192 ? p.qnb[gt - 128] : p.knb[gt - 192];
    }
    if (gt == 0) {
      float a = 0.f, b = 0.f;
      for (int i = 0; i < 64; ++i) { a += p.lq1[i] * p.lk1[i]; b += p.lq2[i] * p.lk2[i]; }
      float* misc = (float*)(p.ws + OFF_MISC);
      misc[0] = expf(a) - expf(b) + 0.2f;
      ((int*)misc)[1] = 0; ((int*)misc)[2] = 0;
    }
  }
}

DI void gemm_mainloop(const u16* __restrict__ A, const u16* __restrict__ Bt, int m0, int n0, char* smem, f32x16 (&acc)[2][2]) {
  u16* As = (u16*)smem;
  u16* Bs = As + 2 * 128 * 72;
  const int tid = opaque_tid() & 255, lane = tid & 63, w = tid >> 6, wm = w >> 1, wn = w & 1, lr = lane & 31, lh = lane >> 5;
#pragma unroll
  for (int a = 0; a < 2; ++a)
#pragma unroll
    for (int b = 0; b < 2; ++b)
#pragma unroll
      for (int r = 0; r < 16; ++r) acc[a][b][r] = 0.f;
  u32x4 raA[4], rbA[4], raB[4], rbB[4];
  const int lrow = tid >> 3, lkc = tid & 7;
  const u16* Ag = A + (size_t)(m0 + lrow) * 1024 + lkc * 8;
  const u16* Bg = Bt + (size_t)(n0 + lrow) * 1024 + lkc * 8;
#define GLOAD(S_, kt) { _Pragma("unroll") for (int i = 0; i < 4; ++i) { gld16(ra##S_[i], Ag + (size_t)i * 32 * 1024 + (kt) * 64); gld16(rb##S_[i], Bg + (size_t)i * 32 * 1024 + (kt) * 64); } }
#define SWRITE(S_, buf, NW_) { vm_wait8n<NW_>(ra##S_[0], ra##S_[1], ra##S_[2], ra##S_[3], rb##S_[0], rb##S_[1], rb##S_[2], rb##S_[3]); \
    _Pragma("unroll") for (int i = 0; i < 4; ++i) { *(u32x4*)(As + ((buf) * 128 + lrow + 32 * i) * 72 + lkc * 8) = ra##S_[i]; *(u32x4*)(Bs + ((buf) * 128 + lrow + 32 * i) * 72 + lkc * 8) = rb##S_[i]; } }
#define GCOMPUTE(buf) { \
    const u16* ab = As + ((buf) * 128 + wm * 64 + lr) * 72 + lh * 8; \
    const u16* bb = Bs + ((buf) * 128 + wn * 64 + lr) * 72 + lh * 8; \
    _Pragma("unroll") for (int s = 0; s < 4; ++s) { \
      const bf16x8 a0 = *(const bf16x8*)(ab + s * 16), a1 = *(const bf16x8*)(ab + 32 * 72 + s * 16); \
      const bf16x8 b0 = *(const bf16x8*)(bb + s * 16), b1 = *(const bf16x8*)(bb + 32 * 72 + s * 16); \
      acc[0][0] = MFMA(a0, b0, acc[0][0]); acc[0][1] = MFMA(a0, b1, acc[0][1]); \
      acc[1][0] = MFMA(a1, b0, acc[1][0]); acc[1][1] = MFMA(a1, b1, acc[1][1]); } }
  GLOAD(A, 0); SWRITE(A, 0, 0); GLOAD(A, 1); __syncthreads();
  for (int kt = 0; kt < 14; kt += 2) {
    GLOAD(B, kt + 2);
    GCOMPUTE(0);
    SWRITE(A, 1, 8);
    __syncthreads();
    GLOAD(A, kt + 3);
    GCOMPUTE(1);
    SWRITE(B, 0, 8);
    __syncthreads();
  }
  GCOMPUTE(0);
  SWRITE(A, 1, 0);
  __syncthreads();
  GCOMPUTE(1);
  __syncthreads();
#undef GCOMPUTE
#undef GLOAD
#undef SWRITE
}

DI void stage_acc(const f32x16 (&acc)[2][2], float* st) {
  const int tid = threadIdx.x & 255, lane = tid & 63, w = tid >> 6, wm = w >> 1, wn = w & 1, lr = lane & 31, lh = lane >> 5;
#pragma unroll
  for (int mt = 0; mt < 2; ++mt)
#pragma unroll
    for (int nt = 0; nt < 2; ++nt)
#pragma unroll
      for (int r = 0; r < 16; ++r) st[(wm * 64 + mt * 32 + crow(r, lh)) * 132 + wn * 64 + nt * 32 + lr] = acc[mt][nt][r];
}

namespace pg8 {
#define PG8_LAS __attribute__((address_space(3)))
typedef unsigned short bf16_t;
typedef short bf16x8 __attribute__((ext_vector_type(8)));
typedef float f32x4 __attribute__((ext_vector_type(4)));
typedef unsigned u32x4 __attribute__((ext_vector_type(4)));
constexpr int BM = 256, BK = 64, HALF = 128, HTB = HALF * BK * 2  , STAGE_BYTES = 8 * HTB, NXCD = 8, WGM = 8;

__host__ __device__ __forceinline__ int lds_byte(int r, int c) { const int st = (r >> 4) * 2 + (c >> 5), rr = r & 15, cc = c & 31, ob = rr * 64 + cc * 2; return st * 1024 + (ob ^ (((ob >> 9) & 1) << 5)); }
__host__ __device__ __forceinline__ void stage_rc(int b, int& R, int& C) { const int st = b / 1024, sb = b % 1024, swz = sb ^ (((sb >> 9) & 1) << 5); R = (st >> 1) * 16 + swz / 64; C = (st & 1) * 32 + (swz % 64) / 2; }
__host__ __device__ __forceinline__ int perm32(int rho) { const int n = rho >> 4, i = rho & 15; return 8 * (i >> 2) + 4 * n + (i & 3); }

struct Unit { int pm, pn; };
struct Gemm { const bf16_t* A; const bf16_t* Bt; int M, N, K; };

struct StaticOrder {
    int nM, nN, nwg, G, c;
    __host__ __device__ void init(int M, int N, int G_, int c_) { nM = M / BM; nN = N / BM; nwg = nM * nN; G = G_; c = c_; }
    __host__ __device__ bool next(int i, Unit& u) const {
        const long L = (long)i * G + c; if (L >= nwg) return false;
        int wgid = (int)L; { const int q = nwg / NXCD, r = nwg % NXCD, xcd = wgid % NXCD, off = wgid / NXCD; wgid = (xcd < r ? xcd * (q + 1) : r * (q + 1) + (xcd - r) * q) + off; }
        const int nig = WGM * nN, gid = wgid / nig, fm = gid * WGM, gsz = (nM - fm) < WGM ? (nM - fm) : WGM;
        u.pm = fm + ((wgid % nig) % gsz); u.pn = (wgid % nig) / gsz; return true;
    }
    __device__ __forceinline__ void a_ready(const Unit&) const {}
    __device__ __forceinline__ void done(const Unit&) const {}
};
template <class Epi, class Sched, bool STAMP = false>
__device__ __forceinline__ void gemm_phase(PG8_LAS unsigned char* lds, const Gemm g, const Sched& S, const Epi& E, unsigned long long* stamps) {
    const int tid = threadIdx.x, wid = __builtin_amdgcn_readfirstlane(tid >> 6), lane = tid & 63, wr = wid >> 2, wc = wid & 3, fr = lane & 15, fq = lane >> 4;
    const int K = g.K, nt = K / BK;
    int ts_lo = 0, ts_hi = 0, nts = 0; const unsigned long long rt_entry = STAMP ? (unsigned long long)wall_clock64() : 0ull;
#define PG8_STAMP() do { if (STAMP && wid == 0 && nts < 64) { const unsigned long long _c = (unsigned long long)clock64(); \
        ts_lo = (lane == nts) ? (int)(unsigned)_c : ts_lo; ts_hi = (lane == nts) ? (int)(unsigned)(_c >> 32) : ts_hi; ++nts; } } while (0)
    PG8_STAMP();
    unsigned voffA[2], voffB[2];
#pragma unroll
    for (int i = 0; i < 2; ++i) { int R, C; stage_rc(tid * 16 + i * 8192, R, C); const int Rb = Epi::PERM ? ((R & ~31) + perm32(R & 31)) : R;
        voffA[i] = (unsigned)(R * K + C) * 2u; voffB[i] = (unsigned)(Rb * K + C) * 2u; }
    const size_t kstep = (size_t)(BK * 2);
    const size_t hstep = (size_t)HALF * K * 2;
    const size_t tstep = 2 * hstep;
    const unsigned ldsw = (unsigned)wid * 1024u;
    const int aoff = lds_byte(wr * 64 + fr, fq * 8), boff = lds_byte(wc * 32 + fr, fq * 8);
#define PG8_SA(b, h) (((b) * 2 + (h)) * HTB)
#define PG8_SB(b, h) ((4 + (b) * 2 + (h)) * HTB)
#define PG8_STAGE(bufoff, gbase, voff) do { _Pragma("unroll") for (int _i = 0; _i < 2; ++_i) \
        __builtin_amdgcn_global_load_lds((const unsigned*)((const char*)(gbase) + (voff)[_i]), (PG8_LAS unsigned*)(lds + (bufoff) + ldsw + _i * 8192), 16, 0, 0); } while (0)
#define PG8_LDA(dst, b, h) do { _Pragma("unroll") for (int m = 0; m < 4; ++m) _Pragma("unroll") for (int k = 0; k < 2; ++k) dst[m][k] = *(const PG8_LAS bf16x8*)(lds + PG8_SA(b, h) + aoff + m * 2048 + k * 1024); } while (0)
#define PG8_LDB(dst, b, h) do { _Pragma("unroll") for (int n = 0; n < 2; ++n) _Pragma("unroll") for (int k = 0; k < 2; ++k) dst[n][k] = *(const PG8_LAS bf16x8*)(lds + PG8_SB(b, h) + boff + n * 2048 + k * 1024); } while (0)
#define PG8_MMA(ai, bj, At, Bt) do { __builtin_amdgcn_s_setprio(1); _Pragma("unroll") for (int m = 0; m < 4; ++m) _Pragma("unroll") for (int n = 0; n < 2; ++n) _Pragma("unroll") for (int k = 0; k < 2; ++k) \
        acc[ai][bj][m][n] = __builtin_amdgcn_mfma_f32_16x16x32_bf16(Bt[n][k], At[m][k], acc[ai][bj][m][n], 0, 0, 0); __builtin_amdgcn_s_setprio(0); } while (0)
#define PG8_WAIT_V(n) asm volatile("s_waitcnt vmcnt(" #n ")" ::: "memory")
#define PG8_WAIT_L(n) asm volatile("s_waitcnt lgkmcnt(" #n ")" ::: "memory")
#define PG8_BAR __builtin_amdgcn_s_barrier()
#define PG8_SCHED __builtin_amdgcn_sched_barrier(0)
    Unit cur, nxt; int ui = 0;
    if (!S.next(0, cur)) return;
    f32x4 acc[2][2][4][2];
#pragma unroll
    for (int a = 0; a < 2; ++a)
#pragma unroll
        for (int b = 0; b < 2; ++b)
#pragma unroll
            for (int m = 0; m < 4; ++m)
#pragma unroll
                for (int n = 0; n < 2; ++n) acc[a][b][m][n] = (f32x4){0.f, 0.f, 0.f, 0.f};
    bf16x8 At[4][2], B0[2][2], B1[2][2];
    const char* cA = (const char*)g.A + (size_t)cur.pm * tstep; const char* cB = (const char*)g.Bt + (size_t)cur.pn * tstep;
    S.a_ready(cur);
    PG8_STAGE(PG8_SB(0, 0), cB, voffB); PG8_STAGE(PG8_SA(0, 0), cA, voffA); PG8_STAGE(PG8_SB(0, 1), cB + hstep, voffB); PG8_STAGE(PG8_SA(0, 1), cA + hstep, voffA);
    if (wr == 1) PG8_BAR;
    PG8_WAIT_V(4); PG8_BAR;
    PG8_STAGE(PG8_SB(1, 0), cB + kstep, voffB); PG8_STAGE(PG8_SA(1, 0), cA + kstep, voffA); PG8_STAGE(PG8_SB(1, 1), cB + hstep + kstep, voffB);
    PG8_WAIT_V(6); PG8_BAR;
    PG8_STAMP();
    for (;;) {
        const bool has_next = S.next(ui + 1, nxt);
        const char* nA = has_next ? (const char*)g.A + (size_t)nxt.pm * tstep : cA; const char* nB = has_next ? (const char*)g.Bt + (size_t)nxt.pn * tstep : cB;
        for (int t = 0; t < nt; t += 2) {
            const bool last = (t == nt - 2);
            const char* a1 = cA + (size_t)(t + 1) * kstep;
            const char* a2 = last ? nA : cA + (size_t)(t + 2) * kstep; const char* b2 = last ? nB : cB + (size_t)(t + 2) * kstep;
            const char* a3 = a2 + kstep; const char* b3 = b2 + kstep;
            if (last && has_next) S.a_ready(nxt);
            PG8_LDB(B0, 0, 0); PG8_SCHED; PG8_LDA(At, 0, 0); PG8_STAGE(PG8_SA(1, 1), a1 + hstep, voffA);
            PG8_WAIT_L(8); PG8_BAR; PG8_WAIT_L(0); PG8_MMA(0, 0, At, B0); PG8_BAR; PG8_SCHED;
            PG8_LDB(B1, 0, 1); PG8_STAGE(PG8_SB(0, 0), b2, voffB);
            PG8_BAR; PG8_WAIT_L(0); PG8_MMA(0, 1, At, B1); PG8_BAR;
            PG8_LDA(At, 0, 1); PG8_STAGE(PG8_SA(0, 0), a2, voffA);
            PG8_BAR; PG8_WAIT_L(0); PG8_MMA(1, 0, At, B0); PG8_BAR; PG8_SCHED;
            PG8_STAGE(PG8_SB(0, 1), b2 + hstep, voffB);
            PG8_WAIT_V(6); PG8_BAR; PG8_MMA(1, 1, At, B1); PG8_BAR;
            PG8_LDB(B0, 1, 0); PG8_SCHED; PG8_LDA(At, 1, 0); PG8_STAGE(PG8_SA(0, 1), a2 + hstep, voffA);
            PG8_WAIT_L(8); PG8_BAR; PG8_WAIT_L(0); PG8_MMA(0, 0, At, B0); PG8_BAR; PG8_SCHED;
            PG8_LDB(B1, 1, 1); PG8_STAGE(PG8_SB(1, 0), b3, voffB);
            PG8_BAR; PG8_WAIT_L(0); PG8_MMA(0, 1, At, B1); PG8_BAR;
            PG8_LDA(At, 1, 1); PG8_STAGE(PG8_SA(1, 0), a3, voffA);
            PG8_BAR; PG8_WAIT_L(0); PG8_MMA(1, 0, At, B0); PG8_BAR; PG8_SCHED;
            PG8_STAGE(PG8_SB(1, 1), b3 + hstep, voffB);
            PG8_WAIT_V(6); PG8_BAR; PG8_MMA(1, 1, At, B1); PG8_BAR;
        }
        PG8_STAMP();
        if constexpr (!Epi::AFTER_DRAIN) { E(acc, cur, wr, wc, fr, fq); S.done(cur); }
        PG8_STAMP();
        if (!has_next) break;
#pragma unroll
        for (int a = 0; a < 2; ++a)
#pragma unroll
            for (int b = 0; b < 2; ++b)
#pragma unroll
                for (int m = 0; m < 4; ++m)
#pragma unroll
                    for (int n = 0; n < 2; ++n) acc[a][b][m][n] = (f32x4){0.f, 0.f, 0.f, 0.f};
        cur = nxt; cA = nA; cB = nB; ++ui;
    }
    PG8_WAIT_V(0);
    if (wr == 0) PG8_BAR;
    PG8_BAR;
    if constexpr (Epi::AFTER_DRAIN) { E.fused(acc, cur, wr, wc, fr, fq, lds, wid, lane); S.done(cur); }
    PG8_STAMP();
    if (STAMP && wid == 0) { stamps[lane] = lane < nts ? (((unsigned long long)(unsigned)ts_hi << 32) | (unsigned)ts_lo) : 0ull;
        if (lane == 62) stamps[62] = rt_entry; if (lane == 63) stamps[63] = (unsigned long long)wall_clock64(); }
#undef PG8_STAMP
#undef PG8_SA
#undef PG8_SB
#undef PG8_STAGE
#undef PG8_LDA
#undef PG8_LDB
#undef PG8_MMA
#undef PG8_WAIT_V
#undef PG8_WAIT_L
#undef PG8_BAR
#undef PG8_SCHED
}
}

__device__ void phase1_tile(const Params& p, int mtile, int j, char* smem) {
  f32x16 acc[2][2];
  const int m0 = mtile * 128, n0 = j * 128;
  gemm_mainloop((const u16*)(p.ws + OFF_XNB), (const u16*)(p.ws + OFF_WIN), m0, n0, smem, acc);
  float* st = (float*)smem;
  stage_acc(acc, st);
  __syncthreads();
  const int tid = threadIdx.x & 255, row = tid & 127, half = tid >> 7;
  const int sec = j >> 2;
  const int tok = m0 + row, b = tok >> 12, s = tok & 4095;
  float v[64];
#pragma unroll
  for (int c = 0; c < 16; ++c) { const float4 t4 = *(const float4*)(st + row * 132 + half * 64 + c * 4); v[4 * c] = t4.x; v[4 * c + 1] = t4.y; v[4 * c + 2] = t4.z; v[4 * c + 3] = t4.w; }
  if (sec != 2 && sec != 5) {
    const float* g = sec == 0 ? p.qna : sec == 1 ? p.kna : sec == 3 ? p.qnb : p.knb;
    float ss = 0.f;
#pragma unroll
    for (int i = 0; i < 64; ++i) ss += v[i] * v[i];
    float r = rsqrtf(ss * (1.f / 64.f) + 1e-6f);
    const float post = (sec == 0 || sec == 3) ? QSCALE : 1.f;
#pragma unroll
    for (int i = 0; i < 64; ++i) v[i] = v[i] * r * g[i];
    const float* rc = (const float*)(p.ws + OFF_ROPEC) + s * 8;
    const float* rs = (const float*)(p.ws + OFF_ROPES) + s * 8;
#pragma unroll
    for (int i = 0; i < 8; ++i) {
      const float c = rc[i], sn = rs[i], x1 = v[i], x2 = v[i + 8];
      v[i] = x1 * c - x2 * sn; v[i + 8] = x2 * c + x1 * sn;
    }
#pragma unroll
    for (int i = 0; i < 64; ++i) v[i] *= post;
  }
  u16* dst;
  if (sec == 5) {
    dst = (u16*)(p.ws + OFF_VB) + ((size_t)(b * 4 + (j & 3)) * 4096 + s) * 128 + half * 64;
  } else {
    const size_t off = sec == 0 ? OFF_QA : sec == 1 ? OFF_KA : sec == 2 ? OFF_VA : sec == 3 ? OFF_QB : OFF_KB;
    const int hc = (j & 3) * 2 + half;
    dst = (u16*)(p.ws + off) + ((size_t)(b * 8 + hc) * 4096 + s) * 64;
  }
#pragma unroll
  for (int c = 0; c < 8; ++c)
    ((uint4*)dst)[c] = make_uint4(pack2(v[8 * c], v[8 * c + 1]), pack2(v[8 * c + 2], v[8 * c + 3]), pack2(v[8 * c + 4], v[8 * c + 5]), pack2(v[8 * c + 6], v[8 * c + 7]));
  __syncthreads();
}

template <int OFF> DI s16x4 tr_read(unsigned addr) {
  s16x4 r; asm volatile("ds_read_b64_tr_b16 %0, %1 offset:%2" : "=v"(r) : "v"(addr), "n"(OFF) : "memory"); return r;
}
DI void wait_tr8(s16x4& a0, s16x4& a1, s16x4& a2, s16x4& a3, s16x4& a4, s16x4& a5, s16x4& a6, s16x4& a7) {
  asm volatile("s_waitcnt lgkmcnt(0)" : "+v"(a0), "+v"(a1), "+v"(a2), "+v"(a3), "+v"(a4), "+v"(a5), "+v"(a6), "+v"(a7) : : "memory");
}

#define TR_ISSUE(S_, MT_) { const unsigned a0_ = vaddr + (MT_) * 64; \
        S_##0 = tr_read<0 * 16 * VST * 2>(a0_); S_##1 = tr_read<(0 * 16 + 8) * VST * 2>(a0_); S_##2 = tr_read<1 * 16 * VST * 2>(a0_); S_##3 = tr_read<(1 * 16 + 8) * VST * 2>(a0_); \
        S_##4 = tr_read<2 * 16 * VST * 2>(a0_); S_##5 = tr_read<(2 * 16 + 8) * VST * 2>(a0_); S_##6 = tr_read<3 * 16 * VST * 2>(a0_); S_##7 = tr_read<(3 * 16 + 8) * VST * 2>(a0_); }
#define TR_MFMA(S_, MT_) { \
        o[MT_] = MFMA(__builtin_shufflevector(S_##0, S_##1, 0, 1, 2, 3, 4, 5, 6, 7), pf[0], o[MT_]); o[MT_] = MFMA(__builtin_shufflevector(S_##2, S_##3, 0, 1, 2, 3, 4, 5, 6, 7), pf[1], o[MT_]); \
        o[MT_] = MFMA(__builtin_shufflevector(S_##4, S_##5, 0, 1, 2, 3, 4, 5, 6, 7), pf[2], o[MT_]); o[MT_] = MFMA(__builtin_shufflevector(S_##6, S_##7, 0, 1, 2, 3, 4, 5, 6, 7), pf[3], o[MT_]); }
template <int DV, bool CAUSAL>
__device__ void attn_unit(const u16* __restrict__ qbase, const u16* __restrict__ kbase, const u16* __restrict__ vbase, int q0, int kb0, int kt_begin, int kt_end,
                          int dil, int res, u16* __restrict__ obase, int ostride, float* __restrict__ lsebase, char* smem) {
  constexpr int VST = DV + 8;
  constexpr int NMT = DV / 32;
  constexpr int WMAX = CAUSAL ? (1 << 30) : 128;
  u16* Ks = (u16*)smem;
  u16* Vs = Ks + 3 * 64 * 72;
  const int tid = opaque_tid(), lane = tid & 63, w = tid >> 6, lr = lane & 31, lh = lane >> 5;
  const int mq = q0 + 32 * w + lr;
  const size_t tq = (size_t)mq * dil + res;
  bf16x8 qf[4];
  {
    const u16* qp = qbase + tq * 64 + lh * 8;
#pragma unroll
    for (int s = 0; s < 4; ++s) qf[s] = *(const bf16x8*)(qp + s * 16);
    asm volatile("" : "+v"(qf[0]), "+v"(qf[1]), "+v"(qf[2]), "+v"(qf[3]));
  }
  f32x16 o[NMT];
#pragma unroll
  for (int mt = 0; mt < NMT; ++mt)
#pragma unroll
    for (int r = 0; r < 16; ++r) o[mt][r] = 0.f;
  float m_run = 0.f, l_run = 0.f;
  u32x4 rkA, rvA0, rvA1, rkB, rvB0, rvB1;
  rvA1 = rvB1 = (u32x4){0u, 0u, 0u, 0u}; rkB = rvB0 = rvA1;
  const int krow_ = tid >> 3, kkc = tid & 7;
  constexpr int VCPR = DV / 8;
  const int vrow = tid / VCPR, vkc = tid % VCPR;
  const u16* kgp = kbase + ((size_t)(kb0 + krow_) * dil + res) * 64 + kkc * 8;
  const u16* vgp = vbase + ((size_t)(kb0 + vrow) * dil + res) * DV + vkc * 8;
  const size_t kstep64 = (size_t)64 * dil * 64;
  const size_t vstep32 = (size_t)32 * dil * DV, vstep64 = (size_t)64 * dil * DV;
  u16* ksw = Ks + krow_ * 72 + kkc * 8;
  u16* vsw = Vs + vrow * VST + vkc * 8;
#define AGLOAD(S_, kt) { gld16(rk##S_, kgp + (size_t)(kt) * kstep64); const u16* vp_ = vgp + (size_t)(kt) * vstep64; gld16(rv##S_##0, vp_); if (NMT == 4) gld16(rv##S_##1, vp_ + vstep32); }
#define ASWRITE(S_, buf, NW_) { vm_wait3n<NW_>(rk##S_, rv##S_##0, rv##S_##1); *(u32x4*)(ksw + (buf) * 64 * 72) = rk##S_; *(u32x4*)(vsw + (buf) * 64 * VST) = rv##S_##0; \
    if (NMT == 4) *(u32x4*)(vsw + (buf) * 64 * VST + 32 * VST) = rv##S_##1; }
  constexpr int NLD = (NMT == 4) ? 3 : 2;
  AGLOAD(A, kt_begin); AGLOAD(B, kt_begin + 1); ASWRITE(A, 0, 0); ASWRITE(B, 1, 0);
  { const int ktl = (kt_begin + 2 < kt_end) ? kt_begin + 2 : kt_end - 1; AGLOAD(A, ktl); }
  __syncthreads();
  const int li = lane & 31, blk = li >> 4, tq_ = (li >> 2) & 3, tp = li & 3;
#define TRR(MT_, KS_, HI_) tr_read<((KS_) * 16 + 8 * (HI_)) * VST * 2 + (MT_) * 64>(vaddr)
#define CAT8(L_, H_) __builtin_shufflevector(L_, H_, 0, 1, 2, 3, 4, 5, 6, 7)
#define ATT_S2(BUF_) { const unsigned vaddr = (unsigned)(size_t)(Vs + ((BUF_) * 64 + 4 * lh + tq_) * VST + 16 * blk + 4 * tp); \
      s16x4 va0, va1, va2, va3, va4, va5, va6, va7; \
      if (NMT == 4) { \
        va0 = TRR(0, 0, 0); va1 = TRR(0, 0, 1); va2 = TRR(1, 0, 0); va3 = TRR(1, 0, 1); va4 = TRR(2, 0, 0); va5 = TRR(2, 0, 1); va6 = TRR(3 % NMT, 0, 0); va7 = TRR(3 % NMT, 0, 1); \
        wait_tr8(va0, va1, va2, va3, va4, va5, va6, va7); \
        o[0] = MFMA(CAT8(va0, va1), pf[0], o[0]); o[1] = MFMA(CAT8(va2, va3), pf[0], o[1]); o[2 % NMT] = MFMA(CAT8(va4, va5), pf[0], o[2 % NMT]); o[3 % NMT] = MFMA(CAT8(va6, va7), pf[0], o[3 % NMT]); \
        va0 = TRR(0, 1, 0); va1 = TRR(0, 1, 1); va2 = TRR(1, 1, 0); va3 = TRR(1, 1, 1); va4 = TRR(2, 1, 0); va5 = TRR(2, 1, 1); va6 = TRR(3 % NMT, 1, 0); va7 = TRR(3 % NMT, 1, 1); \
        wait_tr8(va0, va1, va2, va3, va4, va5, va6, va7); \
        o[0] = MFMA(CAT8(va0, va1), pf[1], o[0]); o[1] = MFMA(CAT8(va2, va3), pf[1], o[1]); o[2 % NMT] = MFMA(CAT8(va4, va5), pf[1], o[2 % NMT]); o[3 % NMT] = MFMA(CAT8(va6, va7), pf[1], o[3 % NMT]); \
        va0 = TRR(0, 2, 0); va1 = TRR(0, 2, 1); va2 = TRR(1, 2, 0); va3 = TRR(1, 2, 1); va4 = TRR(2, 2, 0); va5 = TRR(2, 2, 1); va6 = TRR(3 % NMT, 2, 0); va7 = TRR(3 % NMT, 2, 1); \
        wait_tr8(va0, va1, va2, va3, va4, va5, va6, va7); \
        o[0] = MFMA(CAT8(va0, va1), pf[2], o[0]); o[1] = MFMA(CAT8(va2, va3), pf[2], o[1]); o[2 % NMT] = MFMA(CAT8(va4, va5), pf[2], o[2 % NMT]); o[3 % NMT] = MFMA(CAT8(va6, va7), pf[2], o[3 % NMT]); \
        va0 = TRR(0, 3, 0); va1 = TRR(0, 3, 1); va2 = TRR(1, 3, 0); va3 = TRR(1, 3, 1); va4 = TRR(2, 3, 0); va5 = TRR(2, 3, 1); va6 = TRR(3 % NMT, 3, 0); va7 = TRR(3 % NMT, 3, 1); \
        wait_tr8(va0, va1, va2, va3, va4, va5, va6, va7); \
        o[0] = MFMA(CAT8(va0, va1), pf[3], o[0]); o[1] = MFMA(CAT8(va2, va3), pf[3], o[1]); o[2 % NMT] = MFMA(CAT8(va4, va5), pf[3], o[2 % NMT]); o[3 % NMT] = MFMA(CAT8(va6, va7), pf[3], o[3 % NMT]); \
      } else { \
        va0 = TRR(0, 0, 0); va1 = TRR(0, 0, 1); va2 = TRR(1, 0, 0); va3 = TRR(1, 0, 1); va4 = TRR(0, 1, 0); va5 = TRR(0, 1, 1); va6 = TRR(1, 1, 0); va7 = TRR(1, 1, 1); \
        wait_tr8(va0, va1, va2, va3, va4, va5, va6, va7); \
        o[0] = MFMA(CAT8(va0, va1), pf[0], o[0]); o[1] = MFMA(CAT8(va2, va3), pf[0], o[1]); o[0] = MFMA(CAT8(va4, va5), pf[1], o[0]); o[1] = MFMA(CAT8(va6, va7), pf[1], o[1]); \
        va0 = TRR(0, 2, 0); va1 = TRR(0, 2, 1); va2 = TRR(1, 2, 0); va3 = TRR(1, 2, 1); va4 = TRR(0, 3, 0); va5 = TRR(0, 3, 1); va6 = TRR(1, 3, 0); va7 = TRR(1, 3, 1); \
        wait_tr8(va0, va1, va2, va3, va4, va5, va6, va7); \
        o[0] = MFMA(CAT8(va0, va1), pf[2], o[0]); o[1] = MFMA(CAT8(va2, va3), pf[2], o[1]); o[0] = MFMA(CAT8(va4, va5), pf[3], o[0]); o[1] = MFMA(CAT8(va6, va7), pf[3], o[1]); \
      } }
  bf16x8 pf[4];
  f32x16 stA[2], stB[2];
  int b3 = 0;
  const int q_lo = q0 + 32 * w;
#define ATT_QK(ST_, SLOT_) { const u16* kb_ = Ks + ((SLOT_) * 64 + lr) * 72 + lh * 8; \
_Pragma("unroll") \
    for (int kk = 0; kk < 2; ++kk) \
_Pragma("unroll") \
      for (int r = 0; r < 16; ++r) ST_[kk][r] = -m_run; \
_Pragma("unroll") \
    for (int s = 0; s < 4; ++s) \
_Pragma("unroll") \
      for (int kk = 0; kk < 2; ++kk) { const bf16x8 a = *(const bf16x8*)(kb_ + kk * 32 * 72 + s * 16); ST_[kk] = MFMA(a, qf[s], ST_[kk]); } }
  { const int k_lo = kb0 + 64 * kt_begin; const int dmin = q_lo - (k_lo + 63), dmax = q_lo + 31 - k_lo;
    if (!((dmax < 0) || (dmin > WMAX))) { ATT_QK(stA, 0); } }
#define ATT_STEP(KT_, AGLOAD_Y, ASWRITE_X, CUR, NXT) { const int kt = (KT_); \
    const int sl0 = b3, sl1 = (b3 == 2) ? 0 : b3 + 1, sl2 = (sl1 == 2) ? 0 : sl1 + 1; \
    { const int ktl = (kt + 3 < kt_end) ? kt + 3 : kt_end - 1; AGLOAD_Y(ktl); } \
    __builtin_amdgcn_sched_barrier(0); \
    const int k_lo = kb0 + 64 * kt; \
    const int dmin = q_lo - (k_lo + 63), dmax = q_lo + 31 - k_lo; \
    const bool skip = (dmax < 0) || (dmin > WMAX); \
    const bool skip1 = (kt + 1 >= kt_end) || (dmax - 64 < 0) || (dmin - 64 > WMAX); \
    if (!skip1) { ATT_QK(NXT, sl1); } \
    if (!skip) { \
      const bool need_mask = (dmin < 0) || (dmax > WMAX); \
      if (need_mask) { \
_Pragma("unroll") \
        for (int kk = 0; kk < 2; ++kk) \
_Pragma("unroll") \
          for (int r = 0; r < 16; ++r) { \
            const int d = mq - (k_lo + 32 * kk + crow(r, lh)); \
            if (d < 0 || d > WMAX) CUR[kk][r] = NEG_INF; \
          } \
      } \
      float mx = NEG_INF; \
_Pragma("unroll") \
      for (int kk = 0; kk < 2; ++kk) \
_Pragma("unroll") \
        for (int r = 0; r < 16; r += 2) mx = fmaxf(fmaxf(mx, CUR[kk][r]), CUR[kk][r + 1]); \
      if (__builtin_amdgcn_ballot_w64(mx > SM_THR)) { \
        mx = fmaxf(mx, __shfl_xor(mx, 32)); \
        const float d = fmaxf(mx, 0.f); \
        const float alpha = __builtin_amdgcn_exp2f(-d); \
_Pragma("unroll") \
        for (int kk = 0; kk < 2; ++kk) \
_Pragma("unroll") \
          for (int r = 0; r < 16; ++r) CUR[kk][r] -= d; \
        if (!skip1) { \
_Pragma("unroll") \
          for (int kk = 0; kk < 2; ++kk) \
_Pragma("unroll") \
            for (int r = 0; r < 16; ++r) NXT[kk][r] -= d; \
        } \
        l_run *= alpha; m_run += d; \
_Pragma("unroll") \
        for (int mt = 0; mt < NMT; ++mt) \
_Pragma("unroll") \
          for (int r = 0; r < 16; ++r) o[mt][r] *= alpha; \
      } \
      float ls = 0.f; \
_Pragma("unroll") \
      for (int kk = 0; kk < 2; ++kk) \
_Pragma("unroll") \
        for (int r = 0; r < 16; ++r) { const float e = __builtin_amdgcn_exp2f(CUR[kk][r]); CUR[kk][r] = e; ls += e; } \
      l_run += ls; \
_Pragma("unroll") \
      for (int ks = 0; ks < 4; ++ks) { \
        const int kk = ks >> 1, s2 = ks & 1; \
        u32x4 cv; \
        cv[0] = pack2(CUR[kk][8 * s2 + 0], CUR[kk][8 * s2 + 1]); cv[1] = pack2(CUR[kk][8 * s2 + 2], CUR[kk][8 * s2 + 3]); \
        cv[2] = pack2(CUR[kk][8 * s2 + 4], CUR[kk][8 * s2 + 5]); cv[3] = pack2(CUR[kk][8 * s2 + 6], CUR[kk][8 * s2 + 7]); \
        pf[ks] = __builtin_bit_cast(bf16x8, cv); \
      } \
      ATT_S2(sl0); \
    } \
    ASWRITE_X(sl2); \
    __syncthreads(); \
    b3 = sl1; \
  }
#define LDA(k_) AGLOAD(A, k_)
#define LDB(k_) AGLOAD(B, k_)
#define WRA(b_) ASWRITE(A, b_, NLD)
#define WRB(b_) ASWRITE(B, b_, NLD)
  for (int kt2 = kt_begin; kt2 < kt_end; kt2 += 2) {
    ATT_STEP(kt2, LDB, WRA, stA, stB);
    ATT_STEP(kt2 + 1, LDA, WRB, stB, stA);
  }
#undef LDA
#undef LDB
#undef WRA
#undef WRB
#undef ATT_STEP
#undef ATT_QK
#undef ATT_S2
#undef TRR
#undef CAT8
#undef AGLOAD
#undef ASWRITE
  const float l_tot = l_run + __shfl_xor(l_run, 32);
  const float inv = 1.f / l_tot;
  u16* op = obase + tq * ostride;
#pragma unroll
  for (int mt = 0; mt < NMT; ++mt)
#pragma unroll
    for (int g = 0; g < 4; ++g) {
      const int dv0 = 32 * mt + 8 * g + 4 * lh;
      *(uint2*)(op + dv0) = make_uint2(pack2(o[mt][4 * g] * inv, o[mt][4 * g + 1] * inv), pack2(o[mt][4 * g + 2] * inv, o[mt][4 * g + 3] * inv));
    }
  if (!CAUSAL && lh == 0) lsebase[tq * 8] = m_run + log2f(l_tot);
}

constexpr int N_DIFF_UNITS = 1024, N_DIL_UNITS = 3072;
__device__ void phase2_unit(const Params& p, int u, char* smem) {
  if (u < N_DIFF_UNITS) {
    const int n = 15 - (u >> 6), rem = u & 63, b = rem >> 3, hc = rem & 7, h4 = hc >> 1;
    const u16* qb = (const u16*)(p.ws + OFF_QB) + (size_t)(b * 8 + hc) * 4096 * 64;
    const u16* kb = (const u16*)(p.ws + OFF_KB) + (size_t)(b * 8 + hc) * 4096 * 64;
    const u16* vb = (const u16*)(p.ws + OFF_VB) + (size_t)(b * 4 + h4) * 4096 * 128;
    u16* ob = (u16*)(p.ws + OFF_OBC) + (size_t)b * 4096 * 1024 + hc * 128;
    attn_unit<128, true>(qb, kb, vb, 256 * n, 0, 0, 4 * n + 4, 1, 0, ob, 1024, nullptr, smem);
  } else {
    const int u2 = u - N_DIFF_UNITS, pidx = u2 >> 10, rem = u2 & 1023, b = rem >> 7, h = (rem >> 4) & 7, rn = rem & 15;
    const int sh = 2 * pidx, dil = 1 << sh, nbp = 16 >> sh, res = rn >> (4 - sh), n = 2 * (rn & (nbp - 1));
    const u16* qb = (const u16*)(p.ws + OFF_QA) + (size_t)(b * 8 + h) * 4096 * 64;
    const u16* kb = (const u16*)(p.ws + OFF_KA) + (size_t)(b * 8 + h) * 4096 * 64;
    const u16* vb = (const u16*)(p.ws + OFF_VA) + (size_t)(b * 8 + h) * 4096 * 64;
    u16* ob = (u16*)(p.ws + OFF_OAP) + ((size_t)pidx * T_TOK + (size_t)b * 4096) * 512 + h * 64;
    float* lse = (float*)(p.ws + OFF_LSE) + ((size_t)pidx * T_TOK + (size_t)b * 4096) * 8 + h;
    attn_unit<64, false>(qb, kb, vb, 128 * n, 128 * (n - 1), n == 0 ? 2 : 0, 6, dil, res, ob, 512, lse, smem);
  }
}
__device__ void phase2(const Params& p, char* smem, int slot = 1) {
  int* counter = (int*)(p.ws + OFF_MISC) + slot;
  int* s_unit = (int*)(smem + DYN_LDS - 16);
  while (true) {
    if (threadIdx.x == 0) *s_unit = atomicAdd(counter, 1);
    __syncthreads();
    const int u = *s_unit;
    __syncthreads();
    if (u >= N_DIFF_UNITS + N_DIL_UNITS) break;
    phase2_unit(p, u, smem);
  }
}

__device__ void phase3(const Params& p) {
  const int tid = threadIdx.x, lane = tid & 63, wid = tid >> 6;
  const int gw = blockIdx.x * NWAVE + wid, nw = gridDim.x * NWAVE;
  const float lam = ((const float*)(p.ws + OFF_MISC))[0];
  const u16* oap = (const u16*)(p.ws + OFF_OAP);
  const u16* obc = (const u16*)(p.ws + OFF_OBC);
  const float* lse = (const float*)(p.ws + OFF_LSE);
  u16* mix = (u16*)(p.ws + OFF_XNB);
  for (int tok = gw; tok < T_TOK; tok += nw) {
    float o[16]; float ss = 0.f;
    if (lane < 32) {
      const int head = lane >> 2;
      float l0 = lse[(size_t)tok * 8 + head], l1 = lse[((size_t)T_TOK + tok) * 8 + head], l2 = lse[((size_t)2 * T_TOK + tok) * 8 + head];
      const float mx = fmaxf(l0, fmaxf(l1, l2));
      float w0 = exp2f(l0 - mx), w1 = exp2f(l1 - mx), w2 = exp2f(l2 - mx);
      const float inv = 1.f / (w0 + w1 + w2); w0 *= inv; w1 *= inv; w2 *= inv;
      const uint4* p0 = (const uint4*)(oap + (size_t)tok * 512 + lane * 16);
      const uint4* p1 = (const uint4*)(oap + ((size_t)T_TOK + tok) * 512 + lane * 16);
      const uint4* p2 = (const uint4*)(oap + ((size_t)2 * T_TOK + tok) * 512 + lane * 16);
#pragma unroll
      for (int c = 0; c < 2; ++c) {
        const uint4 a = p0[c], b = p1[c], d = p2[c];
        const unsigned au[4] = {a.x, a.y, a.z, a.w}, bu[4] = {b.x, b.y, b.z, b.w}, du[4] = {d.x, d.y, d.z, d.w};
#pragma unroll
        for (int k = 0; k < 4; ++k) {
          o[c * 8 + 2 * k] = w0 * bflo(au[k]) + w1 * bflo(bu[k]) + w2 * bflo(du[k]);
          o[c * 8 + 2 * k + 1] = w0 * bfhi(au[k]) + w1 * bfhi(bu[k]) + w2 * bfhi(du[k]);
        }
      }
    } else {
      const int l2 = lane - 32, head = l2 >> 3, cc = (l2 & 7) * 16;
      const uint4* p0 = (const uint4*)(obc + (size_t)tok * 1024 + (2 * head) * 128 + cc);
      const uint4* p1 = (const uint4*)(obc + (size_t)tok * 1024 + (2 * head + 1) * 128 + cc);
#pragma unroll
      for (int c = 0; c < 2; ++c) {
        const uint4 a = p0[c], b = p1[c];
        const unsigned au[4] = {a.x, a.y, a.z, a.w}, bu[4] = {b.x, b.y, b.z, b.w};
#pragma unroll
        for (int k = 0; k < 4; ++k) {
          o[c * 8 + 2 * k] = bflo(au[k]) - lam * bflo(bu[k]);
          o[c * 8 + 2 * k + 1] = bfhi(au[k]) - lam * bfhi(bu[k]);
        }
      }
    }
#pragma unroll
    for (int i = 0; i < 16; ++i) ss += o[i] * o[i];
    const float s1 = ss + __shfl_xor(ss, 1);
    const float s2 = s1 + __shfl_xor(s1, 2);
    const float s3 = s2 + __shfl_xor(s2, 4);
    float r; const float* g;
    if (lane < 32) { r = rsqrtf(s2 * (1.f / 64.f) + 1e-6f); g = p.ona + lane * 16; }
    else { r = rsqrtf(s3 * (1.f / 128.f) + 1e-6f) * 0.8f; g = p.onb + (lane - 32) * 16; }
    unsigned pk[8];
#pragma unroll
    for (int k = 0; k < 8; ++k) pk[k] = pack2(o[2 * k] * r * g[2 * k], o[2 * k + 1] * r * g[2 * k + 1]);
    uint4* dst = (uint4*)(mix + (size_t)tok * 1024 + lane * 16);
    dst[0] = make_uint4(pk[0], pk[1], pk[2], pk[3]); dst[1] = make_uint4(pk[4], pk[5], pk[6], pk[7]);
  }
}

__device__ void phase4_tile(const Params& p, int mtile, int j, char* smem) {
  f32x16 acc[2][2];
  const int m0 = mtile * 128, n0 = j * 128;
  gemm_mainloop((const u16*)(p.ws + OFF_XNB), (const u16*)(p.ws + OFF_WOUT), m0, n0, smem, acc);
  float* st = (float*)smem;
  stage_acc(acc, st);
  __syncthreads();
  const int tid = threadIdx.x & 255, cgi = tid & 31, r0 = tid >> 5;
  float* hss = (float*)(p.ws + OFF_HSS);
  u16* hb = (u16*)(p.ws + OFF_OAP);
#pragma unroll 4
  for (int ps = 0; ps < 16; ++ps) {
    const int row = r0 + 8 * ps;
    const float4 a = *(const float4*)(st + row * 132 + cgi * 4);
    const size_t gi = (size_t)(m0 + row) * 1024 + n0 + cgi * 4;
    const float4 xv = *(const float4*)(p.x + gi);
    float4 hv; hv.x = xv.x + a.x; hv.y = xv.y + a.y; hv.z = xv.z + a.z; hv.w = xv.w + a.w;
    *(float4*)(p.out + gi) = hv;
    *(uint2*)(hb + gi) = make_uint2(pack2(hv.x, hv.y), pack2(hv.z, hv.w));
    float ss = hv.x * hv.x + hv.y * hv.y + hv.z * hv.z + hv.w * hv.w;
    ss += __shfl_xor(ss, 16); ss += __shfl_xor(ss, 8); ss += __shfl_xor(ss, 4); ss += __shfl_xor(ss, 2); ss += __shfl_xor(ss, 1);
    if (cgi == 0) atomicAdd(hss + m0 + row, ss);
  }
  __syncthreads();
}


struct EpiInProj {
  static constexpr bool PERM = true, AFTER_DRAIN = false;
  char* ws;
  DI void operator()(const pg8::f32x4 (&acc)[2][2][4][2], const pg8::Unit& u, int wr, int wc, int fr, int fq) const {
    const int sec = u.pn >> 1, cl = (u.pn & 1) * 4 + wc;
    const bool isqk = (sec != 2 && sec != 5);
    float g[16];
    if (isqk) {
      const float* gp = (const float*)(ws + OFF_MISC + 1024) + 64 * (sec < 3 ? sec : sec - 1);
#pragma unroll
      for (int idx = 0; idx < 16; ++idx) {
        const int bj = idx >> 3, n = (idx >> 2) & 1, i = idx & 3;
        const int d = (bj == 0 && fq < 2) ? (4 * fq + 8 * n + i) : (32 * bj + 8 * fq + 4 * n + i);
        g[idx] = gp[d];
      }
    }
    const float post = (sec == 0 || sec == 3) ? QSCALE : 1.f;
    const float* rc = (const float*)(ws + OFF_ROPEC);
    const float* rs = (const float*)(ws + OFF_ROPES);
    const size_t off = OFF_QA + (size_t)sec * (32 * MB);
#pragma unroll
    for (int ai = 0; ai < 2; ++ai)
#pragma unroll
      for (int m = 0; m < 4; ++m) {
        const int row = u.pm * 256 + ai * 128 + wr * 64 + m * 16 + fr, b = row >> 12, sq = row & 4095;
        float v[16];
#pragma unroll
        for (int bj = 0; bj < 2; ++bj)
#pragma unroll
          for (int n = 0; n < 2; ++n)
#pragma unroll
            for (int i = 0; i < 4; ++i) v[bj * 8 + n * 4 + i] = acc[ai][bj][m][n][i];
        if (isqk) {
          float ss = 0.f;
#pragma unroll
          for (int idx = 0; idx < 16; ++idx) ss += v[idx] * v[idx];
          ss += __shfl_xor(ss, 16); ss += __shfl_xor(ss, 32);
          const float r = rsqrtf(ss * (1.f / 64.f) + 1e-6f) * post;
#pragma unroll
          for (int idx = 0; idx < 16; ++idx) v[idx] *= r * g[idx];
          if (fq < 2) {
            const float4 c4 = *(const float4*)(rc + sq * 8 + 4 * fq), s4 = *(const float4*)(rs + sq * 8 + 4 * fq);
            const float cc[4] = {c4.x, c4.y, c4.z, c4.w}, sn[4] = {s4.x, s4.y, s4.z, s4.w};
#pragma unroll
            for (int i = 0; i < 4; ++i) { const float x1 = v[i], x2 = v[4 + i]; v[i] = x1 * cc[i] - x2 * sn[i]; v[4 + i] = x2 * cc[i] + x1 * sn[i]; }
          }
        }
        u16* dst = (sec == 5) ? (u16*)(ws + off) + ((size_t)(b * 4 + (cl >> 1)) * 4096 + sq) * 128 + (cl & 1) * 64
                              : (u16*)(ws + off) + ((size_t)(b * 8 + cl) * 4096 + sq) * 64;
        if (fq < 2) {
          *(uint2*)(dst + 4 * fq) = make_uint2(pack2(v[0], v[1]), pack2(v[2], v[3]));
          *(uint2*)(dst + 8 + 4 * fq) = make_uint2(pack2(v[4], v[5]), pack2(v[6], v[7]));
        } else {
          *(uint4*)(dst + 8 * fq) = make_uint4(pack2(v[0], v[1]), pack2(v[2], v[3]), pack2(v[4], v[5]), pack2(v[6], v[7]));
        }
        *(uint4*)(dst + 32 + 8 * fq) = make_uint4(pack2(v[8], v[9]), pack2(v[10], v[11]), pack2(v[12], v[13]), pack2(v[14], v[15]));
      }
  }
};
__device__ void phase1_big(const Params& p, char* smem) {
  pg8::Gemm g; g.A = (const pg8::bf16_t*)(p.ws + OFF_XNB); g.Bt = (const pg8::bf16_t*)(p.ws + OFF_WIN); g.M = T_TOK; g.N = 3072; g.K = 1024;
  pg8::StaticOrder S; S.init(g.M, g.N, (int)gridDim.x, (int)blockIdx.x);
  EpiInProj E; E.ws = p.ws;
  pg8::gemm_phase<EpiInProj, pg8::StaticOrder, false>((PG8_LAS unsigned char*)smem, g, S, E, nullptr);
}

struct EpiOutProj {
  static constexpr bool PERM = true, AFTER_DRAIN = false;
  const float* x; float* out; u16* hb; float* hss;
  DI void operator()(const pg8::f32x4 (&acc)[2][2][4][2], const pg8::Unit& u, int wr, int wc, int fr, int fq) const {
#pragma unroll
    for (int ai = 0; ai < 2; ++ai)
#pragma unroll
      for (int m = 0; m < 4; ++m) {
        const int row = u.pm * 256 + ai * 128 + wr * 64 + m * 16 + fr;
        float ss = 0.f;
#pragma unroll
        for (int bj = 0; bj < 2; ++bj) {
          const size_t gi = (size_t)row * 1024 + u.pn * 256 + bj * 128 + wc * 32 + 8 * fq;
          const float4 x0 = *(const float4*)(x + gi), x1 = *(const float4*)(x + gi + 4);
          const pg8::f32x4 a0 = acc[ai][bj][m][0], a1 = acc[ai][bj][m][1];
          const float4 h0 = make_float4(x0.x + a0[0], x0.y + a0[1], x0.z + a0[2], x0.w + a0[3]);
          const float4 h1 = make_float4(x1.x + a1[0], x1.y + a1[1], x1.z + a1[2], x1.w + a1[3]);
          *(float4*)(out + gi) = h0; *(float4*)(out + gi + 4) = h1;
          *(uint4*)(hb + gi) = make_uint4(pack2(h0.x, h0.y), pack2(h0.z, h0.w), pack2(h1.x, h1.y), pack2(h1.z, h1.w));
          ss += h0.x * h0.x + h0.y * h0.y + h0.z * h0.z + h0.w * h0.w + h1.x * h1.x + h1.y * h1.y + h1.z * h1.z + h1.w * h1.w;
        }
        ss += __shfl_xor(ss, 16); ss += __shfl_xor(ss, 32);
        if (fq == 0) atomicAdd(hss + row, ss);
      }
  }
};
__device__ void phase4_big(const Params& p, char* smem) {
  pg8::Gemm g; g.A = (const pg8::bf16_t*)(p.ws + OFF_XNB); g.Bt = (const pg8::bf16_t*)(p.ws + OFF_WOUT); g.M = T_TOK; g.N = 1024; g.K = 1024;
  pg8::StaticOrder S; S.init(g.M, g.N, (int)gridDim.x, (int)blockIdx.x);
  EpiOutProj E; E.x = p.x; E.out = p.out; E.hb = (u16*)(p.ws + OFF_OAP); E.hss = (float*)(p.ws + OFF_HSS);
  pg8::gemm_phase<EpiOutProj, pg8::StaticOrder, false>((PG8_LAS unsigned char*)smem, g, S, E, nullptr);
}

#define TK_INSERT(xv, xi) { float x_ = (xv); int i_ = (xi); _Pragma("unroll") for (int q_ = 0; q_ < 16; ++q_) { const bool gt_ = x_ > tv[q_]; const float tvv = tv[q_]; const int tii = ti[q_]; tv[q_] = gt_ ? x_ : tvv; ti[q_] = gt_ ? i_ : tii; x_ = gt_ ? tvv : x_; i_ = gt_ ? tii : i_; } }
__device__ void phase5_tile(const Params& p, int mtile, int j, char* smem) {
  f32x16 acc[2][2];
  const int m0 = mtile * 128, n0 = j * 128;
  gemm_mainloop((const u16*)(p.ws + OFF_OAP), (const u16*)(p.ws + OFF_WPQ), m0, n0, smem, acc);
  const int tid = threadIdx.x & 255, lane = tid & 63, w = tid >> 6, wm = w >> 1, wn = w & 1, lr = lane & 31, lh = lane >> 5;
  u16* Qs = (u16*)smem;
  u16* SKs = Qs + 128 * 136;
  float* rs = (float*)(smem + 2 * 128 * 136 * 2);
  const float* hss = (const float*)(p.ws + OFF_HSS);
  if (tid < 128) rs[tid] = rsqrtf(hss[m0 + tid] * (1.f / 1024.f) + 1e-6f);
  {
    const u16* sk = (const u16*)(p.ws + OFF_SUBK) + (size_t)j * 128 * 128;
#pragma unroll
    for (int i = 0; i < 8; ++i) { const int c = tid + 256 * i, row = c >> 4, kc = c & 15; *(uint4*)(SKs + row * 136 + kc * 8) = *(const uint4*)(sk + row * 128 + kc * 8); }
  }
  __syncthreads();
#pragma unroll
  for (int mt = 0; mt < 2; ++mt)
#pragma unroll
    for (int nt = 0; nt < 2; ++nt)
#pragma unroll
      for (int r = 0; r < 16; ++r) {
        const int row = wm * 64 + mt * 32 + crow(r, lh);
        Qs[row * 136 + wn * 64 + nt * 32 + lr] = f2bf(acc[mt][nt][r] * rs[row]);
      }
  __syncthreads();
#pragma unroll
  for (int a = 0; a < 2; ++a)
#pragma unroll
    for (int b = 0; b < 2; ++b)
#pragma unroll
      for (int r = 0; r < 16; ++r) acc[a][b][r] = 0.f;
  {
    const u16* ab = Qs + (wm * 64 + lr) * 136 + lh * 8;
    const u16* bb = SKs + (wn * 64 + lr) * 136 + lh * 8;
#pragma unroll
    for (int s = 0; s < 8; ++s) {
      const bf16x8 a0 = *(const bf16x8*)(ab + s * 16), a1 = *(const bf16x8*)(ab + 32 * 136 + s * 16);
      const bf16x8 b0 = *(const bf16x8*)(bb + s * 16), b1 = *(const bf16x8*)(bb + 32 * 136 + s * 16);
      acc[0][0] = MFMA(a0, b0, acc[0][0]); acc[0][1] = MFMA(a0, b1, acc[0][1]);
      acc[1][0] = MFMA(a1, b0, acc[1][0]); acc[1][1] = MFMA(a1, b1, acc[1][1]);
    }
  }
  __syncthreads();
  float* st = (float*)smem;
  stage_acc(acc, st);
  __syncthreads();
  const int row = tid & 127, half = tid >> 7;
  unsigned tk[16];
#pragma unroll
  for (int q = 0; q < 16; ++q) tk[q] = 0u;
#define TK_KEY(xv, xi) ({ const unsigned u_ = __float_as_uint(xv); const unsigned o_ = (u_ & 0x80000000u) ? ~u_ : (u_ | 0x80000000u); (o_ & 0xFFFFFF80u) | (unsigned)(127 - (xi)); })
#define TK_INS(kv) { unsigned k_ = (kv); _Pragma("unroll") for (int q_ = 0; q_ < 16; ++q_) { const unsigned hi_ = k_ > tk[q_] ? k_ : tk[q_]; k_ = k_ > tk[q_] ? tk[q_] : k_; tk[q_] = hi_; } }
#pragma unroll 2
  for (int c = 0; c < 16; ++c) {
    const float4 v4 = *(const float4*)(st + row * 132 + half * 64 + c * 4);
    const int bi = half * 64 + c * 4;
    TK_INS(TK_KEY(v4.x, bi)); TK_INS(TK_KEY(v4.y, bi + 1)); TK_INS(TK_KEY(v4.z, bi + 2)); TK_INS(TK_KEY(v4.w, bi + 3));
  }
  __syncthreads();
  if (half == 1) {
#pragma unroll
    for (int q = 0; q < 16; ++q) st[row * 132 + q] = __uint_as_float(tk[q]);
  }
  __syncthreads();
  if (half == 0) {
#pragma unroll 4
    for (int q = 0; q < 16; ++q) TK_INS(__float_as_uint(st[row * 132 + q]));
    const size_t base = ((size_t)(m0 + row) * 16 + j) * 16;
    float* tops = (float*)(p.ws + OFF_TOPS) + base;
    u8* topi = (u8*)(p.ws + OFF_TOPI) + base;
    float tv[16]; unsigned ti[16];
#pragma unroll
    for (int q = 0; q < 16; ++q) {
      const unsigned o = tk[q] & 0xFFFFFF80u;
      tv[q] = __uint_as_float((o & 0x80000000u) ? (o & 0x7FFFFFFFu) : ~o);
      ti[q] = 127u - (tk[q] & 127u);
    }
#pragma unroll
    for (int c = 0; c < 4; ++c) ((float4*)tops)[c] = make_float4(tv[4 * c], tv[4 * c + 1], tv[4 * c + 2], tv[4 * c + 3]);
    unsigned pk[4];
#pragma unroll
    for (int c = 0; c < 4; ++c) pk[c] = ti[4 * c] | (ti[4 * c + 1] << 8) | (ti[4 * c + 2] << 16) | (ti[4 * c + 3] << 24);
    *(uint4*)topi = make_uint4(pk[0], pk[1], pk[2], pk[3]);
  }
  __syncthreads();
#undef TK_KEY
#undef TK_INS
}


DI void sort16_desc(unsigned (&t)[16]) {
#pragma unroll
  for (int k = 2; k <= 16; k <<= 1)
#pragma unroll
    for (int j = k >> 1; j > 0; j >>= 1)
#pragma unroll
      for (int i = 0; i < 16; ++i) {
        const int l = i ^ j;
        if (l > i) { const bool desc = (i & k) == 0; const unsigned a = t[i], b = t[l]; const unsigned mx = a > b ? a : b, mn = a > b ? b : a; t[i] = desc ? mx : mn; t[l] = desc ? mn : mx; }
      }
}
DI void merge16_desc(unsigned (&a)[16], const unsigned (&b)[16]) {
#pragma unroll
  for (int i = 0; i < 16; ++i) { const unsigned x = a[i], y = b[15 - i]; a[i] = x > y ? x : y; }
#pragma unroll
  for (int j = 8; j > 0; j >>= 1)
#pragma unroll
    for (int i = 0; i < 16; ++i) { const int l = i ^ j; if (l > i) { const unsigned p = a[i], q = a[l]; a[i] = p > q ? p : q; a[l] = p > q ? q : p; } }
}
constexpr size_t OFF_QBUF = 128 * MB;
struct EpiPeerQ {
  static constexpr bool PERM = true, AFTER_DRAIN = false;
  const float* hss; u16* q;
  DI void operator()(const pg8::f32x4 (&acc)[2][2][4][2], const pg8::Unit& u, int wr, int wc, int fr, int fq) const {
#pragma unroll
    for (int ai = 0; ai < 2; ++ai)
#pragma unroll
      for (int m = 0; m < 4; ++m) {
        const int row = u.pm * 256 + ai * 128 + wr * 64 + m * 16 + fr;
        const float r = rsqrtf(hss[row] * (1.f / 1024.f) + 1e-6f);
#pragma unroll
        for (int bj = 0; bj < 2; ++bj) {
          const pg8::f32x4 a0 = acc[ai][bj][m][0], a1 = acc[ai][bj][m][1];
          *(uint4*)(q + (size_t)row * 2048 + u.pn * 256 + bj * 128 + wc * 32 + 8 * fq) =
              make_uint4(pack2(a0[0] * r, a0[1] * r), pack2(a0[2] * r, a0[3] * r), pack2(a1[0] * r, a1[1] * r), pack2(a1[2] * r, a1[3] * r));
        }
      }
  }
};
__device__ void peer_score_tile(const Params& p, int pm, int head, int cc, char* smem) {
  const int tid = opaque_tid(), lane = tid & 63, w = tid >> 6, wm = w >> 1, wn = w & 1, lr = lane & 31, lh = lane >> 5;
  u16* Qs = (u16*)smem;
  u16* SKs = Qs + 256 * 136;
  {
    const u16* qg = (const u16*)(p.ws + OFF_QBUF) + (size_t)(pm * 256) * 2048 + head * 256 + cc * 128;
#pragma unroll
    for (int i = 0; i < 8; ++i) { const int c = tid + 512 * i, row = c >> 4, kc = c & 15; *(uint4*)(Qs + row * 136 + kc * 8) = *(const uint4*)(qg + (size_t)row * 2048 + kc * 8); }
    const u16* sk = (const u16*)(p.ws + OFF_SUBK) + (size_t)(head * 2 + cc) * 128 * 128;
#pragma unroll
    for (int i = 0; i < 4; ++i) { const int c = tid + 512 * i, row = c >> 4, kc = c & 15; *(uint4*)(SKs + row * 136 + kc * 8) = *(const uint4*)(sk + row * 128 + kc * 8); }
  }
  __syncthreads();
  f32x16 acc[2][2];
#pragma unroll
  for (int a = 0; a < 2; ++a)
#pragma unroll
    for (int b = 0; b < 2; ++b)
#pragma unroll
      for (int r = 0; r < 16; ++r) acc[a][b][r] = 0.f;
  {
    const u16* ab = Qs + (wm * 64 + lr) * 136 + lh * 8;
    const u16* bb = SKs + (wn * 64 + lr) * 136 + lh * 8;
#pragma unroll
    for (int s = 0; s < 8; ++s) {
      const bf16x8 a0 = *(const bf16x8*)(ab + s * 16), a1 = *(const bf16x8*)(ab + 32 * 136 + s * 16);
      const bf16x8 b0 = *(const bf16x8*)(bb + s * 16), b1 = *(const bf16x8*)(bb + 32 * 136 + s * 16);
      acc[0][0] = MFMA(a0, b0, acc[0][0]); acc[0][1] = MFMA(a0, b1, acc[0][1]);
      acc[1][0] = MFMA(a1, b0, acc[1][0]); acc[1][1] = MFMA(a1, b1, acc[1][1]);
    }
  }
  __syncthreads();
  float* st = (float*)smem;
#pragma unroll
  for (int mt = 0; mt < 2; ++mt)
#pragma unroll
    for (int nt = 0; nt < 2; ++nt)
#pragma unroll
      for (int r = 0; r < 16; ++r) st[(wm * 64 + mt * 32 + crow(r, lh)) * 132 + wn * 64 + nt * 32 + lr] = acc[mt][nt][r];
  __syncthreads();
  const int row = tid & 255, half = tid >> 8;
#define TK_KEY(xv, xi) ({ const unsigned u_ = __float_as_uint(xv); const unsigned o_ = (u_ & 0x80000000u) ? ~u_ : (u_ | 0x80000000u); (o_ & 0xFFFFFF80u) | (unsigned)(127 - (xi)); })
#define TK_LOAD16(T_, g_) { _Pragma("unroll") for (int c_ = 0; c_ < 4; ++c_) { const float4 v4_ = *(const float4*)(st + row * 132 + half * 64 + (g_) * 16 + c_ * 4); const int bi_ = half * 64 + (g_) * 16 + c_ * 4; \
    T_[4 * c_] = TK_KEY(v4_.x, bi_); T_[4 * c_ + 1] = TK_KEY(v4_.y, bi_ + 1); T_[4 * c_ + 2] = TK_KEY(v4_.z, bi_ + 2); T_[4 * c_ + 3] = TK_KEY(v4_.w, bi_ + 3); } }
  unsigned tk[16], tb[16], tc[16];
  TK_LOAD16(tk, 0); sort16_desc(tk);
  TK_LOAD16(tb, 1); sort16_desc(tb);
  merge16_desc(tk, tb);
  TK_LOAD16(tb, 2); sort16_desc(tb);
  TK_LOAD16(tc, 3); sort16_desc(tc);
  merge16_desc(tb, tc);
  merge16_desc(tk, tb);
  __syncthreads();
  if (half == 1) {
#pragma unroll
    for (int q = 0; q < 16; ++q) st[row * 132 + q] = __uint_as_float(tk[q]);
  }
  __syncthreads();
  if (half == 0) {
#pragma unroll
    for (int q = 0; q < 16; ++q) tb[q] = __float_as_uint(st[row * 132 + q]);
    merge16_desc(tk, tb);
    const size_t base = ((size_t)(pm * 256 + row) * 16 + head * 2 + cc) * 16;
    float* tops = (float*)(p.ws + OFF_TOPS) + base;
    u8* topi = (u8*)(p.ws + OFF_TOPI) + base;
    float tv[16]; unsigned ti[16];
#pragma unroll
    for (int q = 0; q < 16; ++q) {
      const unsigned o = tk[q] & 0xFFFFFF80u;
      tv[q] = __uint_as_float((o & 0x80000000u) ? (o & 0x7FFFFFFFu) : ~o);
      ti[q] = 127u - (tk[q] & 127u);
    }
#pragma unroll
    for (int c = 0; c < 4; ++c) ((float4*)tops)[c] = make_float4(tv[4 * c], tv[4 * c + 1], tv[4 * c + 2], tv[4 * c + 3]);
    unsigned pk[4];
#pragma unroll
    for (int c = 0; c < 4; ++c) pk[c] = ti[4 * c] | (ti[4 * c + 1] << 8) | (ti[4 * c + 2] << 16) | (ti[4 * c + 3] << 24);
    *(uint4*)topi = make_uint4(pk[0], pk[1], pk[2], pk[3]);
  }
  __syncthreads();
#undef TK_KEY
#undef TK_LOAD16
}
__device__ void phase5_big(const Params& p, char* smem) {
  pg8::Gemm g; g.A = (const pg8::bf16_t*)(p.ws + OFF_OAP); g.Bt = (const pg8::bf16_t*)(p.ws + OFF_WPQ); g.M = T_TOK; g.N = 2048; g.K = 1024;
  pg8::StaticOrder S; S.init(g.M, g.N, (int)gridDim.x, (int)blockIdx.x);
  EpiPeerQ E; E.hss = (const float*)(p.ws + OFF_HSS); E.q = (u16*)(p.ws + OFF_QBUF);
  pg8::gemm_phase<EpiPeerQ, pg8::StaticOrder, false>((PG8_LAS unsigned char*)smem, g, S, E, nullptr);
  __syncthreads();
  pg8::Unit u;
  for (int i = 0; S.next(i, u); ++i) {
    peer_score_tile(p, u.pm, u.pn, 0, smem);
    peer_score_tile(p, u.pm, u.pn, 1, smem);
  }
}

DI float dpp_xor1(float v) { return __builtin_bit_cast(float, __builtin_amdgcn_update_dpp(0, __builtin_bit_cast(int, v), 0xB1, 0xF, 0xF, true)); }
DI float dpp_xor2(float v) { return __builtin_bit_cast(float, __builtin_amdgcn_update_dpp(0, __builtin_bit_cast(int, v), 0x4E, 0xF, 0xF, true)); }
template <int PAT> DI float swz(float v) { return __builtin_bit_cast(float, __builtin_amdgcn_ds_swizzle(__builtin_bit_cast(int, v), PAT)); }
DI float treduce8(const float (&pp)[8], int lane) {
  const bool b0 = lane & 1, b1 = lane & 2, b2 = lane & 4;
  float q[4];
#pragma unroll
  for (int i = 0; i < 4; ++i) { const float keep = b0 ? pp[2 * i + 1] : pp[2 * i], send = b0 ? pp[2 * i] : pp[2 * i + 1]; q[i] = keep + dpp_xor1(send); }
  float r[2];
#pragma unroll
  for (int i = 0; i < 2; ++i) { const float keep = b1 ? q[2 * i + 1] : q[2 * i], send = b1 ? q[2 * i] : q[2 * i + 1]; r[i] = keep + dpp_xor2(send); }
  float t = (b2 ? r[1] : r[0]) + swz<0x101F>(b2 ? r[0] : r[1]);
  t += swz<0x201F>(t); t += swz<0x401F>(t); t += __shfl_xor(t, 32);
  return t;
}
DI float udot16(const uint4& w, const float (&h)[16]) {
  f32x2 acc = {0.f, 0.f};
  const int ww[4] = {(int)w.x, (int)w.y, (int)w.z, (int)w.w};
#pragma unroll
  for (int j = 0; j < 4; ++j) {
    const f32x2 lo = __builtin_amdgcn_cvt_pk_f32_fp8(ww[j], false), hi = __builtin_amdgcn_cvt_pk_f32_fp8(ww[j], true);
    const f32x2 h0 = {h[4 * j], h[4 * j + 1]}, h1 = {h[4 * j + 2], h[4 * j + 3]};
    acc += lo * h0; acc += hi * h1;
  }
  return acc.x + acc.y;
}
DI void vacc16(const uint4& w, float a, f32x2 (&acc)[8]) {
  const f32x2 a2 = {a, a};
  const int ww[4] = {(int)w.x, (int)w.y, (int)w.z, (int)w.w};
#pragma unroll
  for (int j = 0; j < 4; ++j) {
    acc[2 * j] += a2 * __builtin_amdgcn_cvt_pk_f32_fp8(ww[j], false);
    acc[2 * j + 1] += a2 * __builtin_amdgcn_cvt_pk_f32_fp8(ww[j], true);
  }
}
#define LOAD8(buf, tbl, bidx) { const uint4 i0_ = *(const uint4*)(ids + 8 * (bidx)), i1_ = *(const uint4*)(ids + 8 * (bidx) + 4); \
    const unsigned idv_[8] = {i0_.x, i0_.y, i0_.z, i0_.w, i1_.x, i1_.y, i1_.z, i1_.w}; \
    _Pragma("unroll") for (int k_ = 0; k_ < 8; ++k_) { const unsigned id_ = __builtin_amdgcn_readfirstlane(idv_[k_]); buf[k_] = *(const uint4*)((tbl) + (size_t)id_ * 1024 + lane * 16); } }

__device__ void phase6(const Params& p, char* smem, float* dstbase) {
  const int tid = opaque_tid(), lane = tid & 63, wid = tid >> 6;
  const int gw = blockIdx.x * NWAVE + wid, nw = gridDim.x * NWAVE;
  int* ids = (int*)(smem + wid * 1024);
  float* gts = (float*)(smem + wid * 1024 + 512);
  const float* hss = (const float*)(p.ws + OFF_HSS);
  const float* tops = (const float*)(p.ws + OFF_TOPS);
  const u8* topi = (const u8*)(p.ws + OFF_TOPI);
  const u8* ub = (const u8*)(p.ws + OFF_PUB);
  const u8* vb = (const u8*)(p.ws + OFF_PVB);
  int ci, cj;
  {
    const int L = lane;
    if (L < 16) { ci = 0; cj = L; } else if (L < 24) { ci = 1; cj = L - 16; } else if (L < 29) { ci = 2; cj = L - 24; }
    else if (L < 33) { ci = 3; cj = L - 29; } else if (L < 36) { ci = 4; cj = L - 33; } else if (L < 38) { ci = 5; cj = L - 36; }
    else if (L < 40) { ci = 6; cj = L - 38; } else if (L < 42) { ci = 7; cj = L - 40; } else if (L < 50) { ci = L - 34; cj = 0; }
    else { ci = 0; cj = 0; }
  }
  for (int tok = gw; tok < T_TOK; tok += nw) {
    const float rstd = rsqrtf(hss[tok] * (1.f / 1024.f) + 1e-6f);
    float hres[16], hn[16];
    {
      const float4* hp = (const float4*)(p.out + (size_t)tok * 1024 + lane * 16);
      const float4* gp = (const float4*)(p.g_ffn + lane * 16);
#pragma unroll
      for (int c = 0; c < 4; ++c) {
        const float4 t4 = hp[c], g4 = gp[c];
        hres[4 * c] = t4.x; hres[4 * c + 1] = t4.y; hres[4 * c + 2] = t4.z; hres[4 * c + 3] = t4.w;
        hn[4 * c] = t4.x * rstd * g4.x; hn[4 * c + 1] = t4.y * rstd * g4.y; hn[4 * c + 2] = t4.z * rstd * g4.z; hn[4 * c + 3] = t4.w * rstd * g4.w;
      }
    }
    float sums[8]; int eids[8];
#pragma unroll
    for (int head = 0; head < 8; ++head) {
      const size_t b1 = ((size_t)tok * 16 + head * 2) * 16, b2 = b1 + 16;
      sums[head] = NEG_INF; eids[head] = 0;
      if (lane < 50) { sums[head] = tops[b1 + ci] + tops[b2 + cj]; eids[head] = (int)topi[b1 + ci] * 128 + (int)topi[b2 + cj]; }
    }
#pragma unroll
    for (int head = 0; head < 8; ++head) {
      const float sum = sums[head]; const int eid = eids[head];
      unsigned key;
      {
        const unsigned u_ = __float_as_uint(sum); const unsigned o_ = (u_ & 0x80000000u) ? ~u_ : (u_ | 0x80000000u);
        key = (o_ & 0xFFFFFFC0u) | (unsigned)(63 - lane);
      }
#define BSTEP(K_, J_, SHF_) { const unsigned pr_ = (SHF_); const bool tmx_ = ((lane & (J_)) == 0) == ((lane & (K_)) == 0); \
        const unsigned mx_ = key > pr_ ? key : pr_, mn_ = key > pr_ ? pr_ : key; key = tmx_ ? mx_ : mn_; }
#define SX1 ((unsigned)__builtin_amdgcn_update_dpp(0, (int)key, 0xB1, 0xF, 0xF, true))
#define SX2 ((unsigned)__builtin_amdgcn_update_dpp(0, (int)key, 0x4E, 0xF, 0xF, true))
#define SX4 ((unsigned)__builtin_amdgcn_ds_swizzle((int)key, 0x101F))
#define SX8 ((unsigned)__builtin_amdgcn_ds_swizzle((int)key, 0x201F))
#define SX16 ((unsigned)__builtin_amdgcn_ds_swizzle((int)key, 0x401F))
#define SX32 ((unsigned)__shfl_xor((int)key, 32))
      BSTEP(2, 1, SX1);
      BSTEP(4, 2, SX2); BSTEP(4, 1, SX1);
      BSTEP(8, 4, SX4); BSTEP(8, 2, SX2); BSTEP(8, 1, SX1);
      BSTEP(16, 8, SX8); BSTEP(16, 4, SX4); BSTEP(16, 2, SX2); BSTEP(16, 1, SX1);
      BSTEP(32, 16, SX16); BSTEP(32, 8, SX8); BSTEP(32, 4, SX4); BSTEP(32, 2, SX2); BSTEP(32, 1, SX1);
      BSTEP(64, 32, SX32); BSTEP(64, 16, SX16); BSTEP(64, 8, SX8); BSTEP(64, 4, SX4); BSTEP(64, 2, SX2); BSTEP(64, 1, SX1);
#undef BSTEP
#undef SX1
#undef SX2
#undef SX4
#undef SX8
#undef SX16
#undef SX32
      const int src = 63 - (int)(key & 63u);
      const float sumv = __shfl(sum, src);
      const int eidv = __shfl(eid, src);
      const float mxa = __builtin_bit_cast(float, __builtin_amdgcn_readlane(__builtin_bit_cast(int, sumv), 0));
      const float e = (lane < 16) ? __expf(sumv - mxa) : 0.f;
      float den = e;
      den += dpp_xor1(den); den += dpp_xor2(den); den += swz<0x101F>(den); den += swz<0x201F>(den);
      if (lane < 16) { ids[head * 16 + lane] = eidv; gts[head * 16 + lane] = e / den; }
    }
    __builtin_amdgcn_wave_barrier();
    asm volatile("s_waitcnt lgkmcnt(0)" ::: "memory");
    float dsel0 = 0.f, dsel1 = 0.f;
    {
      uint4 ba[8], bb[8];
      LOAD8(ba, ub, 0);
#pragma unroll 1
      for (int b = 0; b < 16; b += 2) {
        LOAD8(bb, ub, b + 1);
        {
          float pp[8];
#pragma unroll
          for (int k = 0; k < 8; ++k) pp[k] = udot16(ba[k], hn);
          const float t = treduce8(pp, lane);
          if ((lane >> 3) == (b & 7)) { if (b < 8) dsel0 = t; else dsel1 = t; }
        }
        if (b + 2 < 16) LOAD8(ba, ub, b + 2);
        {
          float pp[8];
#pragma unroll
          for (int k = 0; k < 8; ++k) pp[k] = udot16(bb[k], hn);
          const float t = treduce8(pp, lane);
          if ((lane >> 3) == ((b + 1) & 7)) { if (b < 8) dsel0 = t; else dsel1 = t; }
        }
      }
    }
    {
      const float d0 = dsel0 * (1.f / USCALE), d1 = dsel1 * (1.f / USCALE);
      const float a0 = 0.5f * d0 * (1.f + erff(d0 * 0.70710678118654752f)) * gts[lane] * (1.f / VSCALE);
      const float a1 = 0.5f * d1 * (1.f + erff(d1 * 0.70710678118654752f)) * gts[64 + lane] * (1.f / VSCALE);
      gts[lane] = a0; gts[64 + lane] = a1;
    }
    __builtin_amdgcn_wave_barrier();
    asm volatile("s_waitcnt lgkmcnt(0)" ::: "memory");
    f32x2 acc[8];
#pragma unroll
    for (int i = 0; i < 8; ++i) acc[i] = (f32x2){0.f, 0.f};
    {
      uint4 ba[8], bb[8];
      LOAD8(ba, vb, 0);
#pragma unroll 1
      for (int b = 0; b < 16; b += 2) {
        LOAD8(bb, vb, b + 1);
        {
          const float4 g0 = *(const float4*)(gts + 8 * b), g1 = *(const float4*)(gts + 8 * b + 4);
          vacc16(ba[0], g0.x, acc); vacc16(ba[1], g0.y, acc); vacc16(ba[2], g0.z, acc); vacc16(ba[3], g0.w, acc);
          vacc16(ba[4], g1.x, acc); vacc16(ba[5], g1.y, acc); vacc16(ba[6], g1.z, acc); vacc16(ba[7], g1.w, acc);
        }
        if (b + 2 < 16) LOAD8(ba, vb, b + 2);
        {
          const float4 g0 = *(const float4*)(gts + 8 * b + 8), g1 = *(const float4*)(gts + 8 * b + 12);
          vacc16(bb[0], g0.x, acc); vacc16(bb[1], g0.y, acc); vacc16(bb[2], g0.z, acc); vacc16(bb[3], g0.w, acc);
          vacc16(bb[4], g1.x, acc); vacc16(bb[5], g1.y, acc); vacc16(bb[6], g1.z, acc); vacc16(bb[7], g1.w, acc);
        }
      }
    }
    float4* op = (float4*)(dstbase + (size_t)tok * 1024 + lane * 16);
#pragma unroll
    for (int c = 0; c < 4; ++c) op[c] = make_float4(hres[4 * c] + acc[2 * c].x, hres[4 * c + 1] + acc[2 * c].y, hres[4 * c + 2] + acc[2 * c + 1].x, hres[4 * c + 3] + acc[2 * c + 1].y);
    __builtin_amdgcn_wave_barrier();
  }
}


#define XB_TMO      128
#define XB_XCNT(j)  (256  + 64 * (j))
#define XB_XSUB(j)  (1280 + 64 * (j))
#define XB_XGEN(j)  (2304 + 64 * (j))
#define XB_TOP      3328
#define XB_TOPGEN   3392
#define XB_SPIN_CAP (1u << 22)
#define LAS __attribute__((address_space(3)))
DI unsigned xb_ld(unsigned* p) { return __hip_atomic_load(p, __ATOMIC_RELAXED, __HIP_MEMORY_SCOPE_AGENT); }
DI unsigned xb_add(unsigned* p, unsigned v) { return __hip_atomic_fetch_add(p, v, __ATOMIC_RELAXED, __HIP_MEMORY_SCOPE_AGENT); }
DI unsigned xb_xcc_id() { return (unsigned)__builtin_amdgcn_s_getreg((3 << 11) | 20) & 0xFu; }
#define XB_SPIN(cond, bar) do { unsigned _sp = 0; while (cond) { __builtin_amdgcn_s_sleep(1); \
    if ((++_sp & 255u) == 0u) { if (xb_ld(&(bar)[XB_TMO])) break; if (_sp > XB_SPIN_CAP) { atomicAdd(&(bar)[XB_TMO], 1u); break; } } } } while (0)
struct XcdBarrier { unsigned* bar; unsigned x; volatile LAS unsigned* st; };
DI XcdBarrier xcd_barrier_post(unsigned* bar, volatile LAS unsigned* st) {
  XcdBarrier b; b.bar = bar; b.x = xb_xcc_id(); b.st = st;
  if (threadIdx.x == 0) (void)xb_add(&bar[XB_XCNT(b.x)], 1u);
  return b;
}
DI void xcd_barrier_complete(unsigned* bar, unsigned x, unsigned& nloc, unsigned& nx) {
  const unsigned G = gridDim.x * gridDim.y * gridDim.z;
  unsigned sum, cnt, mine, sp = 0u;
  for (;;) {
    sum = 0u; cnt = 0u; mine = 0u;
#pragma unroll
    for (unsigned j = 0; j < 16; ++j) { const unsigned c = xb_ld(&bar[XB_XCNT(j)]); sum += c; cnt += (c > 0u) ? 1u : 0u; mine = (j == x) ? c : mine; }
    if (sum == G) break;
    __builtin_amdgcn_s_sleep(1);
    if ((++sp & 255u) == 0u) { if (xb_ld(&bar[XB_TMO])) break; if (sp > XB_SPIN_CAP) { atomicAdd(&bar[XB_TMO], 1u); break; } }
  }
  nloc = mine > 0u ? mine : 1u; nx = cnt > 0u ? cnt : 1u;
}
DI void xcd_barrier(const XcdBarrier& b) {
  asm volatile("s_waitcnt vmcnt(0)" ::: "memory");
  __syncthreads();
  if (threadIdx.x == 0) {
    unsigned* bar = b.bar;
    __builtin_amdgcn_s_waitcnt(0);
    unsigned nloc = b.st[0], nx = b.st[1];
    if (nloc == 0u) { xcd_barrier_complete(bar, b.x, nloc, nx); b.st[0] = nloc; b.st[1] = nx; }
    const unsigned old = xb_add(&bar[XB_XSUB(b.x)], 1u);
    const unsigned gen = old / nloc;
    if (old + 1u == (gen + 1u) * nloc) {
      __builtin_amdgcn_fence(__ATOMIC_RELEASE, "agent");
      asm volatile("s_waitcnt vmcnt(0)" ::: "memory");
      const unsigned og = xb_add(&bar[XB_TOP], 1u);
      const unsigned tg = og / nx;
      if (og + 1u == (tg + 1u) * nx) xb_add(&bar[XB_TOPGEN], 1u);
      else XB_SPIN(xb_ld(&bar[XB_TOPGEN]) == tg, bar);
      __builtin_amdgcn_fence(__ATOMIC_ACQUIRE, "agent");
      xb_add(&bar[XB_XGEN(b.x)], 1u);
      asm volatile("s_waitcnt vmcnt(0)" ::: "memory");
    } else {
      XB_SPIN(xb_ld(&bar[XB_XGEN(b.x)]) == gen, bar);
      __builtin_amdgcn_fence(__ATOMIC_ACQUIRE, "agent");
      asm volatile("s_waitcnt vmcnt(0)" ::: "memory");
    }
  }
  __syncthreads();
}

__global__ void __launch_bounds__(512, 2) fwd_megakernel(Params p) {
  extern __shared__ __attribute__((aligned(16))) char smem[];
  cg::grid_group grid = cg::this_grid();
  volatile LAS unsigned* xb_words = (volatile LAS unsigned*)(smem + DYN_LDS - 64);
  if (threadIdx.x == 0) { xb_words[0] = 0u; xb_words[1] = 0u; }
  const int half = threadIdx.x >> 8;
  char* hsm = smem + half * SMEM_BYTES;
  const XcdBarrier xb = xcd_barrier_post((unsigned*)(p.ws + OFF_BAR), xb_words);
  phase0(p, smem);
  xcd_barrier(xb);
  phase1_big(p, smem);
  xcd_barrier(xb);
#if PROBE_DUP == 1
  for (int t = blockIdx.x * 2 + half; t < 256 * 24; t += gridDim.x * 2) phase1_tile(p, t / 24, t % 24, hsm);
  xcd_barrier(xb);
#endif
#if PROBE_DUP == 2
  phase2(p, smem, 2);
  xcd_barrier(xb);
#endif
  phase2(p, smem);
  xcd_barrier(xb);
  phase3(p);
  xcd_barrier(xb);
  phase4_big(p, smem);
  xcd_barrier(xb);
  phase5_big(p, smem);
  xcd_barrier(xb);
#if PROBE_DUP == 5
  for (int t = blockIdx.x * 2 + half; t < 256 * 16; t += gridDim.x * 2) phase5_tile(p, t >> 4, t & 15, hsm);
  xcd_barrier(xb);
#endif
#if PROBE_DUP == 6
  phase6(p, smem, (float*)(p.ws + OFF_OAP));
  xcd_barrier(xb);
#endif
  phase6(p, smem, p.out);
  grid.sync();
}

extern "C" void kernel_launch(void* const* d_in, const int* in_sizes, int n_in, void* d_out, int out_size, void* d_ws, size_t ws_size,
                              hipStream_t stream) {
  Params p{};
  p.x = (const float*)d_in[0]; p.g_attn = (const float*)d_in[1]; p.w_in = (const float*)d_in[2]; p.qna = (const float*)d_in[3];
  p.kna = (const float*)d_in[4]; p.ona = (const float*)d_in[5]; p.qnb = (const float*)d_in[6]; p.knb = (const float*)d_in[7];
  p.lq1 = (const float*)d_in[8]; p.lk1 = (const float*)d_in[9]; p.lq2 = (const float*)d_in[10]; p.lk2 = (const float*)d_in[11];
  p.onb = (const float*)d_in[12]; p.w_out = (const float*)d_in[13]; p.g_ffn = (const float*)d_in[14]; p.w_pq = (const float*)d_in[15];
  p.subk = (const float*)d_in[16]; p.pu = (const float*)d_in[17]; p.pv = (const float*)d_in[18];
  p.out = (float*)d_out; p.ws = (char*)d_ws;
  static int grid_blocks = 0;
  if (!grid_blocks) {
    int dev = 0, cus = 0, per_cu = 0;
    hipGetDevice(&dev);
    hipDeviceGetAttribute(&cus, hipDeviceAttributeMultiprocessorCount, dev);
    hipFuncSetAttribute((const void*)fwd_megakernel, hipFuncAttributeMaxDynamicSharedMemorySize, DYN_LDS);
    hipOccupancyMaxActiveBlocksPerMultiprocessor(&per_cu, fwd_megakernel, NTHR, DYN_LDS);
    if (per_cu > 1) per_cu = 1;
    if (per_cu < 1) per_cu = 1;
    grid_blocks = cus * per_cu;
  }
  (void)hipMemsetAsync((char*)d_ws + OFF_BAR, 0, XCD_BAR_WORDS * sizeof(unsigned), stream);
  void* args[] = {&p};
  hipError_t e = hipLaunchCooperativeKernel((void*)fwd_megakernel, dim3(grid_blocks), dim3(NTHR), args, DYN_LDS, stream);
  if (e != hipSuccess) fprintf(stderr, "cooperative launch failed: %s (grid %d)\n", hipGetErrorString(e), grid_blocks);
}
```

```cpp
#include <hip/hip_runtime.h>
#include <hip/hip_cooperative_groups.h>
#include <cstdio>
#include <cstdint>
namespace cg = cooperative_groups;

#ifndef FUSED
#define FUSED 1
#endif
#ifndef PROBE_DUP
#define PROBE_DUP 0
#endif

typedef unsigned short u16;
typedef unsigned char u8;
typedef __attribute__((ext_vector_type(8))) short bf16x8;
typedef __attribute__((ext_vector_type(4))) short s16x4;
typedef __attribute__((ext_vector_type(16))) float f32x16;
typedef __attribute__((ext_vector_type(2))) __bf16 bf2_t;
typedef __attribute__((ext_vector_type(4))) unsigned u32x4;
#define DI __device__ __forceinline__
#define MFMA(a, b, c) __builtin_amdgcn_mfma_f32_32x32x16_bf16((a), (b), (c), 0, 0, 0)

constexpr int T_TOK = 32768;
constexpr int SEQ = 4096;
constexpr size_t MB = 1u << 20;
constexpr size_t OFF_XNB = 0;
constexpr size_t OFF_QA = 64 * MB, OFF_KA = 96 * MB, OFF_VA = 128 * MB, OFF_QB = 160 * MB, OFF_KB = 192 * MB, OFF_VB = 224 * MB;
constexpr size_t OFF_TOPS = 64 * MB;
constexpr size_t OFF_TOPI = 96 * MB;
constexpr size_t OFF_OAP = 256 * MB;
constexpr size_t OFF_OBC = 352 * MB;
constexpr size_t OFF_PUB = 416 * MB, OFF_PVB = 448 * MB;
constexpr size_t OFF_WIN = 480 * MB, OFF_WOUT = 486 * MB, OFF_WPQ = 488 * MB, OFF_SUBK = 492 * MB;
constexpr size_t OFF_ROPEC = 493 * MB, OFF_ROPES = 493 * MB + 128 * 1024;
constexpr size_t OFF_LSE = 494 * MB;
constexpr size_t OFF_HSS = 497 * MB;
constexpr size_t OFF_MISC = 497 * MB + 128 * 1024;

constexpr size_t OFF_BAR = 497 * MB + 256 * 1024;
constexpr int SMEM_BYTES = 73728;
constexpr int NTHR = 512, NWAVE = 8;
constexpr int DYN_LDS = 155648;
#define XCD_BAR_WORDS 3456
constexpr float QSCALE = 0.125f * 1.4426950408889634f;
constexpr float NEG_INF = -__builtin_huge_valf();
constexpr float SM_THR = 8.f;
constexpr float USCALE = 64.f, VSCALE = 16.f;
typedef float f32x2 __attribute__((ext_vector_type(2)));

struct Params {
  const float *x, *g_attn, *w_in, *qna, *kna, *ona, *qnb, *knb, *lq1, *lk1, *lq2, *lk2, *onb, *w_out, *g_ffn, *w_pq, *subk, *pu, *pv;
  float* out;
  char* ws;
};

DI u16 f2bf(float x) { unsigned u = __float_as_uint(x); u += 0x7fffu + ((u >> 16) & 1u); return (u16)(u >> 16); }
DI float bf2f(u16 b) { return __uint_as_float(((unsigned)b) << 16); }
typedef __bf16 bf16x2_t __attribute__((ext_vector_type(2)));
DI unsigned pack2(float a, float b) { bf16x2_t v = {(__bf16)a, (__bf16)b}; return __builtin_bit_cast(unsigned, v); }
DI float bflo(unsigned u) { return __uint_as_float(u << 16); }
DI float bfhi(unsigned u) { return __uint_as_float(u & 0xffff0000u); }
DI float wave_sum(float v) {
  v += __shfl_xor(v, 32); v += __shfl_xor(v, 16); v += __shfl_xor(v, 8); v += __shfl_xor(v, 4); v += __shfl_xor(v, 2); v += __shfl_xor(v, 1);
  return v;
}
DI void gld16(u32x4& dst, const void* ptr) { asm volatile("global_load_dwordx4 %0, %1, off" : "=v"(dst) : "v"(ptr) : "memory"); }
DI void vm_wait8(u32x4& a, u32x4& b, u32x4& c, u32x4& d, u32x4& e, u32x4& f, u32x4& g, u32x4& h) {
  asm volatile("s_waitcnt vmcnt(0)" : "+v"(a), "+v"(b), "+v"(c), "+v"(d), "+v"(e), "+v"(f), "+v"(g), "+v"(h) : : "memory");
}
template <int N> DI void vm_wait8n(u32x4& a, u32x4& b, u32x4& c, u32x4& d, u32x4& e, u32x4& f, u32x4& g, u32x4& h) {
  asm volatile("s_waitcnt vmcnt(%8)" : "+v"(a), "+v"(b), "+v"(c), "+v"(d), "+v"(e), "+v"(f), "+v"(g), "+v"(h) : "n"(N) : "memory");
}
template <int N> DI void vm_wait3n(u32x4& a, u32x4& b, u32x4& c) { asm volatile("s_waitcnt vmcnt(%3)" : "+v"(a), "+v"(b), "+v"(c) : "n"(N) : "memory"); }
DI void vm_wait3(u32x4& a, u32x4& b, u32x4& c) { asm volatile("s_waitcnt vmcnt(0)" : "+v"(a), "+v"(b), "+v"(c) : : "memory"); }
DI void vm_wait6(u32x4& a, u32x4& b, u32x4& c, u32x4& d, u32x4& e, u32x4& f) {
  asm volatile("s_waitcnt vmcnt(0)" : "+v"(a), "+v"(b), "+v"(c), "+v"(d), "+v"(e), "+v"(f) : : "memory");
}
DI int opaque_tid() { int t = threadIdx.x; asm volatile("" : "+v"(t)); return t; }
DI int crow(int reg, int h) { return (reg & 3) + 8 * (reg >> 2) + 4 * h; }

__device__ void phase0(const Params& p, char* smem) {
  const int tid = threadIdx.x, lane = tid & 63, wid = tid >> 6;
  const int gw = blockIdx.x * NWAVE + wid, nw = gridDim.x * NWAVE;
  const int gt = blockIdx.x * NTHR + tid, nt = gridDim.x * NTHR;
  u16* xnb = (u16*)(p.ws + OFF_XNB);
  for (int row = gw; row < T_TOK; row += nw) {
    const float4* xr = (const float4*)(p.x + (size_t)row * 1024);
    float4 v[4]; float ss = 0.f;
#pragma unroll
    for (int i = 0; i < 4; ++i) { v[i] = xr[lane + 64 * i]; ss += v[i].x * v[i].x + v[i].y * v[i].y + v[i].z * v[i].z + v[i].w * v[i].w; }
    ss = wave_sum(ss);
    const float r = rsqrtf(ss * (1.f / 1024.f) + 1e-6f);
    uint2* dst = (uint2*)(xnb + (size_t)row * 1024);
#pragma unroll
    for (int i = 0; i < 4; ++i) dst[lane + 64 * i] = make_uint2(pack2(v[i].x * r, v[i].y * r), pack2(v[i].z * r, v[i].w * r));
  }
  float* tile = (float*)smem;
  for (int job = blockIdx.x; job < 1536; job += gridDim.x) {
    const float* W; const float* g; u16* outp; int N, j;
    if (job < 768) { W = p.w_in; g = p.g_attn; outp = (u16*)(p.ws + OFF_WIN); N = 3072; j = job; }
    else if (job < 1024) { W = p.w_out; g = nullptr; outp = (u16*)(p.ws + OFF_WOUT); N = 1024; j = job - 768; }
    else { W = p.w_pq; g = p.g_ffn; outp = (u16*)(p.ws + OFF_WPQ); N = 2048; j = job - 1024; }
    const int ntn = N >> 6, kt = j / ntn, ntile = j % ntn;
    const int tx = tid & 63, ty = tid >> 6;
#pragma unroll 4
    for (int r = 0; r < 8; ++r) {
      const int k = kt * 64 + ty + 8 * r;
      float v = W[(size_t)k * N + ntile * 64 + tx];
      if (g) v *= g[k];
      tile[(ty + 8 * r) * 65 + tx] = v;
    }
    __syncthreads();
#pragma unroll 4
    for (int r = 0; r < 8; ++r) {
      const int nl = ty + 8 * r;
      int drow = ntile * 64 + nl;
      if (job < 768) {
        const int pos = nl < 16 ? ((nl & 3) | ((nl & 4) << 1) | ((nl & 8) >> 1)) : nl;
        drow = 256 * (ntile >> 2) + 128 * (pos >> 5) + 32 * (ntile & 3) + (pos & 31);
      }
      outp[(size_t)drow * 1024 + kt * 64 + tx] = f2bf(tile[tx * 65 + nl]);
    }
    __syncthreads();
  }
  {
    const float4* s = (const float4*)p.subk; uint2* d = (uint2*)(p.ws + OFF_SUBK);
    for (int i = gt; i < 262144 / 4; i += nt) { float4 v = s[i]; d[i] = make_uint2(pack2(v.x, v.y), pack2(v.z, v.w)); }
    const float4* su = (const float4*)p.pu; int* du = (int*)(p.ws + OFF_PUB);
    const float4* sv = (const float4*)p.pv; int* dv = (int*)(p.ws + OFF_PVB);
    for (int i = gt; i < 16384 * 1024 / 4; i += nt) {
      float4 a = su[i]; float4 b = sv[i];
      int ra = __builtin_amdgcn_cvt_pk_fp8_f32(a.x * USCALE, a.y * USCALE, 0, false);
      ra = __builtin_amdgcn_cvt_pk_fp8_f32(a.z * USCALE, a.w * USCALE, ra, true);
      int rb = __builtin_amdgcn_cvt_pk_fp8_f32(b.x * VSCALE, b.y * VSCALE, 0, false);
      rb = __builtin_amdgcn_cvt_pk_fp8_f32(b.z * VSCALE, b.w * VSCALE, rb, true);
      du[i] = ra; dv[i] = rb;
    }
  }
  {
    float* rc = (float*)(p.ws + OFF_ROPEC); float* rs = (float*)(p.ws + OFF_ROPES);
    for (int i = gt; i < SEQ * 8; i += nt) {
      const int pos = i >> 3, f = i & 7;
      const float invf = (float)pow(500000.0, -(double)f / 8.0);
      const float ang = (float)pos * invf;
      rc[i] = (float)cos((double)ang); rs[i] = (float)sin((double)ang);
    }
    float* hss = (float*)(p.ws + OFF_HSS);
    for (int i = gt; i < T_TOK; i += nt) hss[i] = 0.f;
    if (gt < 256) {
      float* gtab = (float*)(p.ws + OFF_MISC + 1024);
      gtab[gt] = gt < 64 ? p.qna[gt] : gt < 128 ? p.kna[gt - 64] : gt < 192 ? p.qnb[gt - 128] : p.knb[gt - 192];
    }
    unsigned* barw = (unsigned*)(p.ws + OFF_BAR);
    for (int i = gt; i < XCD_BAR_WORDS; i += nt) barw[i] = 0u;
    if (gt == 0) {
      float a = 0.f, b = 0.f;
      for (int i = 0; i < 64; ++i) { a += p.lq1[i] * p.lk1[i]; b += p.lq2[i] * p.lk2[i]; }
      float* misc = (float*)(p.ws + OFF_MISC);
      misc[0] = expf(a) - expf(b) + 0.2f;
      ((int*)misc)[1] = 0; ((int*)misc)[2] = 0;
    }
  }
}

DI void gemm_mainloop(const u16* __restrict__ A, const u16* __restrict__ Bt, int m0, int n0, char* smem, f32x16 (&acc)[2][2]) {
  u16* As = (u16*)smem;
  u16* Bs = As + 2 * 128 * 72;
  const int tid = opaque_tid() & 255, lane = tid & 63, w = tid >> 6, wm = w >> 1, wn = w & 1, lr = lane & 31, lh = lane >> 5;
#pragma unroll
  for (int a = 0; a < 2; ++a)
#pragma unroll
    for (int b = 0; b < 2; ++b)
#pragma unroll
      for (int r = 0; r < 16; ++r) acc[a][b][r] = 0.f;
  u32x4 raA[4], rbA[4], raB[4], rbB[4];
  const int lrow = tid >> 3, lkc = tid & 7;
  const u16* Ag = A + (size_t)(m0 + lrow) * 1024 + lkc * 8;
  const u16* Bg = Bt + (size_t)(n0 + lrow) * 1024 + lkc * 8;
#define GLOAD(S_, kt) { _Pragma("unroll") for (int i = 0; i < 4; ++i) { gld16(ra##S_[i], Ag + (size_t)i * 32 * 1024 + (kt) * 64); gld16(rb##S_[i], Bg + (size_t)i * 32 * 1024 + (kt) * 64); } }
#define SWRITE(S_, buf, NW_) { vm_wait8n<NW_>(ra##S_[0], ra##S_[1], ra##S_[2], ra##S_[3], rb##S_[0], rb##S_[1], rb##S_[2], rb##S_[3]); \
    _Pragma("unroll") for (int i = 0; i < 4; ++i) { *(u32x4*)(As + ((buf) * 128 + lrow + 32 * i) * 72 + lkc * 8) = ra##S_[i]; *(u32x4*)(Bs + ((buf) * 128 + lrow + 32 * i) * 72 + lkc * 8) = rb##S_[i]; } }
#define GCOMPUTE(buf) { \
    const u16* ab = As + ((buf) * 128 + wm * 64 + lr) * 72 + lh * 8; \
    const u16* bb = Bs + ((buf) * 128 + wn * 64 + lr) * 72 + lh * 8; \
    _Pragma("unroll") for (int s = 0; s < 4; ++s) { \
      const bf16x8 a0 = *(const bf16x8*)(ab + s * 16), a1 = *(const bf16x8*)(ab + 32 * 72 + s * 16); \
      const bf16x8 b0 = *(const bf16x8*)(bb + s * 16), b1 = *(const bf16x8*)(bb + 32 * 72 + s * 16); \
      acc[0][0] = MFMA(a0, b0, acc[0][0]); acc[0][1] = MFMA(a0, b1, acc[0][1]); \
      acc[1][0] = MFMA(a1, b0, acc[1][0]); acc[1][1] = MFMA(a1, b1, acc[1][1]); } }
  GLOAD(A, 0); SWRITE(A, 0, 0); GLOAD(A, 1); __syncthreads();
  for (int kt = 0; kt < 14; kt += 2) {
    GLOAD(B, kt + 2);
    GCOMPUTE(0);
    SWRITE(A, 1, 8);
    __syncthreads();
    GLOAD(A, kt + 3);
    GCOMPUTE(1);
    SWRITE(B, 0, 8);
    __syncthreads();
  }
  GCOMPUTE(0);
  SWRITE(A, 1, 0);
  __syncthreads();
  GCOMPUTE(1);
  __syncthreads();
#undef GCOMPUTE
#undef GLOAD
#undef SWRITE
}

DI void stage_acc(const f32x16 (&acc)[2][2], float* st) {
  const int tid = threadIdx.x & 255, lane = tid & 63, w = tid >> 6, wm = w >> 1, wn = w & 1, lr = lane & 31, lh = lane >> 5;
#pragma unroll
  for (int mt = 0; mt < 2; ++mt)
#pragma unroll
    for (int nt = 0; nt < 2; ++nt)
#pragma unroll
      for (int r = 0; r < 16; ++r) st[(wm * 64 + mt * 32 + crow(r, lh)) * 132 + wn * 64 + nt * 32 + lr] = acc[mt][nt][r];
}

namespace pg8 {
#define PG8_LAS __attribute__((address_space(3)))
typedef unsigned short bf16_t;
typedef short bf16x8 __attribute__((ext_vector_type(8)));
typedef float f32x4 __attribute__((ext_vector_type(4)));
typedef unsigned u32x4 __attribute__((ext_vector_type(4)));
constexpr int BM = 256, BK = 64, HALF = 128, HTB = HALF * BK * 2  , STAGE_BYTES = 8 * HTB, NXCD = 8, WGM = 8;

__host__ __device__ __forceinline__ int lds_byte(int r, int c) { const int st = (r >> 4) * 2 + (c >> 5), rr = r & 15, cc = c & 31, ob = rr * 64 + cc * 2; return st * 1024 + (ob ^ (((ob >> 9) & 1) << 5)); }
__host__ __device__ __forceinline__ void stage_rc(int b, int& R, int& C) { const int st = b / 1024, sb = b % 1024, swz = sb ^ (((sb >> 9) & 1) << 5); R = (st >> 1) * 16 + swz / 64; C = (st & 1) * 32 + (swz % 64) / 2; }
__host__ __device__ __forceinline__ int perm32(int rho) { const int n = rho >> 4, i = rho & 15; return 8 * (i >> 2) + 4 * n + (i & 3); }

struct Unit { int pm, pn; };
struct Gemm { const bf16_t* A; const bf16_t* Bt; int M, N, K; };

struct StaticOrder {
    int nM, nN, nwg, G, c;
    __host__ __device__ void init(int M, int N, int G_, int c_) { nM = M / BM; nN = N / BM; nwg = nM * nN; G = G_; c = c_; }
    __host__ __device__ bool next(int i, Unit& u) const {
        const long L = (long)i * G + c; if (L >= nwg) return false;
        int wgid = (int)L; { const int q = nwg / NXCD, r = nwg % NXCD, xcd = wgid % NXCD, off = wgid / NXCD; wgid = (xcd < r ? xcd * (q + 1) : r * (q + 1) + (xcd - r) * q) + off; }
        const int nig = WGM * nN, gid = wgid / nig, fm = gid * WGM, gsz = (nM - fm) < WGM ? (nM - fm) : WGM;
        u.pm = fm + ((wgid % nig) % gsz); u.pn = (wgid % nig) / gsz; return true;
    }
    __device__ __forceinline__ void a_ready(const Unit&) const {}
    __device__ __forceinline__ void done(const Unit&) const {}
};
template <class Epi, class Sched, bool STAMP = false>
__device__ __forceinline__ void gemm_phase(PG8_LAS unsigned char* lds, const Gemm g, const Sched& S, const Epi& E, unsigned long long* stamps) {
    const int tid = threadIdx.x, wid = __builtin_amdgcn_readfirstlane(tid >> 6), lane = tid & 63, wr = wid >> 2, wc = wid & 3, fr = lane & 15, fq = lane >> 4;
    const int K = g.K, nt = K / BK;
    int ts_lo = 0, ts_hi = 0, nts = 0; const unsigned long long rt_entry = STAMP ? (unsigned long long)wall_clock64() : 0ull;
#define PG8_STAMP() do { if (STAMP && wid == 0 && nts < 64) { const unsigned long long _c = (unsigned long long)clock64(); \
        ts_lo = (lane == nts) ? (int)(unsigned)_c : ts_lo; ts_hi = (lane == nts) ? (int)(unsigned)(_c >> 32) : ts_hi; ++nts; } } while (0)
    PG8_STAMP();
    unsigned voffA[2], voffB[2];
#pragma unroll
    for (int i = 0; i < 2; ++i) { int R, C; stage_rc(tid * 16 + i * 8192, R, C); const int Rb = Epi::PERM ? ((R & ~31) + perm32(R & 31)) : R;
        voffA[i] = (unsigned)(R * K + C) * 2u; voffB[i] = (unsigned)(Rb * K + C) * 2u; }
    const size_t kstep = (size_t)(BK * 2);
    const size_t hstep = (size_t)HALF * K * 2;
    const size_t tstep = 2 * hstep;
    const unsigned ldsw = (unsigned)wid * 1024u;
    const int aoff = lds_byte(wr * 64 + fr, fq * 8), boff = lds_byte(wc * 32 + fr, fq * 8);
#define PG8_SA(b, h) (((b) * 2 + (h)) * HTB)
#define PG8_SB(b, h) ((4 + (b) * 2 + (h)) * HTB)
#define PG8_STAGE(bufoff, gbase, voff) do { _Pragma("unroll") for (int _i = 0; _i < 2; ++_i) \
        __builtin_amdgcn_global_load_lds((const unsigned*)((const char*)(gbase) + (voff)[_i]), (PG8_LAS unsigned*)(lds + (bufoff) + ldsw + _i * 8192), 16, 0, 0); } while (0)
#define PG8_LDA(dst, b, h) do { _Pragma("unroll") for (int m = 0; m < 4; ++m) _Pragma("unroll") for (int k = 0; k < 2; ++k) dst[m][k] = *(const PG8_LAS bf16x8*)(lds + PG8_SA(b, h) + aoff + m * 2048 + k * 1024); } while (0)
#define PG8_LDB(dst, b, h) do { _Pragma("unroll") for (int n = 0; n < 2; ++n) _Pragma("unroll") for (int k = 0; k < 2; ++k) dst[n][k] = *(const PG8_LAS bf16x8*)(lds + PG8_SB(b, h) + boff + n * 2048 + k * 1024); } while (0)
#define PG8_MMA(ai, bj, At, Bt) do { __builtin_amdgcn_s_setprio(1); _Pragma("unroll") for (int m = 0; m < 4; ++m) _Pragma("unroll") for (int n = 0; n < 2; ++n) _Pragma("unroll") for (int k = 0; k < 2; ++k) \
        acc[ai][bj][m][n] = __builtin_amdgcn_mfma_f32_16x16x32_bf16(Bt[n][k], At[m][k], acc[ai][bj][m][n], 0, 0, 0); __builtin_amdgcn_s_setprio(0); } while (0)
#define PG8_WAIT_V(n) asm volatile("s_waitcnt vmcnt(" #n ")" ::: "memory")
#define PG8_WAIT_L(n) asm volatile("s_waitcnt lgkmcnt(" #n ")" ::: "memory")
#define PG8_BAR __builtin_amdgcn_s_barrier()
#define PG8_SCHED __builtin_amdgcn_sched_barrier(0)
    Unit cur, nxt; int ui = 0;
    if (!S.next(0, cur)) return;
    f32x4 acc[2][2][4][2];
#pragma unroll
    for (int a = 0; a < 2; ++a)
#pragma unroll
        for (int b = 0; b < 2; ++b)
#pragma unroll
            for (int m = 0; m < 4; ++m)
#pragma unroll
                for (int n = 0; n < 2; ++n) acc[a][b][m][n] = (f32x4){0.f, 0.f, 0.f, 0.f};
    bf16x8 At[4][2], B0[2][2], B1[2][2];
    const char* cA = (const char*)g.A + (size_t)cur.pm * tstep; const char* cB = (const char*)g.Bt + (size_t)cur.pn * tstep;
    S.a_ready(cur);
    PG8_STAGE(PG8_SB(0, 0), cB, voffB); PG8_STAGE(PG8_SA(0, 0), cA, voffA); PG8_STAGE(PG8_SB(0, 1), cB + hstep, voffB); PG8_STAGE(PG8_SA(0, 1), cA + hstep, voffA);
    if (wr == 1) PG8_BAR;
    PG8_WAIT_V(4); PG8_BAR;
    PG8_STAGE(PG8_SB(1, 0), cB + kstep, voffB); PG8_STAGE(PG8_SA(1, 0), cA + kstep, voffA); PG8_STAGE(PG8_SB(1, 1), cB + hstep + kstep, voffB);
    PG8_WAIT_V(6); PG8_BAR;
    PG8_STAMP();
    for (;;) {
        const bool has_next = S.next(ui + 1, nxt);
        const char* nA = has_next ? (const char*)g.A + (size_t)nxt.pm * tstep : cA; const char* nB = has_next ? (const char*)g.Bt + (size_t)nxt.pn * tstep : cB;
        for (int t = 0; t < nt; t += 2) {
            const bool last = (t == nt - 2);
            const char* a1 = cA + (size_t)(t + 1) * kstep;
            const char* a2 = last ? nA : cA + (size_t)(t + 2) * kstep; const char* b2 = last ? nB : cB + (size_t)(t + 2) * kstep;
            const char* a3 = a2 + kstep; const char* b3 = b2 + kstep;
            if (last && has_next) S.a_ready(nxt);
            PG8_LDB(B0, 0, 0); PG8_SCHED; PG8_LDA(At, 0, 0); PG8_STAGE(PG8_SA(1, 1), a1 + hstep, voffA);
            PG8_WAIT_L(8); PG8_BAR; PG8_WAIT_L(0); PG8_MMA(0, 0, At, B0); PG8_BAR; PG8_SCHED;
            PG8_LDB(B1, 0, 1); PG8_STAGE(PG8_SB(0, 0), b2, voffB);
            PG8_BAR; PG8_WAIT_L(0); PG8_MMA(0, 1, At, B1); PG8_BAR;
            PG8_LDA(At, 0, 1); PG8_STAGE(PG8_SA(0, 0), a2, voffA);
            PG8_BAR; PG8_WAIT_L(0); PG8_MMA(1, 0, At, B0); PG8_BAR; PG8_SCHED;
            PG8_STAGE(PG8_SB(0, 1), b2 + hstep, voffB);
            PG8_WAIT_V(6); PG8_BAR; PG8_MMA(1, 1, At, B1); PG8_BAR;
            PG8_LDB(B0, 1, 0); PG8_SCHED; PG8_LDA(At, 1, 0); PG8_STAGE(PG8_SA(0, 1), a2 + hstep, voffA);
            PG8_WAIT_L(8); PG8_BAR; PG8_WAIT_L(0); PG8_MMA(0, 0, At, B0); PG8_BAR; PG8_SCHED;
            PG8_LDB(B1, 1, 1); PG8_STAGE(PG8_SB(1, 0), b3, voffB);
            PG8_BAR; PG8_WAIT_L(0); PG8_MMA(0, 1, At, B1); PG8_BAR;
            PG8_LDA(At, 1, 1); PG8_STAGE(PG8_SA(1, 0), a3, voffA);
            PG8_BAR; PG8_WAIT_L(0); PG8_MMA(1, 0, At, B0); PG8_BAR; PG8_SCHED;
            PG8_STAGE(PG8_SB(1, 1), b3 + hstep, voffB);
            PG8_WAIT_V(6); PG8_BAR; PG8_MMA(1, 1, At, B1); PG8_BAR;
        }
        PG8_STAMP();
        if constexpr (!Epi::AFTER_DRAIN) { E(acc, cur, wr, wc, fr, fq); S.done(cur); }
        PG8_STAMP();
        if (!has_next) break;
#pragma unroll
        for (int a = 0; a < 2; ++a)
#pragma unroll
            for (int b = 0; b < 2; ++b)
#pragma unroll
                for (int m = 0; m < 4; ++m)
#pragma unroll
                    for (int n = 0; n < 2; ++n) acc[a][b][m][n] = (f32x4){0.f, 0.f, 0.f, 0.f};
        cur = nxt; cA = nA; cB = nB; ++ui;
    }
    PG8_WAIT_V(0);
    if (wr == 0) PG8_BAR;
    PG8_BAR;
    if constexpr (Epi::AFTER_DRAIN) { E.fused(acc, cur, wr, wc, fr, fq, lds, wid, lane); S.done(cur); }
    PG8_STAMP();
    if (STAMP && wid == 0) { stamps[lane] = lane < nts ? (((unsigned long long)(unsigned)ts_hi << 32) | (unsigned)ts_lo) : 0ull;
        if (lane == 62) stamps[62] = rt_entry; if (lane == 63) stamps[63] = (unsigned long long)wall_clock64(); }
#undef PG8_STAMP
#undef PG8_SA
#undef PG8_SB
#undef PG8_STAGE
#undef PG8_LDA
#undef PG8_LDB
#undef PG8_MMA
#undef PG8_WAIT_V
#undef PG8_WAIT_L
#undef PG8_BAR
#undef PG8_SCHED
}
}

__device__ void phase1_tile(const Params& p, int mtile, int j, char* smem) {
  f32x16 acc[2][2];
  const int m0 = mtile * 128, n0 = j * 128;
  gemm_mainloop((const u16*)(p.ws + OFF_XNB), (const u16*)(p.ws + OFF_WIN), m0, n0, smem, acc);
  float* st = (float*)smem;
  stage_acc(acc, st);
  __syncthreads();
  const int tid = threadIdx.x & 255, row = tid & 127, half = tid >> 7;
  const int sec = j >> 2;
  const int tok = m0 + row, b = tok >> 12, s = tok & 4095;
  float v[64];
#pragma unroll
  for (int c = 0; c < 16; ++c) { const float4 t4 = *(const float4*)(st + row * 132 + half * 64 + c * 4); v[4 * c] = t4.x; v[4 * c + 1] = t4.y; v[4 * c + 2] = t4.z; v[4 * c + 3] = t4.w; }
  if (sec != 2 && sec != 5) {
    const float* g = sec == 0 ? p.qna : sec == 1 ? p.kna : sec == 3 ? p.qnb : p.knb;
    float ss = 0.f;
#pragma unroll
    for (int i = 0; i < 64; ++i) ss += v[i] * v[i];
    float r = rsqrtf(ss * (1.f / 64.f) + 1e-6f);
    const float post = (sec == 0 || sec == 3) ? QSCALE : 1.f;
#pragma unroll
    for (int i = 0; i < 64; ++i) v[i] = v[i] * r * g[i];
    const float* rc = (const float*)(p.ws + OFF_ROPEC) + s * 8;
    const float* rs = (const float*)(p.ws + OFF_ROPES) + s * 8;
#pragma unroll
    for (int i = 0; i < 8; ++i) {
      const float c = rc[i], sn = rs[i], x1 = v[i], x2 = v[i + 8];
      v[i] = x1 * c - x2 * sn; v[i + 8] = x2 * c + x1 * sn;
    }
#pragma unroll
    for (int i = 0; i < 64; ++i) v[i] *= post;
  }
  u16* dst;
  if (sec == 5) {
    dst = (u16*)(p.ws + OFF_VB) + ((size_t)(b * 4 + (j & 3)) * 4096 + s) * 128 + half * 64;
  } else {
    const size_t off = sec == 0 ? OFF_QA : sec == 1 ? OFF_KA : sec == 2 ? OFF_VA : sec == 3 ? OFF_QB : OFF_KB;
    const int hc = (j & 3) * 2 + half;
    dst = (u16*)(p.ws + off) + ((size_t)(b * 8 + hc) * 4096 + s) * 64;
  }
#pragma unroll
  for (int c = 0; c < 8; ++c)
    ((uint4*)dst)[c] = make_uint4(pack2(v[8 * c], v[8 * c + 1]), pack2(v[8 * c + 2], v[8 * c + 3]), pack2(v[8 * c + 4], v[8 * c + 5]), pack2(v[8 * c + 6], v[8 * c + 7]));
  __syncthreads();
}

template <int OFF> DI s16x4 tr_read(unsigned addr) {
  s16x4 r; asm volatile("ds_read_b64_tr_b16 %0, %1 offset:%2" : "=v"(r) : "v"(addr), "n"(OFF) : "memory"); return r;
}
DI void wait_tr8(s16x4& a0, s16x4& a1, s16x4& a2, s16x4& a3, s16x4& a4, s16x4& a5, s16x4& a6, s16x4& a7) {
  asm volatile("s_waitcnt lgkmcnt(0)" : "+v"(a0), "+v"(a1), "+v"(a2), "+v"(a3), "+v"(a4), "+v"(a5), "+v"(a6), "+v"(a7) : : "memory");
}

#define TR_ISSUE(S_, MT_) { const unsigned a0_ = vaddr + (MT_) * 64; \
        S_##0 = tr_read<0 * 16 * VST * 2>(a0_); S_##1 = tr_read<(0 * 16 + 8) * VST * 2>(a0_); S_##2 = tr_read<1 * 16 * VST * 2>(a0_); S_##3 = tr_read<(1 * 16 + 8) * VST * 2>(a0_); \
        S_##4 = tr_read<2 * 16 * VST * 2>(a0_); S_##5 = tr_read<(2 * 16 + 8) * VST * 2>(a0_); S_##6 = tr_read<3 * 16 * VST * 2>(a0_); S_##7 = tr_read<(3 * 16 + 8) * VST * 2>(a0_); }
#define TR_MFMA(S_, MT_) { \
        o[MT_] = MFMA(__builtin_shufflevector(S_##0, S_##1, 0, 1, 2, 3, 4, 5, 6, 7), pf[0], o[MT_]); o[MT_] = MFMA(__builtin_shufflevector(S_##2, S_##3, 0, 1, 2, 3, 4, 5, 6, 7), pf[1], o[MT_]); \
        o[MT_] = MFMA(__builtin_shufflevector(S_##4, S_##5, 0, 1, 2, 3, 4, 5, 6, 7), pf[2], o[MT_]); o[MT_] = MFMA(__builtin_shufflevector(S_##6, S_##7, 0, 1, 2, 3, 4, 5, 6, 7), pf[3], o[MT_]); }
template <int DV, bool CAUSAL>
__device__ void attn_unit(const u16* __restrict__ qbase, const u16* __restrict__ kbase, const u16* __restrict__ vbase, int q0, int kb0, int kt_begin, int kt_end,
                          int dil, int res, u16* __restrict__ obase, int ostride, float* __restrict__ lsebase, char* smem) {
  constexpr int VST = DV + 32;
  constexpr int NMT = DV / 32;
  constexpr int WMAX = CAUSAL ? (1 << 30) : 128;
  u16* Ks = (u16*)smem;
  u16* Vs = Ks + 3 * 64 * 72;
  const int tid = opaque_tid(), lane = tid & 63, w = tid >> 6, lr = lane & 31, lh = lane >> 5;
  const int mq = q0 + 32 * w + lr;
  const size_t tq = (size_t)mq * dil + res;
  bf16x8 qf[4];
  {
    const u16* qp = qbase + tq * 64 + lh * 8;
#pragma unroll
    for (int s = 0; s < 4; ++s) qf[s] = *(const bf16x8*)(qp + s * 16);
    asm volatile("" : "+v"(qf[0]), "+v"(qf[1]), "+v"(qf[2]), "+v"(qf[3]));
  }
  f32x16 o[NMT];
#pragma unroll
  for (int mt = 0; mt < NMT; ++mt)
#pragma unroll
    for (int r = 0; r < 16; ++r) o[mt][r] = 0.f;
  float m_run = 0.f, l_run = 0.f;
  u32x4 rkA, rvA0, rvA1, rkB, rvB0, rvB1;
  rvA1 = rvB1 = (u32x4){0u, 0u, 0u, 0u}; rkB = rvB0 = rvA1;
  const int krow_ = tid >> 3, kkc = tid & 7;
  constexpr int VCPR = DV / 8;
  const int vrow = tid / VCPR, vkc = tid % VCPR;
  const u16* kgp = kbase + ((size_t)(kb0 + krow_) * dil + res) * 64 + kkc * 8;
  const u16* vgp = vbase + ((size_t)(kb0 + vrow) * dil + res) * DV + vkc * 8;
  const size_t kstep64 = (size_t)64 * dil * 64;
  const size_t vstep32 = (size_t)32 * dil * DV, vstep64 = (size_t)64 * dil * DV;
  u16* ksw = Ks + krow_ * 72 + kkc * 8;
  u16* vsw = Vs + vrow * VST + vkc * 8;
#define AGLOAD(S_, kt) { gld16(rk##S_, kgp + (size_t)(kt) * kstep64); const u16* vp_ = vgp + (size_t)(kt) * vstep64; gld16(rv##S_##0, vp_); if (NMT == 4) gld16(rv##S_##1, vp_ + vstep32); }
#define ASWRITE(S_, buf, NW_) { vm_wait3n<NW_>(rk##S_, rv##S_##0, rv##S_##1); *(u32x4*)(ksw + (buf) * 64 * 72) = rk##S_; *(u32x4*)(vsw + (buf) * 64 * VST) = rv##S_##0; \
    if (NMT == 4) *(u32x4*)(vsw + (buf) * 64 * VST + 32 * VST) = rv##S_##1; }
  constexpr int NLD = (NMT == 4) ? 3 : 2;
  AGLOAD(A, kt_begin); AGLOAD(B, kt_begin + 1); ASWRITE(A, 0, 0); ASWRITE(B, 1, 0);
  { const int ktl = (kt_begin + 2 < kt_end) ? kt_begin + 2 : kt_end - 1; AGLOAD(A, ktl); }
  __syncthreads();
  const int li = lane & 31, blk = li >> 4, tq_ = (li >> 2) & 3, tp = li & 3;
#define TRR(MT_, KS_, HI_) tr_read<((KS_) * 16 + 8 * (HI_)) * VST * 2 + (MT_) * 64>(vaddr)
#define CAT8(L_, H_) __builtin_shufflevector(L_, H_, 0, 1, 2, 3, 4, 5, 6, 7)
#define ATT_S2(BUF_) { const unsigned vaddr = (unsigned)(size_t)(Vs + ((BUF_) * 64 + 4 * lh + tq_) * VST + 16 * blk + 4 * tp); \
      s16x4 va0, va1, va2, va3, va4, va5, va6, va7; \
      if (NMT == 4) { \
        va0 = TRR(0, 0, 0); va1 = TRR(0, 0, 1); va2 = TRR(1, 0, 0); va3 = TRR(1, 0, 1); va4 = TRR(2, 0, 0); va5 = TRR(2, 0, 1); va6 = TRR(3 % NMT, 0, 0); va7 = TRR(3 % NMT, 0, 1); \
        wait_tr8(va0, va1, va2, va3, va4, va5, va6, va7); \
        o[0] = MFMA(CAT8(va0, va1), pf[0], o[0]); o[1] = MFMA(CAT8(va2, va3), pf[0], o[1]); o[2 % NMT] = MFMA(CAT8(va4, va5), pf[0], o[2 % NMT]); o[3 % NMT] = MFMA(CAT8(va6, va7), pf[0], o[3 % NMT]); \
        va0 = TRR(0, 1, 0); va1 = TRR(0, 1, 1); va2 = TRR(1, 1, 0); va3 = TRR(1, 1, 1); va4 = TRR(2, 1, 0); va5 = TRR(2, 1, 1); va6 = TRR(3 % NMT, 1, 0); va7 = TRR(3 % NMT, 1, 1); \
        wait_tr8(va0, va1, va2, va3, va4, va5, va6, va7); \
        o[0] = MFMA(CAT8(va0, va1), pf[1], o[0]); o[1] = MFMA(CAT8(va2, va3), pf[1], o[1]); o[2 % NMT] = MFMA(CAT8(va4, va5), pf[1], o[2 % NMT]); o[3 % NMT] = MFMA(CAT8(va6, va7), pf[1], o[3 % NMT]); \
        va0 = TRR(0, 2, 0); va1 = TRR(0, 2, 1); va2 = TRR(1, 2, 0); va3 = TRR(1, 2, 1); va4 = TRR(2, 2, 0); va5 = TRR(2, 2, 1); va6 = TRR(3 % NMT, 2, 0); va7 = TRR(3 % NMT, 2, 1); \
        wait_tr8(va0, va1, va2, va3, va4, va5, va6, va7); \
        o[0] = MFMA(CAT8(va0, va1), pf[2], o[0]); o[1] = MFMA(CAT8(va2, va3), pf[2], o[1]); o[2 % NMT] = MFMA(CAT8(va4, va5), pf[2], o[2 % NMT]); o[3 % NMT] = MFMA(CAT8(va6, va7), pf[2], o[3 % NMT]); \
        va0 = TRR(0, 3, 0); va1 = TRR(0, 3, 1); va2 = TRR(1, 3, 0); va3 = TRR(1, 3, 1); va4 = TRR(2, 3, 0); va5 = TRR(2, 3, 1); va6 = TRR(3 % NMT, 3, 0); va7 = TRR(3 % NMT, 3, 1); \
        wait_tr8(va0, va1, va2, va3, va4, va5, va6, va7); \
        o[0] = MFMA(CAT8(va0, va1), pf[3], o[0]); o[1] = MFMA(CAT8(va2, va3), pf[3], o[1]); o[2 % NMT] = MFMA(CAT8(va4, va5), pf[3], o[2 % NMT]); o[3 % NMT] = MFMA(CAT8(va6, va7), pf[3], o[3 % NMT]); \
      } else { \
        va0 = TRR(0, 0, 0); va1 = TRR(0, 0, 1); va2 = TRR(1, 0, 0); va3 = TRR(1, 0, 1); va4 = TRR(0, 1, 0); va5 = TRR(0, 1, 1); va6 = TRR(1, 1, 0); va7 = TRR(1, 1, 1); \
        wait_tr8(va0, va1, va2, va3, va4, va5, va6, va7); \
        o[0] = MFMA(CAT8(va0, va1), pf[0], o[0]); o[1] = MFMA(CAT8(va2, va3), pf[0], o[1]); o[0] = MFMA(CAT8(va4, va5), pf[1], o[0]); o[1] = MFMA(CAT8(va6, va7), pf[1], o[1]); \
        va0 = TRR(0, 2, 0); va1 = TRR(0, 2, 1); va2 = TRR(1, 2, 0); va3 = TRR(1, 2, 1); va4 = TRR(0, 3, 0); va5 = TRR(0, 3, 1); va6 = TRR(1, 3, 0); va7 = TRR(1, 3, 1); \
        wait_tr8(va0, va1, va2, va3, va4, va5, va6, va7); \
        o[0] = MFMA(CAT8(va0, va1), pf[2], o[0]); o[1] = MFMA(CAT8(va2, va3), pf[2], o[1]); o[0] = MFMA(CAT8(va4, va5), pf[3], o[0]); o[1] = MFMA(CAT8(va6, va7), pf[3], o[1]); \
      } }
  bf16x8 pf[4];
  f32x16 stA[2], stB[2];
  int b3 = 0;
  const int q_lo = q0 + 32 * w;
#define ATT_QK(ST_, SLOT_) { const u16* kb_ = Ks + ((SLOT_) * 64 + lr) * 72 + lh * 8; \
_Pragma("unroll") \
    for (int kk = 0; kk < 2; ++kk) \
_Pragma("unroll") \
      for (int r = 0; r < 16; ++r) ST_[kk][r] = -m_run; \
_Pragma("unroll") \
    for (int s = 0; s < 4; ++s) \
_Pragma("unroll") \
      for (int kk = 0; kk < 2; ++kk) { const bf16x8 a = *(const bf16x8*)(kb_ + kk * 32 * 72 + s * 16); ST_[kk] = MFMA(a, qf[s], ST_[kk]); } }
  { const int k_lo = kb0 + 64 * kt_begin; const int dmin = q_lo - (k_lo + 63), dmax = q_lo + 31 - k_lo;
    if (!((dmax < 0) || (dmin > WMAX))) { ATT_QK(stA, 0); } }
#define ATT_STEP(KT_, AGLOAD_Y, ASWRITE_X, CUR, NXT) { const int kt = (KT_); \
    const int sl0 = b3, sl1 = (b3 == 2) ? 0 : b3 + 1, sl2 = (sl1 == 2) ? 0 : sl1 + 1; \
    { const int ktl = (kt + 3 < kt_end) ? kt + 3 : kt_end - 1; AGLOAD_Y(ktl); } \
    __builtin_amdgcn_sched_barrier(0); \
    const int k_lo = kb0 + 64 * kt; \
    const int dmin = q_lo - (k_lo + 63), dmax = q_lo + 31 - k_lo; \
    const bool skip = (dmax < 0) || (dmin > WMAX); \
    const bool skip1 = (kt + 1 >= kt_end) || (dmax - 64 < 0) || (dmin - 64 > WMAX); \
    if (!skip1) { ATT_QK(NXT, sl1); } \
    if (!skip) { \
      const bool need_mask = (dmin < 0) || (dmax > WMAX); \
      if (need_mask) { \
_Pragma("unroll") \
        for (int kk = 0; kk < 2; ++kk) \
_Pragma("unroll") \
          for (int r = 0; r < 16; ++r) { \
            const int d = mq - (k_lo + 32 * kk + crow(r, lh)); \
            if (d < 0 || d > WMAX) CUR[kk][r] = NEG_INF; \
          } \
      } \
      float mx = NEG_INF; \
_Pragma("unroll") \
      for (int kk = 0; kk < 2; ++kk) \
_Pragma("unroll") \
        for (int r = 0; r < 16; r += 2) mx = fmaxf(fmaxf(mx, CUR[kk][r]), CUR[kk][r + 1]); \
      if (__builtin_amdgcn_ballot_w64(mx > SM_THR)) { \
        mx = fmaxf(mx, __shfl_xor(mx, 32)); \
        const float d = fmaxf(mx, 0.f); \
        const float alpha = __builtin_amdgcn_exp2f(-d); \
_Pragma("unroll") \
        for (int kk = 0; kk < 2; ++kk) \
_Pragma("unroll") \
          for (int r = 0; r < 16; ++r) CUR[kk][r] -= d; \
        if (!skip1) { \
_Pragma("unroll") \
          for (int kk = 0; kk < 2; ++kk) \
_Pragma("unroll") \
            for (int r = 0; r < 16; ++r) NXT[kk][r] -= d; \
        } \
        l_run *= alpha; m_run += d; \
_Pragma("unroll") \
        for (int mt = 0; mt < NMT; ++mt) \
_Pragma("unroll") \
          for (int r = 0; r < 16; ++r) o[mt][r] *= alpha; \
      } \
      float ls = 0.f; \
_Pragma("unroll") \
      for (int kk = 0; kk < 2; ++kk) \
_Pragma("unroll") \
        for (int r = 0; r < 16; ++r) { const float e = __builtin_amdgcn_exp2f(CUR[kk][r]); CUR[kk][r] = e; ls += e; } \
      l_run += ls; \
_Pragma("unroll") \
      for (int ks = 0; ks < 4; ++ks) { \
        const int kk = ks >> 1, s2 = ks & 1; \
        u32x4 cv; \
        cv[0] = pack2(CUR[kk][8 * s2 + 0], CUR[kk][8 * s2 + 1]); cv[1] = pack2(CUR[kk][8 * s2 + 2], CUR[kk][8 * s2 + 3]); \
        cv[2] = pack2(CUR[kk][8 * s2 + 4], CUR[kk][8 * s2 + 5]); cv[3] = pack2(CUR[kk][8 * s2 + 6], CUR[kk][8 * s2 + 7]); \
        pf[ks] = __builtin_bit_cast(bf16x8, cv); \
      } \
      ATT_S2(sl0); \
    } \
    ASWRITE_X(sl2); \
    __syncthreads(); \
    b3 = sl1; \
  }
#define LDA(k_) AGLOAD(A, k_)
#define LDB(k_) AGLOAD(B, k_)
#define WRA(b_) ASWRITE(A, b_, NLD)
#define WRB(b_) ASWRITE(B, b_, NLD)
  for (int kt2 = kt_begin; kt2 < kt_end; kt2 += 2) {
    ATT_STEP(kt2, LDB, WRA, stA, stB);
    ATT_STEP(kt2 + 1, LDA, WRB, stB, stA);
  }
#undef LDA
#undef LDB
#undef WRA
#undef WRB
#undef ATT_STEP
#undef ATT_QK
#undef ATT_S2
#undef TRR
#undef CAT8
#undef AGLOAD
#undef ASWRITE
  const float l_tot = l_run + __shfl_xor(l_run, 32);
  const float inv = 1.f / l_tot;
  u16* op = obase + tq * ostride;
#pragma unroll
  for (int mt = 0; mt < NMT; ++mt)
#pragma unroll
    for (int g = 0; g < 4; ++g) {
      const int dv0 = 32 * mt + 8 * g + 4 * lh;
      *(uint2*)(op + dv0) = make_uint2(pack2(o[mt][4 * g] * inv, o[mt][4 * g + 1] * inv), pack2(o[mt][4 * g + 2] * inv, o[mt][4 * g + 3] * inv));
    }
  if (!CAUSAL && lh == 0) lsebase[tq * 8] = m_run + log2f(l_tot);
}

constexpr int N_DIFF_UNITS = 1024, N_DIL_UNITS = 3072;
__device__ void phase2_unit(const Params& p, int u, char* smem) {
  if (u < N_DIFF_UNITS) {
    const int n = 15 - (u >> 6), rem = u & 63, b = rem >> 3, hc = rem & 7, h4 = hc >> 1;
    const u16* qb = (const u16*)(p.ws + OFF_QB) + (size_t)(b * 8 + hc) * 4096 * 64;
    const u16* kb = (const u16*)(p.ws + OFF_KB) + (size_t)(b * 8 + hc) * 4096 * 64;
    const u16* vb = (const u16*)(p.ws + OFF_VB) + (size_t)(b * 4 + h4) * 4096 * 128;
    u16* ob = (u16*)(p.ws + OFF_OBC) + (size_t)b * 4096 * 1024 + hc * 128;
    attn_unit<128, true>(qb, kb, vb, 256 * n, 0, 0, 4 * n + 4, 1, 0, ob, 1024, nullptr, smem);
  } else {
    const int u2 = u - N_DIFF_UNITS, pidx = u2 >> 10, rem = u2 & 1023, b = rem >> 7, h = (rem >> 4) & 7, rn = rem & 15;
    const int sh = 2 * pidx, dil = 1 << sh, nbp = 16 >> sh, res = rn >> (4 - sh), n = 2 * (rn & (nbp - 1));
    const u16* qb = (const u16*)(p.ws + OFF_QA) + (size_t)(b * 8 + h) * 4096 * 64;
    const u16* kb = (const u16*)(p.ws + OFF_KA) + (size_t)(b * 8 + h) * 4096 * 64;
    const u16* vb = (const u16*)(p.ws + OFF_VA) + (size_t)(b * 8 + h) * 4096 * 64;
    u16* ob = (u16*)(p.ws + OFF_OAP) + ((size_t)pidx * T_TOK + (size_t)b * 4096) * 512 + h * 64;
    float* lse = (float*)(p.ws + OFF_LSE) + ((size_t)pidx * T_TOK + (size_t)b * 4096) * 8 + h;
    attn_unit<64, false>(qb, kb, vb, 128 * n, 128 * (n - 1), n == 0 ? 2 : 0, 6, dil, res, ob, 512, lse, smem);
  }
}
__device__ void phase2(const Params& p, char* smem, int slot = 1) {
  int* counter = (int*)(p.ws + OFF_MISC) + slot;
  int* s_unit = (int*)(smem + DYN_LDS - 16);
  while (true) {
    if (threadIdx.x == 0) *s_unit = atomicAdd(counter, 1);
    __syncthreads();
    const int u = *s_unit;
    __syncthreads();
    if (u >= N_DIFF_UNITS + N_DIL_UNITS) break;
    phase2_unit(p, u, smem);
  }
}

__device__ void phase3(const Params& p) {
  const int tid = threadIdx.x, lane = tid & 63, wid = tid >> 6;
  const int gw = blockIdx.x * NWAVE + wid, nw = gridDim.x * NWAVE;
  const float lam = ((const float*)(p.ws + OFF_MISC))[0];
  const u16* oap = (const u16*)(p.ws + OFF_OAP);
  const u16* obc = (const u16*)(p.ws + OFF_OBC);
  const float* lse = (const float*)(p.ws + OFF_LSE);
  u16* mix = (u16*)(p.ws + OFF_XNB);
  for (int tok = gw; tok < T_TOK; tok += nw) {
    float o[16]; float ss = 0.f;
    if (lane < 32) {
      const int head = lane >> 2;
      float l0 = lse[(size_t)tok * 8 + head], l1 = lse[((size_t)T_TOK + tok) * 8 + head], l2 = lse[((size_t)2 * T_TOK + tok) * 8 + head];
      const float mx = fmaxf(l0, fmaxf(l1, l2));
      float w0 = exp2f(l0 - mx), w1 = exp2f(l1 - mx), w2 = exp2f(l2 - mx);
      const float inv = 1.f / (w0 + w1 + w2); w0 *= inv; w1 *= inv; w2 *= inv;
      const uint4* p0 = (const uint4*)(oap + (size_t)tok * 512 + lane * 16);
      const uint4* p1 = (const uint4*)(oap + ((size_t)T_TOK + tok) * 512 + lane * 16);
      const uint4* p2 = (const uint4*)(oap + ((size_t)2 * T_TOK + tok) * 512 + lane * 16);
#pragma unroll
      for (int c = 0; c < 2; ++c) {
        const uint4 a = p0[c], b = p1[c], d = p2[c];
        const unsigned au[4] = {a.x, a.y, a.z, a.w}, bu[4] = {b.x, b.y, b.z, b.w}, du[4] = {d.x, d.y, d.z, d.w};
#pragma unroll
        for (int k = 0; k < 4; ++k) {
          o[c * 8 + 2 * k] = w0 * bflo(au[k]) + w1 * bflo(bu[k]) + w2 * bflo(du[k]);
          o[c * 8 + 2 * k + 1] = w0 * bfhi(au[k]) + w1 * bfhi(bu[k]) + w2 * bfhi(du[k]);
        }
      }
    } else {
      const int l2 = lane - 32, head = l2 >> 3, cc = (l2 & 7) * 16;
      const uint4* p0 = (const uint4*)(obc + (size_t)tok * 1024 + (2 * head) * 128 + cc);
      const uint4* p1 = (const uint4*)(obc + (size_t)tok * 1024 + (2 * head + 1) * 128 + cc);
#pragma unroll
      for (int c = 0; c < 2; ++c) {
        const uint4 a = p0[c], b = p1[c];
        const unsigned au[4] = {a.x, a.y, a.z, a.w}, bu[4] = {b.x, b.y, b.z, b.w};
#pragma unroll
        for (int k = 0; k < 4; ++k) {
          o[c * 8 + 2 * k] = bflo(au[k]) - lam * bflo(bu[k]);
          o[c * 8 + 2 * k + 1] = bfhi(au[k]) - lam * bfhi(bu[k]);
        }
      }
    }
#pragma unroll
    for (int i = 0; i < 16; ++i) ss += o[i] * o[i];
    const float s1 = ss + __shfl_xor(ss, 1);
    const float s2 = s1 + __shfl_xor(s1, 2);
    const float s3 = s2 + __shfl_xor(s2, 4);
    float r; const float* g;
    if (lane < 32) { r = rsqrtf(s2 * (1.f / 64.f) + 1e-6f); g = p.ona + lane * 16; }
    else { r = rsqrtf(s3 * (1.f / 128.f) + 1e-6f) * 0.8f; g = p.onb + (lane - 32) * 16; }
    unsigned pk[8];
#pragma unroll
    for (int k = 0; k < 8; ++k) pk[k] = pack2(o[2 * k] * r * g[2 * k], o[2 * k + 1] * r * g[2 * k + 1]);
    uint4* dst = (uint4*)(mix + (size_t)tok * 1024 + lane * 16);
    dst[0] = make_uint4(pk[0], pk[1], pk[2], pk[3]); dst[1] = make_uint4(pk[4], pk[5], pk[6], pk[7]);
  }
}

__device__ void phase4_tile(const Params& p, int mtile, int j, char* smem) {
  f32x16 acc[2][2];
  const int m0 = mtile * 128, n0 = j * 128;
  gemm_mainloop((const u16*)(p.ws + OFF_XNB), (const u16*)(p.ws + OFF_WOUT), m0, n0, smem, acc);
  float* st = (float*)smem;
  stage_acc(acc, st);
  __syncthreads();
  const int tid = threadIdx.x & 255, cgi = tid & 31, r0 = tid >> 5;
  float* hss = (float*)(p.ws + OFF_HSS);
  u16* hb = (u16*)(p.ws + OFF_OAP);
#pragma unroll 4
  for (int ps = 0; ps < 16; ++ps) {
    const int row = r0 + 8 * ps;
    const float4 a = *(const float4*)(st + row * 132 + cgi * 4);
    const size_t gi = (size_t)(m0 + row) * 1024 + n0 + cgi * 4;
    const float4 xv = *(const float4*)(p.x + gi);
    float4 hv; hv.x = xv.x + a.x; hv.y = xv.y + a.y; hv.z = xv.z + a.z; hv.w = xv.w + a.w;
    *(float4*)(p.out + gi) = hv;
    *(uint2*)(hb + gi) = make_uint2(pack2(hv.x, hv.y), pack2(hv.z, hv.w));
    float ss = hv.x * hv.x + hv.y * hv.y + hv.z * hv.z + hv.w * hv.w;
    ss += __shfl_xor(ss, 16); ss += __shfl_xor(ss, 8); ss += __shfl_xor(ss, 4); ss += __shfl_xor(ss, 2); ss += __shfl_xor(ss, 1);
    if (cgi == 0) atomicAdd(hss + m0 + row, ss);
  }
  __syncthreads();
}


struct EpiInProj {
  static constexpr bool PERM = true, AFTER_DRAIN = false;
  char* ws;
  DI void operator()(const pg8::f32x4 (&acc)[2][2][4][2], const pg8::Unit& u, int wr, int wc, int fr, int fq) const {
    const int sec = u.pn >> 1, cl = (u.pn & 1) * 4 + wc;
    const bool isqk = (sec != 2 && sec != 5);
    float g[16];
    if (isqk) {
      const float* gp = (const float*)(ws + OFF_MISC + 1024) + 64 * (sec < 3 ? sec : sec - 1);
#pragma unroll
      for (int idx = 0; idx < 16; ++idx) {
        const int bj = idx >> 3, n = (idx >> 2) & 1, i = idx & 3;
        const int d = (bj == 0 && fq < 2) ? (4 * fq + 8 * n + i) : (32 * bj + 8 * fq + 4 * n + i);
        g[idx] = gp[d];
      }
    }
    const float post = (sec == 0 || sec == 3) ? QSCALE : 1.f;
    const float* rc = (const float*)(ws + OFF_ROPEC);
    const float* rs = (const float*)(ws + OFF_ROPES);
    const size_t off = OFF_QA + (size_t)sec * (32 * MB);
#pragma unroll
    for (int ai = 0; ai < 2; ++ai)
#pragma unroll
      for (int m = 0; m < 4; ++m) {
        const int row = u.pm * 256 + ai * 128 + wr * 64 + m * 16 + fr, b = row >> 12, sq = row & 4095;
        float v[16];
#pragma unroll
        for (int bj = 0; bj < 2; ++bj)
#pragma unroll
          for (int n = 0; n < 2; ++n)
#pragma unroll
            for (int i = 0; i < 4; ++i) v[bj * 8 + n * 4 + i] = acc[ai][bj][m][n][i];
        if (isqk) {
          float ss = 0.f;
#pragma unroll
          for (int idx = 0; idx < 16; ++idx) ss += v[idx] * v[idx];
          ss += __shfl_xor(ss, 16); ss += __shfl_xor(ss, 32);
          const float r = rsqrtf(ss * (1.f / 64.f) + 1e-6f) * post;
#pragma unroll
          for (int idx = 0; idx < 16; ++idx) v[idx] *= r * g[idx];
          if (fq < 2) {
            const float4 c4 = *(const float4*)(rc + sq * 8 + 4 * fq), s4 = *(const float4*)(rs + sq * 8 + 4 * fq);
            const float cc[4] = {c4.x, c4.y, c4.z, c4.w}, sn[4] = {s4.x, s4.y, s4.z, s4.w};
#pragma unroll
            for (int i = 0; i < 4; ++i) { const float x1 = v[i], x2 = v[4 + i]; v[i] = x1 * cc[i] - x2 * sn[i]; v[4 + i] = x2 * cc[i] + x1 * sn[i]; }
          }
        }
        u16* dst = (sec == 5) ? (u16*)(ws + off) + ((size_t)(b * 4 + (cl >> 1)) * 4096 + sq) * 128 + (cl & 1) * 64
                              : (u16*)(ws + off) + ((size_t)(b * 8 + cl) * 4096 + sq) * 64;
        if (fq < 2) {
          *(uint2*)(dst + 4 * fq) = make_uint2(pack2(v[0], v[1]), pack2(v[2], v[3]));
          *(uint2*)(dst + 8 + 4 * fq) = make_uint2(pack2(v[4], v[5]), pack2(v[6], v[7]));
        } else {
          *(uint4*)(dst + 8 * fq) = make_uint4(pack2(v[0], v[1]), pack2(v[2], v[3]), pack2(v[4], v[5]), pack2(v[6], v[7]));
        }
        *(uint4*)(dst + 32 + 8 * fq) = make_uint4(pack2(v[8], v[9]), pack2(v[10], v[11]), pack2(v[12], v[13]), pack2(v[14], v[15]));
      }
  }
};
__device__ void phase1_big(const Params& p, char* smem) {
  pg8::Gemm g; g.A = (const pg8::bf16_t*)(p.ws + OFF_XNB); g.Bt = (const pg8::bf16_t*)(p.ws + OFF_WIN); g.M = T_TOK; g.N = 3072; g.K = 1024;
  pg8::StaticOrder S; S.init(g.M, g.N, (int)gridDim.x, (int)blockIdx.x);
  EpiInProj E; E.ws = p.ws;
  pg8::gemm_phase<EpiInProj, pg8::StaticOrder, false>((PG8_LAS unsigned char*)smem, g, S, E, nullptr);
}

struct EpiOutProj {
  static constexpr bool PERM = true, AFTER_DRAIN = false;
  const float* x; float* out; u16* hb; float* hss;
  DI void operator()(const pg8::f32x4 (&acc)[2][2][4][2], const pg8::Unit& u, int wr, int wc, int fr, int fq) const {
#pragma unroll
    for (int ai = 0; ai < 2; ++ai)
#pragma unroll
      for (int m = 0; m < 4; ++m) {
        const int row = u.pm * 256 + ai * 128 + wr * 64 + m * 16 + fr;
        float ss = 0.f;
#pragma unroll
        for (int bj = 0; bj < 2; ++bj) {
          const size_t gi = (size_t)row * 1024 + u.pn * 256 + bj * 128 + wc * 32 + 8 * fq;
          const float4 x0 = *(const float4*)(x + gi), x1 = *(const float4*)(x + gi + 4);
          const pg8::f32x4 a0 = acc[ai][bj][m][0], a1 = acc[ai][bj][m][1];
          const float4 h0 = make_float4(x0.x + a0[0], x0.y + a0[1], x0.z + a0[2], x0.w + a0[3]);
          const float4 h1 = make_float4(x1.x + a1[0], x1.y + a1[1], x1.z + a1[2], x1.w + a1[3]);
          *(float4*)(out + gi) = h0; *(float4*)(out + gi + 4) = h1;
          *(uint4*)(hb + gi) = make_uint4(pack2(h0.x, h0.y), pack2(h0.z, h0.w), pack2(h1.x, h1.y), pack2(h1.z, h1.w));
          ss += h0.x * h0.x + h0.y * h0.y + h0.z * h0.z + h0.w * h0.w + h1.x * h1.x + h1.y * h1.y + h1.z * h1.z + h1.w * h1.w;
        }
        ss += __shfl_xor(ss, 16); ss += __shfl_xor(ss, 32);
        if (fq == 0) atomicAdd(hss + row, ss);
      }
  }
};
__device__ void phase4_big(const Params& p, char* smem) {
  pg8::Gemm g; g.A = (const pg8::bf16_t*)(p.ws + OFF_XNB); g.Bt = (const pg8::bf16_t*)(p.ws + OFF_WOUT); g.M = T_TOK; g.N = 1024; g.K = 1024;
  pg8::StaticOrder S; S.init(g.M, g.N, (int)gridDim.x, (int)blockIdx.x);
  EpiOutProj E; E.x = p.x; E.out = p.out; E.hb = (u16*)(p.ws + OFF_OAP); E.hss = (float*)(p.ws + OFF_HSS);
  pg8::gemm_phase<EpiOutProj, pg8::StaticOrder, false>((PG8_LAS unsigned char*)smem, g, S, E, nullptr);
}

#define TK_INSERT(xv, xi) { float x_ = (xv); int i_ = (xi); _Pragma("unroll") for (int q_ = 0; q_ < 16; ++q_) { const bool gt_ = x_ > tv[q_]; const float tvv = tv[q_]; const int tii = ti[q_]; tv[q_] = gt_ ? x_ : tvv; ti[q_] = gt_ ? i_ : tii; x_ = gt_ ? tvv : x_; i_ = gt_ ? tii : i_; } }
__device__ void phase5_tile(const Params& p, int mtile, int j, char* smem) {
  f32x16 acc[2][2];
  const int m0 = mtile * 128, n0 = j * 128;
  gemm_mainloop((const u16*)(p.ws + OFF_OAP), (const u16*)(p.ws + OFF_WPQ), m0, n0, smem, acc);
  const int tid = threadIdx.x & 255, lane = tid & 63, w = tid >> 6, wm = w >> 1, wn = w & 1, lr = lane & 31, lh = lane >> 5;
  u16* Qs = (u16*)smem;
  u16* SKs = Qs + 128 * 136;
  float* rs = (float*)(smem + 2 * 128 * 136 * 2);
  const float* hss = (const float*)(p.ws + OFF_HSS);
  if (tid < 128) rs[tid] = rsqrtf(hss[m0 + tid] * (1.f / 1024.f) + 1e-6f);
  {
    const u16* sk = (const u16*)(p.ws + OFF_SUBK) + (size_t)j * 128 * 128;
#pragma unroll
    for (int i = 0; i < 8; ++i) { const int c = tid + 256 * i, row = c >> 4, kc = c & 15; *(uint4*)(SKs + row * 136 + kc * 8) = *(const uint4*)(sk + row * 128 + kc * 8); }
  }
  __syncthreads();
#pragma unroll
  for (int mt = 0; mt < 2; ++mt)
#pragma unroll
    for (int nt = 0; nt < 2; ++nt)
#pragma unroll
      for (int r = 0; r < 16; ++r) {
        const int row = wm * 64 + mt * 32 + crow(r, lh);
        Qs[row * 136 + wn * 64 + nt * 32 + lr] = f2bf(acc[mt][nt][r] * rs[row]);
      }
  __syncthreads();
#pragma unroll
  for (int a = 0; a < 2; ++a)
#pragma unroll
    for (int b = 0; b < 2; ++b)
#pragma unroll
      for (int r = 0; r < 16; ++r) acc[a][b][r] = 0.f;
  {
    const u16* ab = Qs + (wm * 64 + lr) * 136 + lh * 8;
    const u16* bb = SKs + (wn * 64 + lr) * 136 + lh * 8;
#pragma unroll
    for (int s = 0; s < 8; ++s) {
      const bf16x8 a0 = *(const bf16x8*)(ab + s * 16), a1 = *(const bf16x8*)(ab + 32 * 136 + s * 16);
      const bf16x8 b0 = *(const bf16x8*)(bb + s * 16), b1 = *(const bf16x8*)(bb + 32 * 136 + s * 16);
      acc[0][0] = MFMA(a0, b0, acc[0][0]); acc[0][1] = MFMA(a0, b1, acc[0][1]);
      acc[1][0] = MFMA(a1, b0, acc[1][0]); acc[1][1] = MFMA(a1, b1, acc[1][1]);
    }
  }
  __syncthreads();
  float* st = (float*)smem;
  stage_acc(acc, st);
  __syncthreads();
  const int row = tid & 127, half = tid >> 7;
  unsigned tk[16];
#pragma unroll
  for (int q = 0; q < 16; ++q) tk[q] = 0u;
#define TK_KEY(xv, xi) ({ const unsigned u_ = __float_as_uint(xv); const unsigned o_ = (u_ & 0x80000000u) ? ~u_ : (u_ | 0x80000000u); (o_ & 0xFFFFFF80u) | (unsigned)(127 - (xi)); })
#define TK_INS(kv) { unsigned k_ = (kv); _Pragma("unroll") for (int q_ = 0; q_ < 16; ++q_) { const unsigned hi_ = k_ > tk[q_] ? k_ : tk[q_]; k_ = k_ > tk[q_] ? tk[q_] : k_; tk[q_] = hi_; } }
#pragma unroll 2
  for (int c = 0; c < 16; ++c) {
    const float4 v4 = *(const float4*)(st + row * 132 + half * 64 + c * 4);
    const int bi = half * 64 + c * 4;
    TK_INS(TK_KEY(v4.x, bi)); TK_INS(TK_KEY(v4.y, bi + 1)); TK_INS(TK_KEY(v4.z, bi + 2)); TK_INS(TK_KEY(v4.w, bi + 3));
  }
  __syncthreads();
  if (half == 1) {
#pragma unroll
    for (int q = 0; q < 16; ++q) st[row * 132 + q] = __uint_as_float(tk[q]);
  }
  __syncthreads();
  if (half == 0) {
#pragma unroll 4
    for (int q = 0; q < 16; ++q) TK_INS(__float_as_uint(st[row * 132 + q]));
    const size_t base = ((size_t)(m0 + row) * 16 + j) * 16;
    float* tops = (float*)(p.ws + OFF_TOPS) + base;
    u8* topi = (u8*)(p.ws + OFF_TOPI) + base;
    float tv[16]; unsigned ti[16];
#pragma unroll
    for (int q = 0; q < 16; ++q) {
      const unsigned o = tk[q] & 0xFFFFFF80u;
      tv[q] = __uint_as_float((o & 0x80000000u) ? (o & 0x7FFFFFFFu) : ~o);
      ti[q] = 127u - (tk[q] & 127u);
    }
#pragma unroll
    for (int c = 0; c < 4; ++c) ((float4*)tops)[c] = make_float4(tv[4 * c], tv[4 * c + 1], tv[4 * c + 2], tv[4 * c + 3]);
    unsigned pk[4];
#pragma unroll
    for (int c = 0; c < 4; ++c) pk[c] = ti[4 * c] | (ti[4 * c + 1] << 8) | (ti[4 * c + 2] << 16) | (ti[4 * c + 3] << 24);
    *(uint4*)topi = make_uint4(pk[0], pk[1], pk[2], pk[3]);
  }
  __syncthreads();
#undef TK_KEY
#undef TK_INS
}


DI void sort16_desc(unsigned (&t)[16]) {
#pragma unroll
  for (int k = 2; k <= 16; k <<= 1)
#pragma unroll
    for (int j = k >> 1; j > 0; j >>= 1)
#pragma unroll
      for (int i = 0; i < 16; ++i) {
        const int l = i ^ j;
        if (l > i) { const bool desc = (i & k) == 0; const unsigned a = t[i], b = t[l]; const unsigned mx = a > b ? a : b, mn = a > b ? b : a; t[i] = desc ? mx : mn; t[l] = desc ? mn : mx; }
      }
}
DI void merge16_desc(unsigned (&a)[16], const unsigned (&b)[16]) {
#pragma unroll
  for (int i = 0; i < 16; ++i) { const unsigned x = a[i], y = b[15 - i]; a[i] = x > y ? x : y; }
#pragma unroll
  for (int j = 8; j > 0; j >>= 1)
#pragma unroll
    for (int i = 0; i < 16; ++i) { const int l = i ^ j; if (l > i) { const unsigned p = a[i], q = a[l]; a[i] = p > q ? p : q; a[l] = p > q ? q : p; } }
}
constexpr size_t OFF_QBUF = 128 * MB;
struct EpiPeerQ {
  static constexpr bool PERM = true, AFTER_DRAIN = false;
  const float* hss; u16* q;
  DI void operator()(const pg8::f32x4 (&acc)[2][2][4][2], const pg8::Unit& u, int wr, int wc, int fr, int fq) const {
#pragma unroll
    for (int ai = 0; ai < 2; ++ai)
#pragma unroll
      for (int m = 0; m < 4; ++m) {
        const int row = u.pm * 256 + ai * 128 + wr * 64 + m * 16 + fr;
        const float r = rsqrtf(hss[row] * (1.f / 1024.f) + 1e-6f);
#pragma unroll
        for (int bj = 0; bj < 2; ++bj) {
          const pg8::f32x4 a0 = acc[ai][bj][m][0], a1 = acc[ai][bj][m][1];
          *(uint4*)(q + (size_t)row * 2048 + u.pn * 256 + bj * 128 + wc * 32 + 8 * fq) =
              make_uint4(pack2(a0[0] * r, a0[1] * r), pack2(a0[2] * r, a0[3] * r), pack2(a1[0] * r, a1[1] * r), pack2(a1[2] * r, a1[3] * r));
        }
      }
  }
};
__device__ void peer_score_tile(const Params& p, int pm, int head, int cc, char* smem) {
  const int tid = opaque_tid(), lane = tid & 63, w = tid >> 6, wm = w >> 1, wn = w & 1, lr = lane & 31, lh = lane >> 5;
  u16* Qs = (u16*)smem;
  u16* SKs = Qs + 256 * 136;
  {
    const u16* qg = (const u16*)(p.ws + OFF_QBUF) + (size_t)(pm * 256) * 2048 + head * 256 + cc * 128;
#pragma unroll
    for (int i = 0; i < 8; ++i) { const int c = tid + 512 * i, row = c >> 4, kc = c & 15; *(uint4*)(Qs + row * 136 + kc * 8) = *(const uint4*)(qg + (size_t)row * 2048 + kc * 8); }
    const u16* sk = (const u16*)(p.ws + OFF_SUBK) + (size_t)(head * 2 + cc) * 128 * 128;
#pragma unroll
    for (int i = 0; i < 4; ++i) { const int c = tid + 512 * i, row = c >> 4, kc = c & 15; *(uint4*)(SKs + row * 136 + kc * 8) = *(const uint4*)(sk + row * 128 + kc * 8); }
  }
  __syncthreads();
  f32x16 acc[2][2];
#pragma unroll
  for (int a = 0; a < 2; ++a)
#pragma unroll
    for (int b = 0; b < 2; ++b)
#pragma unroll
      for (int r = 0; r < 16; ++r) acc[a][b][r] = 0.f;
  {
    const u16* ab = Qs + (wm * 64 + lr) * 136 + lh * 8;
    const u16* bb = SKs + (wn * 64 + lr) * 136 + lh * 8;
#pragma unroll
    for (int s = 0; s < 8; ++s) {
      const bf16x8 a0 = *(const bf16x8*)(ab + s * 16), a1 = *(const bf16x8*)(ab + 32 * 136 + s * 16);
      const bf16x8 b0 = *(const bf16x8*)(bb + s * 16), b1 = *(const bf16x8*)(bb + 32 * 136 + s * 16);
      acc[0][0] = MFMA(a0, b0, acc[0][0]); acc[0][1] = MFMA(a0, b1, acc[0][1]);
      acc[1][0] = MFMA(a1, b0, acc[1][0]); acc[1][1] = MFMA(a1, b1, acc[1][1]);
    }
  }
  __syncthreads();
  float* st = (float*)smem;
#pragma unroll
  for (int mt = 0; mt < 2; ++mt)
#pragma unroll
    for (int nt = 0; nt < 2; ++nt)
#pragma unroll
      for (int r = 0; r < 16; ++r) st[(wm * 64 + mt * 32 + crow(r, lh)) * 132 + wn * 64 + nt * 32 + lr] = acc[mt][nt][r];
  __syncthreads();
  const int row = tid & 255, half = tid >> 8;
#define TK_KEY(xv, xi) ({ const unsigned u_ = __float_as_uint(xv); const unsigned o_ = (u_ & 0x80000000u) ? ~u_ : (u_ | 0x80000000u); (o_ & 0xFFFFFF80u) | (unsigned)(127 - (xi)); })
#define TK_LOAD16(T_, g_) { _Pragma("unroll") for (int c_ = 0; c_ < 4; ++c_) { const float4 v4_ = *(const float4*)(st + row * 132 + half * 64 + (g_) * 16 + c_ * 4); const int bi_ = half * 64 + (g_) * 16 + c_ * 4; \
    T_[4 * c_] = TK_KEY(v4_.x, bi_); T_[4 * c_ + 1] = TK_KEY(v4_.y, bi_ + 1); T_[4 * c_ + 2] = TK_KEY(v4_.z, bi_ + 2); T_[4 * c_ + 3] = TK_KEY(v4_.w, bi_ + 3); } }
  unsigned tk[16], tb[16], tc[16];
  TK_LOAD16(tk, 0); sort16_desc(tk);
  TK_LOAD16(tb, 1); sort16_desc(tb);
  merge16_desc(tk, tb);
  TK_LOAD16(tb, 2); sort16_desc(tb);
  TK_LOAD16(tc, 3); sort16_desc(tc);
  merge16_desc(tb, tc);
  merge16_desc(tk, tb);
  __syncthreads();
  if (half == 1) {
#pragma unroll
    for (int q = 0; q < 16; ++q) st[row * 132 + q] = __uint_as_float(tk[q]);
  }
  __syncthreads();
  if (half == 0) {
#pragma unroll
    for (int q = 0; q < 16; ++q) tb[q] = __float_as_uint(st[row * 132 + q]);
    merge16_desc(tk, tb);
    const size_t base = ((size_t)(pm * 256 + row) * 16 + head * 2 + cc) * 16;
    float* tops = (float*)(p.ws + OFF_TOPS) + base;
    u8* topi = (u8*)(p.ws + OFF_TOPI) + base;
    float tv[16]; unsigned ti[16];
#pragma unroll
    for (int q = 0; q < 16; ++q) {
      const unsigned o = tk[q] & 0xFFFFFF80u;
      tv[q] = __uint_as_float((o & 0x80000000u) ? (o & 0x7FFFFFFFu) : ~o);
      ti[q] = 127u - (tk[q] & 127u);
    }
#pragma unroll
    for (int c = 0; c < 4; ++c) ((float4*)tops)[c] = make_float4(tv[4 * c], tv[4 * c + 1], tv[4 * c + 2], tv[4 * c + 3]);
    unsigned pk[4];
#pragma unroll
    for (int c = 0; c < 4; ++c) pk[c] = ti[4 * c] | (ti[4 * c + 1] << 8) | (ti[4 * c + 2] << 16) | (ti[4 * c + 3] << 24);
    *(uint4*)topi = make_uint4(pk[0], pk[1], pk[2], pk[3]);
  }
  __syncthreads();
#undef TK_KEY
#undef TK_LOAD16
}
__device__ void phase5_big(const Params& p, char* smem) {
  pg8::Gemm g; g.A = (const pg8::bf16_t*)(p.ws + OFF_OAP); g.Bt = (const pg8::bf16_t*)(p.ws + OFF_WPQ); g.M = T_TOK; g.N = 2048; g.K = 1024;
  pg8::StaticOrder S; S.init(g.M, g.N, (int)gridDim.x, (int)blockIdx.x);
  EpiPeerQ E; E.hss = (const float*)(p.ws + OFF_HSS); E.q = (u16*)(p.ws + OFF_QBUF);
  pg8::gemm_phase<EpiPeerQ, pg8::StaticOrder, false>((PG8_LAS unsigned char*)smem, g, S, E, nullptr);
  __syncthreads();
  pg8::Unit u;
  for (int i = 0; S.next(i, u); ++i) {
    peer_score_tile(p, u.pm, u.pn, 0, smem);
    peer_score_tile(p, u.pm, u.pn, 1, smem);
  }
}

DI float dpp_xor1(float v) { return __builtin_bit_cast(float, __builtin_amdgcn_update_dpp(0, __builtin_bit_cast(int, v), 0xB1, 0xF, 0xF, true)); }
DI float dpp_xor2(float v) { return __builtin_bit_cast(float, __builtin_amdgcn_update_dpp(0, __builtin_bit_cast(int, v), 0x4E, 0xF, 0xF, true)); }
template <int PAT> DI float swz(float v) { return __builtin_bit_cast(float, __builtin_amdgcn_ds_swizzle(__builtin_bit_cast(int, v), PAT)); }
DI float treduce8(const float (&pp)[8], int lane) {
  const bool b0 = lane & 1, b1 = lane & 2, b2 = lane & 4;
  float q[4];
#pragma unroll
  for (int i = 0; i < 4; ++i) { const float keep = b0 ? pp[2 * i + 1] : pp[2 * i], send = b0 ? pp[2 * i] : pp[2 * i + 1]; q[i] = keep + dpp_xor1(send); }
  float r[2];
#pragma unroll
  for (int i = 0; i < 2; ++i) { const float keep = b1 ? q[2 * i + 1] : q[2 * i], send = b1 ? q[2 * i] : q[2 * i + 1]; r[i] = keep + dpp_xor2(send); }
  float t = (b2 ? r[1] : r[0]) + swz<0x101F>(b2 ? r[0] : r[1]);
  t += swz<0x201F>(t); t += swz<0x401F>(t); t += __shfl_xor(t, 32);
  return t;
}
DI float udot16(const uint4& w, const float (&h)[16]) {
  f32x2 acc = {0.f, 0.f};
  const int ww[4] = {(int)w.x, (int)w.y, (int)w.z, (int)w.w};
#pragma unroll
  for (int j = 0; j < 4; ++j) {
    const f32x2 lo = __builtin_amdgcn_cvt_pk_f32_fp8(ww[j], false), hi = __builtin_amdgcn_cvt_pk_f32_fp8(ww[j], true);
    const f32x2 h0 = {h[4 * j], h[4 * j + 1]}, h1 = {h[4 * j + 2], h[4 * j + 3]};
    acc += lo * h0; acc += hi * h1;
  }
  return acc.x + acc.y;
}
DI void vacc16(const uint4& w, float a, f32x2 (&acc)[8]) {
  const f32x2 a2 = {a, a};
  const int ww[4] = {(int)w.x, (int)w.y, (int)w.z, (int)w.w};
#pragma unroll
  for (int j = 0; j < 4; ++j) {
    acc[2 * j] += a2 * __builtin_amdgcn_cvt_pk_f32_fp8(ww[j], false);
    acc[2 * j + 1] += a2 * __builtin_amdgcn_cvt_pk_f32_fp8(ww[j], true);
  }
}
#define LOAD8(buf, tbl, bidx) { const uint4 i0_ = *(const uint4*)(ids + 8 * (bidx)), i1_ = *(const uint4*)(ids + 8 * (bidx) + 4); \
    const unsigned idv_[8] = {i0_.x, i0_.y, i0_.z, i0_.w, i1_.x, i1_.y, i1_.z, i1_.w}; \
    _Pragma("unroll") for (int k_ = 0; k_ < 8; ++k_) { const unsigned id_ = __builtin_amdgcn_readfirstlane(idv_[k_]); buf[k_] = *(const uint4*)((tbl) + (size_t)id_ * 1024 + lane * 16); } }

__device__ void phase6(const Params& p, char* smem, float* dstbase) {
  const int tid = opaque_tid(), lane = tid & 63, wid = tid >> 6;
  const int gw = blockIdx.x * NWAVE + wid, nw = gridDim.x * NWAVE;
  int* ids = (int*)(smem + wid * 1024);
  float* gts = (float*)(smem + wid * 1024 + 512);
  const float* hss = (const float*)(p.ws + OFF_HSS);
  const float* tops = (const float*)(p.ws + OFF_TOPS);
  const u8* topi = (const u8*)(p.ws + OFF_TOPI);
  const u8* ub = (const u8*)(p.ws + OFF_PUB);
  const u8* vb = (const u8*)(p.ws + OFF_PVB);
  int ci, cj;
  {
    const int L = lane;
    if (L < 16) { ci = 0; cj = L; } else if (L < 24) { ci = 1; cj = L - 16; } else if (L < 29) { ci = 2; cj = L - 24; }
    else if (L < 33) { ci = 3; cj = L - 29; } else if (L < 36) { ci = 4; cj = L - 33; } else if (L < 38) { ci = 5; cj = L - 36; }
    else if (L < 40) { ci = 6; cj = L - 38; } else if (L < 42) { ci = 7; cj = L - 40; } else if (L < 50) { ci = L - 34; cj = 0; }
    else { ci = 0; cj = 0; }
  }
  for (int tok = gw; tok < T_TOK; tok += nw) {
    const float rstd = rsqrtf(hss[tok] * (1.f / 1024.f) + 1e-6f);
    float hres[16], hn[16];
    {
      const float4* hp = (const float4*)(p.out + (size_t)tok * 1024 + lane * 16);
      const float4* gp = (const float4*)(p.g_ffn + lane * 16);
#pragma unroll
      for (int c = 0; c < 4; ++c) {
        const float4 t4 = hp[c], g4 = gp[c];
        hres[4 * c] = t4.x; hres[4 * c + 1] = t4.y; hres[4 * c + 2] = t4.z; hres[4 * c + 3] = t4.w;
        hn[4 * c] = t4.x * rstd * g4.x; hn[4 * c + 1] = t4.y * rstd * g4.y; hn[4 * c + 2] = t4.z * rstd * g4.z; hn[4 * c + 3] = t4.w * rstd * g4.w;
      }
    }
    float sums[8]; int eids[8];
#pragma unroll
    for (int head = 0; head < 8; ++head) {
      const size_t b1 = ((size_t)tok * 16 + head * 2) * 16, b2 = b1 + 16;
      sums[head] = NEG_INF; eids[head] = 0;
      if (lane < 50) { sums[head] = tops[b1 + ci] + tops[b2 + cj]; eids[head] = (int)topi[b1 + ci] * 128 + (int)topi[b2 + cj]; }
    }
#pragma unroll
    for (int head = 0; head < 8; ++head) {
      const float sum = sums[head]; const int eid = eids[head];
      unsigned key;
      {
        const unsigned u_ = __float_as_uint(sum); const unsigned o_ = (u_ & 0x80000000u) ? ~u_ : (u_ | 0x80000000u);
        key = (o_ & 0xFFFFFFC0u) | (unsigned)(63 - lane);
      }
#define BSTEP(K_, J_, SHF_) { const unsigned pr_ = (SHF_); const bool tmx_ = ((lane & (J_)) == 0) == ((lane & (K_)) == 0); \
        const unsigned mx_ = key > pr_ ? key : pr_, mn_ = key > pr_ ? pr_ : key; key = tmx_ ? mx_ : mn_; }
#define SX1 ((unsigned)__builtin_amdgcn_update_dpp(0, (int)key, 0xB1, 0xF, 0xF, true))
#define SX2 ((unsigned)__builtin_amdgcn_update_dpp(0, (int)key, 0x4E, 0xF, 0xF, true))
#define SX4 ((unsigned)__builtin_amdgcn_ds_swizzle((int)key, 0x101F))
#define SX8 ((unsigned)__builtin_amdgcn_ds_swizzle((int)key, 0x201F))
#define SX16 ((unsigned)__builtin_amdgcn_ds_swizzle((int)key, 0x401F))
#define SX32 ((unsigned)__shfl_xor((int)key, 32))
      BSTEP(2, 1, SX1);
      BSTEP(4, 2, SX2); BSTEP(4, 1, SX1);
      BSTEP(8, 4, SX4); BSTEP(8, 2, SX2); BSTEP(8, 1, SX1);
      BSTEP(16, 8, SX8); BSTEP(16, 4, SX4); BSTEP(16, 2, SX2); BSTEP(16, 1, SX1);
      BSTEP(32, 16, SX16); BSTEP(32, 8, SX8); BSTEP(32, 4, SX4); BSTEP(32, 2, SX2); BSTEP(32, 1, SX1);
      BSTEP(64, 32, SX32); BSTEP(64, 16, SX16); BSTEP(64, 8, SX8); BSTEP(64, 4, SX4); BSTEP(64, 2, SX2); BSTEP(64, 1, SX1);
#undef BSTEP
#undef SX1
#undef SX2
#undef SX4
#undef SX8
#undef SX16
#undef SX32
      const int src = 63 - (int)(key & 63u);
      const float sumv = __shfl(sum, src);
      const int eidv = __shfl(eid, src);
      const float mxa = __builtin_bit_cast(float, __builtin_amdgcn_readlane(__builtin_bit_cast(int, sumv), 0));
      const float e = (lane < 16) ? __expf(sumv - mxa) : 0.f;
      float den = e;
      den += dpp_xor1(den); den += dpp_xor2(den); den += swz<0x101F>(den); den += swz<0x201F>(den);
      if (lane < 16) { ids[head * 16 + lane] = eidv; gts[head * 16 + lane] = e / den; }
    }
    __builtin_amdgcn_wave_barrier();
    asm volatile("s_waitcnt lgkmcnt(0)" ::: "memory");
    float dsel0 = 0.f, dsel1 = 0.f;
    {
      uint4 ba[8], bb[8];
      LOAD8(ba, ub, 0);
#pragma unroll 1
      for (int b = 0; b < 16; b += 2) {
        LOAD8(bb, ub, b + 1);
        {
          float pp[8];
#pragma unroll
          for (int k = 0; k < 8; ++k) pp[k] = udot16(ba[k], hn);
          const float t = treduce8(pp, lane);
          if ((lane >> 3) == (b & 7)) { if (b < 8) dsel0 = t; else dsel1 = t; }
        }
        if (b + 2 < 16) LOAD8(ba, ub, b + 2);
        {
          float pp[8];
#pragma unroll
          for (int k = 0; k < 8; ++k) pp[k] = udot16(bb[k], hn);
          const float t = treduce8(pp, lane);
          if ((lane >> 3) == ((b + 1) & 7)) { if (b < 8) dsel0 = t; else dsel1 = t; }
        }
      }
    }
    {
      const float d0 = dsel0 * (1.f / USCALE), d1 = dsel1 * (1.f / USCALE);
      const float a0 = 0.5f * d0 * (1.f + erff(d0 * 0.70710678118654752f)) * gts[lane] * (1.f / VSCALE);
      const float a1 = 0.5f * d1 * (1.f + erff(d1 * 0.70710678118654752f)) * gts[64 + lane] * (1.f / VSCALE);
      gts[lane] = a0; gts[64 + lane] = a1;
    }
    __builtin_amdgcn_wave_barrier();
    asm volatile("s_waitcnt lgkmcnt(0)" ::: "memory");
    f32x2 acc[8];
#pragma unroll
    for (int i = 0; i < 8; ++i) acc[i] = (f32x2){0.f, 0.f};
    {
      uint4 ba[8], bb[8];
      LOAD8(ba, vb, 0);
#pragma unroll 1
      for (int b = 0; b < 16; b += 2) {
        LOAD8(bb, vb, b + 1);
        {
          const float4 g0 = *(const float4*)(gts + 8 * b), g1 = *(const float4*)(gts + 8 * b + 4);
          vacc16(ba[0], g0.x, acc); vacc16(ba[1], g0.y, acc); vacc16(ba[2], g0.z, acc); vacc16(ba[3], g0.w, acc);
          vacc16(ba[4], g1.x, acc); vacc16(ba[5], g1.y, acc); vacc16(ba[6], g1.z, acc); vacc16(ba[7], g1.w, acc);
        }
        if (b + 2 < 16) LOAD8(ba, vb, b + 2);
        {
          const float4 g0 = *(const float4*)(gts + 8 * b + 8), g1 = *(const float4*)(gts + 8 * b + 12);
          vacc16(bb[0], g0.x, acc); vacc16(bb[1], g0.y, acc); vacc16(bb[2], g0.z, acc); vacc16(bb[3], g0.w, acc);
          vacc16(bb[4], g1.x, acc); vacc16(bb[5], g1.y, acc); vacc16(bb[6], g1.z, acc); vacc16(bb[7], g1.w, acc);
        }
      }
    }
    float4* op = (float4*)(dstbase + (size_t)tok * 1024 + lane * 16);
#pragma unroll
    for (int c = 0; c < 4; ++c) op[c] = make_float4(hres[4 * c] + acc[2 * c].x, hres[4 * c + 1] + acc[2 * c].y, hres[4 * c + 2] + acc[2 * c + 1].x, hres[4 * c + 3] + acc[2 * c + 1].y);
    __builtin_amdgcn_wave_barrier();
  }
}


#define XB_TMO      128
#define XB_XCNT(j)  (256  + 64 * (j))
#define XB_XSUB(j)  (1280 + 64 * (j))
#define XB_XGEN(j)  (2304 + 64 * (j))
#define XB_TOP      3328
#define XB_TOPGEN   3392
#define XB_SPIN_CAP (1u << 22)
#define LAS __attribute__((address_space(3)))
DI unsigned xb_ld(unsigned* p) { return __hip_atomic_load(p, __ATOMIC_RELAXED, __HIP_MEMORY_SCOPE_AGENT); }
DI unsigned xb_add(unsigned* p, unsigned v) { return __hip_atomic_fetch_add(p, v, __ATOMIC_RELAXED, __HIP_MEMORY_SCOPE_AGENT); }
DI unsigned xb_xcc_id() { return (unsigned)__builtin_amdgcn_s_getreg((3 << 11) | 20) & 0xFu; }
#define XB_SPIN(cond, bar) do { unsigned _sp = 0; while (cond) { __builtin_amdgcn_s_sleep(1); \
    if ((++_sp & 255u) == 0u) { if (xb_ld(&(bar)[XB_TMO])) break; if (_sp > XB_SPIN_CAP) { atomicAdd(&(bar)[XB_TMO], 1u); break; } } } } while (0)
struct XcdBarrier { unsigned* bar; unsigned x; volatile LAS unsigned* st; };
DI XcdBarrier xcd_barrier_post(unsigned* bar, volatile LAS unsigned* st) {
  XcdBarrier b; b.bar = bar; b.x = xb_xcc_id(); b.st = st;
  if (threadIdx.x == 0) (void)xb_add(&bar[XB_XCNT(b.x)], 1u);
  return b;
}
DI void xcd_barrier_complete(unsigned* bar, unsigned x, unsigned& nloc, unsigned& nx) {
  const unsigned G = gridDim.x * gridDim.y * gridDim.z;
  unsigned sum, cnt, mine, sp = 0u;
  for (;;) {
    sum = 0u; cnt = 0u; mine = 0u;
#pragma unroll
    for (unsigned j = 0; j < 16; ++j) { const unsigned c = xb_ld(&bar[XB_XCNT(j)]); sum += c; cnt += (c > 0u) ? 1u : 0u; mine = (j == x) ? c : mine; }
    if (sum == G) break;
    __builtin_amdgcn_s_sleep(1);
    if ((++sp & 255u) == 0u) { if (xb_ld(&bar[XB_TMO])) break; if (sp > XB_SPIN_CAP) { atomicAdd(&bar[XB_TMO], 1u); break; } }
  }
  nloc = mine > 0u ? mine : 1u; nx = cnt > 0u ? cnt : 1u;
}
DI void xcd_barrier(const XcdBarrier& b) {
  asm volatile("s_waitcnt vmcnt(0)" ::: "memory");
  __syncthreads();
  if (threadIdx.x == 0) {
    unsigned* bar = b.bar;
    __builtin_amdgcn_s_waitcnt(0);
    unsigned nloc = b.st[0], nx = b.st[1];
    if (nloc == 0u) { xcd_barrier_complete(bar, b.x, nloc, nx); b.st[0] = nloc; b.st[1] = nx; }
    const unsigned old = xb_add(&bar[XB_XSUB(b.x)], 1u);
    const unsigned gen = old / nloc;
    if (old + 1u == (gen + 1u) * nloc) {
      __builtin_amdgcn_fence(__ATOMIC_RELEASE, "agent");
      asm volatile("s_waitcnt vmcnt(0)" ::: "memory");
      const unsigned og = xb_add(&bar[XB_TOP], 1u);
      const unsigned tg = og / nx;
      if (og + 1u == (tg + 1u) * nx) xb_add(&bar[XB_TOPGEN], 1u);
      else XB_SPIN(xb_ld(&bar[XB_TOPGEN]) == tg, bar);
      __builtin_amdgcn_fence(__ATOMIC_ACQUIRE, "agent");
      xb_add(&bar[XB_XGEN(b.x)], 1u);
      asm volatile("s_waitcnt vmcnt(0)" ::: "memory");
    } else {
      XB_SPIN(xb_ld(&bar[XB_XGEN(b.x)]) == gen, bar);
      __builtin_amdgcn_fence(__ATOMIC_ACQUIRE, "agent");
      asm volatile("s_waitcnt vmcnt(0)" ::: "memory");
    }
  }
  __syncthreads();
}

__global__ void __launch_bounds__(512, 2) fwd_megakernel(Params p) {
  extern __shared__ __attribute__((aligned(16))) char smem[];
  cg::grid_group grid = cg::this_grid();
  volatile LAS unsigned* xb_words = (volatile LAS unsigned*)(smem + DYN_LDS - 64);
  if (threadIdx.x == 0) { xb_words[0] = 0u; xb_words[1] = 0u; }
  const int half = threadIdx.x >> 8;
  char* hsm = smem + half * SMEM_BYTES;
  phase0(p, smem);
  grid.sync();
  const XcdBarrier xb = xcd_barrier_post((unsigned*)(p.ws + OFF_BAR), xb_words);
  phase1_big(p, smem);
  xcd_barrier(xb);
#if PROBE_DUP == 1
  for (int t = blockIdx.x * 2 + half; t < 256 * 24; t += gridDim.x * 2) phase1_tile(p, t / 24, t % 24, hsm);
  xcd_barrier(xb);
#endif
#if PROBE_DUP == 2
  phase2(p, smem, 2);
  xcd_barrier(xb);
#endif
  phase2(p, smem);
  xcd_barrier(xb);
  phase3(p);
  xcd_barrier(xb);
  phase4_big(p, smem);
  xcd_barrier(xb);
  phase5_big(p, smem);
  xcd_barrier(xb);
#if PROBE_DUP == 5
  for (int t = blockIdx.x * 2 + half; t < 256 * 16; t += gridDim.x * 2) phase5_tile(p, t >> 4, t & 15, hsm);
  xcd_barrier(xb);
#endif
#if PROBE_DUP == 6
  phase6(p, smem, (float*)(p.ws + OFF_OAP));
  xcd_barrier(xb);
#endif
  phase6(p, smem, p.out);
}

extern "C" void kernel_launch(void* const* d_in, const int* in_sizes, int n_in, void* d_out, int out_size, void* d_ws, size_t ws_size,
                              hipStream_t stream) {
  Params p{};
  p.x = (const float*)d_in[0]; p.g_attn = (const float*)d_in[1]; p.w_in = (const float*)d_in[2]; p.qna = (const float*)d_in[3];
  p.kna = (const float*)d_in[4]; p.ona = (const float*)d_in[5]; p.qnb = (const float*)d_in[6]; p.knb = (const float*)d_in[7];
  p.lq1 = (const float*)d_in[8]; p.lk1 = (const float*)d_in[9]; p.lq2 = (const float*)d_in[10]; p.lk2 = (const float*)d_in[11];
  p.onb = (const float*)d_in[12]; p.w_out = (const float*)d_in[13]; p.g_ffn = (const float*)d_in[14]; p.w_pq = (const float*)d_in[15];
  p.subk = (const float*)d_in[16]; p.pu = (const float*)d_in[17]; p.pv = (const float*)d_in[18];
  p.out = (float*)d_out; p.ws = (char*)d_ws;
  static int grid_blocks = 0;
  if (!grid_blocks) {
    int dev = 0, cus = 0, per_cu = 0;
    hipGetDevice(&dev);
    hipDeviceGetAttribute(&cus, hipDeviceAttributeMultiprocessorCount, dev);
    hipFuncSetAttribute((const void*)fwd_megakernel, hipFuncAttributeMaxDynamicSharedMemorySize, DYN_LDS);
    hipOccupancyMaxActiveBlocksPerMultiprocessor(&per_cu, fwd_megakernel, NTHR, DYN_LDS);
    if (per_cu > 1) per_cu = 1;
    if (per_cu < 1) per_cu = 1;
    grid_blocks = cus * per_cu;
  }
  void* args[] = {&p};
  hipError_t e = hipLaunchCooperativeKernel((void*)fwd_megakernel, dim3(grid_blocks), dim3(NTHR), args, DYN_LDS, stream);
  if (e != hipSuccess) fprintf(stderr, "cooperative launch failed: %s (grid %d)\n", hipGetErrorString(e), grid_blocks);
}
```

```cpp
#include <hip/hip_runtime.h>
#include <hip/hip_cooperative_groups.h>
#include <cstdio>
#include <cstdint>
namespace cg = cooperative_groups;

#ifndef FUSED
#define FUSED 1
#endif
#ifndef PROBE_DUP
#define PROBE_DUP 0
#endif

typedef unsigned short u16;
typedef unsigned char u8;
typedef __attribute__((ext_vector_type(8))) short bf16x8;
typedef __attribute__((ext_vector_type(4))) short s16x4;
typedef __attribute__((ext_vector_type(16))) float f32x16;
typedef __attribute__((ext_vector_type(2))) __bf16 bf2_t;
typedef __attribute__((ext_vector_type(4))) unsigned u32x4;
#define DI __device__ __forceinline__
#define MFMA(a, b, c) __builtin_amdgcn_mfma_f32_32x32x16_bf16((a), (b), (c), 0, 0, 0)

constexpr int T_TOK = 32768;
constexpr int SEQ = 4096;
constexpr size_t MB = 1u << 20;
constexpr size_t OFF_XNB = 0;
constexpr size_t OFF_QA = 64 * MB, OFF_KA = 96 * MB, OFF_VA = 128 * MB, OFF_QB = 160 * MB, OFF_KB = 192 * MB, OFF_VB = 224 * MB;
constexpr size_t OFF_TOPS = 64 * MB;
constexpr size_t OFF_TOPI = 96 * MB;
constexpr size_t OFF_OAP = 256 * MB;
constexpr size_t OFF_OBC = 352 * MB;
constexpr size_t OFF_PUB = 416 * MB, OFF_PVB = 448 * MB;
constexpr size_t OFF_WIN = 480 * MB, OFF_WOUT = 486 * MB, OFF_WPQ = 488 * MB, OFF_SUBK = 492 * MB;
constexpr size_t OFF_ROPEC = 493 * MB, OFF_ROPES = 493 * MB + 128 * 1024;
constexpr size_t OFF_LSE = 494 * MB;
constexpr size_t OFF_HSS = 497 * MB;
constexpr size_t OFF_MISC = 497 * MB + 128 * 1024;

constexpr size_t OFF_BAR = 497 * MB + 256 * 1024;
constexpr int SMEM_BYTES = 73728;
constexpr int NTHR = 512, NWAVE = 8;
constexpr int DYN_LDS = 155648;
#define XCD_BAR_WORDS 3456
constexpr float QSCALE = 0.125f * 1.4426950408889634f;
constexpr float NEG_INF = -__builtin_huge_valf();
constexpr float SM_THR = 8.f;
constexpr float USCALE = 64.f, VSCALE = 16.f;
typedef float f32x2 __attribute__((ext_vector_type(2)));

struct Params {
  const float *x, *g_attn, *w_in, *qna, *kna, *ona, *qnb, *knb, *lq1, *lk1, *lq2, *lk2, *onb, *w_out, *g_ffn, *w_pq, *subk, *pu, *pv;
  float* out;
  char* ws;
};

DI u16 f2bf(float x) { unsigned u = __float_as_uint(x); u += 0x7fffu + ((u >> 16) & 1u); return (u16)(u >> 16); }
DI float bf2f(u16 b) { return __uint_as_float(((unsigned)b) << 16); }
typedef __bf16 bf16x2_t __attribute__((ext_vector_type(2)));
DI unsigned pack2(float a, float b) { bf16x2_t v = {(__bf16)a, (__bf16)b}; return __builtin_bit_cast(unsigned, v); }
DI float bflo(unsigned u) { return __uint_as_float(u << 16); }
DI float bfhi(unsigned u) { return __uint_as_float(u & 0xffff0000u); }
DI float wave_sum(float v) {
  v += __shfl_xor(v, 32); v += __shfl_xor(v, 16); v += __shfl_xor(v, 8); v += __shfl_xor(v, 4); v += __shfl_xor(v, 2); v += __shfl_xor(v, 1);
  return v;
}
DI void gld16(u32x4& dst, const void* ptr) { asm volatile("global_load_dwordx4 %0, %1, off" : "=v"(dst) : "v"(ptr) : "memory"); }
DI void vm_wait8(u32x4& a, u32x4& b, u32x4& c, u32x4& d, u32x4& e, u32x4& f, u32x4& g, u32x4& h) {
  asm volatile("s_waitcnt vmcnt(0)" : "+v"(a), "+v"(b), "+v"(c), "+v"(d), "+v"(e), "+v"(f), "+v"(g), "+v"(h) : : "memory");
}
template <int N> DI void vm_wait8n(u32x4& a, u32x4& b, u32x4& c, u32x4& d, u32x4& e, u32x4& f, u32x4& g, u32x4& h) {
  asm volatile("s_waitcnt vmcnt(%8)" : "+v"(a), "+v"(b), "+v"(c), "+v"(d), "+v"(e), "+v"(f), "+v"(g), "+v"(h) : "n"(N) : "memory");
}
template <int N> DI void vm_wait3n(u32x4& a, u32x4& b, u32x4& c) { asm volatile("s_waitcnt vmcnt(%3)" : "+v"(a), "+v"(b), "+v"(c) : "n"(N) : "memory"); }
DI void vm_wait3(u32x4& a, u32x4& b, u32x4& c) { asm volatile("s_waitcnt vmcnt(0)" : "+v"(a), "+v"(b), "+v"(c) : : "memory"); }
DI void vm_wait6(u32x4& a, u32x4& b, u32x4& c, u32x4& d, u32x4& e, u32x4& f) {
  asm volatile("s_waitcnt vmcnt(0)" : "+v"(a), "+v"(b), "+v"(c), "+v"(d), "+v"(e), "+v"(f) : : "memory");
}
DI int opaque_tid() { int t = threadIdx.x; asm volatile("" : "+v"(t)); return t; }
DI int crow(int reg, int h) { return (reg & 3) + 8 * (reg >> 2) + 4 * h; }

__device__ void phase0(const Params& p, char* smem) {
  const int tid = threadIdx.x, lane = tid & 63, wid = tid >> 6;
  const int gw = blockIdx.x * NWAVE + wid, nw = gridDim.x * NWAVE;
  const int gt = blockIdx.x * NTHR + tid, nt = gridDim.x * NTHR;
  u16* xnb = (u16*)(p.ws + OFF_XNB);
  for (int row = gw; row < T_TOK; row += nw) {
    const float4* xr = (const float4*)(p.x + (size_t)row * 1024);
    float4 v[4]; float ss = 0.f;
#pragma unroll
    for (int i = 0; i < 4; ++i) { v[i] = xr[lane + 64 * i]; ss += v[i].x * v[i].x + v[i].y * v[i].y + v[i].z * v[i].z + v[i].w * v[i].w; }
    ss = wave_sum(ss);
    const float r = rsqrtf(ss * (1.f / 1024.f) + 1e-6f);
    uint2* dst = (uint2*)(xnb + (size_t)row * 1024);
#pragma unroll
    for (int i = 0; i < 4; ++i) dst[lane + 64 * i] = make_uint2(pack2(v[i].x * r, v[i].y * r), pack2(v[i].z * r, v[i].w * r));
  }
  float* tile = (float*)smem;
  for (int job = blockIdx.x; job < 1536; job += gridDim.x) {
    const float* W; const float* g; u16* outp; int N, j;
    if (job < 768) { W = p.w_in; g = p.g_attn; outp = (u16*)(p.ws + OFF_WIN); N = 3072; j = job; }
    else if (job < 1024) { W = p.w_out; g = nullptr; outp = (u16*)(p.ws + OFF_WOUT); N = 1024; j = job - 768; }
    else { W = p.w_pq; g = p.g_ffn; outp = (u16*)(p.ws + OFF_WPQ); N = 2048; j = job - 1024; }
    const int ntn = N >> 6, kt = j / ntn, ntile = j % ntn;
    const int tx = tid & 63, ty = tid >> 6;
#pragma unroll 4
    for (int r = 0; r < 8; ++r) {
      const int k = kt * 64 + ty + 8 * r;
      float v = W[(size_t)k * N + ntile * 64 + tx];
      if (g) v *= g[k];
      tile[(ty + 8 * r) * 65 + tx] = v;
    }
    __syncthreads();
#pragma unroll 4
    for (int r = 0; r < 8; ++r) {
      const int nl = ty + 8 * r;
      int drow = ntile * 64 + nl;
      if (job < 768) {
        const int pos = nl < 16 ? ((nl & 3) | ((nl & 4) << 1) | ((nl & 8) >> 1)) : nl;
        drow = 256 * (ntile >> 2) + 128 * (pos >> 5) + 32 * (ntile & 3) + (pos & 31);
      }
      outp[(size_t)drow * 1024 + kt * 64 + tx] = f2bf(tile[tx * 65 + nl]);
    }
    __syncthreads();
  }
  {
    const float4* s = (const float4*)p.subk; uint2* d = (uint2*)(p.ws + OFF_SUBK);
    for (int i = gt; i < 262144 / 4; i += nt) { float4 v = s[i]; d[i] = make_uint2(pack2(v.x, v.y), pack2(v.z, v.w)); }
    const float4* su = (const float4*)p.pu; int* du = (int*)(p.ws + OFF_PUB);
    const float4* sv = (const float4*)p.pv; int* dv = (int*)(p.ws + OFF_PVB);
    for (int i = gt; i < 16384 * 1024 / 4; i += nt) {
      float4 a = su[i]; float4 b = sv[i];
      int ra = __builtin_amdgcn_cvt_pk_fp8_f32(a.x * USCALE, a.y * USCALE, 0, false);
      ra = __builtin_amdgcn_cvt_pk_fp8_f32(a.z * USCALE, a.w * USCALE, ra, true);
      int rb = __builtin_amdgcn_cvt_pk_fp8_f32(b.x * VSCALE, b.y * VSCALE, 0, false);
      rb = __builtin_amdgcn_cvt_pk_fp8_f32(b.z * VSCALE, b.w * VSCALE, rb, true);
      du[i] = ra; dv[i] = rb;
    }
  }
  {
    float* rc = (float*)(p.ws + OFF_ROPEC); float* rs = (float*)(p.ws + OFF_ROPES);
    for (int i = gt; i < SEQ * 8; i += nt) {
      const int pos = i >> 3, f = i & 7;
      const float invf = (float)pow(500000.0, -(double)f / 8.0);
      const float ang = (float)pos * invf;
      rc[i] = (float)cos((double)ang); rs[i] = (float)sin((double)ang);
    }
    float* hss = (float*)(p.ws + OFF_HSS);
    for (int i = gt; i < T_TOK; i += nt) hss[i] = 0.f;
    if (gt < 256) {
      float* gtab = (float*)(p.ws + OFF_MISC + 1024);
      gtab[gt] = gt < 64 ? p.qna[gt] : gt < 128 ? p.kna[gt - 64] : gt < 192 ? p.qnb[gt - 128] : p.knb[gt - 192];
    }
    unsigned* barw = (unsigned*)(p.ws + OFF_BAR);
    for (int i = gt; i < XCD_BAR_WORDS; i += nt) barw[i] = 0u;
    if (gt == 0) {
      float a = 0.f, b = 0.f;
      for (int i = 0; i < 64; ++i) { a += p.lq1[i] * p.lk1[i]; b += p.lq2[i] * p.lk2[i]; }
      float* misc = (float*)(p.ws + OFF_MISC);
      misc[0] = expf(a) - expf(b) + 0.2f;
      ((int*)misc)[1] = 0; ((int*)misc)[2] = 0;
    }
  }
}

DI void gemm_mainloop(const u16* __restrict__ A, const u16* __restrict__ Bt, int m0, int n0, char* smem, f32x16 (&acc)[2][2]) {
  u16* As = (u16*)smem;
  u16* Bs = As + 2 * 128 * 72;
  const int tid = opaque_tid() & 255, lane = tid & 63, w = tid >> 6, wm = w >> 1, wn = w & 1, lr = lane & 31, lh = lane >> 5;
#pragma unroll
  for (int a = 0; a < 2; ++a)
#pragma unroll
    for (int b = 0; b < 2; ++b)
#pragma unroll
      for (int r = 0; r < 16; ++r) acc[a][b][r] = 0.f;
  u32x4 raA[4], rbA[4], raB[4], rbB[4];
  const int lrow = tid >> 3, lkc = tid & 7;
  const u16* Ag = A + (size_t)(m0 + lrow) * 1024 + lkc * 8;
  const u16* Bg = Bt + (size_t)(n0 + lrow) * 1024 + lkc * 8;
#define GLOAD(S_, kt) { _Pragma("unroll") for (int i = 0; i < 4; ++i) { gld16(ra##S_[i], Ag + (size_t)i * 32 * 1024 + (kt) * 64); gld16(rb##S_[i], Bg + (size_t)i * 32 * 1024 + (kt) * 64); } }
#define SWRITE(S_, buf, NW_) { vm_wait8n<NW_>(ra##S_[0], ra##S_[1], ra##S_[2], ra##S_[3], rb##S_[0], rb##S_[1], rb##S_[2], rb##S_[3]); \
    _Pragma("unroll") for (int i = 0; i < 4; ++i) { *(u32x4*)(As + ((buf) * 128 + lrow + 32 * i) * 72 + lkc * 8) = ra##S_[i]; *(u32x4*)(Bs + ((buf) * 128 + lrow + 32 * i) * 72 + lkc * 8) = rb##S_[i]; } }
#define GCOMPUTE(buf) { \
    const u16* ab = As + ((buf) * 128 + wm * 64 + lr) * 72 + lh * 8; \
    const u16* bb = Bs + ((buf) * 128 + wn * 64 + lr) * 72 + lh * 8; \
    _Pragma("unroll") for (int s = 0; s < 4; ++s) { \
      const bf16x8 a0 = *(const bf16x8*)(ab + s * 16), a1 = *(const bf16x8*)(ab + 32 * 72 + s * 16); \
      const bf16x8 b0 = *(const bf16x8*)(bb + s * 16), b1 = *(const bf16x8*)(bb + 32 * 72 + s * 16); \
      acc[0][0] = MFMA(a0, b0, acc[0][0]); acc[0][1] = MFMA(a0, b1, acc[0][1]); \
      acc[1][0] = MFMA(a1, b0, acc[1][0]); acc[1][1] = MFMA(a1, b1, acc[1][1]); } }
  GLOAD(A, 0); SWRITE(A, 0, 0); GLOAD(A, 1); __syncthreads();
  for (int kt = 0; kt < 14; kt += 2) {
    GLOAD(B, kt + 2);
    GCOMPUTE(0);
    SWRITE(A, 1, 8);
    __syncthreads();
    GLOAD(A, kt + 3);
    GCOMPUTE(1);
    SWRITE(B, 0, 8);
    __syncthreads();
  }
  GCOMPUTE(0);
  SWRITE(A, 1, 0);
  __syncthreads();
  GCOMPUTE(1);
  __syncthreads();
#undef GCOMPUTE
#undef GLOAD
#undef SWRITE
}

DI void stage_acc(const f32x16 (&acc)[2][2], float* st) {
  const int tid = threadIdx.x & 255, lane = tid & 63, w = tid >> 6, wm = w >> 1, wn = w & 1, lr = lane & 31, lh = lane >> 5;
#pragma unroll
  for (int mt = 0; mt < 2; ++mt)
#pragma unroll
    for (int nt = 0; nt < 2; ++nt)
#pragma unroll
      for (int r = 0; r < 16; ++r) st[(wm * 64 + mt * 32 + crow(r, lh)) * 132 + wn * 64 + nt * 32 + lr] = acc[mt][nt][r];
}

namespace pg8 {
#define PG8_LAS __attribute__((address_space(3)))
typedef unsigned short bf16_t;
typedef short bf16x8 __attribute__((ext_vector_type(8)));
typedef float f32x4 __attribute__((ext_vector_type(4)));
typedef unsigned u32x4 __attribute__((ext_vector_type(4)));
constexpr int BM = 256, BK = 64, HALF = 128, HTB = HALF * BK * 2  , STAGE_BYTES = 8 * HTB, NXCD = 8, WGM = 8;

__host__ __device__ __forceinline__ int lds_byte(int r, int c) { const int st = (r >> 4) * 2 + (c >> 5), rr = r & 15, cc = c & 31, ob = rr * 64 + cc * 2; return st * 1024 + (ob ^ (((ob >> 9) & 1) << 5)); }
__host__ __device__ __forceinline__ void stage_rc(int b, int& R, int& C) { const int st = b / 1024, sb = b % 1024, swz = sb ^ (((sb >> 9) & 1) << 5); R = (st >> 1) * 16 + swz / 64; C = (st & 1) * 32 + (swz % 64) / 2; }
__host__ __device__ __forceinline__ int perm32(int rho) { const int n = rho >> 4, i = rho & 15; return 8 * (i >> 2) + 4 * n + (i & 3); }

struct Unit { int pm, pn; };
struct Gemm { const bf16_t* A; const bf16_t* Bt; int M, N, K; };

struct StaticOrder {
    int nM, nN, nwg, G, c;
    __host__ __device__ void init(int M, int N, int G_, int c_) { nM = M / BM; nN = N / BM; nwg = nM * nN; G = G_; c = c_; }
    __host__ __device__ bool next(int i, Unit& u) const {
        const long L = (long)i * G + c; if (L >= nwg) return false;
        int wgid = (int)L; { const int q = nwg / NXCD, r = nwg % NXCD, xcd = wgid % NXCD, off = wgid / NXCD; wgid = (xcd < r ? xcd * (q + 1) : r * (q + 1) + (xcd - r) * q) + off; }
        const int nig = WGM * nN, gid = wgid / nig, fm = gid * WGM, gsz = (nM - fm) < WGM ? (nM - fm) : WGM;
        u.pm = fm + ((wgid % nig) % gsz); u.pn = (wgid % nig) / gsz; return true;
    }
    __device__ __forceinline__ void a_ready(const Unit&) const {}
    __device__ __forceinline__ void done(const Unit&) const {}
};
template <class Epi, class Sched, bool STAMP = false>
__device__ __forceinline__ void gemm_phase(PG8_LAS unsigned char* lds, const Gemm g, const Sched& S, const Epi& E, unsigned long long* stamps) {
    const int tid = threadIdx.x, wid = __builtin_amdgcn_readfirstlane(tid >> 6), lane = tid & 63, wr = wid >> 2, wc = wid & 3, fr = lane & 15, fq = lane >> 4;
    const int K = g.K, nt = K / BK;
    int ts_lo = 0, ts_hi = 0, nts = 0; const unsigned long long rt_entry = STAMP ? (unsigned long long)wall_clock64() : 0ull;
#define PG8_STAMP() do { if (STAMP && wid == 0 && nts < 64) { const unsigned long long _c = (unsigned long long)clock64(); \
        ts_lo = (lane == nts) ? (int)(unsigned)_c : ts_lo; ts_hi = (lane == nts) ? (int)(unsigned)(_c >> 32) : ts_hi; ++nts; } } while (0)
    PG8_STAMP();
    unsigned voffA[2], voffB[2];
#pragma unroll
    for (int i = 0; i < 2; ++i) { int R, C; stage_rc(tid * 16 + i * 8192, R, C); const int Rb = Epi::PERM ? ((R & ~31) + perm32(R & 31)) : R;
        voffA[i] = (unsigned)(R * K + C) * 2u; voffB[i] = (unsigned)(Rb * K + C) * 2u; }
    const size_t kstep = (size_t)(BK * 2);
    const size_t hstep = (size_t)HALF * K * 2;
    const size_t tstep = 2 * hstep;
    const unsigned ldsw = (unsigned)wid * 1024u;
    const int aoff = lds_byte(wr * 64 + fr, fq * 8), boff = lds_byte(wc * 32 + fr, fq * 8);
#define PG8_SA(b, h) (((b) * 2 + (h)) * HTB)
#define PG8_SB(b, h) ((4 + (b) * 2 + (h)) * HTB)
#define PG8_STAGE(bufoff, gbase, voff) do { _Pragma("unroll") for (int _i = 0; _i < 2; ++_i) \
        __builtin_amdgcn_global_load_lds((const unsigned*)((const char*)(gbase) + (voff)[_i]), (PG8_LAS unsigned*)(lds + (bufoff) + ldsw + _i * 8192), 16, 0, 0); } while (0)
#define PG8_LDA(dst, b, h) do { _Pragma("unroll") for (int m = 0; m < 4; ++m) _Pragma("unroll") for (int k = 0; k < 2; ++k) dst[m][k] = *(const PG8_LAS bf16x8*)(lds + PG8_SA(b, h) + aoff + m * 2048 + k * 1024); } while (0)
#define PG8_LDB(dst, b, h) do { _Pragma("unroll") for (int n = 0; n < 2; ++n) _Pragma("unroll") for (int k = 0; k < 2; ++k) dst[n][k] = *(const PG8_LAS bf16x8*)(lds + PG8_SB(b, h) + boff + n * 2048 + k * 1024); } while (0)
#define PG8_MMA(ai, bj, At, Bt) do { __builtin_amdgcn_s_setprio(1); _Pragma("unroll") for (int m = 0; m < 4; ++m) _Pragma("unroll") for (int n = 0; n < 2; ++n) _Pragma("unroll") for (int k = 0; k < 2; ++k) \
        acc[ai][bj][m][n] = __builtin_amdgcn_mfma_f32_16x16x32_bf16(Bt[n][k], At[m][k], acc[ai][bj][m][n], 0, 0, 0); __builtin_amdgcn_s_setprio(0); } while (0)
#define PG8_WAIT_V(n) asm volatile("s_waitcnt vmcnt(" #n ")" ::: "memory")
#define PG8_WAIT_L(n) asm volatile("s_waitcnt lgkmcnt(" #n ")" ::: "memory")
#define PG8_BAR __builtin_amdgcn_s_barrier()
#define PG8_SCHED __builtin_amdgcn_sched_barrier(0)
    Unit cur, nxt; int ui = 0;
    if (!S.next(0, cur)) return;
    f32x4 acc[2][2][4][2];
#pragma unroll
    for (int a = 0; a < 2; ++a)
#pragma unroll
        for (int b = 0; b < 2; ++b)
#pragma unroll
            for (int m = 0; m < 4; ++m)
#pragma unroll
                for (int n = 0; n < 2; ++n) acc[a][b][m][n] = (f32x4){0.f, 0.f, 0.f, 0.f};
    bf16x8 At[4][2], B0[2][2], B1[2][2];
    const char* cA = (const char*)g.A + (size_t)cur.pm * tstep; const char* cB = (const char*)g.Bt + (size_t)cur.pn * tstep;
    S.a_ready(cur);
    PG8_STAGE(PG8_SB(0, 0), cB, voffB); PG8_STAGE(PG8_SA(0, 0), cA, voffA); PG8_STAGE(PG8_SB(0, 1), cB + hstep, voffB); PG8_STAGE(PG8_SA(0, 1), cA + hstep, voffA);
    if (wr == 1) PG8_BAR;
    PG8_WAIT_V(4); PG8_BAR;
    PG8_STAGE(PG8_SB(1, 0), cB + kstep, voffB); PG8_STAGE(PG8_SA(1, 0), cA + kstep, voffA); PG8_STAGE(PG8_SB(1, 1), cB + hstep + kstep, voffB);
    PG8_WAIT_V(6); PG8_BAR;
    PG8_STAMP();
    for (;;) {
        const bool has_next = S.next(ui + 1, nxt);
        const char* nA = has_next ? (const char*)g.A + (size_t)nxt.pm * tstep : cA; const char* nB = has_next ? (const char*)g.Bt + (size_t)nxt.pn * tstep : cB;
        for (int t = 0; t < nt; t += 2) {
            const bool last = (t == nt - 2);
            const char* a1 = cA + (size_t)(t + 1) * kstep;
            const char* a2 = last ? nA : cA + (size_t)(t + 2) * kstep; const char* b2 = last ? nB : cB + (size_t)(t + 2) * kstep;
            const char* a3 = a2 + kstep; const char* b3 = b2 + kstep;
            if (last && has_next) S.a_ready(nxt);
            PG8_LDB(B0, 0, 0); PG8_SCHED; PG8_LDA(At, 0, 0); PG8_STAGE(PG8_SA(1, 1), a1 + hstep, voffA);
            PG8_WAIT_L(8); PG8_BAR; PG8_WAIT_L(0); PG8_MMA(0, 0, At, B0); PG8_BAR; PG8_SCHED;
            PG8_LDB(B1, 0, 1); PG8_STAGE(PG8_SB(0, 0), b2, voffB);
            PG8_BAR; PG8_WAIT_L(0); PG8_MMA(0, 1, At, B1); PG8_BAR;
            PG8_LDA(At, 0, 1); PG8_STAGE(PG8_SA(0, 0), a2, voffA);
            PG8_BAR; PG8_WAIT_L(0); PG8_MMA(1, 0, At, B0); PG8_BAR; PG8_SCHED;
            PG8_STAGE(PG8_SB(0, 1), b2 + hstep, voffB);
            PG8_WAIT_V(6); PG8_BAR; PG8_MMA(1, 1, At, B1); PG8_BAR;
            PG8_LDB(B0, 1, 0); PG8_SCHED; PG8_LDA(At, 1, 0); PG8_STAGE(PG8_SA(0, 1), a2 + hstep, voffA);
            PG8_WAIT_L(8); PG8_BAR; PG8_WAIT_L(0); PG8_MMA(0, 0, At, B0); PG8_BAR; PG8_SCHED;
            PG8_LDB(B1, 1, 1); PG8_STAGE(PG8_SB(1, 0), b3, voffB);
            PG8_BAR; PG8_WAIT_L(0); PG8_MMA(0, 1, At, B1); PG8_BAR;
            PG8_LDA(At, 1, 1); PG8_STAGE(PG8_SA(1, 0), a3, voffA);
            PG8_BAR; PG8_WAIT_L(0); PG8_MMA(1, 0, At, B0); PG8_BAR; PG8_SCHED;
            PG8_STAGE(PG8_SB(1, 1), b3 + hstep, voffB);
            PG8_WAIT_V(6); PG8_BAR; PG8_MMA(1, 1, At, B1); PG8_BAR;
        }
        PG8_STAMP();
        if constexpr (!Epi::AFTER_DRAIN) { E(acc, cur, wr, wc, fr, fq); S.done(cur); }
        PG8_STAMP();
        if (!has_next) break;
#pragma unroll
        for (int a = 0; a < 2; ++a)
#pragma unroll
            for (int b = 0; b < 2; ++b)
#pragma unroll
                for (int m = 0; m < 4; ++m)
#pragma unroll
                    for (int n = 0; n < 2; ++n) acc[a][b][m][n] = (f32x4){0.f, 0.f, 0.f, 0.f};
        cur = nxt; cA = nA; cB = nB; ++ui;
    }
    PG8_WAIT_V(0);
    if (wr == 0) PG8_BAR;
    PG8_BAR;
    if constexpr (Epi::AFTER_DRAIN) { E.fused(acc, cur, wr, wc, fr, fq, lds, wid, lane); S.done(cur); }
    PG8_STAMP();
    if (STAMP && wid == 0) { stamps[lane] = lane < nts ? (((unsigned long long)(unsigned)ts_hi << 32) | (unsigned)ts_lo) : 0ull;
        if (lane == 62) stamps[62] = rt_entry; if (lane == 63) stamps[63] = (unsigned long long)wall_clock64(); }
#undef PG8_STAMP
#undef PG8_SA
#undef PG8_SB
#undef PG8_STAGE
#undef PG8_LDA
#undef PG8_LDB
#undef PG8_MMA
#undef PG8_WAIT_V
#undef PG8_WAIT_L
#undef PG8_BAR
#undef PG8_SCHED
}
}

__device__ void phase1_tile(const Params& p, int mtile, int j, char* smem) {
  f32x16 acc[2][2];
  const int m0 = mtile * 128, n0 = j * 128;
  gemm_mainloop((const u16*)(p.ws + OFF_XNB), (const u16*)(p.ws + OFF_WIN), m0, n0, smem, acc);
  float* st = (float*)smem;
  stage_acc(acc, st);
  __syncthreads();
  const int tid = threadIdx.x & 255, row = tid & 127, half = tid >> 7;
  const int sec = j >> 2;
  const int tok = m0 + row, b = tok >> 12, s = tok & 4095;
  float v[64];
#pragma unroll
  for (int c = 0; c < 16; ++c) { const float4 t4 = *(const float4*)(st + row * 132 + half * 64 + c * 4); v[4 * c] = t4.x; v[4 * c + 1] = t4.y; v[4 * c + 2] = t4.z; v[4 * c + 3] = t4.w; }
  if (sec != 2 && sec != 5) {
    const float* g = sec == 0 ? p.qna : sec == 1 ? p.kna : sec == 3 ? p.qnb : p.knb;
    float ss = 0.f;
#pragma unroll
    for (int i = 0; i < 64; ++i) ss += v[i] * v[i];
    float r = rsqrtf(ss * (1.f / 64.f) + 1e-6f);
    const float post = (sec == 0 || sec == 3) ? QSCALE : 1.f;
#pragma unroll
    for (int i = 0; i < 64; ++i) v[i] = v[i] * r * g[i];
    const float* rc = (const float*)(p.ws + OFF_ROPEC) + s * 8;
    const float* rs = (const float*)(p.ws + OFF_ROPES) + s * 8;
#pragma unroll
    for (int i = 0; i < 8; ++i) {
      const float c = rc[i], sn = rs[i], x1 = v[i], x2 = v[i + 8];
      v[i] = x1 * c - x2 * sn; v[i + 8] = x2 * c + x1 * sn;
    }
#pragma unroll
    for (int i = 0; i < 64; ++i) v[i] *= post;
  }
  u16* dst;
  if (sec == 5) {
    dst = (u16*)(p.ws + OFF_VB) + ((size_t)(b * 4 + (j & 3)) * 4096 + s) * 128 + half * 64;
  } else {
    const size_t off = sec == 0 ? OFF_QA : sec == 1 ? OFF_KA : sec == 2 ? OFF_VA : sec == 3 ? OFF_QB : OFF_KB;
    const int hc = (j & 3) * 2 + half;
    dst = (u16*)(p.ws + off) + ((size_t)(b * 8 + hc) * 4096 + s) * 64;
  }
#pragma unroll
  for (int c = 0; c < 8; ++c)
    ((uint4*)dst)[c] = make_uint4(pack2(v[8 * c], v[8 * c + 1]), pack2(v[8 * c + 2], v[8 * c + 3]), pack2(v[8 * c + 4], v[8 * c + 5]), pack2(v[8 * c + 6], v[8 * c + 7]));
  __syncthreads();
}

template <int OFF> DI s16x4 tr_read(unsigned addr) {
  s16x4 r; asm volatile("ds_read_b64_tr_b16 %0, %1 offset:%2" : "=v"(r) : "v"(addr), "n"(OFF) : "memory"); return r;
}
template <int N> DI void wait_tr4n(s16x4& a0, s16x4& a1, s16x4& a2, s16x4& a3) {
  asm volatile("s_waitcnt lgkmcnt(%4)" : "+v"(a0), "+v"(a1), "+v"(a2), "+v"(a3) : "n"(N) : "memory");
}
DI void wait_tr8(s16x4& a0, s16x4& a1, s16x4& a2, s16x4& a3, s16x4& a4, s16x4& a5, s16x4& a6, s16x4& a7) {
  asm volatile("s_waitcnt lgkmcnt(0)" : "+v"(a0), "+v"(a1), "+v"(a2), "+v"(a3), "+v"(a4), "+v"(a5), "+v"(a6), "+v"(a7) : : "memory");
}

#define TR_ISSUE(S_, MT_) { const unsigned a0_ = vaddr + (MT_) * 64; \
        S_##0 = tr_read<0 * 16 * VST * 2>(a0_); S_##1 = tr_read<(0 * 16 + 8) * VST * 2>(a0_); S_##2 = tr_read<1 * 16 * VST * 2>(a0_); S_##3 = tr_read<(1 * 16 + 8) * VST * 2>(a0_); \
        S_##4 = tr_read<2 * 16 * VST * 2>(a0_); S_##5 = tr_read<(2 * 16 + 8) * VST * 2>(a0_); S_##6 = tr_read<3 * 16 * VST * 2>(a0_); S_##7 = tr_read<(3 * 16 + 8) * VST * 2>(a0_); }
#define TR_MFMA(S_, MT_) { \
        o[MT_] = MFMA(__builtin_shufflevector(S_##0, S_##1, 0, 1, 2, 3, 4, 5, 6, 7), pf[0], o[MT_]); o[MT_] = MFMA(__builtin_shufflevector(S_##2, S_##3, 0, 1, 2, 3, 4, 5, 6, 7), pf[1], o[MT_]); \
        o[MT_] = MFMA(__builtin_shufflevector(S_##4, S_##5, 0, 1, 2, 3, 4, 5, 6, 7), pf[2], o[MT_]); o[MT_] = MFMA(__builtin_shufflevector(S_##6, S_##7, 0, 1, 2, 3, 4, 5, 6, 7), pf[3], o[MT_]); }
template <int DV, bool CAUSAL>
__device__ void attn_unit(const u16* __restrict__ qbase, const u16* __restrict__ kbase, const u16* __restrict__ vbase, int q0, int kb0, int kt_begin, int kt_end,
                          int dil, int res, u16* __restrict__ obase, int ostride, float* __restrict__ lsebase, char* smem) {
  constexpr int VST = DV + 32;
  constexpr int NMT = DV / 32;
  constexpr int WMAX = CAUSAL ? (1 << 30) : 128;
  u16* Ks = (u16*)smem;
  u16* Vs = Ks + 3 * 64 * 72;
  const int tid = opaque_tid(), lane = tid & 63, w = tid >> 6, lr = lane & 31, lh = lane >> 5;
  const int mq = q0 + 32 * w + lr;
  const size_t tq = (size_t)mq * dil + res;
  bf16x8 qf[4];
  {
    const u16* qp = qbase + tq * 64 + lh * 8;
#pragma unroll
    for (int s = 0; s < 4; ++s) qf[s] = *(const bf16x8*)(qp + s * 16);
    asm volatile("" : "+v"(qf[0]), "+v"(qf[1]), "+v"(qf[2]), "+v"(qf[3]));
  }
  f32x16 o[NMT];
#pragma unroll
  for (int mt = 0; mt < NMT; ++mt)
#pragma unroll
    for (int r = 0; r < 16; ++r) o[mt][r] = 0.f;
  float m_run = 0.f, l_run = 0.f;
  u32x4 rkA, rvA0, rvA1, rkB, rvB0, rvB1;
  rvA1 = rvB1 = (u32x4){0u, 0u, 0u, 0u}; rkB = rvB0 = rvA1;
  const int krow_ = tid >> 3, kkc = tid & 7;
  constexpr int VCPR = DV / 8;
  const int vrow = tid / VCPR, vkc = tid % VCPR;
  const u16* kgp = kbase + ((size_t)(kb0 + krow_) * dil + res) * 64 + kkc * 8;
  const u16* vgp = vbase + ((size_t)(kb0 + vrow) * dil + res) * DV + vkc * 8;
  const size_t kstep64 = (size_t)64 * dil * 64;
  const size_t vstep32 = (size_t)32 * dil * DV, vstep64 = (size_t)64 * dil * DV;
  u16* ksw = Ks + krow_ * 72 + kkc * 8;
  u16* vsw = Vs + vrow * VST + vkc * 8;
#define AGLOAD(S_, kt) { gld16(rk##S_, kgp + (size_t)(kt) * kstep64); const u16* vp_ = vgp + (size_t)(kt) * vstep64; gld16(rv##S_##0, vp_); if (NMT == 4) gld16(rv##S_##1, vp_ + vstep32); }
#define ASWRITE(S_, buf, NW_) { vm_wait3n<NW_>(rk##S_, rv##S_##0, rv##S_##1); *(u32x4*)(ksw + (buf) * 64 * 72) = rk##S_; *(u32x4*)(vsw + (buf) * 64 * VST) = rv##S_##0; \
    if (NMT == 4) *(u32x4*)(vsw + (buf) * 64 * VST + 32 * VST) = rv##S_##1; }
  constexpr int NLD = (NMT == 4) ? 3 : 2;
  AGLOAD(A, kt_begin); AGLOAD(B, kt_begin + 1); ASWRITE(A, 0, 0); ASWRITE(B, 1, 0);
  { const int ktl = (kt_begin + 2 < kt_end) ? kt_begin + 2 : kt_end - 1; AGLOAD(A, ktl); }
  __syncthreads();
  const int li = lane & 31, blk = li >> 4, tq_ = (li >> 2) & 3, tp = li & 3;
#define TRR(MT_, KS_, HI_) tr_read<((KS_) * 16 + 8 * (HI_)) * VST * 2 + (MT_) * 64>(vaddr)
#define CAT8(L_, H_) __builtin_shufflevector(L_, H_, 0, 1, 2, 3, 4, 5, 6, 7)
#define S2_ISSUE(A_, G_) { constexpr int ks_ = (NMT == 4) ? ((G_) >> 1) : (G_); constexpr int m0_ = (NMT == 4) ? 2 * ((G_) & 1) : 0; \
      A_##0 = TRR(m0_, ks_, 0); A_##1 = TRR(m0_, ks_, 1); A_##2 = TRR(m0_ + 1, ks_, 0); A_##3 = TRR(m0_ + 1, ks_, 1); }
#define S2_MFMA(A_, G_, NW_) { constexpr int ks_ = (NMT == 4) ? ((G_) >> 1) : (G_); constexpr int m0_ = (NMT == 4) ? 2 * ((G_) & 1) : 0; \
      wait_tr4n<NW_>(A_##0, A_##1, A_##2, A_##3); \
      o[m0_] = MFMA(CAT8(A_##0, A_##1), pf[ks_], o[m0_]); o[m0_ + 1] = MFMA(CAT8(A_##2, A_##3), pf[ks_], o[m0_ + 1]); }
#define ATT_S2(BUF_) { const unsigned vaddr = (unsigned)(size_t)(Vs + ((BUF_) * 64 + 4 * lh + tq_) * VST + 16 * blk + 4 * tp); \
      s16x4 va0, va1, va2, va3, vb0, vb1, vb2, vb3; \
      S2_ISSUE(va, 0); S2_ISSUE(vb, 1); \
      S2_MFMA(va, 0, 4); S2_ISSUE(va, 2); \
      S2_MFMA(vb, 1, 4); S2_ISSUE(vb, 3); \
      if (NMT == 4) { \
        S2_MFMA(va, 2, 4); S2_ISSUE(va, 4); \
        S2_MFMA(vb, 3, 4); S2_ISSUE(vb, 5); \
        S2_MFMA(va, 4, 4); S2_ISSUE(va, 6); \
        S2_MFMA(vb, 5, 4); S2_ISSUE(vb, 7); \
        S2_MFMA(va, 6, 4); \
        S2_MFMA(vb, 7, 0); \
      } else { \
        S2_MFMA(va, 2, 4); \
        S2_MFMA(vb, 3, 0); \
      } }
  bf16x8 pf[4];
  f32x16 stA[2], stB[2];
  int b3 = 0;
  const int q_lo = q0 + 32 * w;
#define ATT_QK(ST_, SLOT_) { const u16* kb_ = Ks + ((SLOT_) * 64 + lr) * 72 + lh * 8; \
_Pragma("unroll") \
    for (int kk = 0; kk < 2; ++kk) \
_Pragma("unroll") \
      for (int r = 0; r < 16; ++r) ST_[kk][r] = -m_run; \
_Pragma("unroll") \
    for (int s = 0; s < 4; ++s) \
_Pragma("unroll") \
      for (int kk = 0; kk < 2; ++kk) { const bf16x8 a = *(const bf16x8*)(kb_ + kk * 32 * 72 + s * 16); ST_[kk] = MFMA(a, qf[s], ST_[kk]); } }
  { const int k_lo = kb0 + 64 * kt_begin; const int dmin = q_lo - (k_lo + 63), dmax = q_lo + 31 - k_lo;
    if (!((dmax < 0) || (dmin > WMAX))) { ATT_QK(stA, 0); } }
#define ATT_STEP(KT_, AGLOAD_Y, ASWRITE_X, CUR, NXT) { const int kt = (KT_); \
    const int sl0 = b3, sl1 = (b3 == 2) ? 0 : b3 + 1, sl2 = (sl1 == 2) ? 0 : sl1 + 1; \
    { const int ktl = (kt + 3 < kt_end) ? kt + 3 : kt_end - 1; AGLOAD_Y(ktl); } \
    __builtin_amdgcn_sched_barrier(0); \
    const int k_lo = kb0 + 64 * kt; \
    const int dmin = q_lo - (k_lo + 63), dmax = q_lo + 31 - k_lo; \
    const bool skip = (dmax < 0) || (dmin > WMAX); \
    const bool skip1 = (kt + 1 >= kt_end) || (dmax - 64 < 0) || (dmin - 64 > WMAX); \
    if (!skip1) { ATT_QK(NXT, sl1); } \
    if (!skip) { \
      const bool need_mask = (dmin < 0) || (dmax > WMAX); \
      if (need_mask) { \
_Pragma("unroll") \
        for (int kk = 0; kk < 2; ++kk) \
_Pragma("unroll") \
          for (int r = 0; r < 16; ++r) { \
            const int d = mq - (k_lo + 32 * kk + crow(r, lh)); \
            if (d < 0 || d > WMAX) CUR[kk][r] = NEG_INF; \
          } \
      } \
      float mx = NEG_INF; \
_Pragma("unroll") \
      for (int kk = 0; kk < 2; ++kk) \
_Pragma("unroll") \
        for (int r = 0; r < 16; r += 2) mx = fmaxf(fmaxf(mx, CUR[kk][r]), CUR[kk][r + 1]); \
      if (__builtin_amdgcn_ballot_w64(mx > SM_THR)) { \
        mx = fmaxf(mx, __shfl_xor(mx, 32)); \
        const float d = fmaxf(mx, 0.f); \
        const float alpha = __builtin_amdgcn_exp2f(-d); \
_Pragma("unroll") \
        for (int kk = 0; kk < 2; ++kk) \
_Pragma("unroll") \
          for (int r = 0; r < 16; ++r) CUR[kk][r] -= d; \
        if (!skip1) { \
_Pragma("unroll") \
          for (int kk = 0; kk < 2; ++kk) \
_Pragma("unroll") \
            for (int r = 0; r < 16; ++r) NXT[kk][r] -= d; \
        } \
        l_run *= alpha; m_run += d; \
_Pragma("unroll") \
        for (int mt = 0; mt < NMT; ++mt) \
_Pragma("unroll") \
          for (int r = 0; r < 16; ++r) o[mt][r] *= alpha; \
      } \
      float ls = 0.f; \
_Pragma("unroll") \
      for (int kk = 0; kk < 2; ++kk) \
_Pragma("unroll") \
        for (int r = 0; r < 16; ++r) { const float e = __builtin_amdgcn_exp2f(CUR[kk][r]); CUR[kk][r] = e; ls += e; } \
      l_run += ls; \
_Pragma("unroll") \
      for (int ks = 0; ks < 4; ++ks) { \
        const int kk = ks >> 1, s2 = ks & 1; \
        u32x4 cv; \
        cv[0] = pack2(CUR[kk][8 * s2 + 0], CUR[kk][8 * s2 + 1]); cv[1] = pack2(CUR[kk][8 * s2 + 2], CUR[kk][8 * s2 + 3]); \
        cv[2] = pack2(CUR[kk][8 * s2 + 4], CUR[kk][8 * s2 + 5]); cv[3] = pack2(CUR[kk][8 * s2 + 6], CUR[kk][8 * s2 + 7]); \
        pf[ks] = __builtin_bit_cast(bf16x8, cv); \
      } \
      ATT_S2(sl0); \
    } \
    ASWRITE_X(sl2); \
    __syncthreads(); \
    b3 = sl1; \
  }
#define LDA(k_) AGLOAD(A, k_)
#define LDB(k_) AGLOAD(B, k_)
#define WRA(b_) ASWRITE(A, b_, NLD)
#define WRB(b_) ASWRITE(B, b_, NLD)
  for (int kt2 = kt_begin; kt2 < kt_end; kt2 += 2) {
    ATT_STEP(kt2, LDB, WRA, stA, stB);
    ATT_STEP(kt2 + 1, LDA, WRB, stB, stA);
  }
#undef LDA
#undef LDB
#undef WRA
#undef WRB
#undef ATT_STEP
#undef ATT_QK
#undef ATT_S2
#undef S2_ISSUE
#undef S2_MFMA
#undef TRR
#undef CAT8
#undef AGLOAD
#undef ASWRITE
  const float l_tot = l_run + __shfl_xor(l_run, 32);
  const float inv = 1.f / l_tot;
  u16* op = obase + tq * ostride;
#pragma unroll
  for (int mt = 0; mt < NMT; ++mt)
#pragma unroll
    for (int g = 0; g < 4; ++g) {
      const int dv0 = 32 * mt + 8 * g + 4 * lh;
      *(uint2*)(op + dv0) = make_uint2(pack2(o[mt][4 * g] * inv, o[mt][4 * g + 1] * inv), pack2(o[mt][4 * g + 2] * inv, o[mt][4 * g + 3] * inv));
    }
  if (!CAUSAL && lh == 0) lsebase[tq * 8] = m_run + log2f(l_tot);
}

constexpr int N_DIFF_UNITS = 1024, N_DIL_UNITS = 3072;
__device__ void phase2_unit(const Params& p, int u, char* smem) {
  if (u < N_DIFF_UNITS) {
    const int n = 15 - (u >> 6), rem = u & 63, b = rem >> 3, hc = rem & 7, h4 = hc >> 1;
    const u16* qb = (const u16*)(p.ws + OFF_QB) + (size_t)(b * 8 + hc) * 4096 * 64;
    const u16* kb = (const u16*)(p.ws + OFF_KB) + (size_t)(b * 8 + hc) * 4096 * 64;
    const u16* vb = (const u16*)(p.ws + OFF_VB) + (size_t)(b * 4 + h4) * 4096 * 128;
    u16* ob = (u16*)(p.ws + OFF_OBC) + (size_t)b * 4096 * 1024 + hc * 128;
    attn_unit<128, true>(qb, kb, vb, 256 * n, 0, 0, 4 * n + 4, 1, 0, ob, 1024, nullptr, smem);
  } else {
    const int u2 = u - N_DIFF_UNITS, pidx = u2 >> 10, rem = u2 & 1023, b = rem >> 7, h = (rem >> 4) & 7, rn = rem & 15;
    const int sh = 2 * pidx, dil = 1 << sh, nbp = 16 >> sh, res = rn >> (4 - sh), n = 2 * (rn & (nbp - 1));
    const u16* qb = (const u16*)(p.ws + OFF_QA) + (size_t)(b * 8 + h) * 4096 * 64;
    const u16* kb = (const u16*)(p.ws + OFF_KA) + (size_t)(b * 8 + h) * 4096 * 64;
    const u16* vb = (const u16*)(p.ws + OFF_VA) + (size_t)(b * 8 + h) * 4096 * 64;
    u16* ob = (u16*)(p.ws + OFF_OAP) + ((size_t)pidx * T_TOK + (size_t)b * 4096) * 512 + h * 64;
    float* lse = (float*)(p.ws + OFF_LSE) + ((size_t)pidx * T_TOK + (size_t)b * 4096) * 8 + h;
    attn_unit<64, false>(qb, kb, vb, 128 * n, 128 * (n - 1), n == 0 ? 2 : 0, 6, dil, res, ob, 512, lse, smem);
  }
}
__device__ void phase2(const Params& p, char* smem, int slot = 1) {
  int* counter = (int*)(p.ws + OFF_MISC) + slot;
  int* s_unit = (int*)(smem + DYN_LDS - 16);
  while (true) {
    if (threadIdx.x == 0) *s_unit = atomicAdd(counter, 1);
    __syncthreads();
    const int u = *s_unit;
    __syncthreads();
    if (u >= N_DIFF_UNITS + N_DIL_UNITS) break;
    phase2_unit(p, u, smem);
  }
}

__device__ void phase3(const Params& p) {
  const int tid = threadIdx.x, lane = tid & 63, wid = tid >> 6;
  const int gw = blockIdx.x * NWAVE + wid, nw = gridDim.x * NWAVE;
  const float lam = ((const float*)(p.ws + OFF_MISC))[0];
  const u16* oap = (const u16*)(p.ws + OFF_OAP);
  const u16* obc = (const u16*)(p.ws + OFF_OBC);
  const float* lse = (const float*)(p.ws + OFF_LSE);
  u16* mix = (u16*)(p.ws + OFF_XNB);
  for (int tok = gw; tok < T_TOK; tok += nw) {
    float o[16]; float ss = 0.f;
    if (lane < 32) {
      const int head = lane >> 2;
      float l0 = lse[(size_t)tok * 8 + head], l1 = lse[((size_t)T_TOK + tok) * 8 + head], l2 = lse[((size_t)2 * T_TOK + tok) * 8 + head];
      const float mx = fmaxf(l0, fmaxf(l1, l2));
      float w0 = exp2f(l0 - mx), w1 = exp2f(l1 - mx), w2 = exp2f(l2 - mx);
      const float inv = 1.f / (w0 + w1 + w2); w0 *= inv; w1 *= inv; w2 *= inv;
      const uint4* p0 = (const uint4*)(oap + (size_t)tok * 512 + lane * 16);
      const uint4* p1 = (const uint4*)(oap + ((size_t)T_TOK + tok) * 512 + lane * 16);
      const uint4* p2 = (const uint4*)(oap + ((size_t)2 * T_TOK + tok) * 512 + lane * 16);
#pragma unroll
      for (int c = 0; c < 2; ++c) {
        const uint4 a = p0[c], b = p1[c], d = p2[c];
        const unsigned au[4] = {a.x, a.y, a.z, a.w}, bu[4] = {b.x, b.y, b.z, b.w}, du[4] = {d.x, d.y, d.z, d.w};
#pragma unroll
        for (int k = 0; k < 4; ++k) {
          o[c * 8 + 2 * k] = w0 * bflo(au[k]) + w1 * bflo(bu[k]) + w2 * bflo(du[k]);
          o[c * 8 + 2 * k + 1] = w0 * bfhi(au[k]) + w1 * bfhi(bu[k]) + w2 * bfhi(du[k]);
        }
      }
    } else {
      const int l2 = lane - 32, head = l2 >> 3, cc = (l2 & 7) * 16;
      const uint4* p0 = (const uint4*)(obc + (size_t)tok * 1024 + (2 * head) * 128 + cc);
      const uint4* p1 = (const uint4*)(obc + (size_t)tok * 1024 + (2 * head + 1) * 128 + cc);
#pragma unroll
      for (int c = 0; c < 2; ++c) {
        const uint4 a = p0[c], b = p1[c];
        const unsigned au[4] = {a.x, a.y, a.z, a.w}, bu[4] = {b.x, b.y, b.z, b.w};
#pragma unroll
        for (int k = 0; k < 4; ++k) {
          o[c * 8 + 2 * k] = bflo(au[k]) - lam * bflo(bu[k]);
          o[c * 8 + 2 * k + 1] = bfhi(au[k]) - lam * bfhi(bu[k]);
        }
      }
    }
#pragma unroll
    for (int i = 0; i < 16; ++i) ss += o[i] * o[i];
    const float s1 = ss + __shfl_xor(ss, 1);
    const float s2 = s1 + __shfl_xor(s1, 2);
    const float s3 = s2 + __shfl_xor(s2, 4);
    float r; const float* g;
    if (lane < 32) { r = rsqrtf(s2 * (1.f / 64.f) + 1e-6f); g = p.ona + lane * 16; }
    else { r = rsqrtf(s3 * (1.f / 128.f) + 1e-6f) * 0.8f; g = p.onb + (lane - 32) * 16; }
    unsigned pk[8];
#pragma unroll
    for (int k = 0; k < 8; ++k) pk[k] = pack2(o[2 * k] * r * g[2 * k], o[2 * k + 1] * r * g[2 * k + 1]);
    uint4* dst = (uint4*)(mix + (size_t)tok * 1024 + lane * 16);
    dst[0] = make_uint4(pk[0], pk[1], pk[2], pk[3]); dst[1] = make_uint4(pk[4], pk[5], pk[6], pk[7]);
  }
}

__device__ void phase4_tile(const Params& p, int mtile, int j, char* smem) {
  f32x16 acc[2][2];
  const int m0 = mtile * 128, n0 = j * 128;
  gemm_mainloop((const u16*)(p.ws + OFF_XNB), (const u16*)(p.ws + OFF_WOUT), m0, n0, smem, acc);
  float* st = (float*)smem;
  stage_acc(acc, st);
  __syncthreads();
  const int tid = threadIdx.x & 255, cgi = tid & 31, r0 = tid >> 5;
  float* hss = (float*)(p.ws + OFF_HSS);
  u16* hb = (u16*)(p.ws + OFF_OAP);
#pragma unroll 4
  for (int ps = 0; ps < 16; ++ps) {
    const int row = r0 + 8 * ps;
    const float4 a = *(const float4*)(st + row * 132 + cgi * 4);
    const size_t gi = (size_t)(m0 + row) * 1024 + n0 + cgi * 4;
    const float4 xv = *(const float4*)(p.x + gi);
    float4 hv; hv.x = xv.x + a.x; hv.y = xv.y + a.y; hv.z = xv.z + a.z; hv.w = xv.w + a.w;
    *(float4*)(p.out + gi) = hv;
    *(uint2*)(hb + gi) = make_uint2(pack2(hv.x, hv.y), pack2(hv.z, hv.w));
    float ss = hv.x * hv.x + hv.y * hv.y + hv.z * hv.z + hv.w * hv.w;
    ss += __shfl_xor(ss, 16); ss += __shfl_xor(ss, 8); ss += __shfl_xor(ss, 4); ss += __shfl_xor(ss, 2); ss += __shfl_xor(ss, 1);
    if (cgi == 0) atomicAdd(hss + m0 + row, ss);
  }
  __syncthreads();
}


struct EpiInProj {
  static constexpr bool PERM = true, AFTER_DRAIN = false;
  char* ws;
  DI void operator()(const pg8::f32x4 (&acc)[2][2][4][2], const pg8::Unit& u, int wr, int wc, int fr, int fq) const {
    const int sec = u.pn >> 1, cl = (u.pn & 1) * 4 + wc;
    const bool isqk = (sec != 2 && sec != 5);
    float g[16];
    if (isqk) {
      const float* gp = (const float*)(ws + OFF_MISC + 1024) + 64 * (sec < 3 ? sec : sec - 1);
#pragma unroll
      for (int idx = 0; idx < 16; ++idx) {
        const int bj = idx >> 3, n = (idx >> 2) & 1, i = idx & 3;
        const int d = (bj == 0 && fq < 2) ? (4 * fq + 8 * n + i) : (32 * bj + 8 * fq + 4 * n + i);
        g[idx] = gp[d];
      }
    }
    const float post = (sec == 0 || sec == 3) ? QSCALE : 1.f;
    const float* rc = (const float*)(ws + OFF_ROPEC);
    const float* rs = (const float*)(ws + OFF_ROPES);
    const size_t off = OFF_QA + (size_t)sec * (32 * MB);
#pragma unroll
    for (int ai = 0; ai < 2; ++ai)
#pragma unroll
      for (int m = 0; m < 4; ++m) {
        const int row = u.pm * 256 + ai * 128 + wr * 64 + m * 16 + fr, b = row >> 12, sq = row & 4095;
        float v[16];
#pragma unroll
        for (int bj = 0; bj < 2; ++bj)
#pragma unroll
          for (int n = 0; n < 2; ++n)
#pragma unroll
            for (int i = 0; i < 4; ++i) v[bj * 8 + n * 4 + i] = acc[ai][bj][m][n][i];
        if (isqk) {
          float ss = 0.f;
#pragma unroll
          for (int idx = 0; idx < 16; ++idx) ss += v[idx] * v[idx];
          ss += __shfl_xor(ss, 16); ss += __shfl_xor(ss, 32);
          const float r = rsqrtf(ss * (1.f / 64.f) + 1e-6f) * post;
#pragma unroll
          for (int idx = 0; idx < 16; ++idx) v[idx] *= r * g[idx];
          if (fq < 2) {
            const float4 c4 = *(const float4*)(rc + sq * 8 + 4 * fq), s4 = *(const float4*)(rs + sq * 8 + 4 * fq);
            const float cc[4] = {c4.x, c4.y, c4.z, c4.w}, sn[4] = {s4.x, s4.y, s4.z, s4.w};
#pragma unroll
            for (int i = 0; i < 4; ++i) { const float x1 = v[i], x2 = v[4 + i]; v[i] = x1 * cc[i] - x2 * sn[i]; v[4 + i] = x2 * cc[i] + x1 * sn[i]; }
          }
        }
        u16* dst = (sec == 5) ? (u16*)(ws + off) + ((size_t)(b * 4 + (cl >> 1)) * 4096 + sq) * 128 + (cl & 1) * 64
                              : (u16*)(ws + off) + ((size_t)(b * 8 + cl) * 4096 + sq) * 64;
        if (fq < 2) {
          *(uint2*)(dst + 4 * fq) = make_uint2(pack2(v[0], v[1]), pack2(v[2], v[3]));
          *(uint2*)(dst + 8 + 4 * fq) = make_uint2(pack2(v[4], v[5]), pack2(v[6], v[7]));
        } else {
          *(uint4*)(dst + 8 * fq) = make_uint4(pack2(v[0], v[1]), pack2(v[2], v[3]), pack2(v[4], v[5]), pack2(v[6], v[7]));
        }
        *(uint4*)(dst + 32 + 8 * fq) = make_uint4(pack2(v[8], v[9]), pack2(v[10], v[11]), pack2(v[12], v[13]), pack2(v[14], v[15]));
      }
  }
};
__device__ void phase1_big(const Params& p, char* smem) {
  pg8::Gemm g; g.A = (const pg8::bf16_t*)(p.ws + OFF_XNB); g.Bt = (const pg8::bf16_t*)(p.ws + OFF_WIN); g.M = T_TOK; g.N = 3072; g.K = 1024;
  pg8::StaticOrder S; S.init(g.M, g.N, (int)gridDim.x, (int)blockIdx.x);
  EpiInProj E; E.ws = p.ws;
  pg8::gemm_phase<EpiInProj, pg8::StaticOrder, false>((PG8_LAS unsigned char*)smem, g, S, E, nullptr);
}

struct EpiOutProj {
  static constexpr bool PERM = true, AFTER_DRAIN = false;
  const float* x; float* out; u16* hb; float* hss;
  DI void operator()(const pg8::f32x4 (&acc)[2][2][4][2], const pg8::Unit& u, int wr, int wc, int fr, int fq) const {
#pragma unroll
    for (int ai = 0; ai < 2; ++ai)
#pragma unroll
      for (int m = 0; m < 4; ++m) {
        const int row = u.pm * 256 + ai * 128 + wr * 64 + m * 16 + fr;
        float ss = 0.f;
#pragma unroll
        for (int bj = 0; bj < 2; ++bj) {
          const size_t gi = (size_t)row * 1024 + u.pn * 256 + bj * 128 + wc * 32 + 8 * fq;
          const float4 x0 = *(const float4*)(x + gi), x1 = *(const float4*)(x + gi + 4);
          const pg8::f32x4 a0 = acc[ai][bj][m][0], a1 = acc[ai][bj][m][1];
          const float4 h0 = make_float4(x0.x + a0[0], x0.y + a0[1], x0.z + a0[2], x0.w + a0[3]);
          const float4 h1 = make_float4(x1.x + a1[0], x1.y + a1[1], x1.z + a1[2], x1.w + a1[3]);
          *(float4*)(out + gi) = h0; *(float4*)(out + gi + 4) = h1;
          *(uint4*)(hb + gi) = make_uint4(pack2(h0.x, h0.y), pack2(h0.z, h0.w), pack2(h1.x, h1.y), pack2(h1.z, h1.w));
          ss += h0.x * h0.x + h0.y * h0.y + h0.z * h0.z + h0.w * h0.w + h1.x * h1.x + h1.y * h1.y + h1.z * h1.z + h1.w * h1.w;
        }
        ss += __shfl_xor(ss, 16); ss += __shfl_xor(ss, 32);
        if (fq == 0) atomicAdd(hss + row, ss);
      }
  }
};
__device__ void phase4_big(const Params& p, char* smem) {
  pg8::Gemm g; g.A = (const pg8::bf16_t*)(p.ws + OFF_XNB); g.Bt = (const pg8::bf16_t*)(p.ws + OFF_WOUT); g.M = T_TOK; g.N = 1024; g.K = 1024;
  pg8::StaticOrder S; S.init(g.M, g.N, (int)gridDim.x, (int)blockIdx.x);
  EpiOutProj E; E.x = p.x; E.out = p.out; E.hb = (u16*)(p.ws + OFF_OAP); E.hss = (float*)(p.ws + OFF_HSS);
  pg8::gemm_phase<EpiOutProj, pg8::StaticOrder, false>((PG8_LAS unsigned char*)smem, g, S, E, nullptr);
}

#define TK_INSERT(xv, xi) { float x_ = (xv); int i_ = (xi); _Pragma("unroll") for (int q_ = 0; q_ < 16; ++q_) { const bool gt_ = x_ > tv[q_]; const float tvv = tv[q_]; const int tii = ti[q_]; tv[q_] = gt_ ? x_ : tvv; ti[q_] = gt_ ? i_ : tii; x_ = gt_ ? tvv : x_; i_ = gt_ ? tii : i_; } }
__device__ void phase5_tile(const Params& p, int mtile, int j, char* smem) {
  f32x16 acc[2][2];
  const int m0 = mtile * 128, n0 = j * 128;
  gemm_mainloop((const u16*)(p.ws + OFF_OAP), (const u16*)(p.ws + OFF_WPQ), m0, n0, smem, acc);
  const int tid = threadIdx.x & 255, lane = tid & 63, w = tid >> 6, wm = w >> 1, wn = w & 1, lr = lane & 31, lh = lane >> 5;
  u16* Qs = (u16*)smem;
  u16* SKs = Qs + 128 * 136;
  float* rs = (float*)(smem + 2 * 128 * 136 * 2);
  const float* hss = (const float*)(p.ws + OFF_HSS);
  if (tid < 128) rs[tid] = rsqrtf(hss[m0 + tid] * (1.f / 1024.f) + 1e-6f);
  {
    const u16* sk = (const u16*)(p.ws + OFF_SUBK) + (size_t)j * 128 * 128;
#pragma unroll
    for (int i = 0; i < 8; ++i) { const int c = tid + 256 * i, row = c >> 4, kc = c & 15; *(uint4*)(SKs + row * 136 + kc * 8) = *(const uint4*)(sk + row * 128 + kc * 8); }
  }
  __syncthreads();
#pragma unroll
  for (int mt = 0; mt < 2; ++mt)
#pragma unroll
    for (int nt = 0; nt < 2; ++nt)
#pragma unroll
      for (int r = 0; r < 16; ++r) {
        const int row = wm * 64 + mt * 32 + crow(r, lh);
        Qs[row * 136 + wn * 64 + nt * 32 + lr] = f2bf(acc[mt][nt][r] * rs[row]);
      }
  __syncthreads();
#pragma unroll
  for (int a = 0; a < 2; ++a)
#pragma unroll
    for (int b = 0; b < 2; ++b)
#pragma unroll
      for (int r = 0; r < 16; ++r) acc[a][b][r] = 0.f;
  {
    const u16* ab = Qs + (wm * 64 + lr) * 136 + lh * 8;
    const u16* bb = SKs + (wn * 64 + lr) * 136 + lh * 8;
#pragma unroll
    for (int s = 0; s < 8; ++s) {
      const bf16x8 a0 = *(const bf16x8*)(ab + s * 16), a1 = *(const bf16x8*)(ab + 32 * 136 + s * 16);
      const bf16x8 b0 = *(const bf16x8*)(bb + s * 16), b1 = *(const bf16x8*)(bb + 32 * 136 + s * 16);
      acc[0][0] = MFMA(a0, b0, acc[0][0]); acc[0][1] = MFMA(a0, b1, acc[0][1]);
      acc[1][0] = MFMA(a1, b0, acc[1][0]); acc[1][1] = MFMA(a1, b1, acc[1][1]);
    }
  }
  __syncthreads();
  float* st = (float*)smem;
  stage_acc(acc, st);
  __syncthreads();
  const int row = tid & 127, half = tid >> 7;
  unsigned tk[16];
#pragma unroll
  for (int q = 0; q < 16; ++q) tk[q] = 0u;
#define TK_KEY(xv, xi) ({ const unsigned u_ = __float_as_uint(xv); const unsigned o_ = (u_ & 0x80000000u) ? ~u_ : (u_ | 0x80000000u); (o_ & 0xFFFFFF80u) | (unsigned)(127 - (xi)); })
#define TK_INS(kv) { unsigned k_ = (kv); _Pragma("unroll") for (int q_ = 0; q_ < 16; ++q_) { const unsigned hi_ = k_ > tk[q_] ? k_ : tk[q_]; k_ = k_ > tk[q_] ? tk[q_] : k_; tk[q_] = hi_; } }
#pragma unroll 2
  for (int c = 0; c < 16; ++c) {
    const float4 v4 = *(const float4*)(st + row * 132 + half * 64 + c * 4);
    const int bi = half * 64 + c * 4;
    TK_INS(TK_KEY(v4.x, bi)); TK_INS(TK_KEY(v4.y, bi + 1)); TK_INS(TK_KEY(v4.z, bi + 2)); TK_INS(TK_KEY(v4.w, bi + 3));
  }
  __syncthreads();
  if (half == 1) {
#pragma unroll
    for (int q = 0; q < 16; ++q) st[row * 132 + q] = __uint_as_float(tk[q]);
  }
  __syncthreads();
  if (half == 0) {
#pragma unroll 4
    for (int q = 0; q < 16; ++q) TK_INS(__float_as_uint(st[row * 132 + q]));
    const size_t base = ((size_t)(m0 + row) * 16 + j) * 16;
    float* tops = (float*)(p.ws + OFF_TOPS) + base;
    u8* topi = (u8*)(p.ws + OFF_TOPI) + base;
    float tv[16]; unsigned ti[16];
#pragma unroll
    for (int q = 0; q < 16; ++q) {
      const unsigned o = tk[q] & 0xFFFFFF80u;
      tv[q] = __uint_as_float((o & 0x80000000u) ? (o & 0x7FFFFFFFu) : ~o);
      ti[q] = 127u - (tk[q] & 127u);
    }
#pragma unroll
    for (int c = 0; c < 4; ++c) ((float4*)tops)[c] = make_float4(tv[4 * c], tv[4 * c + 1], tv[4 * c + 2], tv[4 * c + 3]);
    unsigned pk[4];
#pragma unroll
    for (int c = 0; c < 4; ++c) pk[c] = ti[4 * c] | (ti[4 * c + 1] << 8) | (ti[4 * c + 2] << 16) | (ti[4 * c + 3] << 24);
    *(uint4*)topi = make_uint4(pk[0], pk[1], pk[2], pk[3]);
  }
  __syncthreads();
#undef TK_KEY
#undef TK_INS
}


DI void sort16_desc(unsigned (&t)[16]) {
#pragma unroll
  for (int k = 2; k <= 16; k <<= 1)
#pragma unroll
    for (int j = k >> 1; j > 0; j >>= 1)
#pragma unroll
      for (int i = 0; i < 16; ++i) {
        const int l = i ^ j;
        if (l > i) { const bool desc = (i & k) == 0; const unsigned a = t[i], b = t[l]; const unsigned mx = a > b ? a : b, mn = a > b ? b : a; t[i] = desc ? mx : mn; t[l] = desc ? mn : mx; }
      }
}
DI void merge16_desc(unsigned (&a)[16], const unsigned (&b)[16]) {
#pragma unroll
  for (int i = 0; i < 16; ++i) { const unsigned x = a[i], y = b[15 - i]; a[i] = x > y ? x : y; }
#pragma unroll
  for (int j = 8; j > 0; j >>= 1)
#pragma unroll
    for (int i = 0; i < 16; ++i) { const int l = i ^ j; if (l > i) { const unsigned p = a[i], q = a[l]; a[i] = p > q ? p : q; a[l] = p > q ? q : p; } }
}
constexpr size_t OFF_QBUF = 128 * MB;
struct EpiPeerQ {
  static constexpr bool PERM = true, AFTER_DRAIN = false;
  const float* hss; u16* q;
  DI void operator()(const pg8::f32x4 (&acc)[2][2][4][2], const pg8::Unit& u, int wr, int wc, int fr, int fq) const {
#pragma unroll
    for (int ai = 0; ai < 2; ++ai)
#pragma unroll
      for (int m = 0; m < 4; ++m) {
        const int row = u.pm * 256 + ai * 128 + wr * 64 + m * 16 + fr;
        const float r = rsqrtf(hss[row] * (1.f / 1024.f) + 1e-6f);
#pragma unroll
        for (int bj = 0; bj < 2; ++bj) {
          const pg8::f32x4 a0 = acc[ai][bj][m][0], a1 = acc[ai][bj][m][1];
          *(uint4*)(q + (size_t)row * 2048 + u.pn * 256 + bj * 128 + wc * 32 + 8 * fq) =
              make_uint4(pack2(a0[0] * r, a0[1] * r), pack2(a0[2] * r, a0[3] * r), pack2(a1[0] * r, a1[1] * r), pack2(a1[2] * r, a1[3] * r));
        }
      }
  }
};
__device__ void peer_score_tile(const Params& p, int pm, int head, int cc, char* smem) {
  const int tid = opaque_tid(), lane = tid & 63, w = tid >> 6, wm = w >> 1, wn = w & 1, lr = lane & 31, lh = lane >> 5;
  u16* Qs = (u16*)smem;
  u16* SKs = Qs + 256 * 136;
  {
    const u16* qg = (const u16*)(p.ws + OFF_QBUF) + (size_t)(pm * 256) * 2048 + head * 256 + cc * 128;
#pragma unroll
    for (int i = 0; i < 8; ++i) { const int c = tid + 512 * i, row = c >> 4, kc = c & 15; *(uint4*)(Qs + row * 136 + kc * 8) = *(const uint4*)(qg + (size_t)row * 2048 + kc * 8); }
    const u16* sk = (const u16*)(p.ws + OFF_SUBK) + (size_t)(head * 2 + cc) * 128 * 128;
#pragma unroll
    for (int i = 0; i < 4; ++i) { const int c = tid + 512 * i, row = c >> 4, kc = c & 15; *(uint4*)(SKs + row * 136 + kc * 8) = *(const uint4*)(sk + row * 128 + kc * 8); }
  }
  __syncthreads();
  f32x16 acc[2][2];
#pragma unroll
  for (int a = 0; a < 2; ++a)
#pragma unroll
    for (int b = 0; b < 2; ++b)
#pragma unroll
      for (int r = 0; r < 16; ++r) acc[a][b][r] = 0.f;
  {
    const u16* ab = Qs + (wm * 64 + lr) * 136 + lh * 8;
    const u16* bb = SKs + (wn * 64 + lr) * 136 + lh * 8;
#pragma unroll
    for (int s = 0; s < 8; ++s) {
      const bf16x8 a0 = *(const bf16x8*)(ab + s * 16), a1 = *(const bf16x8*)(ab + 32 * 136 + s * 16);
      const bf16x8 b0 = *(const bf16x8*)(bb + s * 16), b1 = *(const bf16x8*)(bb + 32 * 136 + s * 16);
      acc[0][0] = MFMA(a0, b0, acc[0][0]); acc[0][1] = MFMA(a0, b1, acc[0][1]);
      acc[1][0] = MFMA(a1, b0, acc[1][0]); acc[1][1] = MFMA(a1, b1, acc[1][1]);
    }
  }
  __syncthreads();
  float* st = (float*)smem;
#pragma unroll
  for (int mt = 0; mt < 2; ++mt)
#pragma unroll
    for (int nt = 0; nt < 2; ++nt)
#pragma unroll
      for (int r = 0; r < 16; ++r) st[(wm * 64 + mt * 32 + crow(r, lh)) * 132 + wn * 64 + nt * 32 + lr] = acc[mt][nt][r];
  __syncthreads();
  const int row = tid & 255, half = tid >> 8;
#define TK_KEY(xv, xi) ({ const unsigned u_ = __float_as_uint(xv); const unsigned o_ = (u_ & 0x80000000u) ? ~u_ : (u_ | 0x80000000u); (o_ & 0xFFFFFF80u) | (unsigned)(127 - (xi)); })
#define TK_LOAD16(T_, g_) { _Pragma("unroll") for (int c_ = 0; c_ < 4; ++c_) { const float4 v4_ = *(const float4*)(st + row * 132 + half * 64 + (g_) * 16 + c_ * 4); const int bi_ = half * 64 + (g_) * 16 + c_ * 4; \
    T_[4 * c_] = TK_KEY(v4_.x, bi_); T_[4 * c_ + 1] = TK_KEY(v4_.y, bi_ + 1); T_[4 * c_ + 2] = TK_KEY(v4_.z, bi_ + 2); T_[4 * c_ + 3] = TK_KEY(v4_.w, bi_ + 3); } }
  unsigned tk[16], tb[16], tc[16];
  TK_LOAD16(tk, 0); sort16_desc(tk);
  TK_LOAD16(tb, 1); sort16_desc(tb);
  merge16_desc(tk, tb);
  TK_LOAD16(tb, 2); sort16_desc(tb);
  TK_LOAD16(tc, 3); sort16_desc(tc);
  merge16_desc(tb, tc);
  merge16_desc(tk, tb);
  __syncthreads();
  if (half == 1) {
#pragma unroll
    for (int q = 0; q < 16; ++q) st[row * 132 + q] = __uint_as_float(tk[q]);
  }
  __syncthreads();
  if (half == 0) {
#pragma unroll
    for (int q = 0; q < 16; ++q) tb[q] = __float_as_uint(st[row * 132 + q]);
    merge16_desc(tk, tb);
    const size_t base = ((size_t)(pm * 256 + row) * 16 + head * 2 + cc) * 16;
    float* tops = (float*)(p.ws + OFF_TOPS) + base;
    u8* topi = (u8*)(p.ws + OFF_TOPI) + base;
    float tv[16]; unsigned ti[16];
#pragma unroll
    for (int q = 0; q < 16; ++q) {
      const unsigned o = tk[q] & 0xFFFFFF80u;
      tv[q] = __uint_as_float((o & 0x80000000u) ? (o & 0x7FFFFFFFu) : ~o);
      ti[q] = 127u - (tk[q] & 127u);
    }
#pragma unroll
    for (int c = 0; c < 4; ++c) ((float4*)tops)[c] = make_float4(tv[4 * c], tv[4 * c + 1], tv[4 * c + 2], tv[4 * c + 3]);
    unsigned pk[4];
#pragma unroll
    for (int c = 0; c < 4; ++c) pk[c] = ti[4 * c] | (ti[4 * c + 1] << 8) | (ti[4 * c + 2] << 16) | (ti[4 * c + 3] << 24);
    *(uint4*)topi = make_uint4(pk[0], pk[1], pk[2], pk[3]);
  }
  __syncthreads();
#undef TK_KEY
#undef TK_LOAD16
}
__device__ void phase5_big(const Params& p, char* smem) {
  pg8::Gemm g; g.A = (const pg8::bf16_t*)(p.ws + OFF_OAP); g.Bt = (const pg8::bf16_t*)(p.ws + OFF_WPQ); g.M = T_TOK; g.N = 2048; g.K = 1024;
  pg8::StaticOrder S; S.init(g.M, g.N, (int)gridDim.x, (int)blockIdx.x);
  EpiPeerQ E; E.hss = (const float*)(p.ws + OFF_HSS); E.q = (u16*)(p.ws + OFF_QBUF);
  pg8::gemm_phase<EpiPeerQ, pg8::StaticOrder, false>((PG8_LAS unsigned char*)smem, g, S, E, nullptr);
  __syncthreads();
  pg8::Unit u;
  for (int i = 0; S.next(i, u); ++i) {
    peer_score_tile(p, u.pm, u.pn, 0, smem);
    peer_score_tile(p, u.pm, u.pn, 1, smem);
  }
}

DI float dpp_xor1(float v) { return __builtin_bit_cast(float, __builtin_amdgcn_update_dpp(0, __builtin_bit_cast(int, v), 0xB1, 0xF, 0xF, true)); }
DI float dpp_xor2(float v) { return __builtin_bit_cast(float, __builtin_amdgcn_update_dpp(0, __builtin_bit_cast(int, v), 0x4E, 0xF, 0xF, true)); }
template <int PAT> DI float swz(float v) { return __builtin_bit_cast(float, __builtin_amdgcn_ds_swizzle(__builtin_bit_cast(int, v), PAT)); }
DI float treduce8(const float (&pp)[8], int lane) {
  const bool b0 = lane & 1, b1 = lane & 2, b2 = lane & 4;
  float q[4];
#pragma unroll
  for (int i = 0; i < 4; ++i) { const float keep = b0 ? pp[2 * i + 1] : pp[2 * i], send = b0 ? pp[2 * i] : pp[2 * i + 1]; q[i] = keep + dpp_xor1(send); }
  float r[2];
#pragma unroll
  for (int i = 0; i < 2; ++i) { const float keep = b1 ? q[2 * i + 1] : q[2 * i], send = b1 ? q[2 * i] : q[2 * i + 1]; r[i] = keep + dpp_xor2(send); }
  float t = (b2 ? r[1] : r[0]) + swz<0x101F>(b2 ? r[0] : r[1]);
  t += swz<0x201F>(t); t += swz<0x401F>(t); t += __shfl_xor(t, 32);
  return t;
}
DI float udot16(const uint4& w, const float (&h)[16]) {
  f32x2 acc = {0.f, 0.f};
  const int ww[4] = {(int)w.x, (int)w.y, (int)w.z, (int)w.w};
#pragma unroll
  for (int j = 0; j < 4; ++j) {
    const f32x2 lo = __builtin_amdgcn_cvt_pk_f32_fp8(ww[j], false), hi = __builtin_amdgcn_cvt_pk_f32_fp8(ww[j], true);
    const f32x2 h0 = {h[4 * j], h[4 * j + 1]}, h1 = {h[4 * j + 2], h[4 * j + 3]};
    acc += lo * h0; acc += hi * h1;
  }
  return acc.x + acc.y;
}
DI void vacc16(const uint4& w, float a, f32x2 (&acc)[8]) {
  const f32x2 a2 = {a, a};
  const int ww[4] = {(int)w.x, (int)w.y, (int)w.z, (int)w.w};
#pragma unroll
  for (int j = 0; j < 4; ++j) {
    acc[2 * j] += a2 * __builtin_amdgcn_cvt_pk_f32_fp8(ww[j], false);
    acc[2 * j + 1] += a2 * __builtin_amdgcn_cvt_pk_f32_fp8(ww[j], true);
  }
}
#define LOAD8(buf, tbl, bidx) { const uint4 i0_ = *(const uint4*)(ids + 8 * (bidx)), i1_ = *(const uint4*)(ids + 8 * (bidx) + 4); \
    const unsigned idv_[8] = {i0_.x, i0_.y, i0_.z, i0_.w, i1_.x, i1_.y, i1_.z, i1_.w}; \
    _Pragma("unroll") for (int k_ = 0; k_ < 8; ++k_) { const unsigned id_ = __builtin_amdgcn_readfirstlane(idv_[k_]); buf[k_] = *(const uint4*)((tbl) + (size_t)id_ * 1024 + lane * 16); } }

__device__ void phase6(const Params& p, char* smem, float* dstbase) {
  const int tid = opaque_tid(), lane = tid & 63, wid = tid >> 6;
  const int gw = blockIdx.x * NWAVE + wid, nw = gridDim.x * NWAVE;
  int* ids = (int*)(smem + wid * 1024);
  float* gts = (float*)(smem + wid * 1024 + 512);
  const float* hss = (const float*)(p.ws + OFF_HSS);
  const float* tops = (const float*)(p.ws + OFF_TOPS);
  const u8* topi = (const u8*)(p.ws + OFF_TOPI);
  const u8* ub = (const u8*)(p.ws + OFF_PUB);
  const u8* vb = (const u8*)(p.ws + OFF_PVB);
  int ci, cj;
  {
    const int L = lane;
    if (L < 16) { ci = 0; cj = L; } else if (L < 24) { ci = 1; cj = L - 16; } else if (L < 29) { ci = 2; cj = L - 24; }
    else if (L < 33) { ci = 3; cj = L - 29; } else if (L < 36) { ci = 4; cj = L - 33; } else if (L < 38) { ci = 5; cj = L - 36; }
    else if (L < 40) { ci = 6; cj = L - 38; } else if (L < 42) { ci = 7; cj = L - 40; } else if (L < 50) { ci = L - 34; cj = 0; }
    else { ci = 0; cj = 0; }
  }
  for (int tok = gw; tok < T_TOK; tok += nw) {
    const float rstd = rsqrtf(hss[tok] * (1.f / 1024.f) + 1e-6f);
    float hres[16], hn[16];
    {
      const float4* hp = (const float4*)(p.out + (size_t)tok * 1024 + lane * 16);
      const float4* gp = (const float4*)(p.g_ffn + lane * 16);
#pragma unroll
      for (int c = 0; c < 4; ++c) {
        const float4 t4 = hp[c], g4 = gp[c];
        hres[4 * c] = t4.x; hres[4 * c + 1] = t4.y; hres[4 * c + 2] = t4.z; hres[4 * c + 3] = t4.w;
        hn[4 * c] = t4.x * rstd * g4.x; hn[4 * c + 1] = t4.y * rstd * g4.y; hn[4 * c + 2] = t4.z * rstd * g4.z; hn[4 * c + 3] = t4.w * rstd * g4.w;
      }
    }
    float sums[8]; int eids[8];
#pragma unroll
    for (int head = 0; head < 8; ++head) {
      const size_t b1 = ((size_t)tok * 16 + head * 2) * 16, b2 = b1 + 16;
      sums[head] = NEG_INF; eids[head] = 0;
      if (lane < 50) { sums[head] = tops[b1 + ci] + tops[b2 + cj]; eids[head] = (int)topi[b1 + ci] * 128 + (int)topi[b2 + cj]; }
    }
#pragma unroll
    for (int head = 0; head < 8; ++head) {
      const float sum = sums[head]; const int eid = eids[head];
      unsigned key;
      {
        const unsigned u_ = __float_as_uint(sum); const unsigned o_ = (u_ & 0x80000000u) ? ~u_ : (u_ | 0x80000000u);
        key = (o_ & 0xFFFFFFC0u) | (unsigned)(63 - lane);
      }
#define BSTEP(K_, J_, SHF_) { const unsigned pr_ = (SHF_); const bool tmx_ = ((lane & (J_)) == 0) == ((lane & (K_)) == 0); \
        const unsigned mx_ = key > pr_ ? key : pr_, mn_ = key > pr_ ? pr_ : key; key = tmx_ ? mx_ : mn_; }
#define SX1 ((unsigned)__builtin_amdgcn_update_dpp(0, (int)key, 0xB1, 0xF, 0xF, true))
#define SX2 ((unsigned)__builtin_amdgcn_update_dpp(0, (int)key, 0x4E, 0xF, 0xF, true))
#define SX4 ((unsigned)__builtin_amdgcn_ds_swizzle((int)key, 0x101F))
#define SX8 ((unsigned)__builtin_amdgcn_ds_swizzle((int)key, 0x201F))
#define SX16 ((unsigned)__builtin_amdgcn_ds_swizzle((int)key, 0x401F))
#define SX32 ((unsigned)__shfl_xor((int)key, 32))
      BSTEP(2, 1, SX1);
      BSTEP(4, 2, SX2); BSTEP(4, 1, SX1);
      BSTEP(8, 4, SX4); BSTEP(8, 2, SX2); BSTEP(8, 1, SX1);
      BSTEP(16, 8, SX8); BSTEP(16, 4, SX4); BSTEP(16, 2, SX2); BSTEP(16, 1, SX1);
      BSTEP(32, 16, SX16); BSTEP(32, 8, SX8); BSTEP(32, 4, SX4); BSTEP(32, 2, SX2); BSTEP(32, 1, SX1);
      BSTEP(64, 32, SX32); BSTEP(64, 16, SX16); BSTEP(64, 8, SX8); BSTEP(64, 4, SX4); BSTEP(64, 2, SX2); BSTEP(64, 1, SX1);
#undef BSTEP
#undef SX1
#undef SX2
#undef SX4
#undef SX8
#undef SX16
#undef SX32
      const int src = 63 - (int)(key & 63u);
      const float sumv = __shfl(sum, src);
      const int eidv = __shfl(eid, src);
      const float mxa = __builtin_bit_cast(float, __builtin_amdgcn_readlane(__builtin_bit_cast(int, sumv), 0));
      const float e = (lane < 16) ? __expf(sumv - mxa) : 0.f;
      float den = e;
      den += dpp_xor1(den); den += dpp_xor2(den); den += swz<0x101F>(den); den += swz<0x201F>(den);
      if (lane < 16) { ids[head * 16 + lane] = eidv; gts[head * 16 + lane] = e / den; }
    }
    __builtin_amdgcn_wave_barrier();
    asm volatile("s_waitcnt lgkmcnt(0)" ::: "memory");
    float dsel0 = 0.f, dsel1 = 0.f;
    {
      uint4 ba[8], bb[8];
      LOAD8(ba, ub, 0);
#pragma unroll 1
      for (int b = 0; b < 16; b += 2) {
        LOAD8(bb, ub, b + 1);
        {
          float pp[8];
#pragma unroll
          for (int k = 0; k < 8; ++k) pp[k] = udot16(ba[k], hn);
          const float t = treduce8(pp, lane);
          if ((lane >> 3) == (b & 7)) { if (b < 8) dsel0 = t; else dsel1 = t; }
        }
        if (b + 2 < 16) LOAD8(ba, ub, b + 2);
        {
          float pp[8];
#pragma unroll
          for (int k = 0; k < 8; ++k) pp[k] = udot16(bb[k], hn);
          const float t = treduce8(pp, lane);
          if ((lane >> 3) == ((b + 1) & 7)) { if (b < 8) dsel0 = t; else dsel1 = t; }
        }
      }
    }
    {
      const float d0 = dsel0 * (1.f / USCALE), d1 = dsel1 * (1.f / USCALE);
      const float a0 = 0.5f * d0 * (1.f + erff(d0 * 0.70710678118654752f)) * gts[lane] * (1.f / VSCALE);
      const float a1 = 0.5f * d1 * (1.f + erff(d1 * 0.70710678118654752f)) * gts[64 + lane] * (1.f / VSCALE);
      gts[lane] = a0; gts[64 + lane] = a1;
    }
    __builtin_amdgcn_wave_barrier();
    asm volatile("s_waitcnt lgkmcnt(0)" ::: "memory");
    f32x2 acc[8];
#pragma unroll
    for (int i = 0; i < 8; ++i) acc[i] = (f32x2){0.f, 0.f};
    {
      uint4 ba[8], bb[8];
      LOAD8(ba, vb, 0);
#pragma unroll 1
      for (int b = 0; b < 16; b += 2) {
        LOAD8(bb, vb, b + 1);
        {
          const float4 g0 = *(const float4*)(gts + 8 * b), g1 = *(const float4*)(gts + 8 * b + 4);
          vacc16(ba[0], g0.x, acc); vacc16(ba[1], g0.y, acc); vacc16(ba[2], g0.z, acc); vacc16(ba[3], g0.w, acc);
          vacc16(ba[4], g1.x, acc); vacc16(ba[5], g1.y, acc); vacc16(ba[6], g1.z, acc); vacc16(ba[7], g1.w, acc);
        }
        if (b + 2 < 16) LOAD8(ba, vb, b + 2);
        {
          const float4 g0 = *(const float4*)(gts + 8 * b + 8), g1 = *(const float4*)(gts + 8 * b + 12);
          vacc16(bb[0], g0.x, acc); vacc16(bb[1], g0.y, acc); vacc16(bb[2], g0.z, acc); vacc16(bb[3], g0.w, acc);
          vacc16(bb[4], g1.x, acc); vacc16(bb[5], g1.y, acc); vacc16(bb[6], g1.z, acc); vacc16(bb[7], g1.w, acc);
        }
      }
    }
    float4* op = (float4*)(dstbase + (size_t)tok * 1024 + lane * 16);
#pragma unroll
    for (int c = 0; c < 4; ++c) op[c] = make_float4(hres[4 * c] + acc[2 * c].x, hres[4 * c + 1] + acc[2 * c].y, hres[4 * c + 2] + acc[2 * c + 1].x, hres[4 * c + 3] + acc[2 * c + 1].y);
    __builtin_amdgcn_wave_barrier();
  }
}


#define XB_TMO      128
#define XB_XCNT(j)  (256  + 64 * (j))
#define XB_XSUB(j)  (1280 + 64 * (j))
#define XB_XGEN(j)  (2304 + 64 * (j))
#define XB_TOP      3328
#define XB_TOPGEN   3392
#define XB_SPIN_CAP (1u << 22)
#define LAS __attribute__((address_space(3)))
DI unsigned xb_ld(unsigned* p) { return __hip_atomic_load(p, __ATOMIC_RELAXED, __HIP_MEMORY_SCOPE_AGENT); }
DI unsigned xb_add(unsigned* p, unsigned v) { return __hip_atomic_fetch_add(p, v, __ATOMIC_RELAXED, __HIP_MEMORY_SCOPE_AGENT); }
DI unsigned xb_xcc_id() { return (unsigned)__builtin_amdgcn_s_getreg((3 << 11) | 20) & 0xFu; }
#define XB_SPIN(cond, bar) do { unsigned _sp = 0; while (cond) { __builtin_amdgcn_s_sleep(1); \
    if ((++_sp & 255u) == 0u) { if (xb_ld(&(bar)[XB_TMO])) break; if (_sp > XB_SPIN_CAP) { atomicAdd(&(bar)[XB_TMO], 1u); break; } } } } while (0)
struct XcdBarrier { unsigned* bar; unsigned x; volatile LAS unsigned* st; };
DI XcdBarrier xcd_barrier_post(unsigned* bar, volatile LAS unsigned* st) {
  XcdBarrier b; b.bar = bar; b.x = xb_xcc_id(); b.st = st;
  if (threadIdx.x == 0) (void)xb_add(&bar[XB_XCNT(b.x)], 1u);
  return b;
}
DI void xcd_barrier_complete(unsigned* bar, unsigned x, unsigned& nloc, unsigned& nx) {
  const unsigned G = gridDim.x * gridDim.y * gridDim.z;
  unsigned sum, cnt, mine, sp = 0u;
  for (;;) {
    sum = 0u; cnt = 0u; mine = 0u;
#pragma unroll
    for (unsigned j = 0; j < 16; ++j) { const unsigned c = xb_ld(&bar[XB_XCNT(j)]); sum += c; cnt += (c > 0u) ? 1u : 0u; mine = (j == x) ? c : mine; }
    if (sum == G) break;
    __builtin_amdgcn_s_sleep(1);
    if ((++sp & 255u) == 0u) { if (xb_ld(&bar[XB_TMO])) break; if (sp > XB_SPIN_CAP) { atomicAdd(&bar[XB_TMO], 1u); break; } }
  }
  nloc = mine > 0u ? mine : 1u; nx = cnt > 0u ? cnt : 1u;
}
DI void xcd_barrier(const XcdBarrier& b) {
  asm volatile("s_waitcnt vmcnt(0)" ::: "memory");
  __syncthreads();
  if (threadIdx.x == 0) {
    unsigned* bar = b.bar;
    __builtin_amdgcn_s_waitcnt(0);
    unsigned nloc = b.st[0], nx = b.st[1];
    if (nloc == 0u) { xcd_barrier_complete(bar, b.x, nloc, nx); b.st[0] = nloc; b.st[1] = nx; }
    const unsigned old = xb_add(&bar[XB_XSUB(b.x)], 1u);
    const unsigned gen = old / nloc;
    if (old + 1u == (gen + 1u) * nloc) {
      __builtin_amdgcn_fence(__ATOMIC_RELEASE, "agent");
      asm volatile("s_waitcnt vmcnt(0)" ::: "memory");
      const unsigned og = xb_add(&bar[XB_TOP], 1u);
      const unsigned tg = og / nx;
      if (og + 1u == (tg + 1u) * nx) xb_add(&bar[XB_TOPGEN], 1u);
      else XB_SPIN(xb_ld(&bar[XB_TOPGEN]) == tg, bar);
      __builtin_amdgcn_fence(__ATOMIC_ACQUIRE, "agent");
      xb_add(&bar[XB_XGEN(b.x)], 1u);
      asm volatile("s_waitcnt vmcnt(0)" ::: "memory");
    } else {
      XB_SPIN(xb_ld(&bar[XB_XGEN(b.x)]) == gen, bar);
      __builtin_amdgcn_fence(__ATOMIC_ACQUIRE, "agent");
      asm volatile("s_waitcnt vmcnt(0)" ::: "memory");
    }
  }
  __syncthreads();
}

__global__ void __launch_bounds__(512, 2) fwd_megakernel(Params p) {
  extern __shared__ __attribute__((aligned(16))) char smem[];
  cg::grid_group grid = cg::this_grid();
  volatile LAS unsigned* xb_words = (volatile LAS unsigned*)(smem + DYN_LDS - 64);
  if (threadIdx.x == 0) { xb_words[0] = 0u; xb_words[1] = 0u; }
  const int half = threadIdx.x >> 8;
  char* hsm = smem + half * SMEM_BYTES;
  phase0(p, smem);
  grid.sync();
  const XcdBarrier xb = xcd_barrier_post((unsigned*)(p.ws + OFF_BAR), xb_words);
  phase1_big(p, smem);
  xcd_barrier(xb);
#if PROBE_DUP == 1
  for (int t = blockIdx.x * 2 + half; t < 256 * 24; t += gridDim.x * 2) phase1_tile(p, t / 24, t % 24, hsm);
  xcd_barrier(xb);
#endif
#if PROBE_DUP == 2
  phase2(p, smem, 2);
  xcd_barrier(xb);
#endif
  phase2(p, smem);
  xcd_barrier(xb);
  phase3(p);
  xcd_barrier(xb);
  phase4_big(p, smem);
  xcd_barrier(xb);
  phase5_big(p, smem);
  xcd_barrier(xb);
#if PROBE_DUP == 5
  for (int t = blockIdx.x * 2 + half; t < 256 * 16; t += gridDim.x * 2) phase5_tile(p, t >> 4, t & 15, hsm);
  xcd_barrier(xb);
#endif
#if PROBE_DUP == 6
  phase6(p, smem, (float*)(p.ws + OFF_OAP));
  xcd_barrier(xb);
#endif
  phase6(p, smem, p.out);
}

extern "C" void kernel_launch(void* const* d_in, const int* in_sizes, int n_in, void* d_out, int out_size, void* d_ws, size_t ws_size,
                              hipStream_t stream) {
  Params p{};
  p.x = (const float*)d_in[0]; p.g_attn = (const float*)d_in[1]; p.w_in = (const float*)d_in[2]; p.qna = (const float*)d_in[3];
  p.kna = (const float*)d_in[4]; p.ona = (const float*)d_in[5]; p.qnb = (const float*)d_in[6]; p.knb = (const float*)d_in[7];
  p.lq1 = (const float*)d_in[8]; p.lk1 = (const float*)d_in[9]; p.lq2 = (const float*)d_in[10]; p.lk2 = (const float*)d_in[11];
  p.onb = (const float*)d_in[12]; p.w_out = (const float*)d_in[13]; p.g_ffn = (const float*)d_in[14]; p.w_pq = (const float*)d_in[15];
  p.subk = (const float*)d_in[16]; p.pu = (const float*)d_in[17]; p.pv = (const float*)d_in[18];
  p.out = (float*)d_out; p.ws = (char*)d_ws;
  static int grid_blocks = 0;
  if (!grid_blocks) {
    int dev = 0, cus = 0, per_cu = 0;
    hipGetDevice(&dev);
    hipDeviceGetAttribute(&cus, hipDeviceAttributeMultiprocessorCount, dev);
    hipFuncSetAttribute((const void*)fwd_megakernel, hipFuncAttributeMaxDynamicSharedMemorySize, DYN_LDS);
    hipOccupancyMaxActiveBlocksPerMultiprocessor(&per_cu, fwd_megakernel, NTHR, DYN_LDS);
    if (per_cu > 1) per_cu = 1;
    if (per_cu < 1) per_cu = 1;
    grid_blocks = cus * per_cu;
  }
  void* args[] = {&p};
  hipError_t e = hipLaunchCooperativeKernel((void*)fwd_megakernel, dim3(grid_blocks), dim3(NTHR), args, DYN_LDS, stream);
  if (e != hipSuccess) fprintf(stderr, "cooperative launch failed: %s (grid %d)\n", hipGetErrorString(e), grid_blocks);
}
```
